# Optimizing an MI355X kernel written in HIP

```python
import math, functools
import jax, jax.numpy as jnp
from jax import lax
import numpy as np

D_MODEL = 2048
BATCH = 4
SEQ = 2048
DEPTH = 2

GRID_W = 64
CTX_LEN = 256
N_MOD = 9
D_FF = 5632
CONV_W = 4
EPS = 1e-6
D_MIX = D_MODEL

SSD_WIDTH = D_MIX // 4
SSD_HEADDIM = 64
SSD_HEADS = SSD_WIDTH // SSD_HEADDIM
SSD_GROUPS = 2
SSD_STATE = 64
SSD_CHUNK = 128
SSD_XBC = SSD_WIDTH + 2 * SSD_GROUPS * SSD_STATE
LRU_WIDTH = D_MIX // 4
LRU_BLOCKS = 8
LRU_BLOCK_DIM = LRU_WIDTH // LRU_BLOCKS
LRU_C = 8.0
HGRN_WIDTH = D_MIX // 4
HGRN_HEADDIM = 128
HGRN_HEADS = HGRN_WIDTH // HGRN_HEADDIM
HGRN_CHUNK = 16
RET_WIDTH = D_MIX // 4
RET_V_DIM = 128
RET_HEADS = RET_WIDTH // RET_V_DIM
RET_QK_DIM = RET_V_DIM // 2
RET_CHUNK = 128
ROPE_BASE = 10000.0

SSD_COLS = SSD_WIDTH + SSD_XBC + 2 * SSD_HEADS
LRU_COLS = 2 * LRU_WIDTH
HGRN_COLS = 5 * HGRN_WIDTH
RET_COLS = 2 * RET_HEADS * RET_QK_DIM + 2 * RET_WIDTH
IN_COLS = SSD_COLS + LRU_COLS + HGRN_COLS + RET_COLS

F32 = jnp.float32

kernel_name = 'hybrid_parallel_ssd_rglru_hgrn2_retention_dit'


def rmsnorm(x, g=None):
    xf = x.astype(F32)
    y = xf * lax.rsqrt(jnp.mean(xf * xf, axis=-1, keepdims=True) + EPS)
    if g is not None:
        y = y * g.astype(F32)
    return y.astype(x.dtype)


def dwconv(x, w, b):
    y = lax.conv_general_dilated(
        x, w.astype(x.dtype)[:, None, :], window_strides=(1,),
        padding=[((CONV_W - 1) // 2, CONV_W // 2)],
        dimension_numbers=('NWC', 'WIO', 'NWC'), feature_group_count=x.shape[-1])
    return y + b.astype(x.dtype)


def rope_1d(x, pos):
    half = x.shape[-1] // 2
    inv = ROPE_BASE ** (-jnp.arange(half, dtype=F32) / half)
    ang = pos.astype(F32)[:, None] * inv[None, :]
    cos, sin = jnp.cos(ang)[:, None, :], jnp.sin(ang)[:, None, :]
    x1, x2 = x[..., :half], x[..., half:]
    return jnp.concatenate([x1 * cos - x2 * sin, x1 * sin + x2 * cos], axis=-1)


def rope_2d(x, rows, cols):
    h = x.shape[-1] // 2
    return jnp.concatenate([rope_1d(x[..., :h], rows), rope_1d(x[..., h:], cols)], axis=-1)


def linear_scan(a, b, h0):
    def comb(l, r):
        return (l[0] * r[0], r[0] * l[1] + r[1])
    a_cum, b_cum = lax.associative_scan(comb, (a, b), axis=1)
    h = a_cum * h0[:, None, :] + b_cum
    return h, h[:, -1]


def scalar_decay_chunks(q, k, v, log_a, s0, chunk):
    Bn, T, H, N = q.shape
    P = v.shape[-1]
    nc = T // chunk
    qc = q.reshape(Bn, nc, chunk, H, N)
    kc = k.reshape(Bn, nc, chunk, H, N)
    vc = v.reshape(Bn, nc, chunk, H, P)
    cum = jnp.cumsum(log_a.astype(F32).reshape(Bn, nc, chunk, H), axis=2)
    tri = jnp.tril(jnp.ones((chunk, chunk), bool))[:, :, None]
    diff = cum[:, :, :, None, :] - cum[:, :, None, :, :]
    decay = jnp.where(tri, jnp.exp(jnp.where(tri, diff, 0.0)), 0.0)
    scores = jnp.einsum('bcthn,bcshn->bctsh', qc, kc) * decay
    y = jnp.einsum('bctsh,bcshp->bcthp', scores, vc)
    last = cum[:, :, -1]
    u = jnp.einsum('bcshn,bcshp->bchnp', kc * jnp.exp(last[:, :, None] - cum)[..., None], vc)

    def step(s, inp):
        g, uc = inp
        return g[..., None, None] * s + uc, s

    s_fin, s_in = lax.scan(step, s0, (jnp.moveaxis(jnp.exp(last), 1, 0), jnp.moveaxis(u, 1, 0)))
    y = y + jnp.einsum('bcthn,bchnp->bcthp', qc * jnp.exp(cum)[..., None], jnp.moveaxis(s_in, 0, 1))
    return y.reshape(Bn, T, H, P), s_fin


def vector_decay_chunks(q, k, v, log_f, s0, chunk):
    Bn, T, H, K = q.shape
    V = v.shape[-1]
    nc = T // chunk
    qc = q.reshape(Bn, nc, chunk, H, K)
    kc = k.reshape(Bn, nc, chunk, H, K)
    vc = v.reshape(Bn, nc, chunk, H, V)
    cum = jnp.cumsum(log_f.astype(F32).reshape(Bn, nc, chunk, H, K), axis=2)
    tri = jnp.tril(jnp.ones((chunk, chunk), bool))[:, :, None, None]
    diff = cum[:, :, :, None] - cum[:, :, None, :]
    decay = jnp.where(tri, jnp.exp(jnp.where(tri, diff, 0.0)), 0.0)
    scores = jnp.einsum('bcthk,bcshk,bctshk->bctsh', qc, kc, decay)
    y = jnp.einsum('bctsh,bcshv->bcthv', scores, vc)
    last = cum[:, :, -1]
    u = jnp.einsum('bcshk,bcshv->bchkv', kc * jnp.exp(last[:, :, None] - cum), vc)

    def step(s, inp):
        g, uc = inp
        return g[..., None] * s + uc, s

    s_fin, s_in = lax.scan(step, s0, (jnp.moveaxis(jnp.exp(last), 1, 0), jnp.moveaxis(u, 1, 0)))
    y = y + jnp.einsum('bcthk,bchkv->bcthv', qc * jnp.exp(cum), jnp.moveaxis(s_in, 0, 1))
    return y.reshape(Bn, T, H, V), s_fin


def bidir_scan(scan, ctx_args, lat_args, s0, reverse):
    if reverse:
        ctx_args = tuple(jnp.flip(t, axis=1) for t in ctx_args)
        lat_args = tuple(jnp.flip(t, axis=1) for t in lat_args)
    y_c, s_c = scan(*ctx_args, s0)
    y_l, _ = scan(*lat_args, s_c)
    if reverse:
        y_c, y_l = jnp.flip(y_c, axis=1), jnp.flip(y_l, axis=1)
    return y_c, y_l


def ssd_mixer(u_c, u_l, conv_w, conv_b, dt_bias, a_log, d_skip, norm_w):
    def prep(u):
        Bn, T = u.shape[:2]
        z, xbc, dt = jnp.split(u, [SSD_WIDTH, SSD_WIDTH + SSD_XBC], axis=-1)
        xbc = jax.nn.silu(dwconv(xbc, conv_w, conv_b))
        xs, bm, cm = jnp.split(xbc, [SSD_WIDTH, SSD_WIDTH + SSD_GROUPS * SSD_STATE], axis=-1)
        rep = SSD_HEADS // SSD_GROUPS
        bm = jnp.repeat(bm.reshape(Bn, T, SSD_GROUPS, SSD_STATE), rep, axis=2)
        cm = jnp.repeat(cm.reshape(Bn, T, SSD_GROUPS, SSD_STATE), rep, axis=2)
        return z, xs.reshape(Bn, T, SSD_HEADS, SSD_HEADDIM), bm, cm, dt

    def dir_args(stream, d):
        _, xs, bm, cm, dt = stream
        delta = jax.nn.softplus(dt[..., d * SSD_HEADS:(d + 1) * SSD_HEADS] + dt_bias[d])
        return (cm, bm * delta[..., None], xs, -jnp.exp(a_log[d]) * delta)

    sc, sl = prep(u_c), prep(u_l)
    scan = functools.partial(scalar_decay_chunks, chunk=SSD_CHUNK)
    s0 = jnp.zeros((u_c.shape[0], SSD_HEADS, SSD_STATE, SSD_HEADDIM), F32)
    y_c = sc[1] * d_skip[:, None]
    y_l = sl[1] * d_skip[:, None]
    for d in range(2):
        yc_d, yl_d = bidir_scan(scan, dir_args(sc, d), dir_args(sl, d), s0, d == 1)
        y_c = y_c + yc_d
        y_l = y_l + yl_d

    def out(y, z):
        return rmsnorm(y.reshape(z.shape) * jax.nn.silu(z), norm_w)

    return out(y_c, sc[0]), out(y_l, sl[0])


def rglru_mixer(u_c, u_l, conv_w, conv_b, wa, ba, wx, bx, lam):
    def prep(u):
        xb, gb = jnp.split(u, 2, axis=-1)
        return dwconv(xb, conv_w, conv_b), gb

    def dir_args(xb, d):
        Bn, T = xb.shape[:2]
        xr = xb.reshape(Bn, T, LRU_BLOCKS, LRU_BLOCK_DIM)
        r = jax.nn.sigmoid(jnp.einsum('bthi,hij->bthj', xr, wa[d]) + ba[d])
        i = jax.nn.sigmoid(jnp.einsum('bthi,hij->bthj', xr, wx[d]) + bx[d])
        log_a = -LRU_C * r * jax.nn.softplus(-lam[d]).reshape(LRU_BLOCKS, LRU_BLOCK_DIM)
        b = jnp.sqrt(jnp.maximum(-jnp.expm1(2.0 * log_a), 1e-12)) * (i * xr)
        return (jnp.exp(log_a).reshape(Bn, T, LRU_WIDTH), b.reshape(Bn, T, LRU_WIDTH))

    (xc, gc), (xl, gl) = prep(u_c), prep(u_l)
    h0 = jnp.zeros((u_c.shape[0], LRU_WIDTH), F32)
    h_c = jnp.zeros_like(xc)
    h_l = jnp.zeros_like(xl)
    for d in range(2):
        hc_d, hl_d = bidir_scan(linear_scan, dir_args(xc, d), dir_args(xl, d), h0, d == 1)
        h_c = h_c + hc_d
        h_l = h_l + hl_d
    return h_c * jax.nn.gelu(gc), h_l * jax.nn.gelu(gl)


def hgrn2_mixer(u_c, u_l, lb, norm_w):
    def prep(u):
        Bn, T = u.shape[:2]
        hs = lambda t: t.reshape(Bn, T, HGRN_HEADS, HGRN_HEADDIM)
        q, ff, fb, i, g = jnp.split(u, 5, axis=-1)
        return hs(jax.nn.silu(q) * HGRN_HEADDIM ** -0.5), (hs(ff), hs(fb)), hs(i), g

    def dir_args(stream, d):
        q, fr, i, _ = stream
        lbd = lb[d].reshape(HGRN_HEADS, HGRN_HEADDIM)
        f = lbd + (1.0 - lbd) * jax.nn.sigmoid(fr[d])
        return (q, 1.0 - f, i, jnp.log(f))

    sc, sl = prep(u_c), prep(u_l)
    scan = functools.partial(vector_decay_chunks, chunk=HGRN_CHUNK)
    s0 = jnp.zeros((u_c.shape[0], HGRN_HEADS, HGRN_HEADDIM, HGRN_HEADDIM), F32)
    o_c = jnp.zeros_like(sc[2])
    o_l = jnp.zeros_like(sl[2])
    for d in range(2):
        oc_d, ol_d = bidir_scan(scan, dir_args(sc, d), dir_args(sl, d), s0, d == 1)
        o_c = o_c + oc_d
        o_l = o_l + ol_d

    def out(o, g):
        return rmsnorm(o, norm_w).reshape(g.shape) * jax.nn.silu(g)

    return out(o_c, sc[3]), out(o_l, sl[3])


def retention_mixer(u_c, u_l, rows, cols, log_decay):
    qk = RET_HEADS * RET_QK_DIM

    def prep(u, rotate):
        Bn, T = u.shape[:2]
        q, k, v, g = jnp.split(u, [qk, 2 * qk, 2 * qk + RET_WIDTH], axis=-1)
        q = q.reshape(Bn, T, RET_HEADS, RET_QK_DIM)
        k = k.reshape(Bn, T, RET_HEADS, RET_QK_DIM)
        if rotate:
            q, k = rope_2d(q, rows, cols), rope_2d(k, rows, cols)
        la = jnp.broadcast_to(log_decay, (Bn, T, RET_HEADS))
        return (q, k * RET_QK_DIM ** -0.5, v.reshape(Bn, T, RET_HEADS, RET_V_DIM), la), g

    (ac, gc), (al, gl) = prep(u_c, False), prep(u_l, True)
    scan = functools.partial(scalar_decay_chunks, chunk=RET_CHUNK)
    s0 = jnp.zeros((u_c.shape[0], RET_HEADS, RET_QK_DIM, RET_V_DIM), F32)
    o_c = jnp.zeros_like(ac[2])
    o_l = jnp.zeros_like(al[2])
    for d in range(2):
        oc_d, ol_d = bidir_scan(scan, ac, al, s0, d == 1)
        o_c = o_c + oc_d
        o_l = o_l + ol_d

    def out(o, g):
        return jax.nn.silu(g) * rmsnorm(o).reshape(g.shape)

    return out(o_c, gc), out(o_l, gl)


def swiglu_half_step(x, m, j, g_pre, g_post, w1, w3, w2):
    h = rmsnorm(x, g_pre) * (1.0 + m[:, j + 1]) + m[:, j]
    y = (jax.nn.silu(h @ w1) * (h @ w3)) @ w2
    return x + 0.5 * m[:, j + 2] * rmsnorm(y, g_post)


def setup_inputs(seed: int = 0) -> dict:
    key = jax.random.key(seed)
    ks = iter(jax.random.split(key, 40))

    def nrm(shape, s):
        return jax.random.normal(next(ks), shape, F32) * s

    dt = jnp.exp(jax.random.uniform(next(ks), (DEPTH, 2, SSD_HEADS), F32,
                                    minval=math.log(1e-3), maxval=math.log(1e-1)))
    a_c = jax.random.uniform(next(ks), (DEPTH, 2, LRU_WIDTH), F32, minval=0.9, maxval=0.999)
    a_lru = a_c ** (1.0 / LRU_C)
    return {
        'x': nrm((BATCH, SEQ, D_MODEL), 1.0),
        'c': nrm((BATCH, D_MODEL), 1.0),
        'ctx': nrm((BATCH, CTX_LEN, D_MODEL), 1.0),
        'c_ctx': nrm((D_MODEL,), 1.0),
        'w_mod': nrm((DEPTH, D_MODEL, N_MOD * D_MODEL), 0.5 * D_MODEL ** -0.5),
        'b_mod': nrm((DEPTH, N_MOD * D_MODEL), 0.02),
        'norm_pre': 1.0 + nrm((DEPTH, 3, D_MODEL), 0.02),
        'norm_post': 1.0 + nrm((DEPTH, 3, D_MODEL), 0.02),
        'ffn_w1': nrm((DEPTH, 2, D_MODEL, D_FF), D_MODEL ** -0.5),
        'ffn_w3': nrm((DEPTH, 2, D_MODEL, D_FF), D_MODEL ** -0.5),
        'ffn_w2': nrm((DEPTH, 2, D_FF, D_MODEL), D_FF ** -0.5),
        'w_in': nrm((DEPTH, D_MODEL, IN_COLS), D_MODEL ** -0.5),
        'w_out': nrm((DEPTH, D_MIX, D_MODEL), D_MIX ** -0.5),
        'ssd_conv_w': nrm((DEPTH, CONV_W, SSD_XBC), CONV_W ** -0.5),
        'ssd_conv_b': nrm((DEPTH, SSD_XBC), 0.02),
        'ssd_dt_bias': dt + jnp.log(-jnp.expm1(-dt)),
        'ssd_a_log': jnp.log(jax.random.uniform(next(ks), (DEPTH, 2, SSD_HEADS), F32, minval=1.0, maxval=16.0)),
        'ssd_d': 1.0 + nrm((DEPTH, SSD_HEADS), 0.1),
        'ssd_norm_w': 1.0 + nrm((DEPTH, SSD_WIDTH), 0.02),
        'lru_conv_w': nrm((DEPTH, CONV_W, LRU_WIDTH), CONV_W ** -0.5),
        'lru_conv_b': nrm((DEPTH, LRU_WIDTH), 0.02),
        'lru_wa': nrm((DEPTH, 2, LRU_BLOCKS, LRU_BLOCK_DIM, LRU_BLOCK_DIM), LRU_BLOCK_DIM ** -0.5),
        'lru_ba': nrm((DEPTH, 2, LRU_BLOCKS, LRU_BLOCK_DIM), 0.02),
        'lru_wx': nrm((DEPTH, 2, LRU_BLOCKS, LRU_BLOCK_DIM, LRU_BLOCK_DIM), LRU_BLOCK_DIM ** -0.5),
        'lru_bx': nrm((DEPTH, 2, LRU_BLOCKS, LRU_BLOCK_DIM), 0.02),
        'lru_lambda': jnp.log(a_lru) - jnp.log1p(-a_lru),
        'hgrn_lb_logits': nrm((2, DEPTH, HGRN_WIDTH), 1.0),
        'hgrn_norm_w': 1.0 + nrm((DEPTH, HGRN_HEADDIM), 0.02),
    }


def reference(x, c, ctx, c_ctx, w_mod, b_mod, norm_pre, norm_post, ffn_w1, ffn_w3, ffn_w2,
              w_in, w_out, ssd_conv_w, ssd_conv_b, ssd_dt_bias, ssd_a_log, ssd_d, ssd_norm_w,
              lru_conv_w, lru_conv_b, lru_wa, lru_ba, lru_wx, lru_bx, lru_lambda,
              hgrn_lb_logits, hgrn_norm_w):
    Bn, L, D = x.shape
    ROWS = L // GRID_W
    rr, cc = jnp.meshgrid(jnp.arange(ROWS), jnp.arange(GRID_W), indexing='ij')
    rows, cols = rr.reshape(-1), cc.reshape(-1)
    sm = jax.nn.softmax(hgrn_lb_logits.astype(F32), axis=1)
    lb_all = jnp.cumsum(sm, axis=1) - sm[:, :1]
    ret_log_decay = jnp.log1p(-jnp.exp2(-5.0 - jnp.arange(RET_HEADS, dtype=F32)))
    splits = [SSD_COLS, SSD_COLS + LRU_COLS, SSD_COLS + LRU_COLS + HGRN_COLS]

    xl, xc = x, ctx
    for l in range(DEPTH):
        last = l == DEPTH - 1
        m_l = (jax.nn.silu(c) @ w_mod[l] + b_mod[l]).reshape(Bn, N_MOD, 1, D)
        m_c = (jax.nn.silu(c_ctx) @ w_mod[l] + b_mod[l]).reshape(1, N_MOD, 1, D)

        xl = swiglu_half_step(xl, m_l, 0, norm_pre[l, 0], norm_post[l, 0], ffn_w1[l, 0], ffn_w3[l, 0], ffn_w2[l, 0])
        xc = swiglu_half_step(xc, m_c, 0, norm_pre[l, 0], norm_post[l, 0], ffn_w1[l, 0], ffn_w3[l, 0], ffn_w2[l, 0])

        h_l = rmsnorm(xl, norm_pre[l, 1]) * (1.0 + m_l[:, 4]) + m_l[:, 3]
        h_c = rmsnorm(xc, norm_pre[l, 1]) * (1.0 + m_c[:, 4]) + m_c[:, 3]
        ua_l, ub_l, uc_l, ud_l = jnp.split((h_l @ w_in[l]).astype(F32), splits, axis=-1)
        ua_c, ub_c, uc_c, ud_c = jnp.split((h_c @ w_in[l]).astype(F32), splits, axis=-1)
        ya = ssd_mixer(ua_c, ua_l, ssd_conv_w[l], ssd_conv_b[l], ssd_dt_bias[l], ssd_a_log[l], ssd_d[l], ssd_norm_w[l])
        yb = rglru_mixer(ub_c, ub_l, lru_conv_w[l], lru_conv_b[l], lru_wa[l], lru_ba[l], lru_wx[l], lru_bx[l], lru_lambda[l])
        yc = hgrn2_mixer(uc_c, uc_l, lb_all[:, l], hgrn_norm_w[l])
        yd = retention_mixer(ud_c, ud_l, rows, cols, ret_log_decay)
        y_l = jnp.concatenate([ya[1], yb[1], yc[1], yd[1]], axis=-1).astype(xl.dtype) @ w_out[l]
        xl = xl + m_l[:, 5] * rmsnorm(y_l, norm_post[l, 1])
        if not last:
            y_c = jnp.concatenate([ya[0], yb[0], yc[0], yd[0]], axis=-1).astype(xc.dtype) @ w_out[l]
            xc = xc + m_c[:, 5] * rmsnorm(y_c, norm_post[l, 1])

        xl = swiglu_half_step(xl, m_l, 6, norm_pre[l, 2], norm_post[l, 2], ffn_w1[l, 1], ffn_w3[l, 1], ffn_w2[l, 1])
        if not last:
            xc = swiglu_half_step(xc, m_c, 6, norm_pre[l, 2], norm_post[l, 2], ffn_w1[l, 1], ffn_w3[l, 1], ffn_w2[l, 1])
    return xl
```

```cpp
#include <hip/hip_runtime.h>
#include <hip/hip_cooperative_groups.h>
#include <cstdio>
#include <cstdint>
namespace cg = cooperative_groups;
#ifndef MK_SINGLE
#define MK_SINGLE 1
#endif
namespace pg8 {
#define PG8_LAS __attribute__((address_space(3)))
typedef unsigned short bf16_t;
typedef short bf16x8 __attribute__((ext_vector_type(8)));
typedef float f32x4 __attribute__((ext_vector_type(4)));
typedef unsigned u32x4 __attribute__((ext_vector_type(4)));
constexpr int BM = 256, BK = 64, HALF = 128, HTB = HALF * BK * 2  , STAGE_BYTES = 8 * HTB, NXCD = 8, WGM = 8;

__host__ __device__ __forceinline__ int lds_byte(int r, int c) { const int st = (r >> 4) * 2 + (c >> 5), rr = r & 15, cc = c & 31, ob = rr * 64 + cc * 2; return st * 1024 + (ob ^ (((ob >> 9) & 1) << 5)); }
__host__ __device__ __forceinline__ void stage_rc(int b, int& R, int& C) { const int st = b / 1024, sb = b % 1024, swz = sb ^ (((sb >> 9) & 1) << 5); R = (st >> 1) * 16 + swz / 64; C = (st & 1) * 32 + (swz % 64) / 2; }
__host__ __device__ __forceinline__ int perm32(int rho) { const int n = rho >> 4, i = rho & 15; return 8 * (i >> 2) + 4 * n + (i & 3); }

struct Unit { int pm, pn; };
struct Gemm { const bf16_t* A; const bf16_t* Bt; int M, N, K, ld; };

struct StaticOrder {
    int nM, nN, nwg, G, c;
    __host__ __device__ void init(int M, int N, int G_, int c_) { nM = M / BM; nN = N / BM; nwg = nM * nN; G = G_; c = c_; }
    __host__ __device__ bool next(int i, Unit& u) const {
        const long L = (long)i * G + c; if (L >= nwg) return false;
        int wgid = (int)L; { const int q = nwg / NXCD, r = nwg % NXCD, xcd = wgid % NXCD, off = wgid / NXCD; wgid = (xcd < r ? xcd * (q + 1) : r * (q + 1) + (xcd - r) * q) + off; }
        const int nig = WGM * nN, gid = wgid / nig, fm = gid * WGM, gsz = (nM - fm) < WGM ? (nM - fm) : WGM;
        u.pm = fm + ((wgid % nig) % gsz); u.pn = (wgid % nig) / gsz; return true;
    }
    __device__ __forceinline__ void a_ready(const Unit&) const {}
    __device__ __forceinline__ void done(const Unit&) const {}
};

__device__ __forceinline__ unsigned cvt_pk_bf16(float lo, float hi) { unsigned r; asm volatile("v_cvt_pk_bf16_f32 %0, %1, %2" : "=v"(r) : "v"(lo), "v"(hi)); return r; }
template <class Epi, class Sched, bool ALIGN_EPI = false, bool SP2 = false>
__device__ __forceinline__ void gemm_phase(PG8_LAS unsigned char* lds, const Gemm g, const Sched& S, const Epi& E) {
    int tid_l = threadIdx.x; asm volatile("" : "+v"(tid_l)); const int tid = tid_l, wid = __builtin_amdgcn_readfirstlane(tid >> 6), lane = tid & 63, wr = wid >> 2, wc = wid & 3, fr = lane & 15, fq = lane >> 4;
    const int K = g.ld, nt = g.K / BK;
    unsigned voffA[2], voffB[2];
#pragma unroll
    for (int i = 0; i < 2; ++i) { int R, C; stage_rc(tid * 16 + i * 8192, R, C); const int Rb = Epi::PERM ? ((R & ~31) + perm32(R & 31)) : R;
        voffA[i] = (unsigned)(R * K + C) * 2u; voffB[i] = (unsigned)(Rb * K + C) * 2u; }
    const size_t kstep = (size_t)(BK * 2);
    const size_t hstep = (size_t)HALF * K * 2;
    const size_t tstep = 2 * hstep;
    const unsigned ldsw = (unsigned)wid * 1024u;
    const int aoff = lds_byte(wr * 64 + fr, fq * 8), boff = lds_byte(wc * 32 + fr, fq * 8);
#define PG8_SA(b, h) (((b) * 2 + (h)) * HTB)
#define PG8_SB(b, h) ((4 + (b) * 2 + (h)) * HTB)
#define PG8_STAGE(bufoff, gbase, voff) do { _Pragma("unroll") for (int _i = 0; _i < 2; ++_i) \
        __builtin_amdgcn_global_load_lds((const unsigned*)((const char*)(gbase) + (voff)[_i]), (PG8_LAS unsigned*)(lds + (bufoff) + ldsw + _i * 8192), 16, 0, 0); } while (0)
#define PG8_LDA(dst, b, h) do { _Pragma("unroll") for (int m = 0; m < 4; ++m) _Pragma("unroll") for (int k = 0; k < 2; ++k) dst[m][k] = *(const PG8_LAS bf16x8*)(lds + PG8_SA(b, h) + aoff + m * 2048 + k * 1024); } while (0)
#define PG8_LDB(dst, b, h) do { _Pragma("unroll") for (int n = 0; n < 2; ++n) _Pragma("unroll") for (int k = 0; k < 2; ++k) dst[n][k] = *(const PG8_LAS bf16x8*)(lds + PG8_SB(b, h) + boff + n * 2048 + k * 1024); } while (0)
#define PG8_MMA(ai, bj, At, Bt) do { __builtin_amdgcn_s_setprio(1); _Pragma("unroll") for (int m = 0; m < 4; ++m) _Pragma("unroll") for (int n = 0; n < 2; ++n) _Pragma("unroll") for (int k = 0; k < 2; ++k) \
        acc[ai][bj][m][n] = __builtin_amdgcn_mfma_f32_16x16x32_bf16(Bt[n][k], At[m][k], acc[ai][bj][m][n], 0, 0, 0); __builtin_amdgcn_s_setprio(0); } while (0)
#define PG8_WAIT_V(n) asm volatile("s_waitcnt vmcnt(" #n ")" ::: "memory")
#define PG8_WAIT_L(n) asm volatile("s_waitcnt lgkmcnt(" #n ")" ::: "memory")
#define PG8_BAR __builtin_amdgcn_s_barrier()
#define PG8_SCHED __builtin_amdgcn_sched_barrier(0)
    Unit cur, nxt; int ui = 0;
    if (!S.next(0, cur)) return;
    f32x4 acc[2][2][4][2];
#pragma unroll
    for (int a = 0; a < 2; ++a)
#pragma unroll
        for (int b = 0; b < 2; ++b)
#pragma unroll
            for (int m = 0; m < 4; ++m)
#pragma unroll
                for (int n = 0; n < 2; ++n) acc[a][b][m][n] = (f32x4){0.f, 0.f, 0.f, 0.f};
    bf16x8 At[4][2], B0[2][2], B1[2][2];
    const char* cA = (const char*)g.A + (size_t)cur.pm * tstep; const char* cB = (const char*)g.Bt + (size_t)cur.pn * tstep;
    S.a_ready(cur);
    if constexpr (SP2) {
        PG8_STAGE(PG8_SB(0, 0), cB, voffB); PG8_STAGE(PG8_SB(0, 1), cB + hstep, voffB); PG8_STAGE(PG8_SA(0, 0), cA, voffA); PG8_STAGE(PG8_SA(0, 1), cA + hstep, voffA);
        if (wr == 1) PG8_BAR;
        PG8_WAIT_V(2); PG8_BAR;
        PG8_STAGE(PG8_SB(1, 0), cB + kstep, voffB); PG8_STAGE(PG8_SA(1, 0), cA + kstep, voffA); PG8_STAGE(PG8_SB(1, 1), cB + hstep + kstep, voffB);
        PG8_WAIT_V(6); PG8_BAR;
    } else {
        PG8_STAGE(PG8_SB(0, 0), cB, voffB); PG8_STAGE(PG8_SA(0, 0), cA, voffA); PG8_STAGE(PG8_SB(0, 1), cB + hstep, voffB); PG8_STAGE(PG8_SA(0, 1), cA + hstep, voffA);
        if (wr == 1) PG8_BAR;
        PG8_WAIT_V(4); PG8_BAR;
        PG8_STAGE(PG8_SB(1, 0), cB + kstep, voffB); PG8_STAGE(PG8_SA(1, 0), cA + kstep, voffA); PG8_STAGE(PG8_SB(1, 1), cB + hstep + kstep, voffB);
        PG8_WAIT_V(6); PG8_BAR;
    }
    for (;;) {
        const bool has_next = S.next(ui + 1, nxt);
        const char* nA = has_next ? (const char*)g.A + (size_t)nxt.pm * tstep : cA; const char* nB = has_next ? (const char*)g.Bt + (size_t)nxt.pn * tstep : cB;
        for (int t = 0; t < nt; t += 2) {
            const bool last = (t == nt - 2);
            const char* a1 = cA + (size_t)(t + 1) * kstep;
            const char* a2 = last ? nA : cA + (size_t)(t + 2) * kstep; const char* b2 = last ? nB : cB + (size_t)(t + 2) * kstep;
            const char* a3 = a2 + kstep; const char* b3 = b2 + kstep;
            if (last && has_next) S.a_ready(nxt);
            if constexpr (SP2) {
            PG8_LDB(B0, 0, 0); PG8_LDB(B1, 0, 1); PG8_SCHED; PG8_LDA(At, 0, 0); PG8_STAGE(PG8_SA(1, 1), a1 + hstep, voffA);
            PG8_WAIT_V(8); PG8_WAIT_L(0); PG8_BAR; PG8_MMA(0, 0, At, B0); PG8_MMA(0, 1, At, B1); PG8_BAR; PG8_SCHED;
            PG8_LDA(At, 0, 1); PG8_STAGE(PG8_SB(0, 0), b2, voffB); PG8_STAGE(PG8_SB(0, 1), b2 + hstep, voffB); PG8_STAGE(PG8_SA(0, 0), a2, voffA);
            PG8_WAIT_V(8); PG8_WAIT_L(0); PG8_BAR; PG8_MMA(1, 0, At, B0); PG8_MMA(1, 1, At, B1); PG8_BAR; PG8_SCHED;
            PG8_LDB(B0, 1, 0); PG8_LDB(B1, 1, 1); PG8_SCHED; PG8_LDA(At, 1, 0); PG8_STAGE(PG8_SA(0, 1), a2 + hstep, voffA);
            PG8_WAIT_V(8); PG8_WAIT_L(0); PG8_BAR; PG8_MMA(0, 0, At, B0); PG8_MMA(0, 1, At, B1); PG8_BAR; PG8_SCHED;
            PG8_LDA(At, 1, 1); PG8_STAGE(PG8_SB(1, 0), b3, voffB); PG8_STAGE(PG8_SB(1, 1), b3 + hstep, voffB); PG8_STAGE(PG8_SA(1, 0), a3, voffA);
            PG8_WAIT_V(8); PG8_WAIT_L(0); PG8_BAR; PG8_MMA(1, 0, At, B0); PG8_MMA(1, 1, At, B1); PG8_BAR; PG8_SCHED;
            } else {
            PG8_LDB(B0, 0, 0); PG8_SCHED; PG8_LDA(At, 0, 0); PG8_STAGE(PG8_SA(1, 1), a1 + hstep, voffA);
            PG8_WAIT_L(8); PG8_BAR; PG8_WAIT_L(0); PG8_MMA(0, 0, At, B0); PG8_BAR; PG8_SCHED;
            PG8_LDB(B1, 0, 1); PG8_STAGE(PG8_SB(0, 0), b2, voffB);
            PG8_BAR; PG8_WAIT_L(0); PG8_MMA(0, 1, At, B1); PG8_BAR;
            PG8_LDA(At, 0, 1); PG8_STAGE(PG8_SA(0, 0), a2, voffA);
            PG8_BAR; PG8_WAIT_L(0); PG8_MMA(1, 0, At, B0); PG8_BAR; PG8_SCHED;
            PG8_STAGE(PG8_SB(0, 1), b2 + hstep, voffB);
            PG8_WAIT_V(6); PG8_BAR; PG8_MMA(1, 1, At, B1); PG8_BAR;
            PG8_LDB(B0, 1, 0); PG8_SCHED; PG8_LDA(At, 1, 0); PG8_STAGE(PG8_SA(0, 1), a2 + hstep, voffA);
            PG8_WAIT_L(8); PG8_BAR; PG8_WAIT_L(0); PG8_MMA(0, 0, At, B0); PG8_BAR; PG8_SCHED;
            PG8_LDB(B1, 1, 1); PG8_STAGE(PG8_SB(1, 0), b3, voffB);
            PG8_BAR; PG8_WAIT_L(0); PG8_MMA(0, 1, At, B1); PG8_BAR;
            PG8_LDA(At, 1, 1); PG8_STAGE(PG8_SA(1, 0), a3, voffA);
            PG8_BAR; PG8_WAIT_L(0); PG8_MMA(1, 0, At, B0); PG8_BAR; PG8_SCHED;
            PG8_STAGE(PG8_SB(1, 1), b3 + hstep, voffB);
            PG8_WAIT_V(6); PG8_BAR; PG8_MMA(1, 1, At, B1); PG8_BAR;
            }
        }
        if constexpr (ALIGN_EPI) { if (wr == 0) PG8_BAR; }
        if constexpr (!Epi::AFTER_DRAIN) { E(acc, cur, wr, wc, fr, fq); S.done(cur); }
        if (!has_next) break;
#pragma unroll
        for (int a = 0; a < 2; ++a)
#pragma unroll
            for (int b = 0; b < 2; ++b)
#pragma unroll
                for (int m = 0; m < 4; ++m)
#pragma unroll
                    for (int n = 0; n < 2; ++n) acc[a][b][m][n] = (f32x4){0.f, 0.f, 0.f, 0.f};
        cur = nxt; cA = nA; cB = nB; ++ui;
        if constexpr (ALIGN_EPI) { if (wr == 1) PG8_BAR; }
    }
    PG8_WAIT_V(0);
    if constexpr (!ALIGN_EPI) { if (wr == 0) PG8_BAR; }
    PG8_BAR;
    if constexpr (Epi::AFTER_DRAIN) { E.fused(acc, cur, wr, wc, fr, fq, lds, wid, lane); S.done(cur); }
#undef PG8_SA
#undef PG8_SB
#undef PG8_STAGE
#undef PG8_LDA
#undef PG8_LDB
#undef PG8_MMA
#undef PG8_WAIT_V
#undef PG8_WAIT_L
#undef PG8_BAR
#undef PG8_SCHED
}
}

#define LAS __attribute__((address_space(3)))
typedef unsigned short bf16;
typedef float f32x4 __attribute__((ext_vector_type(4)));
typedef float f32x2 __attribute__((ext_vector_type(2)));
typedef unsigned u32x4 __attribute__((ext_vector_type(4)));
typedef unsigned u32x2 __attribute__((ext_vector_type(2)));
typedef short bf16x8_t __attribute__((ext_vector_type(8)));
constexpr int DM = 2048, NB = 4, TL = 2048, TC = 256, MLAT = NB * TL, MCTX = NB * TC, MALL = MLAT + MCTX;
constexpr int FF = 5632, NUP = 2 * FF, NIN = 6416, NINP = 6656, NMODV = 9 * DM;
constexpr int TSTEPS = TL + TC, NTILES = TSTEPS / 32;
constexpr float EPS = 1e-6f;
constexpr int U_SSD_XBC = 512, U_SSD_DT = 1280, U_LRU_X = 1296, U_LRU_G = 1808;
constexpr int U_HG_Q = 2320, U_HG_F = 2832, U_HG_I = 3856, U_HG_G = 4368;
constexpr int U_RT_Q = 4880, U_RT_K = 5136, U_RT_V = 5392, U_RT_G = 5904;
constexpr int NPHASES = 26;
constexpr int LDS_BYTES = 147456;
constexpr size_t MiB = 1u << 20;
constexpr size_t WS_MOD = 1 * MiB, WS_W13 = 2 * MiB, WS_W2 = 178 * MiB, WS_WIN = 266 * MiB, WS_WOUT = 318 * MiB, WS_X = 334 * MiB, WS_H = 406 * MiB,
                 WS_Y = 442 * MiB, WS_U = 514 * MiB, WS_XBC = 748 * MiB, WS_LA = 775 * MiB, WS_LB = 811 * MiB, WS_YD = 847 * MiB, WS_END = 991 * MiB;

struct Params {
    const float *x, *c, *ctx, *c_ctx, *w_mod, *b_mod, *norm_pre, *norm_post, *ffn_w1, *ffn_w3, *ffn_w2, *w_in, *w_out,
        *ssd_conv_w, *ssd_conv_b, *ssd_dt_bias, *ssd_a_log, *ssd_d, *ssd_norm_w, *lru_conv_w, *lru_conv_b, *lru_wa, *lru_ba, *lru_wx, *lru_bx, *lru_lambda,
        *hgrn_lb_logits, *hgrn_norm_w;
    float* out; unsigned char* ws; int ph_lo, ph_hi;
};

__device__ __forceinline__ float sigmoid_(float x) { return __builtin_amdgcn_rcpf(1.f + __expf(-x)); }
__device__ __forceinline__ float silu_(float x) { return x * sigmoid_(x); }
__device__ __forceinline__ float softplus_(float x) { return fmaxf(x, 0.f) + log1pf(__expf(-fabsf(x))); }
__device__ __forceinline__ float gelu_tanh_(float x) { const float z = 0.7978845608f * (x + 0.044715f * x * x * x); const float t = 1.f - 2.f * __builtin_amdgcn_rcpf(1.f + __expf(2.f * z)); return 0.5f * x * (1.f + t); }
__device__ __forceinline__ unsigned f2bf(float f) { unsigned u = __builtin_bit_cast(unsigned, f); return (u + 0x7fffu + ((u >> 16) & 1u)) >> 16; }
__device__ __forceinline__ unsigned pk2(float lo, float hi) { return f2bf(lo) | (f2bf(hi) << 16); }
__device__ __forceinline__ float wave_sum(float v) {
#pragma unroll
    for (int o = 1; o < 64; o <<= 1) v += __shfl_xor(v, o);
    return v;
}
__device__ __forceinline__ float half_sum(float v) {
#pragma unroll
    for (int o = 1; o < 32; o <<= 1) v += __shfl_xor(v, o);
    return v;
}
__device__ __forceinline__ float dot4(f32x4 a) { return (a.x * a.x + a.y * a.y) + (a.z * a.z + a.w * a.w); }
__device__ __forceinline__ f32x4 ld_bf4(const bf16* p) { const u32x2 w = *(const u32x2*)p; return (f32x4){__builtin_bit_cast(float, w.x << 16), __builtin_bit_cast(float, w.x & 0xffff0000u), __builtin_bit_cast(float, w.y << 16), __builtin_bit_cast(float, w.y & 0xffff0000u)}; }
#define LDS_WAIT() asm volatile("s_waitcnt lgkmcnt(0)" ::: "memory")
__device__ __forceinline__ int tid_() { int t = threadIdx.x; asm volatile("" : "+v"(t)); return t; }
__device__ __forceinline__ int bid_() { int t = blockIdx.x; asm volatile("" : "+s"(t)); return t; }
__device__ __forceinline__ int scan_row(int b, int d, int i) {
    if (i < TC) { const int t = d ? (TC - 1 - i) : i; return MLAT + b * TC + t; }
    int t = i - TC; if (d) t = TL - 1 - t; return b * TL + t;
}

#define XB_TMO      128
#define XB_XCNT(j)  (256  + 64 * (j))
#define XB_XSUB(j)  (1280 + 64 * (j))
#define XB_XGEN(j)  (2304 + 64 * (j))
#define XB_TOP      3328
#define XB_TOPGEN   3392
#define XCD_BAR_WORDS 3456
#define XB_SPIN_CAP (1u << 18)

__device__ __forceinline__ unsigned xb_ld(unsigned* p)              { return __hip_atomic_load(p, __ATOMIC_RELAXED, __HIP_MEMORY_SCOPE_AGENT); }
__device__ __forceinline__ unsigned xb_add(unsigned* p, unsigned v) { return __hip_atomic_fetch_add(p, v, __ATOMIC_RELAXED, __HIP_MEMORY_SCOPE_AGENT); }
__device__ __forceinline__ unsigned xb_xcc_id() { return (unsigned)__builtin_amdgcn_s_getreg((3 << 11) | 20) & 0xFu; }
#define XB_SPIN(cond, bar) do { unsigned _sp = 0; while (cond) { __builtin_amdgcn_s_sleep(1); \
    if ((++_sp & 255u) == 0u) { if (xb_ld(&(bar)[XB_TMO])) break; if (_sp > XB_SPIN_CAP) { atomicAdd(&(bar)[XB_TMO], 1u); break; } } } } while (0)

struct XcdBarrier {
    unsigned* bar; unsigned x;
    volatile LAS unsigned* st;
};

__device__ __forceinline__ XcdBarrier xcd_barrier_post(unsigned* bar, volatile LAS unsigned* st) {
    XcdBarrier b; b.bar = bar; b.x = xb_xcc_id(); b.st = st;
    if (threadIdx.x == 0) (void)xb_add(&bar[XB_XCNT(b.x)], 1u);
    return b;
}
__device__ __forceinline__ void xcd_barrier_complete(unsigned* bar, unsigned x, unsigned& nloc, unsigned& nx) {
    const unsigned G = gridDim.x * gridDim.y * gridDim.z;
    unsigned sum, cnt, mine, sp = 0u;
    for (;;) {
        sum = 0u; cnt = 0u; mine = 0u;
#pragma unroll
        for (unsigned j = 0; j < 16; ++j) { const unsigned c = xb_ld(&bar[XB_XCNT(j)]); sum += c; cnt += (c > 0u) ? 1u : 0u; mine = (j == x) ? c : mine; }
        if (sum == G) break;
        __builtin_amdgcn_s_sleep(1);
        if ((++sp & 255u) == 0u) { if (xb_ld(&bar[XB_TMO])) break; if (sp > XB_SPIN_CAP) { atomicAdd(&bar[XB_TMO], 1u); break; } }
    }
    nloc = mine > 0u ? mine : 1u; nx = cnt > 0u ? cnt : 1u;
}

__device__ __forceinline__ void xcd_barrier(const XcdBarrier& b) {
    asm volatile("s_waitcnt vmcnt(0)" ::: "memory");
    __syncthreads();
    if (threadIdx.x == 0) {
        unsigned* bar = b.bar;
        __builtin_amdgcn_s_waitcnt(0);
        unsigned nloc = b.st[0], nx = b.st[1];
        if (nloc == 0u) { xcd_barrier_complete(bar, b.x, nloc, nx); b.st[0] = nloc; b.st[1] = nx; }
        const unsigned old = xb_add(&bar[XB_XSUB(b.x)], 1u);
        const unsigned gen = old / nloc;
        if (old + 1u == (gen + 1u) * nloc) {
            __builtin_amdgcn_fence(__ATOMIC_RELEASE, "agent");
            asm volatile("s_waitcnt vmcnt(0)" ::: "memory");
            const unsigned og = xb_add(&bar[XB_TOP], 1u);
            const unsigned tg = og / nx;
            if (og + 1u == (tg + 1u) * nx) xb_add(&bar[XB_TOPGEN], 1u);
            else XB_SPIN(xb_ld(&bar[XB_TOPGEN]) == tg, bar);
            __builtin_amdgcn_fence(__ATOMIC_ACQUIRE, "agent");
            xb_add(&bar[XB_XGEN(b.x)], 1u);
            asm volatile("s_waitcnt vmcnt(0)" ::: "memory");
        } else {
            XB_SPIN(xb_ld(&bar[XB_XGEN(b.x)]) == gen, bar);
            __builtin_amdgcn_fence(__ATOMIC_ACQUIRE, "agent");
            asm volatile("s_waitcnt vmcnt(0)" ::: "memory");
        }
    }
    __syncthreads();
}

namespace pg8 {
struct EpiSwiGLU {
    static constexpr bool PERM = true, AFTER_DRAIN = false;
    bf16_t* O; int ldc;
    __device__ __forceinline__ void operator()(const f32x4 (&acc)[2][2][4][2], const Unit& u, int wr, int wc, int fr, int fq) const {
        const int row0 = u.pm * BM + wr * 64 + fr, col0 = u.pn * HALF + wc * 32 + 8 * fq;
#pragma unroll
        for (int ai = 0; ai < 2; ++ai)
#pragma unroll
            for (int m = 0; m < 4; ++m) {
                bf16_t* rowp = O + (size_t)(row0 + ai * HALF + m * 16) * ldc + col0;
                const f32x4 a0 = acc[ai][0][m][0], a1 = acc[ai][0][m][1], b0 = acc[ai][1][m][0], b1 = acc[ai][1][m][1];
                float r[8];
#pragma unroll
                for (int j = 0; j < 4; ++j) { r[j] = a0[j] * __builtin_amdgcn_rcpf(1.f + __expf(-a0[j])) * b0[j]; r[4 + j] = a1[j] * __builtin_amdgcn_rcpf(1.f + __expf(-a1[j])) * b1[j]; }
                u32x4 w; w.x = cvt_pk_bf16(r[0], r[1]); w.y = cvt_pk_bf16(r[2], r[3]); w.z = cvt_pk_bf16(r[4], r[5]); w.w = cvt_pk_bf16(r[6], r[7]);
                *(u32x4*)rowp = w;
                asm volatile("" ::: "memory");
            }
    }
};
struct EpiF32 {
    static constexpr bool PERM = false, AFTER_DRAIN = false;
    float* O; int ldc; int asbf;
    __device__ __forceinline__ void operator()(const f32x4 (&acc)[2][2][4][2], const Unit& u, int wr, int wc, int fr, int fq) const {
        const int row0 = u.pm * BM + wr * 64 + fr, col0 = u.pn * BM + wc * 32 + 4 * fq;
        if (asbf) {
            bf16_t* Ob = (bf16_t*)O;
#pragma unroll
            for (int ai = 0; ai < 2; ++ai)
#pragma unroll
                for (int m = 0; m < 4; ++m) {
                    bf16_t* rowp = Ob + (size_t)(row0 + ai * HALF + m * 16) * ldc + col0;
#pragma unroll
                    for (int bj = 0; bj < 2; ++bj)
#pragma unroll
                        for (int n = 0; n < 2; ++n) { const f32x4 v = acc[ai][bj][m][n]; u32x2 w; w.x = cvt_pk_bf16(v[0], v[1]); w.y = cvt_pk_bf16(v[2], v[3]); *(u32x2*)(rowp + bj * HALF + n * 16) = w; }
                }
            return;
        }
#pragma unroll
        for (int ai = 0; ai < 2; ++ai)
#pragma unroll
            for (int m = 0; m < 4; ++m) {
                float* rowp = O + (size_t)(row0 + ai * HALF + m * 16) * ldc + col0;
#pragma unroll
                for (int bj = 0; bj < 2; ++bj)
#pragma unroll
                    for (int n = 0; n < 2; ++n) *(f32x4*)(rowp + bj * HALF + n * 16) = acc[ai][bj][m][n];
            }
    }
};
}


namespace pg8 {
struct Order2 {
    StaticOrder so; int one, valid; Unit u1;
    __device__ bool next(int i, Unit& u) const { if (one) { if (i > 0 || !valid) return false; u = u1; return true; } return so.next(i, u); }
    __device__ __forceinline__ void a_ready(const Unit&) const {}
    __device__ __forceinline__ void done(const Unit&) const {}
};
}
__device__ __forceinline__ void transpose_item64(const float* __restrict__ W, int K, int N, bf16* __restrict__ WT, int mode, float* scr, int item, int lane) {
    const int nblk = (N + 63) >> 6, kb = item / nblk, nb = item - kb * nblk, k0 = kb << 6, n0 = nb << 6;
    const int lr = lane >> 4, lc = (lane & 15) << 2;
    const bool ok = (n0 + lc) < N;
#pragma unroll
    for (int i = 0; i < 16; ++i) {
        const int kk = 4 * i + lr; f32x4 v = {0.f, 0.f, 0.f, 0.f};
        if (ok) v = __builtin_nontemporal_load((const f32x4*)(W + (size_t)(k0 + kk) * N + n0 + lc));
        float* s = scr + kk * 65 + lc; s[0] = v.x; s[1] = v.y; s[2] = v.z; s[3] = v.w;
    }
    LDS_WAIT();
    const int c = lane & 7;
#pragma unroll
    for (int j = 0; j < 8; ++j) {
        const int n = (lane >> 3) + 8 * j; const float* s = scr + (8 * c) * 65 + n;
        u32x4 o; o.x = pk2(s[0], s[65]); o.y = pk2(s[2 * 65], s[3 * 65]); o.z = pk2(s[4 * 65], s[5 * 65]); o.w = pk2(s[6 * 65], s[7 * 65]);
        const int dn = n0 + n; int row = dn; if (mode) row = ((dn >> 7) << 8) + (dn & 127) + (mode == 2 ? 128 : 0);
        *(u32x4*)(WT + (size_t)row * K + k0 + 8 * c) = o;
    }
    LDS_WAIT();
}

__device__ __forceinline__ void prologue_phase(const Params& P, float* L) {
    const int tid = tid_(), lane = tid & 63, wave = __builtin_amdgcn_readfirstlane(tid >> 6);
    unsigned char* ws = P.ws;
    float* MOD = (float*)(ws + WS_MOD);
    float* sc = L;
    float* red = L + 5 * DM;
    for (int i = tid; i < 5 * DM; i += 512) { const int r = i >> 11, k = i & (DM - 1); const float v = r < 4 ? P.c[r * DM + k] : P.c_ctx[k]; sc[i] = silu_(v); }
    __syncthreads();
    for (int it = bid_(); it < 1152; it += gridDim.x) {
        const int l = it / 576, j0 = (it % 576) * 32;
        const float* Wm = P.w_mod + (size_t)l * DM * NMODV;
        const int kr = lane >> 3, c4 = (lane & 7) << 2;
        f32x4 acc[5];
#pragma unroll
        for (int r = 0; r < 5; ++r) acc[r] = (f32x4){0.f, 0.f, 0.f, 0.f};
        const int kbase = wave * 256 + kr;
#pragma unroll 16
        for (int kk = 0; kk < 256; kk += 8) {
            const int k = kbase + kk; const f32x4 w = __builtin_nontemporal_load((const f32x4*)(Wm + (size_t)k * NMODV + j0 + c4));
#pragma unroll
            for (int r = 0; r < 5; ++r) acc[r] += w * sc[r * DM + k];
        }
#pragma unroll
        for (int r = 0; r < 5; ++r)
#pragma unroll
            for (int e = 0; e < 4; ++e) { float v = acc[r][e]; v += __shfl_xor(v, 8); v += __shfl_xor(v, 16); v += __shfl_xor(v, 32); acc[r][e] = v; }
        if (lane < 8) {
#pragma unroll
            for (int r = 0; r < 5; ++r) *(f32x4*)&red[(wave * 5 + r) * 32 + c4] = acc[r];
        }
        __syncthreads();
        if (tid < 160) { const int r = tid >> 5, j = tid & 31; float s_ = 0.f;
#pragma unroll
            for (int w = 0; w < 8; ++w) s_ += red[(w * 5 + r) * 32 + j];
            MOD[(size_t)(l * 5 + r) * NMODV + j0 + j] = s_ + P.b_mod[l * NMODV + j0 + j]; }
        __syncthreads();
    }
    bf16* W13 = (bf16*)(ws + WS_W13); bf16* W2 = (bf16*)(ws + WS_W2); bf16* WIN = (bf16*)(ws + WS_WIN); bf16* WOUT = (bf16*)(ws + WS_WOUT);
    float* scr = L + wave * (64 * 65);
    const int gw = bid_() * 8 + wave, NGW = gridDim.x * 8;
    constexpr int I_F = 2816, I_LF = 3 * I_F, I_FFN = 4 * I_LF, I_IN = 32 * 101, I_OUT = 32 * 32, I_ALL = I_FFN + 2 * I_IN + 2 * I_OUT;
    for (int it = gw; it < I_ALL; it += NGW) {
        int r = it;
        if (r < I_FFN) {
            const int lf = r / I_LF, q = r % I_LF, which = q / I_F, item = q % I_F;
            if (which == 0) transpose_item64(P.ffn_w1 + (size_t)lf * DM * FF, DM, FF, W13 + (size_t)lf * NUP * DM, 1, scr, item, lane);
            else if (which == 1) transpose_item64(P.ffn_w3 + (size_t)lf * DM * FF, DM, FF, W13 + (size_t)lf * NUP * DM, 2, scr, item, lane);
            else transpose_item64(P.ffn_w2 + (size_t)lf * FF * DM, FF, DM, W2 + (size_t)lf * DM * FF, 0, scr, item, lane);
        } else {
            r -= I_FFN;
            if (r < 2 * I_IN) { const int l = r / I_IN, item = r % I_IN; transpose_item64(P.w_in + (size_t)l * DM * NIN, DM, NIN, WIN + (size_t)l * NINP * DM, 0, scr, item, lane); }
            else { r -= 2 * I_IN; const int l = r / I_OUT, item = r % I_OUT; transpose_item64(P.w_out + (size_t)l * DM * DM, DM, DM, WOUT + (size_t)l * DM * DM, 0, scr, item, lane); }
        }
    }
}

__device__ __forceinline__ void rowwise_phase(const Params& P, int mrows, bool first, int l_post, int j_post, int gate_idx, float coef, bool final_, int l_pre, int j_pre, int shift_idx, int scale_idx) {
    const int tid = tid_(), lane = tid & 63, wave = __builtin_amdgcn_readfirstlane(tid >> 6);
    const int gw = bid_() * 8 + wave, NGW = gridDim.x * 8;
    const float* MOD = (const float*)(P.ws + WS_MOD);
    float* X = (float*)(P.ws + WS_X); const float* Y = (const float*)(P.ws + WS_Y); bf16* H = (bf16*)(P.ws + WS_H);
    for (int row = gw; row < mrows; row += NGW) {
        const int b = row < MLAT ? (row >> 11) : 4;
        f32x4 xv[8]; float ss_new = 0.f;
        if (first) {
            const float* src = row < MLAT ? P.x + (size_t)row * DM : P.ctx + (size_t)(row - MLAT) * DM;
#pragma unroll
            for (int j = 0; j < 8; ++j) xv[j] = *(const f32x4*)(src + 4 * lane + 256 * j);
        } else {
            const float* xr = (l_post == 0 && j_post == 0) ? (row < MLAT ? P.x + (size_t)row * DM : P.ctx + (size_t)(row - MLAT) * DM) : X + (size_t)row * DM;
            f32x4 yv[8]; float ss = 0.f;
            if (row < MLAT) {
                const bf16* yb = (const bf16*)Y + (size_t)row * DM;
#pragma unroll
                for (int j = 0; j < 8; ++j) { const u32x2 w = *(const u32x2*)(yb + 4 * lane + 256 * j);
                    yv[j] = (f32x4){__builtin_bit_cast(float, w.x << 16), __builtin_bit_cast(float, w.x & 0xffff0000u), __builtin_bit_cast(float, w.y << 16), __builtin_bit_cast(float, w.y & 0xffff0000u)}; }
            } else {
                const bf16* pr = (const bf16*)(P.ws + WS_YD) + (size_t)(row - MLAT) * DM;
#pragma unroll
                for (int j = 0; j < 8; ++j) yv[j] = ld_bf4(pr + 4 * lane + 256 * j);
                for (int ks = 1; ks < 8; ++ks) {
#pragma unroll
                    for (int j = 0; j < 8; ++j) yv[j] += ld_bf4(pr + (size_t)ks * MCTX * DM + 4 * lane + 256 * j);
                }
            }
            const float* gp = P.norm_post + (size_t)(l_post * 3 + j_post) * DM; const float* mg = MOD + (size_t)(l_post * 5 + b) * NMODV + gate_idx * DM;
            float sxx = 0.f, sxt = 0.f, stt = 0.f;
#pragma unroll
            for (int j = 0; j < 8; ++j) { const int c = 4 * lane + 256 * j; xv[j] = *(const f32x4*)(xr + c); const f32x4 g4 = *(const f32x4*)(gp + c), m4 = *(const f32x4*)(mg + c);
                ss += dot4(yv[j]); yv[j] = yv[j] * g4 * m4; sxx += dot4(xv[j]); stt += dot4(yv[j]);
                const f32x4 xt = xv[j] * yv[j]; sxt += (xt.x + xt.y) + (xt.z + xt.w); }
#pragma unroll
            for (int o = 1; o < 64; o <<= 1) { ss += __shfl_xor(ss, o); sxx += __shfl_xor(sxx, o); sxt += __shfl_xor(sxt, o); stt += __shfl_xor(stt, o); }
            const float rs = rsqrtf(ss * (1.f / DM) + EPS) * coef;
            ss_new = sxx + 2.f * rs * sxt + rs * rs * stt;
#pragma unroll
            for (int j = 0; j < 8; ++j) xv[j] += yv[j] * rs;
        }
        if (final_) {
            float* o = P.out + (size_t)row * DM;
#pragma unroll
            for (int j = 0; j < 8; ++j) *(f32x4*)(o + 4 * lane + 256 * j) = xv[j];
            continue;
        }
        {
            float* xr = X + (size_t)row * DM; float ss = 0.f;
#pragma unroll
            for (int j = 0; j < 8; ++j) { if (!first) *(f32x4*)(xr + 4 * lane + 256 * j) = xv[j]; else ss += dot4(xv[j]); }
            if (first) ss = wave_sum(ss); else ss = ss_new;
            const float rs = rsqrtf(ss * (1.f / DM) + EPS);
            const float* gp = P.norm_pre + (size_t)(l_pre * 3 + j_pre) * DM; const float* mb = MOD + (size_t)(l_pre * 5 + b) * NMODV;
            bf16* hr = H + (size_t)row * DM;
#pragma unroll
            for (int j = 0; j < 8; ++j) { const int c = 4 * lane + 256 * j; const f32x4 g4 = *(const f32x4*)(gp + c), sh = *(const f32x4*)(mb + shift_idx * DM + c), scl = *(const f32x4*)(mb + scale_idx * DM + c);
                const f32x4 h = (xv[j] * rs) * g4 * (scl + 1.f) + sh; u32x2 w; w.x = pk2(h.x, h.y); w.y = pk2(h.z, h.w); *(u32x2*)(hr + c) = w; }
        }
    }
}

__device__ __forceinline__ f32x4 conv4(const float* __restrict__ U, int row, int col, const float* __restrict__ cw, int C, const float* __restrict__ cb) {
    int t, len; if (row < MLAT) { t = row & (TL - 1); len = TL; } else { t = (row - MLAT) & (TC - 1); len = TC; }
    f32x4 acc = *(const f32x4*)cb;
#pragma unroll
    for (int j = 0; j < 4; ++j) { const int tt = t + j - 1; if (tt >= 0 && tt < len) { const f32x4 xx = *(const f32x4*)(U + (size_t)(row + j - 1) * NINP + col); const f32x4 w = *(const f32x4*)(cw + j * C); acc += xx * w; } }
    return acc;
}
__device__ __forceinline__ void prep_phase(const Params& P, float* L, int l) {
    const int tid = tid_();
    const float* U = (const float*)(P.ws + WS_U); bf16* XBC = (bf16*)(P.ws + WS_XBC); bf16* LA = (bf16*)(P.ws + WS_LA); bf16* LB = (bf16*)(P.ws + WS_LB);
    { const float* cw = P.ssd_conv_w + (size_t)l * 4 * 768; const float* cb = P.ssd_conv_b + (size_t)l * 768;
      for (int idx = bid_() * 512 + tid; idx < (MALL / 16) * 192; idx += gridDim.x * 512) {
          const int chunk = idx / 192, c4 = (idx - chunk * 192) << 2, row0 = chunk * 16;
          int t0, len; if (row0 < MLAT) { t0 = row0 & (TL - 1); len = TL; } else { t0 = (row0 - MLAT) & (TC - 1); len = TC; }
          const f32x4 w0 = *(const f32x4*)(cw + c4), w1 = *(const f32x4*)(cw + 768 + c4), w2 = *(const f32x4*)(cw + 2 * 768 + c4), w3 = *(const f32x4*)(cw + 3 * 768 + c4), bb = *(const f32x4*)(cb + c4);
          const float* up = U + (size_t)row0 * NINP + U_SSD_XBC + c4;
          const f32x4 z4 = {0.f, 0.f, 0.f, 0.f};
          f32x4 xm1 = (t0 > 0) ? *(const f32x4*)(up - NINP) : z4, x0 = *(const f32x4*)up, x1 = *(const f32x4*)(up + NINP);
#pragma unroll
          for (int r = 0; r < 16; ++r) {
              const f32x4 x2 = (t0 + r + 2 < len) ? *(const f32x4*)(up + (size_t)(r + 2) * NINP) : z4;
              f32x4 v = bb + xm1 * w0 + x0 * w1 + x1 * w2 + x2 * w3;
              v.x = silu_(v.x); v.y = silu_(v.y); v.z = silu_(v.z); v.w = silu_(v.w);
              { u32x2 w_; w_.x = pk2(v.x, v.y); w_.y = pk2(v.z, v.w); *(u32x2*)(XBC + (size_t)(row0 + r) * 768 + c4) = w_; }
              xm1 = x0; x0 = x1; x1 = x2;
          } } }
    unsigned short* WT = (unsigned short*)L;
    unsigned short* xb = WT + 4 * 64 * 72;
    float* xs = (float*)(xb + 64 * 72);
    const float* cw = P.lru_conv_w + (size_t)l * 4 * 512; const float* cb = P.lru_conv_b + (size_t)l * 512;
    const int lane = tid & 63, wave = __builtin_amdgcn_readfirstlane(tid >> 6), fr = lane & 15, fq = lane >> 4;
    int cur_h = -1;
    for (int it = bid_(); it < 144 * 8; it += gridDim.x) {
        const int h = it & 7, row0 = (it >> 3) * 64;
        __syncthreads();
        if (h != cur_h) {
            for (int i = tid; i < 4 * 4096; i += 512) { const int m = i >> 12, ii = (i >> 6) & 63, j = i & 63, d = m >> 1; const float* src = (m & 1) ? P.lru_wx : P.lru_wa;
                WT[(m * 64 + j) * 72 + ii] = (unsigned short)f2bf(src[((size_t)(l * 2 + d) * 8 + h) * 4096 + ii * 64 + j]); }
            cur_h = h;
        }
        for (int i = tid; i < 1024; i += 512) { const int r = i >> 4, c4 = (i & 15) << 2;
            const f32x4 v = conv4(U, row0 + r, U_LRU_X + h * 64 + c4, cw + h * 64 + c4, 512, cb + h * 64 + c4);
            *(f32x4*)&xs[r * 68 + c4] = v; u32x2 w; w.x = pk2(v.x, v.y); w.y = pk2(v.z, v.w); *(u32x2*)&xb[r * 72 + c4] = w; }
        __syncthreads();
        {
            const int tt = wave & 3, d = wave >> 2;
            f32x4 acc[2][4];
#pragma unroll
            for (int g2 = 0; g2 < 2; ++g2)
#pragma unroll
                for (int jt = 0; jt < 4; ++jt) acc[g2][jt] = (f32x4){0.f, 0.f, 0.f, 0.f};
#pragma unroll
            for (int ks = 0; ks < 2; ++ks) {
                const bf16x8_t a = *(const bf16x8_t*)&xb[(tt * 16 + fr) * 72 + ks * 32 + fq * 8];
#pragma unroll
                for (int g2 = 0; g2 < 2; ++g2)
#pragma unroll
                    for (int jt = 0; jt < 4; ++jt) { const bf16x8_t bq = *(const bf16x8_t*)&WT[((d * 2 + g2) * 64 + jt * 16 + fr) * 72 + ks * 32 + fq * 8];
                        acc[g2][jt] = __builtin_amdgcn_mfma_f32_16x16x32_bf16(a, bq, acc[g2][jt], 0, 0, 0); }
            }
#pragma unroll
            for (int jt = 0; jt < 4; ++jt) {
                const int j = jt * 16 + fr, c = h * 64 + j;
                const float ba1 = P.lru_ba[(size_t)(l * 2 + d) * 512 + c], bx1 = P.lru_bx[(size_t)(l * 2 + d) * 512 + c], sp = softplus_(-P.lru_lambda[(size_t)(l * 2 + d) * 512 + c]);
#pragma unroll
                for (int jj = 0; jj < 4; ++jj) {
                    const int t = tt * 16 + 4 * fq + jj, row = row0 + t;
                    const float rg = sigmoid_(acc[0][jt][jj] + ba1), ig = sigmoid_(acc[1][jt][jj] + bx1);
                    const float la = -8.f * rg * sp;
                    const float a_ = __expf(la); LA[((size_t)d * MALL + row) * 512 + c] = (bf16)f2bf(1.f - a_);
                    LB[((size_t)d * MALL + row) * 512 + c] = (bf16)f2bf(sqrtf(fmaxf(1.f - a_ * a_, 1e-12f)) * (ig * xs[t * 68 + j]));
                }
            }
        }
    }
}


#define MEMFENCE() asm volatile("" ::: "memory")
struct StepOps { f32x4 k0, k1, q0, q1; float v, a; };
__device__ __forceinline__ void ssd_core(const float* __restrict__ qs, const float* __restrict__ ks, const float* __restrict__ vs, const float* __restrict__ as, const float* __restrict__ la, const float* __restrict__ lb,
                                         float* __restrict__ lo, float* __restrict__ yp, f32x2& S0, f32x2& S1, f32x2& S2, f32x2& S3, float& hl, int tid, int p, int sl, float dsk, bool has_a) {
    StepOps c, n;
#define LD_OPS(o, s_) do { (o).k0 = *(const f32x4*)&ks[(s_) * 64 + sl * 8]; (o).k1 = *(const f32x4*)&ks[(s_) * 64 + sl * 8 + 4]; (o).q0 = *(const f32x4*)&qs[(s_) * 64 + sl * 8]; (o).q1 = *(const f32x4*)&qs[(s_) * 64 + sl * 8 + 4]; \
        (o).v = vs[(s_) * 64 + p]; (o).a = has_a ? as[(s_)] : dsk; } while (0)
#define DO_STEP(o, s_) do { const float a_ = has_a ? (o).a : dsk; const float v_ = (o).v; \
        S0 = S0 * a_ + (f32x2){(o).k0.x, (o).k0.y} * v_; S1 = S1 * a_ + (f32x2){(o).k0.z, (o).k0.w} * v_; S2 = S2 * a_ + (f32x2){(o).k1.x, (o).k1.y} * v_; S3 = S3 * a_ + (f32x2){(o).k1.z, (o).k1.w} * v_; \
        const f32x2 y2_ = ((f32x2){(o).q0.x, (o).q0.y} * S0 + (f32x2){(o).q0.z, (o).q0.w} * S1) + ((f32x2){(o).q1.x, (o).q1.y} * S2 + (f32x2){(o).q1.z, (o).q1.w} * S3); \
        float y_ = y2_.x + y2_.y; if (has_a && sl == 0) y_ += dsk * v_; yp[(s_) * 512 + tid] = y_; } while (0)
    LD_OPS(c, 0); MEMFENCE();
#pragma unroll 2
    for (int s = 0; s < 32; s += 2) {
        LD_OPS(n, s + 1); MEMFENCE();
        DO_STEP(c, s); MEMFENCE();
        if (s + 2 < 32) { LD_OPS(c, s + 2); } MEMFENCE();
        DO_STEP(n, s + 1); MEMFENCE();
    }
#undef LD_OPS
#undef DO_STEP
    if (has_a && tid < 64) {
#pragma unroll 8
        for (int s = 0; s < 32; ++s) { hl = la[s * 64 + tid] * hl + lb[s * 64 + tid]; lo[s * 64 + tid] = hl; }
    }
}
__device__ __forceinline__ void hgrn_core(const float* __restrict__ qs, const float* __restrict__ fs, const float* __restrict__ vs, float* __restrict__ yp, f32x2& S0, f32x2& S1, f32x2& S2, f32x2& S3, int tid, int p, int sl) {
    StepOps c, n;
#define LD_OPS(o, s_) do { (o).k0 = *(const f32x4*)&fs[(s_) * 128 + sl * 4]; (o).k1 = *(const f32x4*)&fs[(s_) * 128 + 64 + sl * 4]; (o).q0 = *(const f32x4*)&qs[(s_) * 128 + sl * 4]; (o).q1 = *(const f32x4*)&qs[(s_) * 128 + 64 + sl * 4]; \
        (o).v = vs[(s_) * 32 + p]; } while (0)
#define DO_STEP(o, s_) do { const f32x2 v2_ = {(o).v, (o).v}; \
        S0 = v2_ + (f32x2){(o).k0.x, (o).k0.y} * (S0 - v2_); S1 = v2_ + (f32x2){(o).k0.z, (o).k0.w} * (S1 - v2_); S2 = v2_ + (f32x2){(o).k1.x, (o).k1.y} * (S2 - v2_); S3 = v2_ + (f32x2){(o).k1.z, (o).k1.w} * (S3 - v2_); \
        const f32x2 y2_ = ((f32x2){(o).q0.x, (o).q0.y} * S0 + (f32x2){(o).q0.z, (o).q0.w} * S1) + ((f32x2){(o).q1.x, (o).q1.y} * S2 + (f32x2){(o).q1.z, (o).q1.w} * S3); \
        yp[(s_) * 512 + tid] = y2_.x + y2_.y; } while (0)
    LD_OPS(c, 0); MEMFENCE();
#pragma unroll 2
    for (int s = 0; s < 32; s += 2) {
        LD_OPS(n, s + 1); MEMFENCE();
        DO_STEP(c, s); MEMFENCE();
        if (s + 2 < 32) { LD_OPS(c, s + 2); } MEMFENCE();
        DO_STEP(n, s + 1); MEMFENCE();
    }
#undef LD_OPS
#undef DO_STEP
}
constexpr int L_YP = 12544;
__device__ __forceinline__ void scan_ssd(const Params& P, float* L, int l, int c) {
    const int tid = tid_(), b = c >> 4, d = (c >> 3) & 1, h = c & 7, g = h >> 2;
    const float* U = (const float*)(P.ws + WS_U); const float* XBC = (const float*)(P.ws + WS_XBC); const float* LA = (const float*)(P.ws + WS_LA); const float* LB = (const float*)(P.ws + WS_LB);
    bf16* YD = (bf16*)(P.ws + WS_YD);
    float* qs = L; float* ks = L + 2048; float* vs = L + 4096; float* as = L + 6144; float* la = L + 6400; float* lb = L + 8448; float* lo = L + 10496; float* yp = L + L_YP;
    const float dtb = P.ssd_dt_bias[(l * 2 + d) * 8 + h], aneg = -__expf(P.ssd_a_log[(l * 2 + d) * 8 + h]), dsk = (d == 0) ? P.ssd_d[l * 8 + h] : 0.f;
    const int st = tid >> 4, sc4 = (tid & 15) << 2, p = tid >> 3, sl = tid & 7;
    f32x2 S0 = {0.f, 0.f}, S1 = {0.f, 0.f}, S2 = {0.f, 0.f}, S3 = {0.f, 0.f}; float hl = 0.f;
    f32x4 rx, rB, rC, ra, rb; float rdt;
#define SSD_LOAD(tile) do { const int row_ = scan_row(b, d, (tile) * 32 + st); const float* xr_ = XBC + (size_t)row_ * 768; \
        rx = *(const f32x4*)(xr_ + h * 64 + sc4); rB = *(const f32x4*)(xr_ + 512 + g * 64 + sc4); rC = *(const f32x4*)(xr_ + 640 + g * 64 + sc4); \
        rdt = U[(size_t)row_ * NINP + U_SSD_DT + d * 8 + h]; \
        ra = *(const f32x4*)(LA + ((size_t)d * MALL + row_) * 512 + h * 64 + sc4); rb = *(const f32x4*)(LB + ((size_t)d * MALL + row_) * 512 + h * 64 + sc4); } while (0)
    __syncthreads();
    SSD_LOAD(0);
    for (int tile = 0; tile < NTILES; ++tile) {
        { const float delta = softplus_(rdt + dtb);
          *(f32x4*)&vs[st * 64 + sc4] = rx; *(f32x4*)&ks[st * 64 + sc4] = rB * delta; *(f32x4*)&qs[st * 64 + sc4] = rC;
          if ((tid & 15) == 0) as[st] = __expf(aneg * delta);
          *(f32x4*)&la[st * 64 + sc4] = ra; *(f32x4*)&lb[st * 64 + sc4] = rb; }
        __syncthreads();
        if (tile + 1 < NTILES) SSD_LOAD(tile + 1);
        ssd_core(qs, ks, vs, as, la, lb, lo, yp, S0, S1, S2, S3, hl, tid, p, sl, dsk, true);
        __syncthreads();
#pragma unroll
        for (int j = 0; j < 4; ++j) {
            const int idx = tid + 512 * j, t = idx >> 6, pp = idx & 63;
            const f32x4 a0 = *(const f32x4*)&yp[t * 512 + pp * 8], a1 = *(const f32x4*)&yp[t * 512 + pp * 8 + 4];
            const int row = scan_row(b, d, tile * 32 + t);
            YD[((size_t)(0 * 2 + d) * MALL + row) * 512 + h * 64 + pp] = ((a0.x + a0.y) + (a0.z + a0.w)) + ((a1.x + a1.y) + (a1.z + a1.w));
            YD[((size_t)(1 * 2 + d) * MALL + row) * 512 + h * 64 + pp] = lo[t * 64 + pp];
        }
    }
#undef SSD_LOAD
}
__device__ __forceinline__ void scan_ret(const Params& P, float* L, int c) {
    const int tid = tid_(), b = c >> 4, h = (c >> 2) & 3, d = (c >> 1) & 1, vh = c & 1;
    const float* U = (const float*)(P.ws + WS_U); bf16* YD = (bf16*)(P.ws + WS_YD);
    float* qs = L; float* ks = L + 2048; float* vs = L + 4096; float* rope = L + 6400; float* yp = L + L_YP;
    const float a = 1.f - exp2f(-5.f - (float)h);
    const int st = tid >> 4, rem = tid & 15, sc4 = rem << 2, isk = rem >> 3, hs = (rem >> 2) & 1, cc = rem & 3, p = tid >> 3, sl = tid & 7;
    __syncthreads();
    for (int i = tid; i < 1024; i += 512) { const int pos = i >> 4, fi = i & 15; const float inv = exp2f(-(float)fi * 0.83048202372184f); const float rev = ((float)pos * inv) * 0.15915494309189535f;
        rope[2 * i] = __builtin_amdgcn_cosf(rev); rope[2 * i + 1] = __builtin_amdgcn_sinf(rev); }
    f32x2 S0 = {0.f, 0.f}, S1 = {0.f, 0.f}, S2 = {0.f, 0.f}, S3 = {0.f, 0.f};
    f32x4 r1, r2, rv;
    const int qkbase = (isk ? U_RT_K : U_RT_Q) + h * 64 + hs * 32 + 4 * cc;
#define RET_LOAD(tile) do { const float* ur_ = U + (size_t)scan_row(b, d, (tile) * 32 + st) * NINP; r1 = *(const f32x4*)(ur_ + qkbase); r2 = *(const f32x4*)(ur_ + qkbase + 16); \
        rv = *(const f32x4*)(ur_ + U_RT_V + h * 128 + vh * 64 + sc4); } while (0)
    RET_LOAD(0);
    for (int tile = 0; tile < NTILES; ++tile) {
        { f32x4 o1 = r1, o2 = r2;
          if (tile >= TC / 32) {
              const int tok = scan_row(b, d, tile * 32 + st) & (TL - 1); const int pos = hs ? (tok & 63) : (tok >> 6);
              const f32x4 cs0 = *(const f32x4*)&rope[(pos * 16 + 4 * cc) * 2], cs1 = *(const f32x4*)&rope[(pos * 16 + 4 * cc) * 2 + 4];
              const f32x4 cv = {cs0.x, cs0.z, cs1.x, cs1.z}, sv = {cs0.y, cs0.w, cs1.y, cs1.w};
              o1 = r1 * cv - r2 * sv; o2 = r1 * sv + r2 * cv;
          }
          float* dst = isk ? ks : qs; const float scl = isk ? 0.125f : 1.f;
          *(f32x4*)&dst[st * 64 + hs * 32 + 4 * cc] = o1 * scl; *(f32x4*)&dst[st * 64 + hs * 32 + 16 + 4 * cc] = o2 * scl;
          *(f32x4*)&vs[st * 64 + sc4] = rv; }
        __syncthreads();
        if (tile + 1 < NTILES) RET_LOAD(tile + 1);
        { float hl_ = 0.f; ssd_core(qs, ks, vs, vs, vs, vs, yp, yp, S0, S1, S2, S3, hl_, tid, p, sl, a, false); }
        __syncthreads();
#pragma unroll
        for (int j = 0; j < 4; ++j) {
            const int idx = tid + 512 * j, t = idx >> 6, pp = idx & 63;
            const f32x4 a0 = *(const f32x4*)&yp[t * 512 + pp * 8], a1 = *(const f32x4*)&yp[t * 512 + pp * 8 + 4];
            const int row = scan_row(b, d, tile * 32 + t);
            YD[((size_t)(3 * 2 + d) * MALL + row) * 512 + h * 128 + vh * 64 + pp] = ((a0.x + a0.y) + (a0.z + a0.w)) + ((a1.x + a1.y) + (a1.z + a1.w));
        }
    }
#undef RET_LOAD
}
__device__ __forceinline__ void scan_hgrn(const Params& P, float* L, int l, int c) {
    const int tid = tid_(), b = c >> 5, h = (c >> 3) & 3, d = (c >> 2) & 1, vq = c & 3;
    const float* U = (const float*)(P.ws + WS_U); bf16* YD = (bf16*)(P.ws + WS_YD);
    float* qs = L; float* fs = L + 4096; float* vs = L + 8192; float* yp = L + L_YP;
    const int st = tid >> 5, sc4 = (tid & 31) << 2, p = tid >> 4, sl = tid & 15;
    f32x4 lbv = {0.f, 0.f, 0.f, 0.f};
    if (l == 1) { const f32x4 g0 = *(const f32x4*)(P.hgrn_lb_logits + (size_t)(d * 2 + 0) * 512 + h * 128 + sc4), g1 = *(const f32x4*)(P.hgrn_lb_logits + (size_t)(d * 2 + 1) * 512 + h * 128 + sc4);
        lbv.x = sigmoid_(g1.x - g0.x); lbv.y = sigmoid_(g1.y - g0.y); lbv.z = sigmoid_(g1.z - g0.z); lbv.w = sigmoid_(g1.w - g0.w); }
    f32x2 S0 = {0.f, 0.f}, S1 = {0.f, 0.f}, S2 = {0.f, 0.f}, S3 = {0.f, 0.f};
    f32x4 rq0, rq1, rf0, rf1, rv = {0.f, 0.f, 0.f, 0.f};
#define HG_LOAD(tile) do { const float* u0_ = U + (size_t)scan_row(b, d, (tile) * 32 + st) * NINP; const float* u1_ = U + (size_t)scan_row(b, d, (tile) * 32 + st + 16) * NINP; \
        rq0 = *(const f32x4*)(u0_ + U_HG_Q + h * 128 + sc4); rq1 = *(const f32x4*)(u1_ + U_HG_Q + h * 128 + sc4); \
        rf0 = *(const f32x4*)(u0_ + U_HG_F + d * 512 + h * 128 + sc4); rf1 = *(const f32x4*)(u1_ + U_HG_F + d * 512 + h * 128 + sc4); \
        if (tid < 256) rv = *(const f32x4*)(U + (size_t)scan_row(b, d, (tile) * 32 + (tid >> 3)) * NINP + U_HG_I + h * 128 + vq * 32 + ((tid & 7) << 2)); } while (0)
    __syncthreads();
    HG_LOAD(0);
    for (int tile = 0; tile < NTILES; ++tile) {
        { f32x4 q, f;
#pragma unroll
          for (int e = 0; e < 4; ++e) { q[e] = silu_(rq0[e]) * 0.08838834764831845f; f[e] = lbv[e] + (1.f - lbv[e]) * sigmoid_(rf0[e]); }
          *(f32x4*)&qs[st * 128 + sc4] = q; *(f32x4*)&fs[st * 128 + sc4] = f;
#pragma unroll
          for (int e = 0; e < 4; ++e) { q[e] = silu_(rq1[e]) * 0.08838834764831845f; f[e] = lbv[e] + (1.f - lbv[e]) * sigmoid_(rf1[e]); }
          *(f32x4*)&qs[(st + 16) * 128 + sc4] = q; *(f32x4*)&fs[(st + 16) * 128 + sc4] = f;
          if (tid < 256) *(f32x4*)&vs[(tid >> 3) * 32 + ((tid & 7) << 2)] = rv; }
        __syncthreads();
        if (tile + 1 < NTILES) HG_LOAD(tile + 1);
        hgrn_core(qs, fs, vs, yp, S0, S1, S2, S3, tid, p, sl);
        __syncthreads();
#pragma unroll
        for (int j = 0; j < 2; ++j) {
            const int idx = tid + 512 * j, t = idx >> 5, pp = idx & 31;
            const f32x4 a0 = *(const f32x4*)&yp[t * 512 + pp * 16], a1 = *(const f32x4*)&yp[t * 512 + pp * 16 + 4], a2 = *(const f32x4*)&yp[t * 512 + pp * 16 + 8], a3 = *(const f32x4*)&yp[t * 512 + pp * 16 + 12];
            const int row = scan_row(b, d, tile * 32 + t);
            YD[((size_t)(2 * 2 + d) * MALL + row) * 512 + h * 128 + vq * 32 + pp] =
                (((a0.x + a0.y) + (a0.z + a0.w)) + ((a1.x + a1.y) + (a1.z + a1.w))) + (((a2.x + a2.y) + (a2.z + a2.w)) + ((a3.x + a3.y) + (a3.z + a3.w)));
        }
    }
#undef HG_LOAD
}

typedef __bf16 bf16x2_n __attribute__((ext_vector_type(2)));
__device__ __forceinline__ unsigned cvtpk(float lo, float hi) { f32x2 v = {lo, hi}; bf16x2_n b = __builtin_convertvector(v, bf16x2_n); return __builtin_bit_cast(unsigned, b); }
template <int KD, int VN> struct ChunkLds {
    static constexpr int PQ = (KD + 8) * 2;
    static constexpr int PT = 80;
    static constexpr int KM = 0, QM = KM + 16 * PQ, QE = QM + 16 * PQ, KWT = QE + 16 * PQ, G = KWT + KD * PT, VT = G + KD * 4, SIZE = VT + VN * PT;
};
template <int KD, int VN>
__device__ __forceinline__ f32x4 chunk_step(const unsigned char* C, int v0, int fr, int fq, f32x4 (&S)[KD / 16]) {
    using CL = ChunkLds<KD, VN>;
    f32x4 mt = {0.f, 0.f, 0.f, 0.f}, mt1 = {0.f, 0.f, 0.f, 0.f};
#pragma unroll
    for (int ks = 0; ks < KD / 32; ks += 2) {
        const bf16x8_t a = *(const bf16x8_t*)(C + CL::KM + fr * CL::PQ + (32 * ks + 8 * fq) * 2);
        const bf16x8_t b = *(const bf16x8_t*)(C + CL::QM + fr * CL::PQ + (32 * ks + 8 * fq) * 2);
        mt = __builtin_amdgcn_mfma_f32_16x16x32_bf16(a, b, mt, 0, 0, 0);
        const bf16x8_t a1 = *(const bf16x8_t*)(C + CL::KM + fr * CL::PQ + (32 * ks + 32 + 8 * fq) * 2);
        const bf16x8_t b1 = *(const bf16x8_t*)(C + CL::QM + fr * CL::PQ + (32 * ks + 32 + 8 * fq) * 2);
        mt1 = __builtin_amdgcn_mfma_f32_16x16x32_bf16(a1, b1, mt1, 0, 0, 0);
    }
    mt += mt1;
#pragma unroll
    for (int j = 0; j < 4; ++j) if (4 * fq + j > fr) mt[j] = 0.f;
    u32x4 bw; bw.x = cvtpk(mt[0], mt[1]); bw.y = cvtpk(mt[2], mt[3]); bw.z = 0u; bw.w = 0u;
    const u32x2 va = *(const u32x2*)(C + CL::VT + (v0 + fr) * CL::PT + (4 * fq) * 2);
    u32x4 aw; aw.x = va.x; aw.y = va.y; aw.z = 0u; aw.w = 0u;
    f32x4 yi = __builtin_amdgcn_mfma_f32_16x16x32_bf16(__builtin_bit_cast(bf16x8_t, aw), __builtin_bit_cast(bf16x8_t, bw), (f32x4){0.f, 0.f, 0.f, 0.f}, 0, 0, 0);
    f32x4 y = {0.f, 0.f, 0.f, 0.f};
#pragma unroll
    for (int i = 0; i < KD / 32; ++i) {
        u32x4 sa; sa.x = cvtpk(S[2 * i][0], S[2 * i][1]); sa.y = cvtpk(S[2 * i][2], S[2 * i][3]); sa.z = cvtpk(S[2 * i + 1][0], S[2 * i + 1][1]); sa.w = cvtpk(S[2 * i + 1][2], S[2 * i + 1][3]);
        const u32x2 lo = *(const u32x2*)(C + CL::QE + fr * CL::PQ + (32 * i + 4 * fq) * 2), hi = *(const u32x2*)(C + CL::QE + fr * CL::PQ + (32 * i + 16 + 4 * fq) * 2);
        u32x4 qb; qb.x = lo.x; qb.y = lo.y; qb.z = hi.x; qb.w = hi.y;
        y = __builtin_amdgcn_mfma_f32_16x16x32_bf16(__builtin_bit_cast(bf16x8_t, sa), __builtin_bit_cast(bf16x8_t, qb), y, 0, 0, 0);
    }
    y += yi;
    const bf16x8_t bv = *(const bf16x8_t*)(C + CL::VT + (v0 + fr) * CL::PT + (8 * fq) * 2);
#pragma unroll
    for (int i = 0; i < KD / 16; ++i) {
        const f32x4 g4 = *(const f32x4*)(C + CL::G + (16 * i + 4 * fq) * 4);
        const bf16x8_t ak = *(const bf16x8_t*)(C + CL::KWT + (16 * i + fr) * CL::PT + (8 * fq) * 2);
        S[i] = __builtin_amdgcn_mfma_f32_16x16x32_bf16(ak, bv, S[i] * g4, 0, 0, 0);
    }
    return y;
}
template <int KD, int VN, bool LVEC>
__device__ __forceinline__ void build_operands(const float* __restrict__ rq, const float* __restrict__ rk, const float* __restrict__ rL, const float* __restrict__ rv, unsigned char* __restrict__ OP, int t0, int nthr) {
    using CL = ChunkLds<KD, VN>;
    for (int idx = t0; idx < 8 * KD; idx += nthr) {
        const int kq = idx % (KD / 4), t = (idx / (KD / 4)) & 15, c = idx / (4 * KD), k = 4 * kq, row = c * 16 + t;
        const f32x4 q4 = *(const f32x4*)&rq[row * KD + k], k4 = *(const f32x4*)&rk[row * KD + k];
        f32x4 Lt, Lm;
        if (LVEC) { Lt = *(const f32x4*)&rL[row * KD + k]; Lm = *(const f32x4*)&rL[(c * 16 + 7) * KD + k]; } else { const float a_ = rL[row], b_ = rL[c * 16 + 7]; Lt = (f32x4){a_, a_, a_, a_}; Lm = (f32x4){b_, b_, b_, b_}; }
        f32x4 qe, qm, km;
#pragma unroll
        for (int e = 0; e < 4; ++e) { qe[e] = q4[e] * __expf(Lt[e]); qm[e] = q4[e] * __expf(fminf(Lt[e] - Lm[e], 80.f)); km[e] = k4[e] * __expf(fminf(Lm[e] - Lt[e], 80.f)); }
        unsigned char* base = OP + c * CL::SIZE + t * CL::PQ + k * 2;
        u32x2 w; w.x = cvtpk(qe[0], qe[1]); w.y = cvtpk(qe[2], qe[3]); *(u32x2*)(base + CL::QE) = w;
        w.x = cvtpk(qm[0], qm[1]); w.y = cvtpk(qm[2], qm[3]); *(u32x2*)(base + CL::QM) = w;
        w.x = cvtpk(km[0], km[1]); w.y = cvtpk(km[2], km[3]); *(u32x2*)(base + CL::KM) = w;
    }
    for (int idx = t0; idx < 4 * KD; idx += nthr) {
        const int k = idx % KD, oc = (idx / KD) & 1, c = idx / (2 * KD);
        const float Le = LVEC ? rL[(c * 16 + 15) * KD + k] : rL[c * 16 + 15];
        float w[8];
#pragma unroll
        for (int e = 0; e < 8; ++e) { const int row = c * 16 + 8 * oc + e; const float Lt = LVEC ? rL[row * KD + k] : rL[row]; w[e] = rk[row * KD + k] * __expf(Le - Lt); }
        u32x4 o; o.x = cvtpk(w[0], w[1]); o.y = cvtpk(w[2], w[3]); o.z = cvtpk(w[4], w[5]); o.w = cvtpk(w[6], w[7]);
        *(u32x4*)(OP + c * CL::SIZE + CL::KWT + k * CL::PT + oc * 16) = o;
        if (oc == 0) *(float*)(OP + c * CL::SIZE + CL::G + k * 4) = __expf(Le);
    }
    for (int idx = t0; idx < 4 * VN; idx += nthr) {
        const int v = idx % VN, oc = (idx / VN) & 1, c = idx / (2 * VN);
        float w[8];
#pragma unroll
        for (int e = 0; e < 8; ++e) w[e] = rv[(c * 16 + 8 * oc + e) * VN + v];
        u32x4 o; o.x = cvtpk(w[0], w[1]); o.y = cvtpk(w[2], w[3]); o.z = cvtpk(w[4], w[5]); o.w = cvtpk(w[6], w[7]);
        *(u32x4*)(OP + c * CL::SIZE + CL::VT + v * CL::PT + oc * 16) = o;
    }
}
template <int KD, int VN>
__device__ __forceinline__ void zero_operand_pads(unsigned char* OP, int t0, int nthr) {
    using CL = ChunkLds<KD, VN>;
    for (int idx = t0; idx < 2 * (KD + VN) * 2; idx += nthr) {
        const int half = idx & 1, r = (idx >> 1) % (KD + VN), c = (idx >> 1) / (KD + VN);
        unsigned char* row = OP + c * CL::SIZE + (r < KD ? CL::KWT + r * CL::PT : CL::VT + (r - KD) * CL::PT);
        *(u32x4*)(row + 32 + half * 16) = (u32x4){0u, 0u, 0u, 0u};
    }
}
constexpr int L_RAW_Q = 0, L_RAW_K = 16384, L_RAW_L = 32768, L_RAW_V = 49152, L_OP = 65536;

__device__ __forceinline__ void scan_ret_mfma(const Params& P, unsigned char* LB, int c) {
    const int tid = tid_(), lane = tid & 63, wave = __builtin_amdgcn_readfirstlane(tid >> 6), fr = lane & 15, fq = lane >> 4;
    const int vh = c & 1, b = c >> 4, h = (c >> 2) & 3, d = (c >> 1) & 1;
    const float* U = (const float*)(P.ws + WS_U); bf16* YD = (bf16*)(P.ws + WS_YD);
    float* rq = (float*)(LB + L_RAW_Q); float* rk = (float*)(LB + L_RAW_K); float* rL = (float*)(LB + L_RAW_L); float* rv = (float*)(LB + L_RAW_V);
    float* rope = (float*)(LB + L_RAW_L + 1024);
    unsigned char* OP = LB + L_OP;
    const float la = __logf(1.f - exp2f(-5.f - (float)h));
    const int st = tid >> 4, rem = tid & 15, isk = rem >> 3, hs = (rem >> 2) & 1, cc = rem & 3;
    __syncthreads();
    for (int i = tid; i < 1024; i += 512) { const int pos = i >> 4, fi = i & 15; const float inv = exp2f(-(float)fi * 0.83048202372184f); const float rev = ((float)pos * inv) * 0.15915494309189535f;
        rope[2 * i] = __builtin_amdgcn_cosf(rev); rope[2 * i + 1] = __builtin_amdgcn_sinf(rev); }
    if (tid < 32) rL[tid] = (float)((tid & 15) + 1) * la;
    zero_operand_pads<64, 64>(OP, tid, 512);
    f32x4 S[4];
#pragma unroll
    for (int i = 0; i < 4; ++i) S[i] = (f32x4){0.f, 0.f, 0.f, 0.f};
    f32x4 r1, r2, rv0;
    const int qkbase = (isk ? U_RT_K : U_RT_Q) + h * 64 + hs * 32 + 4 * cc;
#define RETM_LOAD(tile) do { const float* ur_ = U + (size_t)scan_row(b, d, (tile) * 32 + st) * NINP; r1 = *(const f32x4*)(ur_ + qkbase); r2 = *(const f32x4*)(ur_ + qkbase + 16); \
        rv0 = *(const f32x4*)(ur_ + U_RT_V + h * 128 + vh * 64 + rem * 4); } while (0)
    RETM_LOAD(0);
    for (int tile = 0; tile < NTILES; ++tile) {
        { f32x4 o1 = r1, o2 = r2;
          if (tile >= TC / 32) {
              const int tok = scan_row(b, d, tile * 32 + st) & (TL - 1); const int pos = hs ? (tok & 63) : (tok >> 6);
              const f32x4 cs0 = *(const f32x4*)&rope[(pos * 16 + 4 * cc) * 2], cs1 = *(const f32x4*)&rope[(pos * 16 + 4 * cc) * 2 + 4];
              const f32x4 cv = {cs0.x, cs0.z, cs1.x, cs1.z}, sv = {cs0.y, cs0.w, cs1.y, cs1.w};
              o1 = r1 * cv - r2 * sv; o2 = r1 * sv + r2 * cv;
          }
          float* dst = isk ? rk : rq; const float scl = isk ? 0.125f : 1.f;
          *(f32x4*)&dst[st * 64 + hs * 32 + 4 * cc] = o1 * scl; *(f32x4*)&dst[st * 64 + hs * 32 + 16 + 4 * cc] = o2 * scl;
          *(f32x4*)&rv[st * 64 + rem * 4] = rv0; }
        __syncthreads();
        if (tile + 1 < NTILES) RETM_LOAD(tile + 1);
        build_operands<64, 64, false>(rq, rk, rL, rv, OP, tid, 512);
        __syncthreads();
        if (wave < 4) {
#pragma unroll
        for (int ch = 0; ch < 2; ++ch) {
            const f32x4 y = chunk_step<64, 64>(OP + ch * ChunkLds<64, 64>::SIZE, wave * 16, fr, fq, S);
            const int row = scan_row(b, d, tile * 32 + ch * 16 + fr);
            { u32x2 w_; w_.x = cvtpk(y[0], y[1]); w_.y = cvtpk(y[2], y[3]); *(u32x2*)(YD + ((size_t)(3 * 2 + d) * MALL + row) * 512 + h * 128 + vh * 64 + wave * 16 + 4 * fq) = w_; }
        }
        }
    }
#undef RETM_LOAD
}

__device__ __forceinline__ void scan_hgrn_mfma(const Params& P, unsigned char* LB, int l, int c) {
    using CL = ChunkLds<128, 64>;
    const int tid = tid_(), lane = tid & 63, wave = __builtin_amdgcn_readfirstlane(tid >> 6), fr = lane & 15, fq = lane >> 4;
    const int vq = c & 1, b = c >> 4, h = (c >> 2) & 3, d = (c >> 1) & 1;
    const float* U = (const float*)(P.ws + WS_U); bf16* YD = (bf16*)(P.ws + WS_YD);
    unsigned char* OP = LB;
    float* tot = (float*)(LB + 58368);
    const int k = 2 * lane, qt = wave & 3, cb = wave >> 2;
    const int vv_ = tid & 63, vqt = wave & 3, vc = wave >> 2;
    f32x2 lb2 = {0.f, 0.f};
    if (l == 1) { const f32x2 g0 = *(const f32x2*)(P.hgrn_lb_logits + (size_t)(d * 2 + 0) * 512 + h * 128 + k), g1 = *(const f32x2*)(P.hgrn_lb_logits + (size_t)(d * 2 + 1) * 512 + h * 128 + k);
        lb2.x = sigmoid_(g1.x - g0.x); lb2.y = sigmoid_(g1.y - g0.y); }
    __syncthreads();
    zero_operand_pads<128, 64>(OP, tid, 512);
    f32x4 S[8];
#pragma unroll
    for (int i = 0; i < 8; ++i) S[i] = (f32x4){0.f, 0.f, 0.f, 0.f};
    f32x2 pq[4], pf[4]; float pv[4] = {0.f, 0.f, 0.f, 0.f};
#define HGM_LOAD(tile) do { _Pragma("unroll") for (int r_ = 0; r_ < 4; ++r_) { const float* u_ = U + (size_t)scan_row(b, d, (tile) * 32 + cb * 16 + qt * 4 + r_) * NINP; \
        pq[r_] = *(const f32x2*)(u_ + U_HG_Q + h * 128 + k); pf[r_] = *(const f32x2*)(u_ + U_HG_F + d * 512 + h * 128 + k); } \
        { _Pragma("unroll") for (int r_ = 0; r_ < 4; ++r_) pv[r_] = U[(size_t)scan_row(b, d, (tile) * 32 + vc * 16 + vqt * 4 + r_) * NINP + U_HG_I + h * 128 + vq * 64 + vv_]; } } while (0)
    HGM_LOAD(0);
    for (int tile = 0; tile < NTILES; ++tile) {
        f32x2 q[4], kk[4], pre[4], suf[4]; float vv[4];
        { f32x2 fc[4];
#pragma unroll
          for (int r = 0; r < 4; ++r) {
              const float eq0 = 1.f + __expf(fminf(-pq[r].x, 40.f)), ef0 = 1.f + __expf(fminf(-pf[r].x, 40.f)), r0_ = __builtin_amdgcn_rcpf(eq0 * ef0);
              const float eq1 = 1.f + __expf(fminf(-pq[r].y, 40.f)), ef1 = 1.f + __expf(fminf(-pf[r].y, 40.f)), r1_ = __builtin_amdgcn_rcpf(eq1 * ef1);
              q[r].x = pq[r].x * (ef0 * r0_) * 0.08838834764831845f; q[r].y = pq[r].y * (ef1 * r1_) * 0.08838834764831845f;
              const float f0 = lb2.x + (1.f - lb2.x) * (eq0 * r0_), f1 = lb2.y + (1.f - lb2.y) * (eq1 * r1_);
              kk[r].x = 1.f - f0; kk[r].y = 1.f - f1; fc[r].x = fmaxf(f0, 1e-4f); fc[r].y = fmaxf(f1, 1e-4f); vv[r] = pv[r];
          }
          pre[0] = fc[0]; pre[1] = pre[0] * fc[1]; pre[2] = pre[1] * fc[2]; pre[3] = pre[2] * fc[3];
          suf[3] = (f32x2){1.f, 1.f}; suf[2] = fc[3]; suf[1] = suf[2] * fc[2]; suf[0] = suf[1] * fc[1]; }
        *(f32x2*)&tot[(cb * 4 + qt) * 128 + k] = pre[3];
        __syncthreads();
        if (tile + 1 < NTILES) HGM_LOAD(tile + 1);
        {
            const f32x2 t0 = *(const f32x2*)&tot[(cb * 4 + 0) * 128 + k], t1 = *(const f32x2*)&tot[(cb * 4 + 1) * 128 + k], t2 = *(const f32x2*)&tot[(cb * 4 + 2) * 128 + k], t3 = *(const f32x2*)&tot[(cb * 4 + 3) * 128 + k];
            const f32x2 Pm = t0 * t1, T23 = t2 * t3;
            unsigned char* C = OP + cb * CL::SIZE;
            float kw0[4], kw1[4];
#pragma unroll
            for (int r = 0; r < 4; ++r) {
                const int t = qt * 4 + r;
                f32x2 R, iR;
                if (qt >= 2) { R = pre[r]; if (qt == 3) R *= t2; iR.x = __builtin_amdgcn_rcpf(R.x); iR.y = __builtin_amdgcn_rcpf(R.y); }
                else { iR = suf[r]; if (qt == 0) iR *= t1; R.x = __builtin_amdgcn_rcpf(iR.x); R.y = __builtin_amdgcn_rcpf(iR.y); }
                const f32x2 Pt = Pm * R;
                unsigned char* p = C + t * CL::PQ + k * 2;
                *(unsigned*)(p + CL::QE) = cvtpk(q[r].x * Pt.x, q[r].y * Pt.y);
                *(unsigned*)(p + CL::QM) = cvtpk(q[r].x * R.x, q[r].y * R.y);
                *(unsigned*)(p + CL::KM) = cvtpk(kk[r].x * iR.x, kk[r].y * iR.y);
                kw0[r] = kk[r].x * T23.x * iR.x; kw1[r] = kk[r].y * T23.y * iR.y;
            }
            u32x2 w; w.x = cvtpk(kw0[0], kw0[1]); w.y = cvtpk(kw0[2], kw0[3]); *(u32x2*)(C + CL::KWT + k * CL::PT + qt * 8) = w;
            w.x = cvtpk(kw1[0], kw1[1]); w.y = cvtpk(kw1[2], kw1[3]); *(u32x2*)(C + CL::KWT + (k + 1) * CL::PT + qt * 8) = w;
            if (qt == 0) *(f32x2*)(C + CL::G + k * 4) = Pm * T23;
            { u32x2 wv; wv.x = cvtpk(vv[0], vv[1]); wv.y = cvtpk(vv[2], vv[3]); *(u32x2*)(OP + vc * CL::SIZE + CL::VT + vv_ * CL::PT + vqt * 8) = wv; }
        }
        __syncthreads();
        if (wave < 4) {
#pragma unroll
            for (int ch = 0; ch < 2; ++ch) {
                const f32x4 y = chunk_step<128, 64>(OP + ch * CL::SIZE, wave * 16, fr, fq, S);
                const int row = scan_row(b, d, tile * 32 + ch * 16 + fr);
                { u32x2 w_; w_.x = cvtpk(y[0], y[1]); w_.y = cvtpk(y[2], y[3]); *(u32x2*)(YD + ((size_t)(2 * 2 + d) * MALL + row) * 512 + h * 128 + vq * 64 + wave * 16 + 4 * fq) = w_; }
            }
        }
    }
#undef HGM_LOAD
}
__device__ __forceinline__ void scan_ssd_mfma(const Params& P, unsigned char* LB, int l, int c) {
    const int tid = tid_(), lane = tid & 63, wave = __builtin_amdgcn_readfirstlane(tid >> 6), fr = lane & 15, fq = lane >> 4;
    const int b = c >> 4, d = (c >> 3) & 1, h = c & 7, g = h >> 2;
    const float* U = (const float*)(P.ws + WS_U); const bf16* XBC = (const bf16*)(P.ws + WS_XBC); bf16* YD = (bf16*)(P.ws + WS_YD);
    float* rq = (float*)(LB + L_RAW_Q); float* rk = (float*)(LB + L_RAW_K); float* rL = (float*)(LB + L_RAW_L); float* lg = (float*)(LB + L_RAW_L + 256); float* rv = (float*)(LB + L_RAW_V);
    unsigned char* OP = LB + L_OP;
    const float dtb = P.ssd_dt_bias[(l * 2 + d) * 8 + h], aneg = -__expf(P.ssd_a_log[(l * 2 + d) * 8 + h]);
    const int st = tid >> 4, sc4 = (tid & 15) << 2;
    __syncthreads();
    zero_operand_pads<64, 64>(OP, tid, 512);
    f32x4 S[4];
#pragma unroll
    for (int i = 0; i < 4; ++i) S[i] = (f32x4){0.f, 0.f, 0.f, 0.f};
    f32x4 px, pB, pC; float pdt;
#define SSM_LOAD(tile) do { const int row_ = scan_row(b, d, (tile) * 32 + st); const bf16* xr_ = XBC + (size_t)row_ * 768; \
        px = ld_bf4(xr_ + h * 64 + sc4); pB = ld_bf4(xr_ + 512 + g * 64 + sc4); pC = ld_bf4(xr_ + 640 + g * 64 + sc4); pdt = U[(size_t)row_ * NINP + U_SSD_DT + d * 8 + h]; } while (0)
    SSM_LOAD(0);
    for (int tile = 0; tile < NTILES; ++tile) {
        { const float delta = softplus_(pdt + dtb); const int o = st * 64 + sc4;
          *(f32x4*)&rv[o] = px; *(f32x4*)&rk[o] = pB * delta; *(f32x4*)&rq[o] = pC;
          if ((tid & 15) == 0) lg[st] = aneg * delta; }
        __syncthreads();
        if (tile + 1 < NTILES) SSM_LOAD(tile + 1);
        if (tid < 32) { const int c0 = tid & 16; float acc = 0.f;
#pragma unroll
            for (int t = 0; t < 16; ++t) { const float v_ = lg[c0 + t]; acc += (c0 + t <= tid) ? v_ : 0.f; }
            rL[tid] = acc; }
        __syncthreads();
        build_operands<64, 64, false>(rq, rk, rL, rv, OP, tid, 512);
        __syncthreads();
        if (wave < 4) {
#pragma unroll
            for (int ch = 0; ch < 2; ++ch) {
                const f32x4 y = chunk_step<64, 64>(OP + ch * ChunkLds<64, 64>::SIZE, wave * 16, fr, fq, S);
                const int row = scan_row(b, d, tile * 32 + ch * 16 + fr);
                { u32x2 w_; w_.x = cvtpk(y[0], y[1]); w_.y = cvtpk(y[2], y[3]); *(u32x2*)(YD + ((size_t)(0 * 2 + d) * MALL + row) * 512 + h * 64 + wave * 16 + 4 * fq) = w_; }
            }
        }
    }
#undef SSM_LOAD
}
__device__ __forceinline__ void scan_lru(const Params& P, float* L, int c) {
    const int tid = tid_(), ch = tid & 63, seg = __builtin_amdgcn_readfirstlane(tid >> 6), b = c >> 3, d = (c >> 2) & 1, cgp = c & 3;
    const bf16* LA = (const bf16*)(P.ws + WS_LA) + (size_t)d * MALL * 512 + cgp * 128 + ch; const bf16* LBp = (const bf16*)(P.ws + WS_LB) + (size_t)d * MALL * 512 + cgp * 128 + ch;
    bf16* YD = (bf16*)(P.ws + WS_YD) + (size_t)(1 * 2 + d) * MALL * 512 + cgp * 128 + ch;
    float* car = L;
    const int s0 = seg * 288;
    __syncthreads();
    float h0 = 0.f, h1 = 0.f, ap0 = 1.f, ap1 = 1.f;
#pragma unroll 1
    for (int pass = 0; pass < 2; ++pass) {
        float a0[16], b0[16], c0[16], d0[16];
#pragma unroll
        for (int s = 0; s < 16; ++s) { const size_t r = (size_t)scan_row(b, d, s0 + s) * 512; a0[s] = 1.f - __builtin_bit_cast(float, (unsigned)LA[r] << 16); b0[s] = __builtin_bit_cast(float, (unsigned)LBp[r] << 16); c0[s] = 1.f - __builtin_bit_cast(float, (unsigned)LA[r + 64] << 16); d0[s] = __builtin_bit_cast(float, (unsigned)LBp[r + 64] << 16); }
#pragma unroll 1
        for (int tile = 0; tile < 18; ++tile) {
            float a1[16], b1[16], c1[16], d1[16];
            if (tile + 1 < 18) {
#pragma unroll
                for (int s = 0; s < 16; ++s) { const size_t r = (size_t)scan_row(b, d, s0 + (tile + 1) * 16 + s) * 512; a1[s] = 1.f - __builtin_bit_cast(float, (unsigned)LA[r] << 16); b1[s] = __builtin_bit_cast(float, (unsigned)LBp[r] << 16); c1[s] = 1.f - __builtin_bit_cast(float, (unsigned)LA[r + 64] << 16); d1[s] = __builtin_bit_cast(float, (unsigned)LBp[r + 64] << 16); }
            }
            if (pass == 0) {
#pragma unroll
                for (int s = 0; s < 16; ++s) { h0 = a0[s] * h0 + b0[s]; ap0 *= a0[s]; h1 = c0[s] * h1 + d0[s]; ap1 *= c0[s]; }
            } else {
#pragma unroll
                for (int s = 0; s < 16; ++s) { h0 = a0[s] * h0 + b0[s]; h1 = c0[s] * h1 + d0[s]; const size_t r = (size_t)scan_row(b, d, s0 + tile * 16 + s) * 512; YD[r] = (bf16)f2bf(h0); YD[r + 64] = (bf16)f2bf(h1); }
            }
#pragma unroll
            for (int s = 0; s < 16; ++s) { a0[s] = a1[s]; b0[s] = b1[s]; c0[s] = c1[s]; d0[s] = d1[s]; }
        }
        if (pass == 0) {
            car[(seg * 128 + ch) * 2] = ap0; car[(seg * 128 + ch) * 2 + 1] = h0; car[(seg * 128 + 64 + ch) * 2] = ap1; car[(seg * 128 + 64 + ch) * 2 + 1] = h1;
            __syncthreads();
            float hin0 = 0.f, hin1 = 0.f;
            for (int sg = 0; sg < seg; ++sg) { hin0 = car[(sg * 128 + ch) * 2] * hin0 + car[(sg * 128 + ch) * 2 + 1]; hin1 = car[(sg * 128 + 64 + ch) * 2] * hin1 + car[(sg * 128 + 64 + ch) * 2 + 1]; }
            h0 = hin0; h1 = hin1;
        }
    }
}
__device__ __forceinline__ void scan_phase(const Params& P, float* L, int l) {
    for (int it = bid_(); it < 224; it += gridDim.x) {
        if (it < 64) scan_hgrn_mfma(P, (unsigned char*)L, l, it);
        else if (it < 128) scan_ssd_mfma(P, (unsigned char*)L, l, it - 64);
        else if (it < 192) scan_ret_mfma(P, (unsigned char*)L, it - 128);
        else scan_lru(P, L, it - 192);
    }
}

__device__ __forceinline__ void post_phase(const Params& P, int l, int mrows) {
    const int tid = tid_(), lane = tid & 63, wave = __builtin_amdgcn_readfirstlane(tid >> 6);
    const int gw = bid_() * 8 + wave, NGW = gridDim.x * 8;
    const float* U = (const float*)(P.ws + WS_U); const bf16* YD = (const bf16*)(P.ws + WS_YD); bf16* YC = (bf16*)(P.ws + WS_H);
    for (int row = gw; row < mrows; row += NGW) {
        const float* ur = U + (size_t)row * NINP; bf16* yc = YC + (size_t)row * DM;
#define YDP(m, d) (YD + ((size_t)((m) * 2 + (d)) * MALL + row) * 512)
#define LDY(p) ld_bf4(p)
        {
            f32x4 gg[2]; float ss = 0.f;
#pragma unroll
            for (int j = 0; j < 2; ++j) { const int c = 4 * lane + 256 * j; const float dsk = P.ssd_d[l * 8 + (c >> 6)]; const f32x4 y = LDY(YDP(0, 0) + c) + LDY(YDP(0, 1) + c) + ld_bf4((const bf16*)(P.ws + WS_XBC) + (size_t)row * 768 + c) * dsk; const f32x4 z = *(const f32x4*)(ur + c);
                f32x4 t; t.x = y.x * silu_(z.x); t.y = y.y * silu_(z.y); t.z = y.z * silu_(z.z); t.w = y.w * silu_(z.w); gg[j] = t; ss += dot4(t); }
            const float rs = rsqrtf(wave_sum(ss) * (1.f / 512.f) + EPS);
#pragma unroll
            for (int j = 0; j < 2; ++j) { const int c = 4 * lane + 256 * j; const f32x4 w = *(const f32x4*)(P.ssd_norm_w + (size_t)l * 512 + c); const f32x4 o = gg[j] * rs * w;
                u32x2 pk; pk.x = pk2(o.x, o.y); pk.y = pk2(o.z, o.w); *(u32x2*)(yc + c) = pk; }
        }
        {
#pragma unroll
            for (int j = 0; j < 2; ++j) { const int c = 4 * lane + 256 * j; const f32x4 hh = LDY(YDP(1, 0) + c) + LDY(YDP(1, 1) + c); const f32x4 gb = *(const f32x4*)(ur + U_LRU_G + c);
                f32x4 o; o.x = hh.x * gelu_tanh_(gb.x); o.y = hh.y * gelu_tanh_(gb.y); o.z = hh.z * gelu_tanh_(gb.z); o.w = hh.w * gelu_tanh_(gb.w);
                u32x2 pk; pk.x = pk2(o.x, o.y); pk.y = pk2(o.z, o.w); *(u32x2*)(yc + 512 + c) = pk; }
        }
        {
#pragma unroll
            for (int j = 0; j < 2; ++j) { const int c = 4 * lane + 256 * j; const f32x4 o = LDY(YDP(2, 0) + c) + LDY(YDP(2, 1) + c);
                const float rs = rsqrtf(half_sum(dot4(o)) * (1.f / 128.f) + EPS); const f32x4 w = *(const f32x4*)(P.hgrn_norm_w + (size_t)l * 128 + (c & 127)); const f32x4 gt = *(const f32x4*)(ur + U_HG_G + c);
                f32x4 r; r.x = o.x * rs * w.x * silu_(gt.x); r.y = o.y * rs * w.y * silu_(gt.y); r.z = o.z * rs * w.z * silu_(gt.z); r.w = o.w * rs * w.w * silu_(gt.w);
                u32x2 pk; pk.x = pk2(r.x, r.y); pk.y = pk2(r.z, r.w); *(u32x2*)(yc + 1024 + c) = pk; }
        }
        {
#pragma unroll
            for (int j = 0; j < 2; ++j) { const int c = 4 * lane + 256 * j; const f32x4 o = LDY(YDP(3, 0) + c) + LDY(YDP(3, 1) + c);
                const float rs = rsqrtf(half_sum(dot4(o)) * (1.f / 128.f) + EPS); const f32x4 gt = *(const f32x4*)(ur + U_RT_G + c);
                f32x4 r; r.x = o.x * rs * silu_(gt.x); r.y = o.y * rs * silu_(gt.y); r.z = o.z * rs * silu_(gt.z); r.w = o.w * rs * silu_(gt.w);
                u32x2 pk; pk.x = pk2(r.x, r.y); pk.y = pk2(r.z, r.w); *(u32x2*)(yc + 1536 + c) = pk; }
        }
#undef YDP
    }
}

__global__ void __launch_bounds__(512, 2) mk_fwd(Params Pkarg) {
    extern __shared__ __attribute__((aligned(16))) unsigned char lds_raw[];
    float* L = (float*)lds_raw;
    const __attribute__((address_space(4))) Params* kp = (const __attribute__((address_space(4))) Params*)__builtin_amdgcn_kernarg_segment_ptr();
    const int ph_lo = kp->ph_lo, ph_hi = kp->ph_hi;
    {
        volatile LAS unsigned* st0 = (volatile LAS unsigned*)((LAS unsigned char*)lds_raw + (LDS_BYTES - 128));
        if (threadIdx.x == 0) { st0[0] = 0u; st0[1] = 0u; }
        __syncthreads();
        (void)xcd_barrier_post((unsigned*)kp->ws, st0);
    }
    for (int ph = ph_lo; ph < ph_hi; ++ph) {
        asm volatile("" : "+s"(kp));
#if defined(__HIP_DEVICE_COMPILE__)
        const Params P = *kp;
#else
        const Params P = Pkarg;
#endif
        unsigned char* ws = P.ws;
#ifdef PROBE_DUP
        const int kk_ = ph < 2 ? 100 + ph : (ph - 2) % 12;
        const int nrep_ = (kk_ == PROBE_DUP || kk_ == PROBE_DUP2) ? 2 : 1;
        for (int rep_ = 0; rep_ < nrep_; ++rep_) { if (rep_) cg::this_grid().sync();
#endif
        if (ph == 0) prologue_phase(P, L);
        else if (ph == 1) rowwise_phase(P, MALL, true, 0, 0, 0, 0.f, false, 0, 0, 0, 1);
        else {
            const int q = ph - 2, l = q / 12, k = q % 12;
            const int Mg = (l == 1 && k >= 6) ? MLAT : MALL;
            if (k == 0 || k == 9) {
                const int lf = l * 2 + (k == 9);
                pg8::Gemm g{(const pg8::bf16_t*)(ws + WS_H), (const pg8::bf16_t*)(ws + WS_W13) + (size_t)lf * NUP * DM, Mg, NUP, DM, DM};
                pg8::StaticOrder S; S.init(Mg, NUP, (int)gridDim.x, bid_());
                pg8::EpiSwiGLU E{(pg8::bf16_t*)(ws + WS_U), FF};
                pg8::gemm_phase<pg8::EpiSwiGLU, pg8::StaticOrder, true, true>((LAS unsigned char*)lds_raw, g, S, E);
            } else if (k == 1 || k == 10 || k == 3 || k == 7) {
                const pg8::bf16_t* A; const pg8::bf16_t* Bt; int N, K; float* O;
                if (k == 3) { A = (const pg8::bf16_t*)(ws + WS_H); Bt = (const pg8::bf16_t*)(ws + WS_WIN) + (size_t)l * NINP * DM; N = NINP; K = DM; O = (float*)(ws + WS_U); }
                else if (k == 7) { A = (const pg8::bf16_t*)(ws + WS_H); Bt = (const pg8::bf16_t*)(ws + WS_WOUT) + (size_t)l * DM * DM; N = DM; K = DM; O = (float*)(ws + WS_Y); }
                else { const int lf = l * 2 + (k == 10); A = (const pg8::bf16_t*)(ws + WS_U); Bt = (const pg8::bf16_t*)(ws + WS_W2) + (size_t)lf * DM * FF; N = DM; K = FF; O = (float*)(ws + WS_Y); }
                const bool splitk = (k != 3) && (Mg == MALL);
                const int M1 = splitk ? MLAT : Mg;
                { pg8::Gemm g{A, Bt, M1, N, K, K};
                  pg8::Order2 S; S.so.init(M1, N, (int)gridDim.x, bid_()); S.one = 0; S.valid = 1; S.u1.pm = 0; S.u1.pn = 0;
                  pg8::EpiF32 E{O, N, (k != 3) ? 1 : 0};
                  pg8::gemm_phase<pg8::EpiF32, pg8::Order2, true, true>((LAS unsigned char*)lds_raw, g, S, E); }
                if (splitk) {
                    for (int c = bid_(); c < 256; c += (int)gridDim.x) {
                        const int u = c >> 3, ks = c & 7, nt2 = K >> 7;
                        const int kt0 = 2 * ((ks * nt2) >> 3), kt1 = 2 * (((ks + 1) * nt2) >> 3);
                        pg8::Gemm g{A + kt0 * 64, Bt + kt0 * 64, MALL, N, (kt1 - kt0) * 64, K};
                        pg8::Order2 S; S.so.init(MALL, N, 1, 0); S.one = 1; S.valid = 1; S.u1.pm = 32 + (u >> 3); S.u1.pn = u & 7;
                        pg8::EpiF32 E{(float*)((bf16*)(ws + WS_YD) + (size_t)ks * MCTX * DM - (size_t)MLAT * DM), N, 1};
                        pg8::gemm_phase<pg8::EpiF32, pg8::Order2, true, true>((LAS unsigned char*)lds_raw, g, S, E);
                    }
                }
            } else if (k == 2) rowwise_phase(P, MALL, false, l, 0, 2, 0.5f, false, l, 1, 3, 4);
            else if (k == 8) rowwise_phase(P, Mg, false, l, 1, 5, 1.0f, false, l, 2, 6, 7);
            else if (k == 11) rowwise_phase(P, Mg, false, l, 2, 8, 0.5f, l == 1, l + 1, 0, 0, 1);
            else if (k == 4) prep_phase(P, L, l);
            else if (k == 5) scan_phase(P, L, l);
            else post_phase(P, l, Mg);
        }
#ifdef PROBE_DUP
        }
#endif
        if (ph + 1 < ph_hi) {
            if (ph == 0) cg::this_grid().sync();
            else { XcdBarrier xb; xb.bar = (unsigned*)ws; xb.x = xb_xcc_id(); xb.st = (volatile LAS unsigned*)((LAS unsigned char*)lds_raw + (LDS_BYTES - 128)); xcd_barrier(xb); }
        }
    }
}

extern "C" void kernel_launch(void* const* d_in, const int* in_sizes, int n_in, void* d_out, int out_size, void* d_ws, size_t ws_size, hipStream_t stream) {
    static int grid = 0;
    if (grid == 0) {
        if (n_in != 28 || out_size != MLAT * DM || ws_size < WS_END) { fprintf(stderr, "kernel_launch: unexpected shapes (n_in %d out %d ws %zu need %zu)\n", n_in, out_size, ws_size, (size_t)WS_END); grid = -1; return; }
        int dev = 0, cus = 0, per_cu = 0;
        (void)hipGetDevice(&dev); (void)hipDeviceGetAttribute(&cus, hipDeviceAttributeMultiprocessorCount, dev);
        if (hipFuncSetAttribute((const void*)mk_fwd, hipFuncAttributeMaxDynamicSharedMemorySize, LDS_BYTES) != hipSuccess) { fprintf(stderr, "kernel_launch: hipFuncSetAttribute failed\n"); grid = -1; return; }
        if (hipOccupancyMaxActiveBlocksPerMultiprocessor(&per_cu, (const void*)mk_fwd, 512, LDS_BYTES) != hipSuccess || per_cu < 1) { fprintf(stderr, "kernel_launch: occupancy query says %d\n", per_cu); per_cu = 1; }
        (void)hipGetLastError();
        grid = cus * per_cu;
    }
    if (grid < 0) return;
    (void)hipMemsetAsync(d_ws, 0, 16384, stream);
    Params p{};
    const float** pp = (const float**)&p;
    for (int i = 0; i < 28; ++i) pp[i] = (const float*)d_in[i];
    p.out = (float*)d_out; p.ws = (unsigned char*)d_ws;
#if MK_SINGLE
    p.ph_lo = 0; p.ph_hi = NPHASES;
    void* args[] = {&p};
    hipError_t e = hipLaunchCooperativeKernel((const void*)mk_fwd, dim3(grid), dim3(512), args, LDS_BYTES, stream);
    if (e != hipSuccess) fprintf(stderr, "cooperative launch failed: %s (grid %d)\n", hipGetErrorString(e), grid);
#else
    for (int ph = 0; ph < NPHASES; ++ph) { p.ph_lo = ph; p.ph_hi = ph + 1; hipLaunchKernelGGL(mk_fwd, dim3(grid), dim3(512), LDS_BYTES, stream, p); }
#endif
}
```

```cpp
#include <hip/hip_runtime.h>
#include <hip/hip_cooperative_groups.h>
#include <cstdio>
#include <cstdint>
namespace cg = cooperative_groups;
#ifndef MK_SINGLE
#define MK_SINGLE 1
#endif
namespace pg8 {
#define PG8_LAS __attribute__((address_space(3)))
typedef unsigned short bf16_t;
typedef short bf16x8 __attribute__((ext_vector_type(8)));
typedef float f32x4 __attribute__((ext_vector_type(4)));
typedef unsigned u32x4 __attribute__((ext_vector_type(4)));
constexpr int BM = 256, BK = 64, HALF = 128, HTB = HALF * BK * 2  , STAGE_BYTES = 8 * HTB, NXCD = 8, WGM = 8;

__host__ __device__ __forceinline__ int lds_byte(int r, int c) { const int st = (r >> 4) * 2 + (c >> 5), rr = r & 15, cc = c & 31, ob = rr * 64 + cc * 2; return st * 1024 + (ob ^ (((ob >> 9) & 1) << 5)); }
__host__ __device__ __forceinline__ void stage_rc(int b, int& R, int& C) { const int st = b / 1024, sb = b % 1024, swz = sb ^ (((sb >> 9) & 1) << 5); R = (st >> 1) * 16 + swz / 64; C = (st & 1) * 32 + (swz % 64) / 2; }
__host__ __device__ __forceinline__ int perm32(int rho) { const int n = rho >> 4, i = rho & 15; return 8 * (i >> 2) + 4 * n + (i & 3); }

struct Unit { int pm, pn; };
struct Gemm { const bf16_t* A; const bf16_t* Bt; int M, N, K, ld; };

struct StaticOrder {
    int nM, nN, nwg, G, c;
    __host__ __device__ void init(int M, int N, int G_, int c_) { nM = M / BM; nN = N / BM; nwg = nM * nN; G = G_; c = c_; }
    __host__ __device__ bool next(int i, Unit& u) const {
        const long L = (long)i * G + c; if (L >= nwg) return false;
        int wgid = (int)L; { const int q = nwg / NXCD, r = nwg % NXCD, xcd = wgid % NXCD, off = wgid / NXCD; wgid = (xcd < r ? xcd * (q + 1) : r * (q + 1) + (xcd - r) * q) + off; }
        const int nig = WGM * nN, gid = wgid / nig, fm = gid * WGM, gsz = (nM - fm) < WGM ? (nM - fm) : WGM;
        u.pm = fm + ((wgid % nig) % gsz); u.pn = (wgid % nig) / gsz; return true;
    }
    __device__ __forceinline__ void a_ready(const Unit&) const {}
    __device__ __forceinline__ void done(const Unit&) const {}
};

__device__ __forceinline__ unsigned cvt_pk_bf16(float lo, float hi) { unsigned r; asm volatile("v_cvt_pk_bf16_f32 %0, %1, %2" : "=v"(r) : "v"(lo), "v"(hi)); return r; }
template <class Epi, class Sched, bool ALIGN_EPI = false, bool SP2 = false>
__device__ __forceinline__ void gemm_phase(PG8_LAS unsigned char* lds, const Gemm g, const Sched& S, const Epi& E) {
    int tid_l = threadIdx.x; asm volatile("" : "+v"(tid_l)); const int tid = tid_l, wid = __builtin_amdgcn_readfirstlane(tid >> 6), lane = tid & 63, wr = wid >> 2, wc = wid & 3, fr = lane & 15, fq = lane >> 4;
    const int K = g.ld, nt = g.K / BK;
    unsigned voffA[2], voffB[2];
#pragma unroll
    for (int i = 0; i < 2; ++i) { int R, C; stage_rc(tid * 16 + i * 8192, R, C); const int Rb = Epi::PERM ? ((R & ~31) + perm32(R & 31)) : R;
        voffA[i] = (unsigned)(R * K + C) * 2u; voffB[i] = (unsigned)(Rb * K + C) * 2u; }
    const size_t kstep = (size_t)(BK * 2);
    const size_t hstep = (size_t)HALF * K * 2;
    const size_t tstep = 2 * hstep;
    const unsigned ldsw = (unsigned)wid * 1024u;
    const int aoff = lds_byte(wr * 64 + fr, fq * 8), boff = lds_byte(wc * 32 + fr, fq * 8);
#define PG8_SA(b, h) (((b) * 2 + (h)) * HTB)
#define PG8_SB(b, h) ((4 + (b) * 2 + (h)) * HTB)
#define PG8_STAGE(bufoff, gbase, voff) do { _Pragma("unroll") for (int _i = 0; _i < 2; ++_i) \
        __builtin_amdgcn_global_load_lds((const unsigned*)((const char*)(gbase) + (voff)[_i]), (PG8_LAS unsigned*)(lds + (bufoff) + ldsw + _i * 8192), 16, 0, 0); } while (0)
#define PG8_LDA(dst, b, h) do { _Pragma("unroll") for (int m = 0; m < 4; ++m) _Pragma("unroll") for (int k = 0; k < 2; ++k) dst[m][k] = *(const PG8_LAS bf16x8*)(lds + PG8_SA(b, h) + aoff + m * 2048 + k * 1024); } while (0)
#define PG8_LDB(dst, b, h) do { _Pragma("unroll") for (int n = 0; n < 2; ++n) _Pragma("unroll") for (int k = 0; k < 2; ++k) dst[n][k] = *(const PG8_LAS bf16x8*)(lds + PG8_SB(b, h) + boff + n * 2048 + k * 1024); } while (0)
#define PG8_MMA(ai, bj, At, Bt) do { __builtin_amdgcn_s_setprio(1); _Pragma("unroll") for (int m = 0; m < 4; ++m) _Pragma("unroll") for (int n = 0; n < 2; ++n) _Pragma("unroll") for (int k = 0; k < 2; ++k) \
        acc[ai][bj][m][n] = __builtin_amdgcn_mfma_f32_16x16x32_bf16(Bt[n][k], At[m][k], acc[ai][bj][m][n], 0, 0, 0); __builtin_amdgcn_s_setprio(0); } while (0)
#define PG8_WAIT_V(n) asm volatile("s_waitcnt vmcnt(" #n ")" ::: "memory")
#define PG8_WAIT_L(n) asm volatile("s_waitcnt lgkmcnt(" #n ")" ::: "memory")
#define PG8_BAR __builtin_amdgcn_s_barrier()
#define PG8_SCHED __builtin_amdgcn_sched_barrier(0)
    Unit cur, nxt; int ui = 0;
    if (!S.next(0, cur)) return;
    f32x4 acc[2][2][4][2];
#pragma unroll
    for (int a = 0; a < 2; ++a)
#pragma unroll
        for (int b = 0; b < 2; ++b)
#pragma unroll
            for (int m = 0; m < 4; ++m)
#pragma unroll
                for (int n = 0; n < 2; ++n) acc[a][b][m][n] = (f32x4){0.f, 0.f, 0.f, 0.f};
    bf16x8 At[4][2], B0[2][2], B1[2][2];
    const char* cA = (const char*)g.A + (size_t)cur.pm * tstep; const char* cB = (const char*)g.Bt + (size_t)cur.pn * tstep;
    S.a_ready(cur);
    if constexpr (SP2) {
        PG8_STAGE(PG8_SB(0, 0), cB, voffB); PG8_STAGE(PG8_SB(0, 1), cB + hstep, voffB); PG8_STAGE(PG8_SA(0, 0), cA, voffA); PG8_STAGE(PG8_SA(0, 1), cA + hstep, voffA);
        if (wr == 1) PG8_BAR;
        PG8_WAIT_V(2); PG8_BAR;
        PG8_STAGE(PG8_SB(1, 0), cB + kstep, voffB); PG8_STAGE(PG8_SA(1, 0), cA + kstep, voffA); PG8_STAGE(PG8_SB(1, 1), cB + hstep + kstep, voffB);
        PG8_WAIT_V(6); PG8_BAR;
    } else {
        PG8_STAGE(PG8_SB(0, 0), cB, voffB); PG8_STAGE(PG8_SA(0, 0), cA, voffA); PG8_STAGE(PG8_SB(0, 1), cB + hstep, voffB); PG8_STAGE(PG8_SA(0, 1), cA + hstep, voffA);
        if (wr == 1) PG8_BAR;
        PG8_WAIT_V(4); PG8_BAR;
        PG8_STAGE(PG8_SB(1, 0), cB + kstep, voffB); PG8_STAGE(PG8_SA(1, 0), cA + kstep, voffA); PG8_STAGE(PG8_SB(1, 1), cB + hstep + kstep, voffB);
        PG8_WAIT_V(6); PG8_BAR;
    }
    for (;;) {
        const bool has_next = S.next(ui + 1, nxt);
        const char* nA = has_next ? (const char*)g.A + (size_t)nxt.pm * tstep : cA; const char* nB = has_next ? (const char*)g.Bt + (size_t)nxt.pn * tstep : cB;
        for (int t = 0; t < nt; t += 2) {
            const bool last = (t == nt - 2);
            const char* a1 = cA + (size_t)(t + 1) * kstep;
            const char* a2 = last ? nA : cA + (size_t)(t + 2) * kstep; const char* b2 = last ? nB : cB + (size_t)(t + 2) * kstep;
            const char* a3 = a2 + kstep; const char* b3 = b2 + kstep;
            if (last && has_next) S.a_ready(nxt);
            if constexpr (SP2) {
            PG8_LDB(B0, 0, 0); PG8_LDB(B1, 0, 1); PG8_SCHED; PG8_LDA(At, 0, 0); PG8_STAGE(PG8_SA(1, 1), a1 + hstep, voffA);
            PG8_WAIT_V(8); PG8_WAIT_L(0); PG8_BAR; PG8_MMA(0, 0, At, B0); PG8_MMA(0, 1, At, B1); PG8_BAR; PG8_SCHED;
            PG8_LDA(At, 0, 1); PG8_STAGE(PG8_SB(0, 0), b2, voffB); PG8_STAGE(PG8_SB(0, 1), b2 + hstep, voffB); PG8_STAGE(PG8_SA(0, 0), a2, voffA);
            PG8_WAIT_V(8); PG8_WAIT_L(0); PG8_BAR; PG8_MMA(1, 0, At, B0); PG8_MMA(1, 1, At, B1); PG8_BAR; PG8_SCHED;
            PG8_LDB(B0, 1, 0); PG8_LDB(B1, 1, 1); PG8_SCHED; PG8_LDA(At, 1, 0); PG8_STAGE(PG8_SA(0, 1), a2 + hstep, voffA);
            PG8_WAIT_V(8); PG8_WAIT_L(0); PG8_BAR; PG8_MMA(0, 0, At, B0); PG8_MMA(0, 1, At, B1); PG8_BAR; PG8_SCHED;
            PG8_LDA(At, 1, 1); PG8_STAGE(PG8_SB(1, 0), b3, voffB); PG8_STAGE(PG8_SB(1, 1), b3 + hstep, voffB); PG8_STAGE(PG8_SA(1, 0), a3, voffA);
            PG8_WAIT_V(8); PG8_WAIT_L(0); PG8_BAR; PG8_MMA(1, 0, At, B0); PG8_MMA(1, 1, At, B1); PG8_BAR; PG8_SCHED;
            } else {
            PG8_LDB(B0, 0, 0); PG8_SCHED; PG8_LDA(At, 0, 0); PG8_STAGE(PG8_SA(1, 1), a1 + hstep, voffA);
            PG8_WAIT_L(8); PG8_BAR; PG8_WAIT_L(0); PG8_MMA(0, 0, At, B0); PG8_BAR; PG8_SCHED;
            PG8_LDB(B1, 0, 1); PG8_STAGE(PG8_SB(0, 0), b2, voffB);
            PG8_BAR; PG8_WAIT_L(0); PG8_MMA(0, 1, At, B1); PG8_BAR;
            PG8_LDA(At, 0, 1); PG8_STAGE(PG8_SA(0, 0), a2, voffA);
            PG8_BAR; PG8_WAIT_L(0); PG8_MMA(1, 0, At, B0); PG8_BAR; PG8_SCHED;
            PG8_STAGE(PG8_SB(0, 1), b2 + hstep, voffB);
            PG8_WAIT_V(6); PG8_BAR; PG8_MMA(1, 1, At, B1); PG8_BAR;
            PG8_LDB(B0, 1, 0); PG8_SCHED; PG8_LDA(At, 1, 0); PG8_STAGE(PG8_SA(0, 1), a2 + hstep, voffA);
            PG8_WAIT_L(8); PG8_BAR; PG8_WAIT_L(0); PG8_MMA(0, 0, At, B0); PG8_BAR; PG8_SCHED;
            PG8_LDB(B1, 1, 1); PG8_STAGE(PG8_SB(1, 0), b3, voffB);
            PG8_BAR; PG8_WAIT_L(0); PG8_MMA(0, 1, At, B1); PG8_BAR;
            PG8_LDA(At, 1, 1); PG8_STAGE(PG8_SA(1, 0), a3, voffA);
            PG8_BAR; PG8_WAIT_L(0); PG8_MMA(1, 0, At, B0); PG8_BAR; PG8_SCHED;
            PG8_STAGE(PG8_SB(1, 1), b3 + hstep, voffB);
            PG8_WAIT_V(6); PG8_BAR; PG8_MMA(1, 1, At, B1); PG8_BAR;
            }
        }
        if constexpr (ALIGN_EPI) { if (wr == 0) PG8_BAR; }
        if constexpr (!Epi::AFTER_DRAIN) { E(acc, cur, wr, wc, fr, fq); S.done(cur); }
        if (!has_next) break;
#pragma unroll
        for (int a = 0; a < 2; ++a)
#pragma unroll
            for (int b = 0; b < 2; ++b)
#pragma unroll
                for (int m = 0; m < 4; ++m)
#pragma unroll
                    for (int n = 0; n < 2; ++n) acc[a][b][m][n] = (f32x4){0.f, 0.f, 0.f, 0.f};
        cur = nxt; cA = nA; cB = nB; ++ui;
        if constexpr (ALIGN_EPI) { if (wr == 1) PG8_BAR; }
    }
    PG8_WAIT_V(0);
    if constexpr (!ALIGN_EPI) { if (wr == 0) PG8_BAR; }
    PG8_BAR;
    if constexpr (Epi::AFTER_DRAIN) { E.fused(acc, cur, wr, wc, fr, fq, lds, wid, lane); S.done(cur); }
#undef PG8_SA
#undef PG8_SB
#undef PG8_STAGE
#undef PG8_LDA
#undef PG8_LDB
#undef PG8_MMA
#undef PG8_WAIT_V
#undef PG8_WAIT_L
#undef PG8_BAR
#undef PG8_SCHED
}
}

#define LAS __attribute__((address_space(3)))
typedef unsigned short bf16;
typedef float f32x4 __attribute__((ext_vector_type(4)));
typedef float f32x2 __attribute__((ext_vector_type(2)));
typedef unsigned u32x4 __attribute__((ext_vector_type(4)));
typedef unsigned u32x2 __attribute__((ext_vector_type(2)));
typedef short bf16x8_t __attribute__((ext_vector_type(8)));
constexpr int DM = 2048, NB = 4, TL = 2048, TC = 256, MLAT = NB * TL, MCTX = NB * TC, MALL = MLAT + MCTX;
constexpr int FF = 5632, NUP = 2 * FF, NIN = 6416, NINP = 6656, NMODV = 9 * DM;
constexpr int TSTEPS = TL + TC, NTILES = TSTEPS / 32;
constexpr float EPS = 1e-6f;
constexpr int U_SSD_XBC = 512, U_SSD_DT = 1280, U_LRU_X = 1296, U_LRU_G = 1808;
constexpr int U_HG_Q = 2320, U_HG_F = 2832, U_HG_I = 3856, U_HG_G = 4368;
constexpr int U_RT_Q = 4880, U_RT_K = 5136, U_RT_V = 5392, U_RT_G = 5904;
constexpr int NPHASES = 26;
constexpr int LDS_BYTES = 147456;
constexpr size_t MiB = 1u << 20;
constexpr size_t WS_MOD = 1 * MiB, WS_W13 = 2 * MiB, WS_W2 = 178 * MiB, WS_WIN = 266 * MiB, WS_WOUT = 318 * MiB, WS_X = 334 * MiB, WS_H = 406 * MiB,
                 WS_Y = 442 * MiB, WS_U = 514 * MiB, WS_XBC = 748 * MiB, WS_LA = 775 * MiB, WS_LB = 811 * MiB, WS_YD = 847 * MiB, WS_END = 991 * MiB;

struct Params {
    const float *x, *c, *ctx, *c_ctx, *w_mod, *b_mod, *norm_pre, *norm_post, *ffn_w1, *ffn_w3, *ffn_w2, *w_in, *w_out,
        *ssd_conv_w, *ssd_conv_b, *ssd_dt_bias, *ssd_a_log, *ssd_d, *ssd_norm_w, *lru_conv_w, *lru_conv_b, *lru_wa, *lru_ba, *lru_wx, *lru_bx, *lru_lambda,
        *hgrn_lb_logits, *hgrn_norm_w;
    float* out; unsigned char* ws; int ph_lo, ph_hi;
};

__device__ __forceinline__ float sigmoid_(float x) { return __builtin_amdgcn_rcpf(1.f + __expf(-x)); }
__device__ __forceinline__ float silu_(float x) { return x * sigmoid_(x); }
__device__ __forceinline__ float softplus_(float x) { return fmaxf(x, 0.f) + log1pf(__expf(-fabsf(x))); }
__device__ __forceinline__ float gelu_tanh_(float x) { const float z = 0.7978845608f * (x + 0.044715f * x * x * x); const float t = 1.f - 2.f * __builtin_amdgcn_rcpf(1.f + __expf(2.f * z)); return 0.5f * x * (1.f + t); }
__device__ __forceinline__ unsigned f2bf(float f) { unsigned u = __builtin_bit_cast(unsigned, f); return (u + 0x7fffu + ((u >> 16) & 1u)) >> 16; }
__device__ __forceinline__ unsigned pk2(float lo, float hi) { return f2bf(lo) | (f2bf(hi) << 16); }
__device__ __forceinline__ float wave_sum(float v) {
#pragma unroll
    for (int o = 1; o < 64; o <<= 1) v += __shfl_xor(v, o);
    return v;
}
__device__ __forceinline__ float half_sum(float v) {
#pragma unroll
    for (int o = 1; o < 32; o <<= 1) v += __shfl_xor(v, o);
    return v;
}
__device__ __forceinline__ float dot4(f32x4 a) { return (a.x * a.x + a.y * a.y) + (a.z * a.z + a.w * a.w); }
__device__ __forceinline__ f32x4 ld_bf4(const bf16* p) { const u32x2 w = *(const u32x2*)p; return (f32x4){__builtin_bit_cast(float, w.x << 16), __builtin_bit_cast(float, w.x & 0xffff0000u), __builtin_bit_cast(float, w.y << 16), __builtin_bit_cast(float, w.y & 0xffff0000u)}; }
#define LDS_WAIT() asm volatile("s_waitcnt lgkmcnt(0)" ::: "memory")
__device__ __forceinline__ int tid_() { int t = threadIdx.x; asm volatile("" : "+v"(t)); return t; }
__device__ __forceinline__ int bid_() { int t = blockIdx.x; asm volatile("" : "+s"(t)); return t; }
__device__ __forceinline__ int scan_row(int b, int d, int i) {
    if (i < TC) { const int t = d ? (TC - 1 - i) : i; return MLAT + b * TC + t; }
    int t = i - TC; if (d) t = TL - 1 - t; return b * TL + t;
}

#define XB_TMO      128
#define XB_XCNT(j)  (256  + 64 * (j))
#define XB_XSUB(j)  (1280 + 64 * (j))
#define XB_XGEN(j)  (2304 + 64 * (j))
#define XB_TOP      3328
#define XB_TOPGEN   3392
#define XCD_BAR_WORDS 3456
#define XB_SPIN_CAP (1u << 18)

__device__ __forceinline__ unsigned xb_ld(unsigned* p)              { return __hip_atomic_load(p, __ATOMIC_RELAXED, __HIP_MEMORY_SCOPE_AGENT); }
__device__ __forceinline__ unsigned xb_add(unsigned* p, unsigned v) { return __hip_atomic_fetch_add(p, v, __ATOMIC_RELAXED, __HIP_MEMORY_SCOPE_AGENT); }
__device__ __forceinline__ unsigned xb_xcc_id() { return (unsigned)__builtin_amdgcn_s_getreg((3 << 11) | 20) & 0xFu; }
#define XB_SPIN(cond, bar) do { unsigned _sp = 0; while (cond) { __builtin_amdgcn_s_sleep(1); \
    if ((++_sp & 255u) == 0u) { if (xb_ld(&(bar)[XB_TMO])) break; if (_sp > XB_SPIN_CAP) { atomicAdd(&(bar)[XB_TMO], 1u); break; } } } } while (0)

struct XcdBarrier {
    unsigned* bar; unsigned x;
    volatile LAS unsigned* st;
};

__device__ __forceinline__ XcdBarrier xcd_barrier_post(unsigned* bar, volatile LAS unsigned* st) {
    XcdBarrier b; b.bar = bar; b.x = xb_xcc_id(); b.st = st;
    if (threadIdx.x == 0) (void)xb_add(&bar[XB_XCNT(b.x)], 1u);
    return b;
}
__device__ __forceinline__ void xcd_barrier_complete(unsigned* bar, unsigned x, unsigned& nloc, unsigned& nx) {
    const unsigned G = gridDim.x * gridDim.y * gridDim.z;
    unsigned sum, cnt, mine, sp = 0u;
    for (;;) {
        sum = 0u; cnt = 0u; mine = 0u;
#pragma unroll
        for (unsigned j = 0; j < 16; ++j) { const unsigned c = xb_ld(&bar[XB_XCNT(j)]); sum += c; cnt += (c > 0u) ? 1u : 0u; mine = (j == x) ? c : mine; }
        if (sum == G) break;
        __builtin_amdgcn_s_sleep(1);
        if ((++sp & 255u) == 0u) { if (xb_ld(&bar[XB_TMO])) break; if (sp > XB_SPIN_CAP) { atomicAdd(&bar[XB_TMO], 1u); break; } }
    }
    nloc = mine > 0u ? mine : 1u; nx = cnt > 0u ? cnt : 1u;
}

__device__ __forceinline__ void xcd_barrier(const XcdBarrier& b) {
    asm volatile("s_waitcnt vmcnt(0)" ::: "memory");
    __syncthreads();
    if (threadIdx.x == 0) {
        unsigned* bar = b.bar;
        __builtin_amdgcn_s_waitcnt(0);
        unsigned nloc = b.st[0], nx = b.st[1];
        if (nloc == 0u) { xcd_barrier_complete(bar, b.x, nloc, nx); b.st[0] = nloc; b.st[1] = nx; }
        const unsigned old = xb_add(&bar[XB_XSUB(b.x)], 1u);
        const unsigned gen = old / nloc;
        if (old + 1u == (gen + 1u) * nloc) {
            __builtin_amdgcn_fence(__ATOMIC_RELEASE, "agent");
            asm volatile("s_waitcnt vmcnt(0)" ::: "memory");
            const unsigned og = xb_add(&bar[XB_TOP], 1u);
            const unsigned tg = og / nx;
            if (og + 1u == (tg + 1u) * nx) xb_add(&bar[XB_TOPGEN], 1u);
            else XB_SPIN(xb_ld(&bar[XB_TOPGEN]) == tg, bar);
            __builtin_amdgcn_fence(__ATOMIC_ACQUIRE, "agent");
            xb_add(&bar[XB_XGEN(b.x)], 1u);
            asm volatile("s_waitcnt vmcnt(0)" ::: "memory");
        } else {
            XB_SPIN(xb_ld(&bar[XB_XGEN(b.x)]) == gen, bar);
            __builtin_amdgcn_fence(__ATOMIC_ACQUIRE, "agent");
            asm volatile("s_waitcnt vmcnt(0)" ::: "memory");
        }
    }
    __syncthreads();
}

namespace pg8 {
struct EpiSwiGLU {
    static constexpr bool PERM = true, AFTER_DRAIN = false;
    bf16_t* O; int ldc;
    __device__ __forceinline__ void operator()(const f32x4 (&acc)[2][2][4][2], const Unit& u, int wr, int wc, int fr, int fq) const {
        const int row0 = u.pm * BM + wr * 64 + fr, col0 = u.pn * HALF + wc * 32 + 8 * fq;
#pragma unroll
        for (int ai = 0; ai < 2; ++ai)
#pragma unroll
            for (int m = 0; m < 4; ++m) {
                bf16_t* rowp = O + (size_t)(row0 + ai * HALF + m * 16) * ldc + col0;
                const f32x4 a0 = acc[ai][0][m][0], a1 = acc[ai][0][m][1], b0 = acc[ai][1][m][0], b1 = acc[ai][1][m][1];
                float r[8];
#pragma unroll
                for (int j = 0; j < 4; ++j) { r[j] = a0[j] * __builtin_amdgcn_rcpf(1.f + __expf(-a0[j])) * b0[j]; r[4 + j] = a1[j] * __builtin_amdgcn_rcpf(1.f + __expf(-a1[j])) * b1[j]; }
                u32x4 w; w.x = cvt_pk_bf16(r[0], r[1]); w.y = cvt_pk_bf16(r[2], r[3]); w.z = cvt_pk_bf16(r[4], r[5]); w.w = cvt_pk_bf16(r[6], r[7]);
                *(u32x4*)rowp = w;
                asm volatile("" ::: "memory");
            }
    }
};
struct EpiF32 {
    static constexpr bool PERM = false, AFTER_DRAIN = false;
    float* O; int ldc; int asbf;
    __device__ __forceinline__ void operator()(const f32x4 (&acc)[2][2][4][2], const Unit& u, int wr, int wc, int fr, int fq) const {
        const int row0 = u.pm * BM + wr * 64 + fr, col0 = u.pn * BM + wc * 32 + 4 * fq;
        if (asbf) {
            bf16_t* Ob = (bf16_t*)O;
#pragma unroll
            for (int ai = 0; ai < 2; ++ai)
#pragma unroll
                for (int m = 0; m < 4; ++m) {
                    bf16_t* rowp = Ob + (size_t)(row0 + ai * HALF + m * 16) * ldc + col0;
#pragma unroll
                    for (int bj = 0; bj < 2; ++bj)
#pragma unroll
                        for (int n = 0; n < 2; ++n) { const f32x4 v = acc[ai][bj][m][n]; u32x2 w; w.x = cvt_pk_bf16(v[0], v[1]); w.y = cvt_pk_bf16(v[2], v[3]); *(u32x2*)(rowp + bj * HALF + n * 16) = w; }
                }
            return;
        }
#pragma unroll
        for (int ai = 0; ai < 2; ++ai)
#pragma unroll
            for (int m = 0; m < 4; ++m) {
                float* rowp = O + (size_t)(row0 + ai * HALF + m * 16) * ldc + col0;
#pragma unroll
                for (int bj = 0; bj < 2; ++bj)
#pragma unroll
                    for (int n = 0; n < 2; ++n) *(f32x4*)(rowp + bj * HALF + n * 16) = acc[ai][bj][m][n];
            }
    }
};
}


namespace pg8 {
struct Order2 {
    StaticOrder so; int one, valid; Unit u1;
    __device__ bool next(int i, Unit& u) const { if (one) { if (i > 0 || !valid) return false; u = u1; return true; } return so.next(i, u); }
    __device__ __forceinline__ void a_ready(const Unit&) const {}
    __device__ __forceinline__ void done(const Unit&) const {}
};
}
__device__ __forceinline__ void transpose_item64(const float* __restrict__ W, int K, int N, bf16* __restrict__ WT, int mode, float* scr, int item, int lane) {
    const int nblk = (N + 63) >> 6, kb = item / nblk, nb = item - kb * nblk, k0 = kb << 6, n0 = nb << 6;
    const int lr = lane >> 4, lc = (lane & 15) << 2;
    const bool ok = (n0 + lc) < N;
#pragma unroll
    for (int i = 0; i < 16; ++i) {
        const int kk = 4 * i + lr; f32x4 v = {0.f, 0.f, 0.f, 0.f};
        if (ok) v = __builtin_nontemporal_load((const f32x4*)(W + (size_t)(k0 + kk) * N + n0 + lc));
        float* s = scr + kk * 65 + lc; s[0] = v.x; s[1] = v.y; s[2] = v.z; s[3] = v.w;
    }
    LDS_WAIT();
    const int c = lane & 7;
#pragma unroll
    for (int j = 0; j < 8; ++j) {
        const int n = (lane >> 3) + 8 * j; const float* s = scr + (8 * c) * 65 + n;
        u32x4 o; o.x = pk2(s[0], s[65]); o.y = pk2(s[2 * 65], s[3 * 65]); o.z = pk2(s[4 * 65], s[5 * 65]); o.w = pk2(s[6 * 65], s[7 * 65]);
        const int dn = n0 + n; int row = dn; if (mode) row = ((dn >> 7) << 8) + (dn & 127) + (mode == 2 ? 128 : 0);
        *(u32x4*)(WT + (size_t)row * K + k0 + 8 * c) = o;
    }
    LDS_WAIT();
}

__device__ __forceinline__ void prologue_phase(const Params& P, float* L) {
    const int tid = tid_(), lane = tid & 63, wave = __builtin_amdgcn_readfirstlane(tid >> 6);
    unsigned char* ws = P.ws;
    float* MOD = (float*)(ws + WS_MOD);
    float* sc = L;
    float* red = L + 5 * DM;
    for (int i = tid; i < 5 * DM; i += 512) { const int r = i >> 11, k = i & (DM - 1); const float v = r < 4 ? P.c[r * DM + k] : P.c_ctx[k]; sc[i] = silu_(v); }
    __syncthreads();
    for (int it = bid_(); it < 1152; it += gridDim.x) {
        const int l = it / 576, j0 = (it % 576) * 32;
        const float* Wm = P.w_mod + (size_t)l * DM * NMODV;
        const int kr = lane >> 3, c4 = (lane & 7) << 2;
        f32x4 acc[5];
#pragma unroll
        for (int r = 0; r < 5; ++r) acc[r] = (f32x4){0.f, 0.f, 0.f, 0.f};
        const int kbase = wave * 256 + kr;
#pragma unroll 16
        for (int kk = 0; kk < 256; kk += 8) {
            const int k = kbase + kk; const f32x4 w = __builtin_nontemporal_load((const f32x4*)(Wm + (size_t)k * NMODV + j0 + c4));
#pragma unroll
            for (int r = 0; r < 5; ++r) acc[r] += w * sc[r * DM + k];
        }
#pragma unroll
        for (int r = 0; r < 5; ++r)
#pragma unroll
            for (int e = 0; e < 4; ++e) { float v = acc[r][e]; v += __shfl_xor(v, 8); v += __shfl_xor(v, 16); v += __shfl_xor(v, 32); acc[r][e] = v; }
        if (lane < 8) {
#pragma unroll
            for (int r = 0; r < 5; ++r) *(f32x4*)&red[(wave * 5 + r) * 32 + c4] = acc[r];
        }
        __syncthreads();
        if (tid < 160) { const int r = tid >> 5, j = tid & 31; float s_ = 0.f;
#pragma unroll
            for (int w = 0; w < 8; ++w) s_ += red[(w * 5 + r) * 32 + j];
            MOD[(size_t)(l * 5 + r) * NMODV + j0 + j] = s_ + P.b_mod[l * NMODV + j0 + j]; }
        __syncthreads();
    }
    bf16* W13 = (bf16*)(ws + WS_W13); bf16* W2 = (bf16*)(ws + WS_W2); bf16* WIN = (bf16*)(ws + WS_WIN); bf16* WOUT = (bf16*)(ws + WS_WOUT);
    float* scr = L + wave * (64 * 65);
    const int gw = bid_() * 8 + wave, NGW = gridDim.x * 8;
    constexpr int I_F = 2816, I_LF = 3 * I_F, I_FFN = 4 * I_LF, I_IN = 32 * 101, I_OUT = 32 * 32, I_ALL = I_FFN + 2 * I_IN + 2 * I_OUT;
    for (int it = gw; it < I_ALL; it += NGW) {
        int r = it;
        if (r < I_FFN) {
            const int lf = r / I_LF, q = r % I_LF, which = q / I_F, item = q % I_F;
            if (which == 0) transpose_item64(P.ffn_w1 + (size_t)lf * DM * FF, DM, FF, W13 + (size_t)lf * NUP * DM, 1, scr, item, lane);
            else if (which == 1) transpose_item64(P.ffn_w3 + (size_t)lf * DM * FF, DM, FF, W13 + (size_t)lf * NUP * DM, 2, scr, item, lane);
            else transpose_item64(P.ffn_w2 + (size_t)lf * FF * DM, FF, DM, W2 + (size_t)lf * DM * FF, 0, scr, item, lane);
        } else {
            r -= I_FFN;
            if (r < 2 * I_IN) { const int l = r / I_IN, item = r % I_IN; transpose_item64(P.w_in + (size_t)l * DM * NIN, DM, NIN, WIN + (size_t)l * NINP * DM, 0, scr, item, lane); }
            else { r -= 2 * I_IN; const int l = r / I_OUT, item = r % I_OUT; transpose_item64(P.w_out + (size_t)l * DM * DM, DM, DM, WOUT + (size_t)l * DM * DM, 0, scr, item, lane); }
        }
    }
}

__device__ __forceinline__ void rowwise_phase(const Params& P, int mrows, bool first, int l_post, int j_post, int gate_idx, float coef, bool final_, int l_pre, int j_pre, int shift_idx, int scale_idx) {
    const int tid = tid_(), lane = tid & 63, wave = __builtin_amdgcn_readfirstlane(tid >> 6);
    const int gw = bid_() * 8 + wave, NGW = gridDim.x * 8;
    const float* MOD = (const float*)(P.ws + WS_MOD);
    float* X = (float*)(P.ws + WS_X); const float* Y = (const float*)(P.ws + WS_Y); bf16* H = (bf16*)(P.ws + WS_H);
    for (int row = gw; row < mrows; row += NGW) {
        const int b = row < MLAT ? (row >> 11) : 4;
        f32x4 xv[8]; float ss_new = 0.f;
        if (first) {
            const float* src = row < MLAT ? P.x + (size_t)row * DM : P.ctx + (size_t)(row - MLAT) * DM;
#pragma unroll
            for (int j = 0; j < 8; ++j) xv[j] = *(const f32x4*)(src + 4 * lane + 256 * j);
        } else {
            const float* xr = (l_post == 0 && j_post == 0) ? (row < MLAT ? P.x + (size_t)row * DM : P.ctx + (size_t)(row - MLAT) * DM) : X + (size_t)row * DM;
            f32x4 yv[8]; float ss = 0.f;
            if (row < MLAT) {
                const bf16* yb = (const bf16*)Y + (size_t)row * DM;
#pragma unroll
                for (int j = 0; j < 8; ++j) { const u32x2 w = *(const u32x2*)(yb + 4 * lane + 256 * j);
                    yv[j] = (f32x4){__builtin_bit_cast(float, w.x << 16), __builtin_bit_cast(float, w.x & 0xffff0000u), __builtin_bit_cast(float, w.y << 16), __builtin_bit_cast(float, w.y & 0xffff0000u)}; }
            } else {
                const bf16* pr = (const bf16*)(P.ws + WS_YD) + (size_t)(row - MLAT) * DM;
#pragma unroll
                for (int j = 0; j < 8; ++j) yv[j] = ld_bf4(pr + 4 * lane + 256 * j);
                for (int ks = 1; ks < 8; ++ks) {
#pragma unroll
                    for (int j = 0; j < 8; ++j) yv[j] += ld_bf4(pr + (size_t)ks * MCTX * DM + 4 * lane + 256 * j);
                }
            }
            const float* gp = P.norm_post + (size_t)(l_post * 3 + j_post) * DM; const float* mg = MOD + (size_t)(l_post * 5 + b) * NMODV + gate_idx * DM;
            float sxx = 0.f, sxt = 0.f, stt = 0.f;
#pragma unroll
            for (int j = 0; j < 8; ++j) { const int c = 4 * lane + 256 * j; xv[j] = *(const f32x4*)(xr + c); const f32x4 g4 = *(const f32x4*)(gp + c), m4 = *(const f32x4*)(mg + c);
                ss += dot4(yv[j]); yv[j] = yv[j] * g4 * m4; sxx += dot4(xv[j]); stt += dot4(yv[j]);
                const f32x4 xt = xv[j] * yv[j]; sxt += (xt.x + xt.y) + (xt.z + xt.w); }
#pragma unroll
            for (int o = 1; o < 64; o <<= 1) { ss += __shfl_xor(ss, o); sxx += __shfl_xor(sxx, o); sxt += __shfl_xor(sxt, o); stt += __shfl_xor(stt, o); }
            const float rs = rsqrtf(ss * (1.f / DM) + EPS) * coef;
            ss_new = sxx + 2.f * rs * sxt + rs * rs * stt;
#pragma unroll
            for (int j = 0; j < 8; ++j) xv[j] += yv[j] * rs;
        }
        if (final_) {
            float* o = P.out + (size_t)row * DM;
#pragma unroll
            for (int j = 0; j < 8; ++j) *(f32x4*)(o + 4 * lane + 256 * j) = xv[j];
            continue;
        }
        {
            float* xr = X + (size_t)row * DM; float ss = 0.f;
#pragma unroll
            for (int j = 0; j < 8; ++j) { if (!first) *(f32x4*)(xr + 4 * lane + 256 * j) = xv[j]; else ss += dot4(xv[j]); }
            if (first) ss = wave_sum(ss); else ss = ss_new;
            const float rs = rsqrtf(ss * (1.f / DM) + EPS);
            const float* gp = P.norm_pre + (size_t)(l_pre * 3 + j_pre) * DM; const float* mb = MOD + (size_t)(l_pre * 5 + b) * NMODV;
            bf16* hr = H + (size_t)row * DM;
#pragma unroll
            for (int j = 0; j < 8; ++j) { const int c = 4 * lane + 256 * j; const f32x4 g4 = *(const f32x4*)(gp + c), sh = *(const f32x4*)(mb + shift_idx * DM + c), scl = *(const f32x4*)(mb + scale_idx * DM + c);
                const f32x4 h = (xv[j] * rs) * g4 * (scl + 1.f) + sh; u32x2 w; w.x = pk2(h.x, h.y); w.y = pk2(h.z, h.w); *(u32x2*)(hr + c) = w; }
        }
    }
}

__device__ __forceinline__ f32x4 conv4(const float* __restrict__ U, int row, int col, const float* __restrict__ cw, int C, const float* __restrict__ cb) {
    int t, len; if (row < MLAT) { t = row & (TL - 1); len = TL; } else { t = (row - MLAT) & (TC - 1); len = TC; }
    f32x4 acc = *(const f32x4*)cb;
#pragma unroll
    for (int j = 0; j < 4; ++j) { const int tt = t + j - 1; if (tt >= 0 && tt < len) { const f32x4 xx = *(const f32x4*)(U + (size_t)(row + j - 1) * NINP + col); const f32x4 w = *(const f32x4*)(cw + j * C); acc += xx * w; } }
    return acc;
}
__device__ __forceinline__ void prep_phase(const Params& P, float* L, int l) {
    const int tid = tid_();
    const float* U = (const float*)(P.ws + WS_U); bf16* XBC = (bf16*)(P.ws + WS_XBC); float* LA = (float*)(P.ws + WS_LA); bf16* LB = (bf16*)(P.ws + WS_LB);
    { const float* cw = P.ssd_conv_w + (size_t)l * 4 * 768; const float* cb = P.ssd_conv_b + (size_t)l * 768;
      for (int idx = bid_() * 512 + tid; idx < (MALL / 16) * 192; idx += gridDim.x * 512) {
          const int chunk = idx / 192, c4 = (idx - chunk * 192) << 2, row0 = chunk * 16;
          int t0, len; if (row0 < MLAT) { t0 = row0 & (TL - 1); len = TL; } else { t0 = (row0 - MLAT) & (TC - 1); len = TC; }
          const f32x4 w0 = *(const f32x4*)(cw + c4), w1 = *(const f32x4*)(cw + 768 + c4), w2 = *(const f32x4*)(cw + 2 * 768 + c4), w3 = *(const f32x4*)(cw + 3 * 768 + c4), bb = *(const f32x4*)(cb + c4);
          const float* up = U + (size_t)row0 * NINP + U_SSD_XBC + c4;
          const f32x4 z4 = {0.f, 0.f, 0.f, 0.f};
          f32x4 xm1 = (t0 > 0) ? *(const f32x4*)(up - NINP) : z4, x0 = *(const f32x4*)up, x1 = *(const f32x4*)(up + NINP);
#pragma unroll
          for (int r = 0; r < 16; ++r) {
              const f32x4 x2 = (t0 + r + 2 < len) ? *(const f32x4*)(up + (size_t)(r + 2) * NINP) : z4;
              f32x4 v = bb + xm1 * w0 + x0 * w1 + x1 * w2 + x2 * w3;
              v.x = silu_(v.x); v.y = silu_(v.y); v.z = silu_(v.z); v.w = silu_(v.w);
              { u32x2 w_; w_.x = pk2(v.x, v.y); w_.y = pk2(v.z, v.w); *(u32x2*)(XBC + (size_t)(row0 + r) * 768 + c4) = w_; }
              xm1 = x0; x0 = x1; x1 = x2;
          } } }
    unsigned short* WT = (unsigned short*)L;
    unsigned short* xb = WT + 4 * 64 * 72;
    float* xs = (float*)(xb + 64 * 72);
    const float* cw = P.lru_conv_w + (size_t)l * 4 * 512; const float* cb = P.lru_conv_b + (size_t)l * 512;
    const int lane = tid & 63, wave = __builtin_amdgcn_readfirstlane(tid >> 6), fr = lane & 15, fq = lane >> 4;
    int cur_h = -1;
    for (int it = bid_(); it < 144 * 8; it += gridDim.x) {
        const int h = it & 7, row0 = (it >> 3) * 64;
        __syncthreads();
        if (h != cur_h) {
            for (int i = tid; i < 4 * 4096; i += 512) { const int m = i >> 12, ii = (i >> 6) & 63, j = i & 63, d = m >> 1; const float* src = (m & 1) ? P.lru_wx : P.lru_wa;
                WT[(m * 64 + j) * 72 + ii] = (unsigned short)f2bf(src[((size_t)(l * 2 + d) * 8 + h) * 4096 + ii * 64 + j]); }
            cur_h = h;
        }
        for (int i = tid; i < 1024; i += 512) { const int r = i >> 4, c4 = (i & 15) << 2;
            const f32x4 v = conv4(U, row0 + r, U_LRU_X + h * 64 + c4, cw + h * 64 + c4, 512, cb + h * 64 + c4);
            *(f32x4*)&xs[r * 68 + c4] = v; u32x2 w; w.x = pk2(v.x, v.y); w.y = pk2(v.z, v.w); *(u32x2*)&xb[r * 72 + c4] = w; }
        __syncthreads();
        {
            const int tt = wave & 3, d = wave >> 2;
            f32x4 acc[2][4];
#pragma unroll
            for (int g2 = 0; g2 < 2; ++g2)
#pragma unroll
                for (int jt = 0; jt < 4; ++jt) acc[g2][jt] = (f32x4){0.f, 0.f, 0.f, 0.f};
#pragma unroll
            for (int ks = 0; ks < 2; ++ks) {
                const bf16x8_t a = *(const bf16x8_t*)&xb[(tt * 16 + fr) * 72 + ks * 32 + fq * 8];
#pragma unroll
                for (int g2 = 0; g2 < 2; ++g2)
#pragma unroll
                    for (int jt = 0; jt < 4; ++jt) { const bf16x8_t bq = *(const bf16x8_t*)&WT[((d * 2 + g2) * 64 + jt * 16 + fr) * 72 + ks * 32 + fq * 8];
                        acc[g2][jt] = __builtin_amdgcn_mfma_f32_16x16x32_bf16(a, bq, acc[g2][jt], 0, 0, 0); }
            }
#pragma unroll
            for (int jt = 0; jt < 4; ++jt) {
                const int j = jt * 16 + fr, c = h * 64 + j;
                const float ba1 = P.lru_ba[(size_t)(l * 2 + d) * 512 + c], bx1 = P.lru_bx[(size_t)(l * 2 + d) * 512 + c], sp = softplus_(-P.lru_lambda[(size_t)(l * 2 + d) * 512 + c]);
#pragma unroll
                for (int jj = 0; jj < 4; ++jj) {
                    const int t = tt * 16 + 4 * fq + jj, row = row0 + t;
                    const float rg = sigmoid_(acc[0][jt][jj] + ba1), ig = sigmoid_(acc[1][jt][jj] + bx1);
                    const float la = -8.f * rg * sp;
                    const float a_ = __expf(la); LA[((size_t)d * MALL + row) * 512 + c] = a_;
                    LB[((size_t)d * MALL + row) * 512 + c] = (bf16)f2bf(sqrtf(fmaxf(1.f - a_ * a_, 1e-12f)) * (ig * xs[t * 68 + j]));
                }
            }
        }
    }
}


#define MEMFENCE() asm volatile("" ::: "memory")
struct StepOps { f32x4 k0, k1, q0, q1; float v, a; };
__device__ __forceinline__ void ssd_core(const float* __restrict__ qs, const float* __restrict__ ks, const float* __restrict__ vs, const float* __restrict__ as, const float* __restrict__ la, const float* __restrict__ lb,
                                         float* __restrict__ lo, float* __restrict__ yp, f32x2& S0, f32x2& S1, f32x2& S2, f32x2& S3, float& hl, int tid, int p, int sl, float dsk, bool has_a) {
    StepOps c, n;
#define LD_OPS(o, s_) do { (o).k0 = *(const f32x4*)&ks[(s_) * 64 + sl * 8]; (o).k1 = *(const f32x4*)&ks[(s_) * 64 + sl * 8 + 4]; (o).q0 = *(const f32x4*)&qs[(s_) * 64 + sl * 8]; (o).q1 = *(const f32x4*)&qs[(s_) * 64 + sl * 8 + 4]; \
        (o).v = vs[(s_) * 64 + p]; (o).a = has_a ? as[(s_)] : dsk; } while (0)
#define DO_STEP(o, s_) do { const float a_ = has_a ? (o).a : dsk; const float v_ = (o).v; \
        S0 = S0 * a_ + (f32x2){(o).k0.x, (o).k0.y} * v_; S1 = S1 * a_ + (f32x2){(o).k0.z, (o).k0.w} * v_; S2 = S2 * a_ + (f32x2){(o).k1.x, (o).k1.y} * v_; S3 = S3 * a_ + (f32x2){(o).k1.z, (o).k1.w} * v_; \
        const f32x2 y2_ = ((f32x2){(o).q0.x, (o).q0.y} * S0 + (f32x2){(o).q0.z, (o).q0.w} * S1) + ((f32x2){(o).q1.x, (o).q1.y} * S2 + (f32x2){(o).q1.z, (o).q1.w} * S3); \
        float y_ = y2_.x + y2_.y; if (has_a && sl == 0) y_ += dsk * v_; yp[(s_) * 512 + tid] = y_; } while (0)
    LD_OPS(c, 0); MEMFENCE();
#pragma unroll 2
    for (int s = 0; s < 32; s += 2) {
        LD_OPS(n, s + 1); MEMFENCE();
        DO_STEP(c, s); MEMFENCE();
        if (s + 2 < 32) { LD_OPS(c, s + 2); } MEMFENCE();
        DO_STEP(n, s + 1); MEMFENCE();
    }
#undef LD_OPS
#undef DO_STEP
    if (has_a && tid < 64) {
#pragma unroll 8
        for (int s = 0; s < 32; ++s) { hl = la[s * 64 + tid] * hl + lb[s * 64 + tid]; lo[s * 64 + tid] = hl; }
    }
}
__device__ __forceinline__ void hgrn_core(const float* __restrict__ qs, const float* __restrict__ fs, const float* __restrict__ vs, float* __restrict__ yp, f32x2& S0, f32x2& S1, f32x2& S2, f32x2& S3, int tid, int p, int sl) {
    StepOps c, n;
#define LD_OPS(o, s_) do { (o).k0 = *(const f32x4*)&fs[(s_) * 128 + sl * 4]; (o).k1 = *(const f32x4*)&fs[(s_) * 128 + 64 + sl * 4]; (o).q0 = *(const f32x4*)&qs[(s_) * 128 + sl * 4]; (o).q1 = *(const f32x4*)&qs[(s_) * 128 + 64 + sl * 4]; \
        (o).v = vs[(s_) * 32 + p]; } while (0)
#define DO_STEP(o, s_) do { const f32x2 v2_ = {(o).v, (o).v}; \
        S0 = v2_ + (f32x2){(o).k0.x, (o).k0.y} * (S0 - v2_); S1 = v2_ + (f32x2){(o).k0.z, (o).k0.w} * (S1 - v2_); S2 = v2_ + (f32x2){(o).k1.x, (o).k1.y} * (S2 - v2_); S3 = v2_ + (f32x2){(o).k1.z, (o).k1.w} * (S3 - v2_); \
        const f32x2 y2_ = ((f32x2){(o).q0.x, (o).q0.y} * S0 + (f32x2){(o).q0.z, (o).q0.w} * S1) + ((f32x2){(o).q1.x, (o).q1.y} * S2 + (f32x2){(o).q1.z, (o).q1.w} * S3); \
        yp[(s_) * 512 + tid] = y2_.x + y2_.y; } while (0)
    LD_OPS(c, 0); MEMFENCE();
#pragma unroll 2
    for (int s = 0; s < 32; s += 2) {
        LD_OPS(n, s + 1); MEMFENCE();
        DO_STEP(c, s); MEMFENCE();
        if (s + 2 < 32) { LD_OPS(c, s + 2); } MEMFENCE();
        DO_STEP(n, s + 1); MEMFENCE();
    }
#undef LD_OPS
#undef DO_STEP
}
constexpr int L_YP = 12544;
__device__ __forceinline__ void scan_ssd(const Params& P, float* L, int l, int c) {
    const int tid = tid_(), b = c >> 4, d = (c >> 3) & 1, h = c & 7, g = h >> 2;
    const float* U = (const float*)(P.ws + WS_U); const float* XBC = (const float*)(P.ws + WS_XBC); const float* LA = (const float*)(P.ws + WS_LA); const float* LB = (const float*)(P.ws + WS_LB);
    bf16* YD = (bf16*)(P.ws + WS_YD);
    float* qs = L; float* ks = L + 2048; float* vs = L + 4096; float* as = L + 6144; float* la = L + 6400; float* lb = L + 8448; float* lo = L + 10496; float* yp = L + L_YP;
    const float dtb = P.ssd_dt_bias[(l * 2 + d) * 8 + h], aneg = -__expf(P.ssd_a_log[(l * 2 + d) * 8 + h]), dsk = (d == 0) ? P.ssd_d[l * 8 + h] : 0.f;
    const int st = tid >> 4, sc4 = (tid & 15) << 2, p = tid >> 3, sl = tid & 7;
    f32x2 S0 = {0.f, 0.f}, S1 = {0.f, 0.f}, S2 = {0.f, 0.f}, S3 = {0.f, 0.f}; float hl = 0.f;
    f32x4 rx, rB, rC, ra, rb; float rdt;
#define SSD_LOAD(tile) do { const int row_ = scan_row(b, d, (tile) * 32 + st); const float* xr_ = XBC + (size_t)row_ * 768; \
        rx = *(const f32x4*)(xr_ + h * 64 + sc4); rB = *(const f32x4*)(xr_ + 512 + g * 64 + sc4); rC = *(const f32x4*)(xr_ + 640 + g * 64 + sc4); \
        rdt = U[(size_t)row_ * NINP + U_SSD_DT + d * 8 + h]; \
        ra = *(const f32x4*)(LA + ((size_t)d * MALL + row_) * 512 + h * 64 + sc4); rb = *(const f32x4*)(LB + ((size_t)d * MALL + row_) * 512 + h * 64 + sc4); } while (0)
    __syncthreads();
    SSD_LOAD(0);
    for (int tile = 0; tile < NTILES; ++tile) {
        { const float delta = softplus_(rdt + dtb);
          *(f32x4*)&vs[st * 64 + sc4] = rx; *(f32x4*)&ks[st * 64 + sc4] = rB * delta; *(f32x4*)&qs[st * 64 + sc4] = rC;
          if ((tid & 15) == 0) as[st] = __expf(aneg * delta);
          *(f32x4*)&la[st * 64 + sc4] = ra; *(f32x4*)&lb[st * 64 + sc4] = rb; }
        __syncthreads();
        if (tile + 1 < NTILES) SSD_LOAD(tile + 1);
        ssd_core(qs, ks, vs, as, la, lb, lo, yp, S0, S1, S2, S3, hl, tid, p, sl, dsk, true);
        __syncthreads();
#pragma unroll
        for (int j = 0; j < 4; ++j) {
            const int idx = tid + 512 * j, t = idx >> 6, pp = idx & 63;
            const f32x4 a0 = *(const f32x4*)&yp[t * 512 + pp * 8], a1 = *(const f32x4*)&yp[t * 512 + pp * 8 + 4];
            const int row = scan_row(b, d, tile * 32 + t);
            YD[((size_t)(0 * 2 + d) * MALL + row) * 512 + h * 64 + pp] = ((a0.x + a0.y) + (a0.z + a0.w)) + ((a1.x + a1.y) + (a1.z + a1.w));
            YD[((size_t)(1 * 2 + d) * MALL + row) * 512 + h * 64 + pp] = lo[t * 64 + pp];
        }
    }
#undef SSD_LOAD
}
__device__ __forceinline__ void scan_ret(const Params& P, float* L, int c) {
    const int tid = tid_(), b = c >> 4, h = (c >> 2) & 3, d = (c >> 1) & 1, vh = c & 1;
    const float* U = (const float*)(P.ws + WS_U); bf16* YD = (bf16*)(P.ws + WS_YD);
    float* qs = L; float* ks = L + 2048; float* vs = L + 4096; float* rope = L + 6400; float* yp = L + L_YP;
    const float a = 1.f - exp2f(-5.f - (float)h);
    const int st = tid >> 4, rem = tid & 15, sc4 = rem << 2, isk = rem >> 3, hs = (rem >> 2) & 1, cc = rem & 3, p = tid >> 3, sl = tid & 7;
    __syncthreads();
    for (int i = tid; i < 1024; i += 512) { const int pos = i >> 4, fi = i & 15; const float inv = exp2f(-(float)fi * 0.83048202372184f); const float rev = ((float)pos * inv) * 0.15915494309189535f;
        rope[2 * i] = __builtin_amdgcn_cosf(rev); rope[2 * i + 1] = __builtin_amdgcn_sinf(rev); }
    f32x2 S0 = {0.f, 0.f}, S1 = {0.f, 0.f}, S2 = {0.f, 0.f}, S3 = {0.f, 0.f};
    f32x4 r1, r2, rv;
    const int qkbase = (isk ? U_RT_K : U_RT_Q) + h * 64 + hs * 32 + 4 * cc;
#define RET_LOAD(tile) do { const float* ur_ = U + (size_t)scan_row(b, d, (tile) * 32 + st) * NINP; r1 = *(const f32x4*)(ur_ + qkbase); r2 = *(const f32x4*)(ur_ + qkbase + 16); \
        rv = *(const f32x4*)(ur_ + U_RT_V + h * 128 + vh * 64 + sc4); } while (0)
    RET_LOAD(0);
    for (int tile = 0; tile < NTILES; ++tile) {
        { f32x4 o1 = r1, o2 = r2;
          if (tile >= TC / 32) {
              const int tok = scan_row(b, d, tile * 32 + st) & (TL - 1); const int pos = hs ? (tok & 63) : (tok >> 6);
              const f32x4 cs0 = *(const f32x4*)&rope[(pos * 16 + 4 * cc) * 2], cs1 = *(const f32x4*)&rope[(pos * 16 + 4 * cc) * 2 + 4];
              const f32x4 cv = {cs0.x, cs0.z, cs1.x, cs1.z}, sv = {cs0.y, cs0.w, cs1.y, cs1.w};
              o1 = r1 * cv - r2 * sv; o2 = r1 * sv + r2 * cv;
          }
          float* dst = isk ? ks : qs; const float scl = isk ? 0.125f : 1.f;
          *(f32x4*)&dst[st * 64 + hs * 32 + 4 * cc] = o1 * scl; *(f32x4*)&dst[st * 64 + hs * 32 + 16 + 4 * cc] = o2 * scl;
          *(f32x4*)&vs[st * 64 + sc4] = rv; }
        __syncthreads();
        if (tile + 1 < NTILES) RET_LOAD(tile + 1);
        { float hl_ = 0.f; ssd_core(qs, ks, vs, vs, vs, vs, yp, yp, S0, S1, S2, S3, hl_, tid, p, sl, a, false); }
        __syncthreads();
#pragma unroll
        for (int j = 0; j < 4; ++j) {
            const int idx = tid + 512 * j, t = idx >> 6, pp = idx & 63;
            const f32x4 a0 = *(const f32x4*)&yp[t * 512 + pp * 8], a1 = *(const f32x4*)&yp[t * 512 + pp * 8 + 4];
            const int row = scan_row(b, d, tile * 32 + t);
            YD[((size_t)(3 * 2 + d) * MALL + row) * 512 + h * 128 + vh * 64 + pp] = ((a0.x + a0.y) + (a0.z + a0.w)) + ((a1.x + a1.y) + (a1.z + a1.w));
        }
    }
#undef RET_LOAD
}
__device__ __forceinline__ void scan_hgrn(const Params& P, float* L, int l, int c) {
    const int tid = tid_(), b = c >> 5, h = (c >> 3) & 3, d = (c >> 2) & 1, vq = c & 3;
    const float* U = (const float*)(P.ws + WS_U); bf16* YD = (bf16*)(P.ws + WS_YD);
    float* qs = L; float* fs = L + 4096; float* vs = L + 8192; float* yp = L + L_YP;
    const int st = tid >> 5, sc4 = (tid & 31) << 2, p = tid >> 4, sl = tid & 15;
    f32x4 lbv = {0.f, 0.f, 0.f, 0.f};
    if (l == 1) { const f32x4 g0 = *(const f32x4*)(P.hgrn_lb_logits + (size_t)(d * 2 + 0) * 512 + h * 128 + sc4), g1 = *(const f32x4*)(P.hgrn_lb_logits + (size_t)(d * 2 + 1) * 512 + h * 128 + sc4);
        lbv.x = sigmoid_(g1.x - g0.x); lbv.y = sigmoid_(g1.y - g0.y); lbv.z = sigmoid_(g1.z - g0.z); lbv.w = sigmoid_(g1.w - g0.w); }
    f32x2 S0 = {0.f, 0.f}, S1 = {0.f, 0.f}, S2 = {0.f, 0.f}, S3 = {0.f, 0.f};
    f32x4 rq0, rq1, rf0, rf1, rv = {0.f, 0.f, 0.f, 0.f};
#define HG_LOAD(tile) do { const float* u0_ = U + (size_t)scan_row(b, d, (tile) * 32 + st) * NINP; const float* u1_ = U + (size_t)scan_row(b, d, (tile) * 32 + st + 16) * NINP; \
        rq0 = *(const f32x4*)(u0_ + U_HG_Q + h * 128 + sc4); rq1 = *(const f32x4*)(u1_ + U_HG_Q + h * 128 + sc4); \
        rf0 = *(const f32x4*)(u0_ + U_HG_F + d * 512 + h * 128 + sc4); rf1 = *(const f32x4*)(u1_ + U_HG_F + d * 512 + h * 128 + sc4); \
        if (tid < 256) rv = *(const f32x4*)(U + (size_t)scan_row(b, d, (tile) * 32 + (tid >> 3)) * NINP + U_HG_I + h * 128 + vq * 32 + ((tid & 7) << 2)); } while (0)
    __syncthreads();
    HG_LOAD(0);
    for (int tile = 0; tile < NTILES; ++tile) {
        { f32x4 q, f;
#pragma unroll
          for (int e = 0; e < 4; ++e) { q[e] = silu_(rq0[e]) * 0.08838834764831845f; f[e] = lbv[e] + (1.f - lbv[e]) * sigmoid_(rf0[e]); }
          *(f32x4*)&qs[st * 128 + sc4] = q; *(f32x4*)&fs[st * 128 + sc4] = f;
#pragma unroll
          for (int e = 0; e < 4; ++e) { q[e] = silu_(rq1[e]) * 0.08838834764831845f; f[e] = lbv[e] + (1.f - lbv[e]) * sigmoid_(rf1[e]); }
          *(f32x4*)&qs[(st + 16) * 128 + sc4] = q; *(f32x4*)&fs[(st + 16) * 128 + sc4] = f;
          if (tid < 256) *(f32x4*)&vs[(tid >> 3) * 32 + ((tid & 7) << 2)] = rv; }
        __syncthreads();
        if (tile + 1 < NTILES) HG_LOAD(tile + 1);
        hgrn_core(qs, fs, vs, yp, S0, S1, S2, S3, tid, p, sl);
        __syncthreads();
#pragma unroll
        for (int j = 0; j < 2; ++j) {
            const int idx = tid + 512 * j, t = idx >> 5, pp = idx & 31;
            const f32x4 a0 = *(const f32x4*)&yp[t * 512 + pp * 16], a1 = *(const f32x4*)&yp[t * 512 + pp * 16 + 4], a2 = *(const f32x4*)&yp[t * 512 + pp * 16 + 8], a3 = *(const f32x4*)&yp[t * 512 + pp * 16 + 12];
            const int row = scan_row(b, d, tile * 32 + t);
            YD[((size_t)(2 * 2 + d) * MALL + row) * 512 + h * 128 + vq * 32 + pp] =
                (((a0.x + a0.y) + (a0.z + a0.w)) + ((a1.x + a1.y) + (a1.z + a1.w))) + (((a2.x + a2.y) + (a2.z + a2.w)) + ((a3.x + a3.y) + (a3.z + a3.w)));
        }
    }
#undef HG_LOAD
}

typedef __bf16 bf16x2_n __attribute__((ext_vector_type(2)));
__device__ __forceinline__ unsigned cvtpk(float lo, float hi) { f32x2 v = {lo, hi}; bf16x2_n b = __builtin_convertvector(v, bf16x2_n); return __builtin_bit_cast(unsigned, b); }
template <int KD, int VN> struct ChunkLds {
    static constexpr int PQ = (KD + 8) * 2;
    static constexpr int PT = 80;
    static constexpr int KM = 0, QM = KM + 16 * PQ, QE = QM + 16 * PQ, KWT = QE + 16 * PQ, G = KWT + KD * PT, VT = G + KD * 4, SIZE = VT + VN * PT;
};
template <int KD, int VN>
__device__ __forceinline__ f32x4 chunk_step(const unsigned char* C, int v0, int fr, int fq, f32x4 (&S)[KD / 16]) {
    using CL = ChunkLds<KD, VN>;
    f32x4 mt = {0.f, 0.f, 0.f, 0.f}, mt1 = {0.f, 0.f, 0.f, 0.f};
#pragma unroll
    for (int ks = 0; ks < KD / 32; ks += 2) {
        const bf16x8_t a = *(const bf16x8_t*)(C + CL::KM + fr * CL::PQ + (32 * ks + 8 * fq) * 2);
        const bf16x8_t b = *(const bf16x8_t*)(C + CL::QM + fr * CL::PQ + (32 * ks + 8 * fq) * 2);
        mt = __builtin_amdgcn_mfma_f32_16x16x32_bf16(a, b, mt, 0, 0, 0);
        const bf16x8_t a1 = *(const bf16x8_t*)(C + CL::KM + fr * CL::PQ + (32 * ks + 32 + 8 * fq) * 2);
        const bf16x8_t b1 = *(const bf16x8_t*)(C + CL::QM + fr * CL::PQ + (32 * ks + 32 + 8 * fq) * 2);
        mt1 = __builtin_amdgcn_mfma_f32_16x16x32_bf16(a1, b1, mt1, 0, 0, 0);
    }
    mt += mt1;
#pragma unroll
    for (int j = 0; j < 4; ++j) if (4 * fq + j > fr) mt[j] = 0.f;
    u32x4 bw; bw.x = cvtpk(mt[0], mt[1]); bw.y = cvtpk(mt[2], mt[3]); bw.z = 0u; bw.w = 0u;
    const u32x2 va = *(const u32x2*)(C + CL::VT + (v0 + fr) * CL::PT + (4 * fq) * 2);
    u32x4 aw; aw.x = va.x; aw.y = va.y; aw.z = 0u; aw.w = 0u;
    f32x4 yi = __builtin_amdgcn_mfma_f32_16x16x32_bf16(__builtin_bit_cast(bf16x8_t, aw), __builtin_bit_cast(bf16x8_t, bw), (f32x4){0.f, 0.f, 0.f, 0.f}, 0, 0, 0);
    f32x4 y = {0.f, 0.f, 0.f, 0.f};
#pragma unroll
    for (int i = 0; i < KD / 32; ++i) {
        u32x4 sa; sa.x = cvtpk(S[2 * i][0], S[2 * i][1]); sa.y = cvtpk(S[2 * i][2], S[2 * i][3]); sa.z = cvtpk(S[2 * i + 1][0], S[2 * i + 1][1]); sa.w = cvtpk(S[2 * i + 1][2], S[2 * i + 1][3]);
        const u32x2 lo = *(const u32x2*)(C + CL::QE + fr * CL::PQ + (32 * i + 4 * fq) * 2), hi = *(const u32x2*)(C + CL::QE + fr * CL::PQ + (32 * i + 16 + 4 * fq) * 2);
        u32x4 qb; qb.x = lo.x; qb.y = lo.y; qb.z = hi.x; qb.w = hi.y;
        y = __builtin_amdgcn_mfma_f32_16x16x32_bf16(__builtin_bit_cast(bf16x8_t, sa), __builtin_bit_cast(bf16x8_t, qb), y, 0, 0, 0);
    }
    y += yi;
    const bf16x8_t bv = *(const bf16x8_t*)(C + CL::VT + (v0 + fr) * CL::PT + (8 * fq) * 2);
#pragma unroll
    for (int i = 0; i < KD / 16; ++i) {
        const f32x4 g4 = *(const f32x4*)(C + CL::G + (16 * i + 4 * fq) * 4);
        const bf16x8_t ak = *(const bf16x8_t*)(C + CL::KWT + (16 * i + fr) * CL::PT + (8 * fq) * 2);
        S[i] = __builtin_amdgcn_mfma_f32_16x16x32_bf16(ak, bv, S[i] * g4, 0, 0, 0);
    }
    return y;
}
template <int KD, int VN, bool LVEC>
__device__ __forceinline__ void build_operands(const float* __restrict__ rq, const float* __restrict__ rk, const float* __restrict__ rL, const float* __restrict__ rv, unsigned char* __restrict__ OP, int t0, int nthr) {
    using CL = ChunkLds<KD, VN>;
    for (int idx = t0; idx < 8 * KD; idx += nthr) {
        const int kq = idx % (KD / 4), t = (idx / (KD / 4)) & 15, c = idx / (4 * KD), k = 4 * kq, row = c * 16 + t;
        const f32x4 q4 = *(const f32x4*)&rq[row * KD + k], k4 = *(const f32x4*)&rk[row * KD + k];
        f32x4 Lt, Lm;
        if (LVEC) { Lt = *(const f32x4*)&rL[row * KD + k]; Lm = *(const f32x4*)&rL[(c * 16 + 7) * KD + k]; } else { const float a_ = rL[row], b_ = rL[c * 16 + 7]; Lt = (f32x4){a_, a_, a_, a_}; Lm = (f32x4){b_, b_, b_, b_}; }
        f32x4 qe, qm, km;
#pragma unroll
        for (int e = 0; e < 4; ++e) { qe[e] = q4[e] * __expf(Lt[e]); qm[e] = q4[e] * __expf(fminf(Lt[e] - Lm[e], 80.f)); km[e] = k4[e] * __expf(fminf(Lm[e] - Lt[e], 80.f)); }
        unsigned char* base = OP + c * CL::SIZE + t * CL::PQ + k * 2;
        u32x2 w; w.x = cvtpk(qe[0], qe[1]); w.y = cvtpk(qe[2], qe[3]); *(u32x2*)(base + CL::QE) = w;
        w.x = cvtpk(qm[0], qm[1]); w.y = cvtpk(qm[2], qm[3]); *(u32x2*)(base + CL::QM) = w;
        w.x = cvtpk(km[0], km[1]); w.y = cvtpk(km[2], km[3]); *(u32x2*)(base + CL::KM) = w;
    }
    for (int idx = t0; idx < 4 * KD; idx += nthr) {
        const int k = idx % KD, oc = (idx / KD) & 1, c = idx / (2 * KD);
        const float Le = LVEC ? rL[(c * 16 + 15) * KD + k] : rL[c * 16 + 15];
        float w[8];
#pragma unroll
        for (int e = 0; e < 8; ++e) { const int row = c * 16 + 8 * oc + e; const float Lt = LVEC ? rL[row * KD + k] : rL[row]; w[e] = rk[row * KD + k] * __expf(Le - Lt); }
        u32x4 o; o.x = cvtpk(w[0], w[1]); o.y = cvtpk(w[2], w[3]); o.z = cvtpk(w[4], w[5]); o.w = cvtpk(w[6], w[7]);
        *(u32x4*)(OP + c * CL::SIZE + CL::KWT + k * CL::PT + oc * 16) = o;
        if (oc == 0) *(float*)(OP + c * CL::SIZE + CL::G + k * 4) = __expf(Le);
    }
    for (int idx = t0; idx < 4 * VN; idx += nthr) {
        const int v = idx % VN, oc = (idx / VN) & 1, c = idx / (2 * VN);
        float w[8];
#pragma unroll
        for (int e = 0; e < 8; ++e) w[e] = rv[(c * 16 + 8 * oc + e) * VN + v];
        u32x4 o; o.x = cvtpk(w[0], w[1]); o.y = cvtpk(w[2], w[3]); o.z = cvtpk(w[4], w[5]); o.w = cvtpk(w[6], w[7]);
        *(u32x4*)(OP + c * CL::SIZE + CL::VT + v * CL::PT + oc * 16) = o;
    }
}
template <int KD, int VN>
__device__ __forceinline__ void zero_operand_pads(unsigned char* OP, int t0, int nthr) {
    using CL = ChunkLds<KD, VN>;
    for (int idx = t0; idx < 2 * (KD + VN) * 2; idx += nthr) {
        const int half = idx & 1, r = (idx >> 1) % (KD + VN), c = (idx >> 1) / (KD + VN);
        unsigned char* row = OP + c * CL::SIZE + (r < KD ? CL::KWT + r * CL::PT : CL::VT + (r - KD) * CL::PT);
        *(u32x4*)(row + 32 + half * 16) = (u32x4){0u, 0u, 0u, 0u};
    }
}
constexpr int L_RAW_Q = 0, L_RAW_K = 16384, L_RAW_L = 32768, L_RAW_V = 49152, L_OP = 65536;

__device__ __forceinline__ void scan_ret_mfma(const Params& P, unsigned char* LB, int c) {
    const int tid = tid_(), lane = tid & 63, wave = __builtin_amdgcn_readfirstlane(tid >> 6), fr = lane & 15, fq = lane >> 4;
    const int vh = c & 1, b = c >> 4, h = (c >> 2) & 3, d = (c >> 1) & 1;
    const float* U = (const float*)(P.ws + WS_U); bf16* YD = (bf16*)(P.ws + WS_YD);
    float* rq = (float*)(LB + L_RAW_Q); float* rk = (float*)(LB + L_RAW_K); float* rL = (float*)(LB + L_RAW_L); float* rv = (float*)(LB + L_RAW_V);
    float* rope = (float*)(LB + L_RAW_L + 1024);
    unsigned char* OP = LB + L_OP;
    const float la = __logf(1.f - exp2f(-5.f - (float)h));
    const int st = tid >> 4, rem = tid & 15, isk = rem >> 3, hs = (rem >> 2) & 1, cc = rem & 3;
    __syncthreads();
    for (int i = tid; i < 1024; i += 512) { const int pos = i >> 4, fi = i & 15; const float inv = exp2f(-(float)fi * 0.83048202372184f); const float rev = ((float)pos * inv) * 0.15915494309189535f;
        rope[2 * i] = __builtin_amdgcn_cosf(rev); rope[2 * i + 1] = __builtin_amdgcn_sinf(rev); }
    if (tid < 32) rL[tid] = (float)((tid & 15) + 1) * la;
    zero_operand_pads<64, 64>(OP, tid, 512);
    f32x4 S[4];
#pragma unroll
    for (int i = 0; i < 4; ++i) S[i] = (f32x4){0.f, 0.f, 0.f, 0.f};
    f32x4 r1, r2, rv0;
    const int qkbase = (isk ? U_RT_K : U_RT_Q) + h * 64 + hs * 32 + 4 * cc;
#define RETM_LOAD(tile) do { const float* ur_ = U + (size_t)scan_row(b, d, (tile) * 32 + st) * NINP; r1 = *(const f32x4*)(ur_ + qkbase); r2 = *(const f32x4*)(ur_ + qkbase + 16); \
        rv0 = *(const f32x4*)(ur_ + U_RT_V + h * 128 + vh * 64 + rem * 4); } while (0)
    RETM_LOAD(0);
    for (int tile = 0; tile < NTILES; ++tile) {
        { f32x4 o1 = r1, o2 = r2;
          if (tile >= TC / 32) {
              const int tok = scan_row(b, d, tile * 32 + st) & (TL - 1); const int pos = hs ? (tok & 63) : (tok >> 6);
              const f32x4 cs0 = *(const f32x4*)&rope[(pos * 16 + 4 * cc) * 2], cs1 = *(const f32x4*)&rope[(pos * 16 + 4 * cc) * 2 + 4];
              const f32x4 cv = {cs0.x, cs0.z, cs1.x, cs1.z}, sv = {cs0.y, cs0.w, cs1.y, cs1.w};
              o1 = r1 * cv - r2 * sv; o2 = r1 * sv + r2 * cv;
          }
          float* dst = isk ? rk : rq; const float scl = isk ? 0.125f : 1.f;
          *(f32x4*)&dst[st * 64 + hs * 32 + 4 * cc] = o1 * scl; *(f32x4*)&dst[st * 64 + hs * 32 + 16 + 4 * cc] = o2 * scl;
          *(f32x4*)&rv[st * 64 + rem * 4] = rv0; }
        __syncthreads();
        if (tile + 1 < NTILES) RETM_LOAD(tile + 1);
        build_operands<64, 64, false>(rq, rk, rL, rv, OP, tid, 512);
        __syncthreads();
        if (wave < 4) {
#pragma unroll
        for (int ch = 0; ch < 2; ++ch) {
            const f32x4 y = chunk_step<64, 64>(OP + ch * ChunkLds<64, 64>::SIZE, wave * 16, fr, fq, S);
            const int row = scan_row(b, d, tile * 32 + ch * 16 + fr);
            { u32x2 w_; w_.x = cvtpk(y[0], y[1]); w_.y = cvtpk(y[2], y[3]); *(u32x2*)(YD + ((size_t)(3 * 2 + d) * MALL + row) * 512 + h * 128 + vh * 64 + wave * 16 + 4 * fq) = w_; }
        }
        }
    }
#undef RETM_LOAD
}

__device__ __forceinline__ void scan_hgrn_mfma(const Params& P, unsigned char* LB, int l, int c) {
    using CL = ChunkLds<128, 64>;
    const int tid = tid_(), lane = tid & 63, wave = __builtin_amdgcn_readfirstlane(tid >> 6), fr = lane & 15, fq = lane >> 4;
    const int vq = c & 1, b = c >> 4, h = (c >> 2) & 3, d = (c >> 1) & 1;
    const float* U = (const float*)(P.ws + WS_U); bf16* YD = (bf16*)(P.ws + WS_YD);
    unsigned char* OP = LB;
    float* tot = (float*)(LB + 58368);
    const int k = 2 * lane, qt = wave & 3, cb = wave >> 2;
    const int vv_ = tid & 63, vqt = wave & 3, vc = wave >> 2;
    f32x2 lb2 = {0.f, 0.f};
    if (l == 1) { const f32x2 g0 = *(const f32x2*)(P.hgrn_lb_logits + (size_t)(d * 2 + 0) * 512 + h * 128 + k), g1 = *(const f32x2*)(P.hgrn_lb_logits + (size_t)(d * 2 + 1) * 512 + h * 128 + k);
        lb2.x = sigmoid_(g1.x - g0.x); lb2.y = sigmoid_(g1.y - g0.y); }
    __syncthreads();
    zero_operand_pads<128, 64>(OP, tid, 512);
    f32x4 S[8];
#pragma unroll
    for (int i = 0; i < 8; ++i) S[i] = (f32x4){0.f, 0.f, 0.f, 0.f};
    f32x2 pq[4], pf[4]; float pv[4] = {0.f, 0.f, 0.f, 0.f};
#define HGM_LOAD(tile) do { const float* ub_ = U + (size_t)scan_row(b, d, (tile) * 32 + cb * 16 + qt * 4) * NINP;     \
        _Pragma("unroll") for (int r_ = 0; r_ < 4; ++r_) { const float* u_ = ub_ + (ptrdiff_t)(d ? -r_ : r_) * NINP; \
        pq[r_] = *(const f32x2*)(u_ + U_HG_Q + h * 128 + k); pf[r_] = *(const f32x2*)(u_ + U_HG_F + d * 512 + h * 128 + k); \
        pv[r_] = u_[U_HG_I + h * 128 + vq * 64 + vv_]; } } while (0)
    HGM_LOAD(0);
    for (int tile = 0; tile < NTILES; ++tile) {
        f32x2 q[4], kk[4], pre[4], suf[4]; float vv[4];
        { f32x2 fc[4];
#pragma unroll
          for (int r = 0; r < 4; ++r) {
              const float eq0 = 1.f + __expf(fminf(-pq[r].x, 40.f)), ef0 = 1.f + __expf(fminf(-pf[r].x, 40.f)), r0_ = __builtin_amdgcn_rcpf(eq0 * ef0);
              const float eq1 = 1.f + __expf(fminf(-pq[r].y, 40.f)), ef1 = 1.f + __expf(fminf(-pf[r].y, 40.f)), r1_ = __builtin_amdgcn_rcpf(eq1 * ef1);
              q[r].x = pq[r].x * (ef0 * r0_) * 0.08838834764831845f; q[r].y = pq[r].y * (ef1 * r1_) * 0.08838834764831845f;
              const float f0 = lb2.x + (1.f - lb2.x) * (eq0 * r0_), f1 = lb2.y + (1.f - lb2.y) * (eq1 * r1_);
              kk[r].x = 1.f - f0; kk[r].y = 1.f - f1; fc[r].x = fmaxf(f0, 1e-4f); fc[r].y = fmaxf(f1, 1e-4f); vv[r] = pv[r];
          }
          pre[0] = fc[0]; pre[1] = pre[0] * fc[1]; pre[2] = pre[1] * fc[2]; pre[3] = pre[2] * fc[3];
          suf[3] = (f32x2){1.f, 1.f}; suf[2] = fc[3]; suf[1] = suf[2] * fc[2]; suf[0] = suf[1] * fc[1]; }
        *(f32x2*)&tot[(cb * 4 + qt) * 128 + k] = pre[3];
        __syncthreads();
        if (tile + 1 < NTILES) HGM_LOAD(tile + 1);
        {
            const f32x2 t0 = *(const f32x2*)&tot[(cb * 4 + 0) * 128 + k], t1 = *(const f32x2*)&tot[(cb * 4 + 1) * 128 + k], t2 = *(const f32x2*)&tot[(cb * 4 + 2) * 128 + k], t3 = *(const f32x2*)&tot[(cb * 4 + 3) * 128 + k];
            const f32x2 Pm = t0 * t1, T23 = t2 * t3;
            unsigned char* C = OP + cb * CL::SIZE;
            float kw0[4], kw1[4];
#pragma unroll
            for (int r = 0; r < 4; ++r) {
                const int t = qt * 4 + r;
                f32x2 R, iR;
                if (qt >= 2) { R = pre[r]; if (qt == 3) R *= t2; iR.x = __builtin_amdgcn_rcpf(R.x); iR.y = __builtin_amdgcn_rcpf(R.y); }
                else { iR = suf[r]; if (qt == 0) iR *= t1; R.x = __builtin_amdgcn_rcpf(iR.x); R.y = __builtin_amdgcn_rcpf(iR.y); }
                const f32x2 Pt = Pm * R;
                unsigned char* p = C + t * CL::PQ + k * 2;
                *(unsigned*)(p + CL::QE) = cvtpk(q[r].x * Pt.x, q[r].y * Pt.y);
                *(unsigned*)(p + CL::QM) = cvtpk(q[r].x * R.x, q[r].y * R.y);
                *(unsigned*)(p + CL::KM) = cvtpk(kk[r].x * iR.x, kk[r].y * iR.y);
                kw0[r] = kk[r].x * T23.x * iR.x; kw1[r] = kk[r].y * T23.y * iR.y;
            }
            u32x2 w; w.x = cvtpk(kw0[0], kw0[1]); w.y = cvtpk(kw0[2], kw0[3]); *(u32x2*)(C + CL::KWT + k * CL::PT + qt * 8) = w;
            w.x = cvtpk(kw1[0], kw1[1]); w.y = cvtpk(kw1[2], kw1[3]); *(u32x2*)(C + CL::KWT + (k + 1) * CL::PT + qt * 8) = w;
            if (qt == 0) *(f32x2*)(C + CL::G + k * 4) = Pm * T23;
            { u32x2 wv; wv.x = cvtpk(vv[0], vv[1]); wv.y = cvtpk(vv[2], vv[3]); *(u32x2*)(OP + vc * CL::SIZE + CL::VT + vv_ * CL::PT + vqt * 8) = wv; }
        }
        __syncthreads();
        if (wave < 4) {
#pragma unroll
            for (int ch = 0; ch < 2; ++ch) {
                const f32x4 y = chunk_step<128, 64>(OP + ch * CL::SIZE, wave * 16, fr, fq, S);
                const int row = scan_row(b, d, tile * 32 + ch * 16 + fr);
                { u32x2 w_; w_.x = cvtpk(y[0], y[1]); w_.y = cvtpk(y[2], y[3]); *(u32x2*)(YD + ((size_t)(2 * 2 + d) * MALL + row) * 512 + h * 128 + vq * 64 + wave * 16 + 4 * fq) = w_; }
            }
        }
    }
#undef HGM_LOAD
}
__device__ __forceinline__ void scan_ssd_mfma(const Params& P, unsigned char* LB, int l, int c) {
    const int tid = tid_(), lane = tid & 63, wave = __builtin_amdgcn_readfirstlane(tid >> 6), fr = lane & 15, fq = lane >> 4;
    const int b = c >> 4, d = (c >> 3) & 1, h = c & 7, g = h >> 2;
    const float* U = (const float*)(P.ws + WS_U); const bf16* XBC = (const bf16*)(P.ws + WS_XBC); bf16* YD = (bf16*)(P.ws + WS_YD);
    float* rq = (float*)(LB + L_RAW_Q); float* rk = (float*)(LB + L_RAW_K); float* rL = (float*)(LB + L_RAW_L); float* lg = (float*)(LB + L_RAW_L + 256); float* rv = (float*)(LB + L_RAW_V);
    unsigned char* OP = LB + L_OP;
    const float dtb = P.ssd_dt_bias[(l * 2 + d) * 8 + h], aneg = -__expf(P.ssd_a_log[(l * 2 + d) * 8 + h]);
    const int st = tid >> 4, sc4 = (tid & 15) << 2;
    __syncthreads();
    zero_operand_pads<64, 64>(OP, tid, 512);
    f32x4 S[4];
#pragma unroll
    for (int i = 0; i < 4; ++i) S[i] = (f32x4){0.f, 0.f, 0.f, 0.f};
    f32x4 px, pB, pC; float pdt;
#define SSM_LOAD(tile) do { const int row_ = scan_row(b, d, (tile) * 32 + st); const bf16* xr_ = XBC + (size_t)row_ * 768; \
        px = ld_bf4(xr_ + h * 64 + sc4); pB = ld_bf4(xr_ + 512 + g * 64 + sc4); pC = ld_bf4(xr_ + 640 + g * 64 + sc4); pdt = U[(size_t)row_ * NINP + U_SSD_DT + d * 8 + h]; } while (0)
    SSM_LOAD(0);
    for (int tile = 0; tile < NTILES; ++tile) {
        { const float delta = softplus_(pdt + dtb); const int o = st * 64 + sc4;
          *(f32x4*)&rv[o] = px; *(f32x4*)&rk[o] = pB * delta; *(f32x4*)&rq[o] = pC;
          if ((tid & 15) == 0) lg[st] = aneg * delta; }
        __syncthreads();
        if (tile + 1 < NTILES) SSM_LOAD(tile + 1);
        if (tid < 32) { const int c0 = tid & 16; float acc = 0.f;
#pragma unroll
            for (int t = 0; t < 16; ++t) { const float v_ = lg[c0 + t]; acc += (c0 + t <= tid) ? v_ : 0.f; }
            rL[tid] = acc; }
        __syncthreads();
        build_operands<64, 64, false>(rq, rk, rL, rv, OP, tid, 512);
        __syncthreads();
        if (wave < 4) {
#pragma unroll
            for (int ch = 0; ch < 2; ++ch) {
                const f32x4 y = chunk_step<64, 64>(OP + ch * ChunkLds<64, 64>::SIZE, wave * 16, fr, fq, S);
                const int row = scan_row(b, d, tile * 32 + ch * 16 + fr);
                { u32x2 w_; w_.x = cvtpk(y[0], y[1]); w_.y = cvtpk(y[2], y[3]); *(u32x2*)(YD + ((size_t)(0 * 2 + d) * MALL + row) * 512 + h * 64 + wave * 16 + 4 * fq) = w_; }
            }
        }
    }
#undef SSM_LOAD
}
__device__ __forceinline__ void scan_lru(const Params& P, float* L, int c) {
    const int tid = tid_(), ch = tid & 63, seg = __builtin_amdgcn_readfirstlane(tid >> 6), b = c >> 3, d = (c >> 2) & 1, cgp = c & 3;
    const float* LA = (const float*)(P.ws + WS_LA) + (size_t)d * MALL * 512 + cgp * 128 + ch; const bf16* LBp = (const bf16*)(P.ws + WS_LB) + (size_t)d * MALL * 512 + cgp * 128 + ch;
    bf16* YD = (bf16*)(P.ws + WS_YD) + (size_t)(1 * 2 + d) * MALL * 512 + cgp * 128 + ch;
    float* car = L;
    const int s0 = seg * 288;
    __syncthreads();
    float h0 = 0.f, h1 = 0.f, ap0 = 1.f, ap1 = 1.f;
#pragma unroll 1
    for (int pass = 0; pass < 2; ++pass) {
        float a0[16], b0[16], c0[16], d0[16];
#pragma unroll
        for (int s = 0; s < 16; ++s) { const size_t r = (size_t)scan_row(b, d, s0 + s) * 512; a0[s] = LA[r]; b0[s] = __builtin_bit_cast(float, (unsigned)LBp[r] << 16); c0[s] = LA[r + 64]; d0[s] = __builtin_bit_cast(float, (unsigned)LBp[r + 64] << 16); }
#pragma unroll 1
        for (int tile = 0; tile < 18; ++tile) {
            float a1[16], b1[16], c1[16], d1[16];
            if (tile + 1 < 18) {
#pragma unroll
                for (int s = 0; s < 16; ++s) { const size_t r = (size_t)scan_row(b, d, s0 + (tile + 1) * 16 + s) * 512; a1[s] = LA[r]; b1[s] = __builtin_bit_cast(float, (unsigned)LBp[r] << 16); c1[s] = LA[r + 64]; d1[s] = __builtin_bit_cast(float, (unsigned)LBp[r + 64] << 16); }
            }
            if (pass == 0) {
#pragma unroll
                for (int s = 0; s < 16; ++s) { h0 = a0[s] * h0 + b0[s]; ap0 *= a0[s]; h1 = c0[s] * h1 + d0[s]; ap1 *= c0[s]; }
            } else {
#pragma unroll
                for (int s = 0; s < 16; ++s) { h0 = a0[s] * h0 + b0[s]; h1 = c0[s] * h1 + d0[s]; const size_t r = (size_t)scan_row(b, d, s0 + tile * 16 + s) * 512; YD[r] = (bf16)f2bf(h0); YD[r + 64] = (bf16)f2bf(h1); }
            }
#pragma unroll
            for (int s = 0; s < 16; ++s) { a0[s] = a1[s]; b0[s] = b1[s]; c0[s] = c1[s]; d0[s] = d1[s]; }
        }
        if (pass == 0) {
            car[(seg * 128 + ch) * 2] = ap0; car[(seg * 128 + ch) * 2 + 1] = h0; car[(seg * 128 + 64 + ch) * 2] = ap1; car[(seg * 128 + 64 + ch) * 2 + 1] = h1;
            __syncthreads();
            float hin0 = 0.f, hin1 = 0.f;
            for (int sg = 0; sg < seg; ++sg) { hin0 = car[(sg * 128 + ch) * 2] * hin0 + car[(sg * 128 + ch) * 2 + 1]; hin1 = car[(sg * 128 + 64 + ch) * 2] * hin1 + car[(sg * 128 + 64 + ch) * 2 + 1]; }
            h0 = hin0; h1 = hin1;
        }
    }
}
__device__ __forceinline__ void scan_phase(const Params& P, float* L, int l) {
    for (int it = bid_(); it < 224; it += gridDim.x) {
        if (it < 64) scan_hgrn_mfma(P, (unsigned char*)L, l, it);
        else if (it < 128) scan_ssd_mfma(P, (unsigned char*)L, l, it - 64);
        else if (it < 192) scan_ret_mfma(P, (unsigned char*)L, it - 128);
        else scan_lru(P, L, it - 192);
    }
}

__device__ __forceinline__ void post_phase(const Params& P, int l, int mrows) {
    const int tid = tid_(), lane = tid & 63, wave = __builtin_amdgcn_readfirstlane(tid >> 6);
    const int gw = bid_() * 8 + wave, NGW = gridDim.x * 8;
    const float* U = (const float*)(P.ws + WS_U); const bf16* YD = (const bf16*)(P.ws + WS_YD); bf16* YC = (bf16*)(P.ws + WS_H);
    for (int row = gw; row < mrows; row += NGW) {
        const float* ur = U + (size_t)row * NINP; bf16* yc = YC + (size_t)row * DM;
#define YDP(m, d) (YD + ((size_t)((m) * 2 + (d)) * MALL + row) * 512)
#define LDY(p) ld_bf4(p)
        {
            f32x4 gg[2]; float ss = 0.f;
#pragma unroll
            for (int j = 0; j < 2; ++j) { const int c = 4 * lane + 256 * j; const float dsk = P.ssd_d[l * 8 + (c >> 6)]; const f32x4 y = LDY(YDP(0, 0) + c) + LDY(YDP(0, 1) + c) + ld_bf4((const bf16*)(P.ws + WS_XBC) + (size_t)row * 768 + c) * dsk; const f32x4 z = *(const f32x4*)(ur + c);
                f32x4 t; t.x = y.x * silu_(z.x); t.y = y.y * silu_(z.y); t.z = y.z * silu_(z.z); t.w = y.w * silu_(z.w); gg[j] = t; ss += dot4(t); }
            const float rs = rsqrtf(wave_sum(ss) * (1.f / 512.f) + EPS);
#pragma unroll
            for (int j = 0; j < 2; ++j) { const int c = 4 * lane + 256 * j; const f32x4 w = *(const f32x4*)(P.ssd_norm_w + (size_t)l * 512 + c); const f32x4 o = gg[j] * rs * w;
                u32x2 pk; pk.x = pk2(o.x, o.y); pk.y = pk2(o.z, o.w); *(u32x2*)(yc + c) = pk; }
        }
        {
#pragma unroll
            for (int j = 0; j < 2; ++j) { const int c = 4 * lane + 256 * j; const f32x4 hh = LDY(YDP(1, 0) + c) + LDY(YDP(1, 1) + c); const f32x4 gb = *(const f32x4*)(ur + U_LRU_G + c);
                f32x4 o; o.x = hh.x * gelu_tanh_(gb.x); o.y = hh.y * gelu_tanh_(gb.y); o.z = hh.z * gelu_tanh_(gb.z); o.w = hh.w * gelu_tanh_(gb.w);
                u32x2 pk; pk.x = pk2(o.x, o.y); pk.y = pk2(o.z, o.w); *(u32x2*)(yc + 512 + c) = pk; }
        }
        {
#pragma unroll
            for (int j = 0; j < 2; ++j) { const int c = 4 * lane + 256 * j; const f32x4 o = LDY(YDP(2, 0) + c) + LDY(YDP(2, 1) + c);
                const float rs = rsqrtf(half_sum(dot4(o)) * (1.f / 128.f) + EPS); const f32x4 w = *(const f32x4*)(P.hgrn_norm_w + (size_t)l * 128 + (c & 127)); const f32x4 gt = *(const f32x4*)(ur + U_HG_G + c);
                f32x4 r; r.x = o.x * rs * w.x * silu_(gt.x); r.y = o.y * rs * w.y * silu_(gt.y); r.z = o.z * rs * w.z * silu_(gt.z); r.w = o.w * rs * w.w * silu_(gt.w);
                u32x2 pk; pk.x = pk2(r.x, r.y); pk.y = pk2(r.z, r.w); *(u32x2*)(yc + 1024 + c) = pk; }
        }
        {
#pragma unroll
            for (int j = 0; j < 2; ++j) { const int c = 4 * lane + 256 * j; const f32x4 o = LDY(YDP(3, 0) + c) + LDY(YDP(3, 1) + c);
                const float rs = rsqrtf(half_sum(dot4(o)) * (1.f / 128.f) + EPS); const f32x4 gt = *(const f32x4*)(ur + U_RT_G + c);
                f32x4 r; r.x = o.x * rs * silu_(gt.x); r.y = o.y * rs * silu_(gt.y); r.z = o.z * rs * silu_(gt.z); r.w = o.w * rs * silu_(gt.w);
                u32x2 pk; pk.x = pk2(r.x, r.y); pk.y = pk2(r.z, r.w); *(u32x2*)(yc + 1536 + c) = pk; }
        }
#undef YDP
    }
}

__global__ void __launch_bounds__(512, 2) mk_fwd(Params Pkarg) {
    extern __shared__ __attribute__((aligned(16))) unsigned char lds_raw[];
    float* L = (float*)lds_raw;
    const __attribute__((address_space(4))) Params* kp = (const __attribute__((address_space(4))) Params*)__builtin_amdgcn_kernarg_segment_ptr();
    const int ph_lo = kp->ph_lo, ph_hi = kp->ph_hi;
    {
        volatile LAS unsigned* st0 = (volatile LAS unsigned*)((LAS unsigned char*)lds_raw + (LDS_BYTES - 128));
        if (threadIdx.x == 0) { st0[0] = 0u; st0[1] = 0u; }
        __syncthreads();
        (void)xcd_barrier_post((unsigned*)kp->ws, st0);
    }
    for (int ph = ph_lo; ph < ph_hi; ++ph) {
        asm volatile("" : "+s"(kp));
#if defined(__HIP_DEVICE_COMPILE__)
        const Params P = *kp;
#else
        const Params P = Pkarg;
#endif
        unsigned char* ws = P.ws;
#ifdef PROBE_DUP
        const int kk_ = ph < 2 ? 100 + ph : (ph - 2) % 12;
        const int nrep_ = (kk_ == PROBE_DUP || kk_ == PROBE_DUP2) ? 2 : 1;
        for (int rep_ = 0; rep_ < nrep_; ++rep_) { if (rep_) cg::this_grid().sync();
#endif
        if (ph == 0) prologue_phase(P, L);
        else if (ph == 1) rowwise_phase(P, MALL, true, 0, 0, 0, 0.f, false, 0, 0, 0, 1);
        else {
            const int q = ph - 2, l = q / 12, k = q % 12;
            const int Mg = (l == 1 && k >= 6) ? MLAT : MALL;
            if (k == 0 || k == 9) {
                const int lf = l * 2 + (k == 9);
                pg8::Gemm g{(const pg8::bf16_t*)(ws + WS_H), (const pg8::bf16_t*)(ws + WS_W13) + (size_t)lf * NUP * DM, Mg, NUP, DM, DM};
                pg8::StaticOrder S; S.init(Mg, NUP, (int)gridDim.x, bid_());
                pg8::EpiSwiGLU E{(pg8::bf16_t*)(ws + WS_U), FF};
                pg8::gemm_phase<pg8::EpiSwiGLU, pg8::StaticOrder, true, true>((LAS unsigned char*)lds_raw, g, S, E);
            } else if (k == 1 || k == 10 || k == 3 || k == 7) {
                const pg8::bf16_t* A; const pg8::bf16_t* Bt; int N, K; float* O;
                if (k == 3) { A = (const pg8::bf16_t*)(ws + WS_H); Bt = (const pg8::bf16_t*)(ws + WS_WIN) + (size_t)l * NINP * DM; N = NINP; K = DM; O = (float*)(ws + WS_U); }
                else if (k == 7) { A = (const pg8::bf16_t*)(ws + WS_H); Bt = (const pg8::bf16_t*)(ws + WS_WOUT) + (size_t)l * DM * DM; N = DM; K = DM; O = (float*)(ws + WS_Y); }
                else { const int lf = l * 2 + (k == 10); A = (const pg8::bf16_t*)(ws + WS_U); Bt = (const pg8::bf16_t*)(ws + WS_W2) + (size_t)lf * DM * FF; N = DM; K = FF; O = (float*)(ws + WS_Y); }
                const bool splitk = (k != 3) && (Mg == MALL);
                const int M1 = splitk ? MLAT : Mg;
                { pg8::Gemm g{A, Bt, M1, N, K, K};
                  pg8::Order2 S; S.so.init(M1, N, (int)gridDim.x, bid_()); S.one = 0; S.valid = 1; S.u1.pm = 0; S.u1.pn = 0;
                  pg8::EpiF32 E{O, N, (k != 3) ? 1 : 0};
                  pg8::gemm_phase<pg8::EpiF32, pg8::Order2, true, true>((LAS unsigned char*)lds_raw, g, S, E); }
                if (splitk) {
                    for (int c = bid_(); c < 256; c += (int)gridDim.x) {
                        const int u = c >> 3, ks = c & 7, nt2 = K >> 7;
                        const int kt0 = 2 * ((ks * nt2) >> 3), kt1 = 2 * (((ks + 1) * nt2) >> 3);
                        pg8::Gemm g{A + kt0 * 64, Bt + kt0 * 64, MALL, N, (kt1 - kt0) * 64, K};
                        pg8::Order2 S; S.so.init(MALL, N, 1, 0); S.one = 1; S.valid = 1; S.u1.pm = 32 + (u >> 3); S.u1.pn = u & 7;
                        pg8::EpiF32 E{(float*)((bf16*)(ws + WS_YD) + (size_t)ks * MCTX * DM - (size_t)MLAT * DM), N, 1};
                        pg8::gemm_phase<pg8::EpiF32, pg8::Order2, true, true>((LAS unsigned char*)lds_raw, g, S, E);
                    }
                }
            } else if (k == 2) rowwise_phase(P, MALL, false, l, 0, 2, 0.5f, false, l, 1, 3, 4);
            else if (k == 8) rowwise_phase(P, Mg, false, l, 1, 5, 1.0f, false, l, 2, 6, 7);
            else if (k == 11) rowwise_phase(P, Mg, false, l, 2, 8, 0.5f, l == 1, l + 1, 0, 0, 1);
            else if (k == 4) prep_phase(P, L, l);
            else if (k == 5) scan_phase(P, L, l);
            else post_phase(P, l, Mg);
        }
#ifdef PROBE_DUP
        }
#endif
        if (ph + 1 < ph_hi) {
            if (ph == 0) cg::this_grid().sync();
            else { XcdBarrier xb; xb.bar = (unsigned*)ws; xb.x = xb_xcc_id(); xb.st = (volatile LAS unsigned*)((LAS unsigned char*)lds_raw + (LDS_BYTES - 128)); xcd_barrier(xb); }
        }
    }
}

extern "C" void kernel_launch(void* const* d_in, const int* in_sizes, int n_in, void* d_out, int out_size, void* d_ws, size_t ws_size, hipStream_t stream) {
    static int grid = 0;
    if (grid == 0) {
        if (n_in != 28 || out_size != MLAT * DM || ws_size < WS_END) { fprintf(stderr, "kernel_launch: unexpected shapes (n_in %d out %d ws %zu need %zu)\n", n_in, out_size, ws_size, (size_t)WS_END); grid = -1; return; }
        int dev = 0, cus = 0, per_cu = 0;
        (void)hipGetDevice(&dev); (void)hipDeviceGetAttribute(&cus, hipDeviceAttributeMultiprocessorCount, dev);
        if (hipFuncSetAttribute((const void*)mk_fwd, hipFuncAttributeMaxDynamicSharedMemorySize, LDS_BYTES) != hipSuccess) { fprintf(stderr, "kernel_launch: hipFuncSetAttribute failed\n"); grid = -1; return; }
        if (hipOccupancyMaxActiveBlocksPerMultiprocessor(&per_cu, (const void*)mk_fwd, 512, LDS_BYTES) != hipSuccess || per_cu < 1) { fprintf(stderr, "kernel_launch: occupancy query says %d\n", per_cu); per_cu = 1; }
        (void)hipGetLastError();
        grid = cus * per_cu;
    }
    if (grid < 0) return;
    (void)hipMemsetAsync(d_ws, 0, 16384, stream);
    Params p{};
    const float** pp = (const float**)&p;
    for (int i = 0; i < 28; ++i) pp[i] = (const float*)d_in[i];
    p.out = (float*)d_out; p.ws = (unsigned char*)d_ws;
#if MK_SINGLE
    p.ph_lo = 0; p.ph_hi = NPHASES;
    void* args[] = {&p};
    hipError_t e = hipLaunchCooperativeKernel((const void*)mk_fwd, dim3(grid), dim3(512), args, LDS_BYTES, stream);
    if (e != hipSuccess) fprintf(stderr, "cooperative launch failed: %s (grid %d)\n", hipGetErrorString(e), grid);
#else
    for (int ph = 0; ph < NPHASES; ++ph) { p.ph_lo = ph; p.ph_hi = ph + 1; hipLaunchKernelGGL(mk_fwd, dim3(grid), dim3(512), LDS_BYTES, stream, p); }
#endif
}
```

```cpp
#include <hip/hip_runtime.h>
#include <hip/hip_cooperative_groups.h>
#include <cstdio>
#include <cstdint>
namespace cg = cooperative_groups;
#ifndef MK_SINGLE
#define MK_SINGLE 1
#endif
namespace pg8 {
#define PG8_LAS __attribute__((address_space(3)))
typedef unsigned short bf16_t;
typedef short bf16x8 __attribute__((ext_vector_type(8)));
typedef float f32x4 __attribute__((ext_vector_type(4)));
typedef unsigned u32x4 __attribute__((ext_vector_type(4)));
constexpr int BM = 256, BK = 64, HALF = 128, HTB = HALF * BK * 2  , STAGE_BYTES = 8 * HTB, NXCD = 8, WGM = 8;

__host__ __device__ __forceinline__ int lds_byte(int r, int c) { const int st = (r >> 4) * 2 + (c >> 5), rr = r & 15, cc = c & 31, ob = rr * 64 + cc * 2; return st * 1024 + (ob ^ (((ob >> 9) & 1) << 5)); }
__host__ __device__ __forceinline__ void stage_rc(int b, int& R, int& C) { const int st = b / 1024, sb = b % 1024, swz = sb ^ (((sb >> 9) & 1) << 5); R = (st >> 1) * 16 + swz / 64; C = (st & 1) * 32 + (swz % 64) / 2; }
__host__ __device__ __forceinline__ int perm32(int rho) { const int n = rho >> 4, i = rho & 15; return 8 * (i >> 2) + 4 * n + (i & 3); }

struct Unit { int pm, pn; };
struct Gemm { const bf16_t* A; const bf16_t* Bt; int M, N, K, ld; };

struct StaticOrder {
    int nM, nN, nwg, G, c;
    __host__ __device__ void init(int M, int N, int G_, int c_) { nM = M / BM; nN = N / BM; nwg = nM * nN; G = G_; c = c_; }
    __host__ __device__ bool next(int i, Unit& u) const {
        const long L = (long)i * G + c; if (L >= nwg) return false;
        int wgid = (int)L; { const int q = nwg / NXCD, r = nwg % NXCD, xcd = wgid % NXCD, off = wgid / NXCD; wgid = (xcd < r ? xcd * (q + 1) : r * (q + 1) + (xcd - r) * q) + off; }
        const int nig = WGM * nN, gid = wgid / nig, fm = gid * WGM, gsz = (nM - fm) < WGM ? (nM - fm) : WGM;
        u.pm = fm + ((wgid % nig) % gsz); u.pn = (wgid % nig) / gsz; return true;
    }
    __device__ __forceinline__ void a_ready(const Unit&) const {}
    __device__ __forceinline__ void done(const Unit&) const {}
};

__device__ __forceinline__ unsigned cvt_pk_bf16(float lo, float hi) { unsigned r; asm volatile("v_cvt_pk_bf16_f32 %0, %1, %2" : "=v"(r) : "v"(lo), "v"(hi)); return r; }
template <class Epi, class Sched, bool ALIGN_EPI = false, bool SP2 = false>
__device__ __forceinline__ void gemm_phase(PG8_LAS unsigned char* lds, const Gemm g, const Sched& S, const Epi& E) {
    int tid_l = threadIdx.x; asm volatile("" : "+v"(tid_l)); const int tid = tid_l, wid = __builtin_amdgcn_readfirstlane(tid >> 6), lane = tid & 63, wr = wid >> 2, wc = wid & 3, fr = lane & 15, fq = lane >> 4;
    const int K = g.ld, nt = g.K / BK;
    unsigned voffA[2], voffB[2];
#pragma unroll
    for (int i = 0; i < 2; ++i) { int R, C; stage_rc(tid * 16 + i * 8192, R, C); const int Rb = Epi::PERM ? ((R & ~31) + perm32(R & 31)) : R;
        voffA[i] = (unsigned)(R * K + C) * 2u; voffB[i] = (unsigned)(Rb * K + C) * 2u; }
    const size_t kstep = (size_t)(BK * 2);
    const size_t hstep = (size_t)HALF * K * 2;
    const size_t tstep = 2 * hstep;
    const unsigned ldsw = (unsigned)wid * 1024u;
    const int aoff = lds_byte(wr * 64 + fr, fq * 8), boff = lds_byte(wc * 32 + fr, fq * 8);
#define PG8_SA(b, h) (((b) * 2 + (h)) * HTB)
#define PG8_SB(b, h) ((4 + (b) * 2 + (h)) * HTB)
#define PG8_STAGE(bufoff, gbase, voff) do { _Pragma("unroll") for (int _i = 0; _i < 2; ++_i) \
        __builtin_amdgcn_global_load_lds((const unsigned*)((const char*)(gbase) + (voff)[_i]), (PG8_LAS unsigned*)(lds + (bufoff) + ldsw + _i * 8192), 16, 0, 0); } while (0)
#define PG8_LDA(dst, b, h) do { _Pragma("unroll") for (int m = 0; m < 4; ++m) _Pragma("unroll") for (int k = 0; k < 2; ++k) dst[m][k] = *(const PG8_LAS bf16x8*)(lds + PG8_SA(b, h) + aoff + m * 2048 + k * 1024); } while (0)
#define PG8_LDB(dst, b, h) do { _Pragma("unroll") for (int n = 0; n < 2; ++n) _Pragma("unroll") for (int k = 0; k < 2; ++k) dst[n][k] = *(const PG8_LAS bf16x8*)(lds + PG8_SB(b, h) + boff + n * 2048 + k * 1024); } while (0)
#define PG8_MMA(ai, bj, At, Bt) do { __builtin_amdgcn_s_setprio(1); _Pragma("unroll") for (int m = 0; m < 4; ++m) _Pragma("unroll") for (int n = 0; n < 2; ++n) _Pragma("unroll") for (int k = 0; k < 2; ++k) \
        acc[ai][bj][m][n] = __builtin_amdgcn_mfma_f32_16x16x32_bf16(Bt[n][k], At[m][k], acc[ai][bj][m][n], 0, 0, 0); __builtin_amdgcn_s_setprio(0); } while (0)
#define PG8_WAIT_V(n) asm volatile("s_waitcnt vmcnt(" #n ")" ::: "memory")
#define PG8_WAIT_L(n) asm volatile("s_waitcnt lgkmcnt(" #n ")" ::: "memory")
#define PG8_BAR __builtin_amdgcn_s_barrier()
#define PG8_SCHED __builtin_amdgcn_sched_barrier(0)
    Unit cur, nxt; int ui = 0;
    if (!S.next(0, cur)) return;
    f32x4 acc[2][2][4][2];
#pragma unroll
    for (int a = 0; a < 2; ++a)
#pragma unroll
        for (int b = 0; b < 2; ++b)
#pragma unroll
            for (int m = 0; m < 4; ++m)
#pragma unroll
                for (int n = 0; n < 2; ++n) acc[a][b][m][n] = (f32x4){0.f, 0.f, 0.f, 0.f};
    bf16x8 At[4][2], B0[2][2], B1[2][2];
    const char* cA = (const char*)g.A + (size_t)cur.pm * tstep; const char* cB = (const char*)g.Bt + (size_t)cur.pn * tstep;
    S.a_ready(cur);
    if constexpr (SP2) {
        PG8_STAGE(PG8_SB(0, 0), cB, voffB); PG8_STAGE(PG8_SB(0, 1), cB + hstep, voffB); PG8_STAGE(PG8_SA(0, 0), cA, voffA); PG8_STAGE(PG8_SA(0, 1), cA + hstep, voffA);
        if (wr == 1) PG8_BAR;
        PG8_WAIT_V(2); PG8_BAR;
        PG8_STAGE(PG8_SB(1, 0), cB + kstep, voffB); PG8_STAGE(PG8_SA(1, 0), cA + kstep, voffA); PG8_STAGE(PG8_SB(1, 1), cB + hstep + kstep, voffB);
        PG8_WAIT_V(6); PG8_BAR;
    } else {
        PG8_STAGE(PG8_SB(0, 0), cB, voffB); PG8_STAGE(PG8_SA(0, 0), cA, voffA); PG8_STAGE(PG8_SB(0, 1), cB + hstep, voffB); PG8_STAGE(PG8_SA(0, 1), cA + hstep, voffA);
        if (wr == 1) PG8_BAR;
        PG8_WAIT_V(4); PG8_BAR;
        PG8_STAGE(PG8_SB(1, 0), cB + kstep, voffB); PG8_STAGE(PG8_SA(1, 0), cA + kstep, voffA); PG8_STAGE(PG8_SB(1, 1), cB + hstep + kstep, voffB);
        PG8_WAIT_V(6); PG8_BAR;
    }
    for (;;) {
        const bool has_next = S.next(ui + 1, nxt);
        const char* nA = has_next ? (const char*)g.A + (size_t)nxt.pm * tstep : cA; const char* nB = has_next ? (const char*)g.Bt + (size_t)nxt.pn * tstep : cB;
        for (int t = 0; t < nt; t += 2) {
            const bool last = (t == nt - 2);
            const char* a1 = cA + (size_t)(t + 1) * kstep;
            const char* a2 = last ? nA : cA + (size_t)(t + 2) * kstep; const char* b2 = last ? nB : cB + (size_t)(t + 2) * kstep;
            const char* a3 = a2 + kstep; const char* b3 = b2 + kstep;
            if (last && has_next) S.a_ready(nxt);
            if constexpr (SP2) {
            PG8_LDB(B0, 0, 0); PG8_LDB(B1, 0, 1); PG8_SCHED; PG8_LDA(At, 0, 0); PG8_STAGE(PG8_SA(1, 1), a1 + hstep, voffA);
            PG8_WAIT_V(8); PG8_WAIT_L(0); PG8_BAR; PG8_MMA(0, 0, At, B0); PG8_MMA(0, 1, At, B1); PG8_BAR; PG8_SCHED;
            PG8_LDA(At, 0, 1); PG8_STAGE(PG8_SB(0, 0), b2, voffB); PG8_STAGE(PG8_SB(0, 1), b2 + hstep, voffB); PG8_STAGE(PG8_SA(0, 0), a2, voffA);
            PG8_WAIT_V(8); PG8_WAIT_L(0); PG8_BAR; PG8_MMA(1, 0, At, B0); PG8_MMA(1, 1, At, B1); PG8_BAR; PG8_SCHED;
            PG8_LDB(B0, 1, 0); PG8_LDB(B1, 1, 1); PG8_SCHED; PG8_LDA(At, 1, 0); PG8_STAGE(PG8_SA(0, 1), a2 + hstep, voffA);
            PG8_WAIT_V(8); PG8_WAIT_L(0); PG8_BAR; PG8_MMA(0, 0, At, B0); PG8_MMA(0, 1, At, B1); PG8_BAR; PG8_SCHED;
            PG8_LDA(At, 1, 1); PG8_STAGE(PG8_SB(1, 0), b3, voffB); PG8_STAGE(PG8_SB(1, 1), b3 + hstep, voffB); PG8_STAGE(PG8_SA(1, 0), a3, voffA);
            PG8_WAIT_V(8); PG8_WAIT_L(0); PG8_BAR; PG8_MMA(1, 0, At, B0); PG8_MMA(1, 1, At, B1); PG8_BAR; PG8_SCHED;
            } else {
            PG8_LDB(B0, 0, 0); PG8_SCHED; PG8_LDA(At, 0, 0); PG8_STAGE(PG8_SA(1, 1), a1 + hstep, voffA);
            PG8_WAIT_L(8); PG8_BAR; PG8_WAIT_L(0); PG8_MMA(0, 0, At, B0); PG8_BAR; PG8_SCHED;
            PG8_LDB(B1, 0, 1); PG8_STAGE(PG8_SB(0, 0), b2, voffB);
            PG8_BAR; PG8_WAIT_L(0); PG8_MMA(0, 1, At, B1); PG8_BAR;
            PG8_LDA(At, 0, 1); PG8_STAGE(PG8_SA(0, 0), a2, voffA);
            PG8_BAR; PG8_WAIT_L(0); PG8_MMA(1, 0, At, B0); PG8_BAR; PG8_SCHED;
            PG8_STAGE(PG8_SB(0, 1), b2 + hstep, voffB);
            PG8_WAIT_V(6); PG8_BAR; PG8_MMA(1, 1, At, B1); PG8_BAR;
            PG8_LDB(B0, 1, 0); PG8_SCHED; PG8_LDA(At, 1, 0); PG8_STAGE(PG8_SA(0, 1), a2 + hstep, voffA);
            PG8_WAIT_L(8); PG8_BAR; PG8_WAIT_L(0); PG8_MMA(0, 0, At, B0); PG8_BAR; PG8_SCHED;
            PG8_LDB(B1, 1, 1); PG8_STAGE(PG8_SB(1, 0), b3, voffB);
            PG8_BAR; PG8_WAIT_L(0); PG8_MMA(0, 1, At, B1); PG8_BAR;
            PG8_LDA(At, 1, 1); PG8_STAGE(PG8_SA(1, 0), a3, voffA);
            PG8_BAR; PG8_WAIT_L(0); PG8_MMA(1, 0, At, B0); PG8_BAR; PG8_SCHED;
            PG8_STAGE(PG8_SB(1, 1), b3 + hstep, voffB);
            PG8_WAIT_V(6); PG8_BAR; PG8_MMA(1, 1, At, B1); PG8_BAR;
            }
        }
        if constexpr (ALIGN_EPI) { if (wr == 0) PG8_BAR; }
        if constexpr (!Epi::AFTER_DRAIN) { E(acc, cur, wr, wc, fr, fq); S.done(cur); }
        if (!has_next) break;
#pragma unroll
        for (int a = 0; a < 2; ++a)
#pragma unroll
            for (int b = 0; b < 2; ++b)
#pragma unroll
                for (int m = 0; m < 4; ++m)
#pragma unroll
                    for (int n = 0; n < 2; ++n) acc[a][b][m][n] = (f32x4){0.f, 0.f, 0.f, 0.f};
        cur = nxt; cA = nA; cB = nB; ++ui;
        if constexpr (ALIGN_EPI) { if (wr == 1) PG8_BAR; }
    }
    PG8_WAIT_V(0);
    if constexpr (!ALIGN_EPI) { if (wr == 0) PG8_BAR; }
    PG8_BAR;
    if constexpr (Epi::AFTER_DRAIN) { E.fused(acc, cur, wr, wc, fr, fq, lds, wid, lane); S.done(cur); }
#undef PG8_SA
#undef PG8_SB
#undef PG8_STAGE
#undef PG8_LDA
#undef PG8_LDB
#undef PG8_MMA
#undef PG8_WAIT_V
#undef PG8_WAIT_L
#undef PG8_BAR
#undef PG8_SCHED
}
}

#define LAS __attribute__((address_space(3)))
typedef unsigned short bf16;
typedef float f32x4 __attribute__((ext_vector_type(4)));
typedef float f32x2 __attribute__((ext_vector_type(2)));
typedef unsigned u32x4 __attribute__((ext_vector_type(4)));
typedef unsigned u32x2 __attribute__((ext_vector_type(2)));
typedef short bf16x8_t __attribute__((ext_vector_type(8)));
constexpr int DM = 2048, NB = 4, TL = 2048, TC = 256, MLAT = NB * TL, MCTX = NB * TC, MALL = MLAT + MCTX;
constexpr int FF = 5632, NUP = 2 * FF, NIN = 6416, NINP_W = 6656, NMODV = 9 * DM;
constexpr int TSTEPS = TL + TC, NTILES = TSTEPS / 32;
constexpr float EPS = 1e-6f;
constexpr int NUF = 4608, NUG = 2048;
constexpr int U_SSD_XBC = 0, U_SSD_DT = 768, U_LRU_X = 784;
constexpr int U_HG_Q = 1296, U_HG_F = 1808, U_HG_I = 2832;
constexpr int U_RT_Q = 3344, U_RT_K = 3600, U_RT_V = 3856;
constexpr int G_SSD_Z = 0, G_LRU_G = 512, G_HG_G = 1024, G_RT_G = 1536;
constexpr int U_LRU_G = 0, U_HG_G = 0, U_RT_G = 0;
__host__ __device__ constexpr int u_newpos(int n) {
    return n < 512 ? NUF + n : n < 1296 ? n - 512 : n < 1808 ? 784 + (n - 1296) : n < 2320 ? NUF + 512 + (n - 1808) : n < 4368 ? 1296 + (n - 2320)
         : n < 4880 ? NUF + 1024 + (n - 4368) : n < 5904 ? 3344 + (n - 4880) : n < 6416 ? NUF + 1536 + (n - 5904) : 4368 + (n - 6416); }
constexpr int NPHASES = 26;
constexpr int LDS_BYTES = 147456;
constexpr size_t MiB = 1u << 20;
constexpr size_t WS_MOD = 1 * MiB, WS_W13 = 2 * MiB, WS_W2 = 178 * MiB, WS_WIN = 266 * MiB, WS_WOUT = 318 * MiB, WS_X = 334 * MiB, WS_H = 406 * MiB,
                 WS_Y = 442 * MiB, WS_U = 514 * MiB, WS_XBC = 748 * MiB, WS_LA = 775 * MiB, WS_LB = 811 * MiB, WS_YD = 847 * MiB, WS_END = 991 * MiB, WS_UG = 682 * MiB;

struct Params {
    const float *x, *c, *ctx, *c_ctx, *w_mod, *b_mod, *norm_pre, *norm_post, *ffn_w1, *ffn_w3, *ffn_w2, *w_in, *w_out,
        *ssd_conv_w, *ssd_conv_b, *ssd_dt_bias, *ssd_a_log, *ssd_d, *ssd_norm_w, *lru_conv_w, *lru_conv_b, *lru_wa, *lru_ba, *lru_wx, *lru_bx, *lru_lambda,
        *hgrn_lb_logits, *hgrn_norm_w;
    float* out; unsigned char* ws; int ph_lo, ph_hi;
};

__device__ __forceinline__ float sigmoid_(float x) { return __builtin_amdgcn_rcpf(1.f + __expf(-x)); }
__device__ __forceinline__ float silu_(float x) { return x * sigmoid_(x); }
__device__ __forceinline__ float softplus_(float x) { return fmaxf(x, 0.f) + log1pf(__expf(-fabsf(x))); }
__device__ __forceinline__ float gelu_tanh_(float x) { const float z = 0.7978845608f * (x + 0.044715f * x * x * x); const float t = 1.f - 2.f * __builtin_amdgcn_rcpf(1.f + __expf(2.f * z)); return 0.5f * x * (1.f + t); }
__device__ __forceinline__ unsigned f2bf(float f) { unsigned u = __builtin_bit_cast(unsigned, f); return (u + 0x7fffu + ((u >> 16) & 1u)) >> 16; }
__device__ __forceinline__ unsigned pk2(float lo, float hi) { return f2bf(lo) | (f2bf(hi) << 16); }
__device__ __forceinline__ float wave_sum(float v) {
#pragma unroll
    for (int o = 1; o < 64; o <<= 1) v += __shfl_xor(v, o);
    return v;
}
__device__ __forceinline__ float half_sum(float v) {
#pragma unroll
    for (int o = 1; o < 32; o <<= 1) v += __shfl_xor(v, o);
    return v;
}
__device__ __forceinline__ float dot4(f32x4 a) { return (a.x * a.x + a.y * a.y) + (a.z * a.z + a.w * a.w); }
__device__ __forceinline__ f32x4 ld_bf4(const bf16* p) { const u32x2 w = *(const u32x2*)p; return (f32x4){__builtin_bit_cast(float, w.x << 16), __builtin_bit_cast(float, w.x & 0xffff0000u), __builtin_bit_cast(float, w.y << 16), __builtin_bit_cast(float, w.y & 0xffff0000u)}; }
#define LDS_WAIT() asm volatile("s_waitcnt lgkmcnt(0)" ::: "memory")
__device__ __forceinline__ int tid_() { int t = threadIdx.x; asm volatile("" : "+v"(t)); return t; }
__device__ __forceinline__ int bid_() { int t = blockIdx.x; asm volatile("" : "+s"(t)); return t; }
__device__ __forceinline__ int scan_row(int b, int d, int i) {
    if (i < TC) { const int t = d ? (TC - 1 - i) : i; return MLAT + b * TC + t; }
    int t = i - TC; if (d) t = TL - 1 - t; return b * TL + t;
}

#define XB_TMO      128
#define XB_XCNT(j)  (256  + 64 * (j))
#define XB_XSUB(j)  (1280 + 64 * (j))
#define XB_XGEN(j)  (2304 + 64 * (j))
#define XB_TOP      3328
#define XB_TOPGEN   3392
#define XCD_BAR_WORDS 3456
#define XB_SPIN_CAP (1u << 18)

__device__ __forceinline__ unsigned xb_ld(unsigned* p)              { return __hip_atomic_load(p, __ATOMIC_RELAXED, __HIP_MEMORY_SCOPE_AGENT); }
__device__ __forceinline__ unsigned xb_add(unsigned* p, unsigned v) { return __hip_atomic_fetch_add(p, v, __ATOMIC_RELAXED, __HIP_MEMORY_SCOPE_AGENT); }
__device__ __forceinline__ unsigned xb_xcc_id() { return (unsigned)__builtin_amdgcn_s_getreg((3 << 11) | 20) & 0xFu; }
#define XB_SPIN(cond, bar) do { unsigned _sp = 0; while (cond) { __builtin_amdgcn_s_sleep(1); \
    if ((++_sp & 255u) == 0u) { if (xb_ld(&(bar)[XB_TMO])) break; if (_sp > XB_SPIN_CAP) { atomicAdd(&(bar)[XB_TMO], 1u); break; } } } } while (0)

struct XcdBarrier {
    unsigned* bar; unsigned x;
    volatile LAS unsigned* st;
};

__device__ __forceinline__ XcdBarrier xcd_barrier_post(unsigned* bar, volatile LAS unsigned* st) {
    XcdBarrier b; b.bar = bar; b.x = xb_xcc_id(); b.st = st;
    if (threadIdx.x == 0) (void)xb_add(&bar[XB_XCNT(b.x)], 1u);
    return b;
}
__device__ __forceinline__ void xcd_barrier_complete(unsigned* bar, unsigned x, unsigned& nloc, unsigned& nx) {
    const unsigned G = gridDim.x * gridDim.y * gridDim.z;
    unsigned sum, cnt, mine, sp = 0u;
    for (;;) {
        sum = 0u; cnt = 0u; mine = 0u;
#pragma unroll
        for (unsigned j = 0; j < 16; ++j) { const unsigned c = xb_ld(&bar[XB_XCNT(j)]); sum += c; cnt += (c > 0u) ? 1u : 0u; mine = (j == x) ? c : mine; }
        if (sum == G) break;
        __builtin_amdgcn_s_sleep(1);
        if ((++sp & 255u) == 0u) { if (xb_ld(&bar[XB_TMO])) break; if (sp > XB_SPIN_CAP) { atomicAdd(&bar[XB_TMO], 1u); break; } }
    }
    nloc = mine > 0u ? mine : 1u; nx = cnt > 0u ? cnt : 1u;
}

__device__ __forceinline__ void xcd_barrier(const XcdBarrier& b) {
    asm volatile("s_waitcnt vmcnt(0)" ::: "memory");
    __syncthreads();
    if (threadIdx.x == 0) {
        unsigned* bar = b.bar;
        __builtin_amdgcn_s_waitcnt(0);
        unsigned nloc = b.st[0], nx = b.st[1];
        if (nloc == 0u) { xcd_barrier_complete(bar, b.x, nloc, nx); b.st[0] = nloc; b.st[1] = nx; }
        const unsigned old = xb_add(&bar[XB_XSUB(b.x)], 1u);
        const unsigned gen = old / nloc;
        if (old + 1u == (gen + 1u) * nloc) {
            __builtin_amdgcn_fence(__ATOMIC_RELEASE, "agent");
            asm volatile("s_waitcnt vmcnt(0)" ::: "memory");
            const unsigned og = xb_add(&bar[XB_TOP], 1u);
            const unsigned tg = og / nx;
            if (og + 1u == (tg + 1u) * nx) xb_add(&bar[XB_TOPGEN], 1u);
            else XB_SPIN(xb_ld(&bar[XB_TOPGEN]) == tg, bar);
            __builtin_amdgcn_fence(__ATOMIC_ACQUIRE, "agent");
            xb_add(&bar[XB_XGEN(b.x)], 1u);
            asm volatile("s_waitcnt vmcnt(0)" ::: "memory");
        } else {
            XB_SPIN(xb_ld(&bar[XB_XGEN(b.x)]) == gen, bar);
            __builtin_amdgcn_fence(__ATOMIC_ACQUIRE, "agent");
            asm volatile("s_waitcnt vmcnt(0)" ::: "memory");
        }
    }
    __syncthreads();
}

namespace pg8 {
struct EpiSwiGLU {
    static constexpr bool PERM = true, AFTER_DRAIN = false;
    bf16_t* O; int ldc;
    __device__ __forceinline__ void operator()(const f32x4 (&acc)[2][2][4][2], const Unit& u, int wr, int wc, int fr, int fq) const {
        const int row0 = u.pm * BM + wr * 64 + fr, col0 = u.pn * HALF + wc * 32 + 8 * fq;
#pragma unroll
        for (int ai = 0; ai < 2; ++ai)
#pragma unroll
            for (int m = 0; m < 4; ++m) {
                bf16_t* rowp = O + (size_t)(row0 + ai * HALF + m * 16) * ldc + col0;
                const f32x4 a0 = acc[ai][0][m][0], a1 = acc[ai][0][m][1], b0 = acc[ai][1][m][0], b1 = acc[ai][1][m][1];
                float r[8];
#pragma unroll
                for (int j = 0; j < 4; ++j) { r[j] = a0[j] * __builtin_amdgcn_rcpf(1.f + __expf(-a0[j])) * b0[j]; r[4 + j] = a1[j] * __builtin_amdgcn_rcpf(1.f + __expf(-a1[j])) * b1[j]; }
                u32x4 w; w.x = cvt_pk_bf16(r[0], r[1]); w.y = cvt_pk_bf16(r[2], r[3]); w.z = cvt_pk_bf16(r[4], r[5]); w.w = cvt_pk_bf16(r[6], r[7]);
                *(u32x4*)rowp = w;
                asm volatile("" ::: "memory");
            }
    }
};
struct EpiF32 {
    static constexpr bool PERM = false, AFTER_DRAIN = false;
    float* O; int ldc; int asbf; bf16_t* O2; int ldc2, split_pn;
    __device__ __forceinline__ void operator()(const f32x4 (&acc)[2][2][4][2], const Unit& u, int wr, int wc, int fr, int fq) const {
        const bool sec = split_pn > 0 && u.pn >= split_pn;
        const int row0 = u.pm * BM + wr * 64 + fr, col0 = (sec ? u.pn - split_pn : u.pn) * BM + wc * 32 + 4 * fq;
        if (asbf || sec) {
            bf16_t* Ob = sec ? O2 : (bf16_t*)O; const int ldc = sec ? ldc2 : this->ldc;
#pragma unroll
            for (int ai = 0; ai < 2; ++ai)
#pragma unroll
                for (int m = 0; m < 4; ++m) {
                    bf16_t* rowp = Ob + (size_t)(row0 + ai * HALF + m * 16) * ldc + col0;
#pragma unroll
                    for (int bj = 0; bj < 2; ++bj)
#pragma unroll
                        for (int n = 0; n < 2; ++n) { const f32x4 v = acc[ai][bj][m][n]; u32x2 w; w.x = cvt_pk_bf16(v[0], v[1]); w.y = cvt_pk_bf16(v[2], v[3]); *(u32x2*)(rowp + bj * HALF + n * 16) = w; }
                }
            return;
        }
#pragma unroll
        for (int ai = 0; ai < 2; ++ai)
#pragma unroll
            for (int m = 0; m < 4; ++m) {
                float* rowp = O + (size_t)(row0 + ai * HALF + m * 16) * ldc + col0;
#pragma unroll
                for (int bj = 0; bj < 2; ++bj)
#pragma unroll
                    for (int n = 0; n < 2; ++n) *(f32x4*)(rowp + bj * HALF + n * 16) = acc[ai][bj][m][n];
            }
    }
};
}


namespace pg8 {
struct Order2 {
    StaticOrder so; int one, valid; Unit u1;
    __device__ bool next(int i, Unit& u) const { if (one) { if (i > 0 || !valid) return false; u = u1; return true; } return so.next(i, u); }
    __device__ __forceinline__ void a_ready(const Unit&) const {}
    __device__ __forceinline__ void done(const Unit&) const {}
};
}
__device__ __forceinline__ void transpose_item64(const float* __restrict__ W, int K, int N, bf16* __restrict__ WT, int mode, float* scr, int item, int lane) {
    const int nblk = (N + 63) >> 6, kb = item / nblk, nb = item - kb * nblk, k0 = kb << 6, n0 = nb << 6;
    const int lr = lane >> 4, lc = (lane & 15) << 2;
    const bool ok = (n0 + lc) < N;
#pragma unroll
    for (int i = 0; i < 16; ++i) {
        const int kk = 4 * i + lr; f32x4 v = {0.f, 0.f, 0.f, 0.f};
        if (ok) v = __builtin_nontemporal_load((const f32x4*)(W + (size_t)(k0 + kk) * N + n0 + lc));
        float* s = scr + kk * 65 + lc; s[0] = v.x; s[1] = v.y; s[2] = v.z; s[3] = v.w;
    }
    LDS_WAIT();
    const int c = lane & 7;
#pragma unroll
    for (int j = 0; j < 8; ++j) {
        const int n = (lane >> 3) + 8 * j; const float* s = scr + (8 * c) * 65 + n;
        u32x4 o; o.x = pk2(s[0], s[65]); o.y = pk2(s[2 * 65], s[3 * 65]); o.z = pk2(s[4 * 65], s[5 * 65]); o.w = pk2(s[6 * 65], s[7 * 65]);
        const int dn = n0 + n; int row = dn; if (mode == 3) row = u_newpos(dn); else if (mode) row = ((dn >> 7) << 8) + (dn & 127) + (mode == 2 ? 128 : 0);
        *(u32x4*)(WT + (size_t)row * K + k0 + 8 * c) = o;
    }
    LDS_WAIT();
}

__device__ __forceinline__ void prologue_phase(const Params& P, float* L) {
    const int tid = tid_(), lane = tid & 63, wave = __builtin_amdgcn_readfirstlane(tid >> 6);
    unsigned char* ws = P.ws;
    float* MOD = (float*)(ws + WS_MOD);
    float* sc = L;
    float* red = L + 5 * DM;
    for (int i = tid; i < 5 * DM; i += 512) { const int r = i >> 11, k = i & (DM - 1); const float v = r < 4 ? P.c[r * DM + k] : P.c_ctx[k]; sc[i] = silu_(v); }
    __syncthreads();
    for (int it = bid_(); it < 1152; it += gridDim.x) {
        const int l = it / 576, j0 = (it % 576) * 32;
        const float* Wm = P.w_mod + (size_t)l * DM * NMODV;
        const int kr = lane >> 3, c4 = (lane & 7) << 2;
        f32x4 acc[5];
#pragma unroll
        for (int r = 0; r < 5; ++r) acc[r] = (f32x4){0.f, 0.f, 0.f, 0.f};
        const int kbase = wave * 256 + kr;
#pragma unroll 16
        for (int kk = 0; kk < 256; kk += 8) {
            const int k = kbase + kk; const f32x4 w = __builtin_nontemporal_load((const f32x4*)(Wm + (size_t)k * NMODV + j0 + c4));
#pragma unroll
            for (int r = 0; r < 5; ++r) acc[r] += w * sc[r * DM + k];
        }
#pragma unroll
        for (int r = 0; r < 5; ++r)
#pragma unroll
            for (int e = 0; e < 4; ++e) { float v = acc[r][e]; v += __shfl_xor(v, 8); v += __shfl_xor(v, 16); v += __shfl_xor(v, 32); acc[r][e] = v; }
        if (lane < 8) {
#pragma unroll
            for (int r = 0; r < 5; ++r) *(f32x4*)&red[(wave * 5 + r) * 32 + c4] = acc[r];
        }
        __syncthreads();
        if (tid < 160) { const int r = tid >> 5, j = tid & 31; float s_ = 0.f;
#pragma unroll
            for (int w = 0; w < 8; ++w) s_ += red[(w * 5 + r) * 32 + j];
            MOD[(size_t)(l * 5 + r) * NMODV + j0 + j] = s_ + P.b_mod[l * NMODV + j0 + j]; }
        __syncthreads();
    }
    bf16* W13 = (bf16*)(ws + WS_W13); bf16* W2 = (bf16*)(ws + WS_W2); bf16* WIN = (bf16*)(ws + WS_WIN); bf16* WOUT = (bf16*)(ws + WS_WOUT);
    float* scr = L + wave * (64 * 65);
    const int gw = bid_() * 8 + wave, NGW = gridDim.x * 8;
    constexpr int I_F = 2816, I_LF = 3 * I_F, I_FFN = 4 * I_LF, I_IN = 32 * 101, I_OUT = 32 * 32, I_ALL = I_FFN + 2 * I_IN + 2 * I_OUT;
    for (int it = gw; it < I_ALL; it += NGW) {
        int r = it;
        if (r < I_FFN) {
            const int lf = r / I_LF, q = r % I_LF, which = q / I_F, item = q % I_F;
            if (which == 0) transpose_item64(P.ffn_w1 + (size_t)lf * DM * FF, DM, FF, W13 + (size_t)lf * NUP * DM, 1, scr, item, lane);
            else if (which == 1) transpose_item64(P.ffn_w3 + (size_t)lf * DM * FF, DM, FF, W13 + (size_t)lf * NUP * DM, 2, scr, item, lane);
            else transpose_item64(P.ffn_w2 + (size_t)lf * FF * DM, FF, DM, W2 + (size_t)lf * DM * FF, 0, scr, item, lane);
        } else {
            r -= I_FFN;
            if (r < 2 * I_IN) { const int l = r / I_IN, item = r % I_IN; transpose_item64(P.w_in + (size_t)l * DM * NIN, DM, NIN, WIN + (size_t)l * NINP_W * DM, 3, scr, item, lane); }
            else { r -= 2 * I_IN; const int l = r / I_OUT, item = r % I_OUT; transpose_item64(P.w_out + (size_t)l * DM * DM, DM, DM, WOUT + (size_t)l * DM * DM, 0, scr, item, lane); }
        }
    }
}

__device__ __forceinline__ void rowwise_phase(const Params& P, int mrows, bool first, int l_post, int j_post, int gate_idx, float coef, bool final_, int l_pre, int j_pre, int shift_idx, int scale_idx) {
    const int tid = tid_(), lane = tid & 63, wave = __builtin_amdgcn_readfirstlane(tid >> 6);
    const int gw = bid_() * 8 + wave, NGW = gridDim.x * 8;
    const float* MOD = (const float*)(P.ws + WS_MOD);
    float* X = (float*)(P.ws + WS_X); const float* Y = (const float*)(P.ws + WS_Y); bf16* H = (bf16*)(P.ws + WS_H);
    for (int row = gw; row < mrows; row += NGW) {
        const int b = row < MLAT ? (row >> 11) : 4;
        f32x4 xv[8]; float ss_new = 0.f;
        if (first) {
            const float* src = row < MLAT ? P.x + (size_t)row * DM : P.ctx + (size_t)(row - MLAT) * DM;
#pragma unroll
            for (int j = 0; j < 8; ++j) xv[j] = *(const f32x4*)(src + 4 * lane + 256 * j);
        } else {
            const float* xr = (l_post == 0 && j_post == 0) ? (row < MLAT ? P.x + (size_t)row * DM : P.ctx + (size_t)(row - MLAT) * DM) : X + (size_t)row * DM;
            f32x4 yv[8]; float ss = 0.f;
            if (row < MLAT) {
                const bf16* yb = (const bf16*)Y + (size_t)row * DM;
#pragma unroll
                for (int j = 0; j < 8; ++j) { const u32x2 w = *(const u32x2*)(yb + 4 * lane + 256 * j);
                    yv[j] = (f32x4){__builtin_bit_cast(float, w.x << 16), __builtin_bit_cast(float, w.x & 0xffff0000u), __builtin_bit_cast(float, w.y << 16), __builtin_bit_cast(float, w.y & 0xffff0000u)}; }
            } else {
                const bf16* pr = (const bf16*)(P.ws + WS_YD) + (size_t)(row - MLAT) * DM;
#pragma unroll
                for (int j = 0; j < 8; ++j) yv[j] = ld_bf4(pr + 4 * lane + 256 * j);
                for (int ks = 1; ks < 8; ++ks) {
#pragma unroll
                    for (int j = 0; j < 8; ++j) yv[j] += ld_bf4(pr + (size_t)ks * MCTX * DM + 4 * lane + 256 * j);
                }
            }
            const float* gp = P.norm_post + (size_t)(l_post * 3 + j_post) * DM; const float* mg = MOD + (size_t)(l_post * 5 + b) * NMODV + gate_idx * DM;
            float sxx = 0.f, sxt = 0.f, stt = 0.f;
#pragma unroll
            for (int j = 0; j < 8; ++j) { const int c = 4 * lane + 256 * j; xv[j] = *(const f32x4*)(xr + c); const f32x4 g4 = *(const f32x4*)(gp + c), m4 = *(const f32x4*)(mg + c);
                ss += dot4(yv[j]); yv[j] = yv[j] * g4 * m4; sxx += dot4(xv[j]); stt += dot4(yv[j]);
                const f32x4 xt = xv[j] * yv[j]; sxt += (xt.x + xt.y) + (xt.z + xt.w); }
#pragma unroll
            for (int o = 1; o < 64; o <<= 1) { ss += __shfl_xor(ss, o); sxx += __shfl_xor(sxx, o); sxt += __shfl_xor(sxt, o); stt += __shfl_xor(stt, o); }
            const float rs = rsqrtf(ss * (1.f / DM) + EPS) * coef;
            ss_new = sxx + 2.f * rs * sxt + rs * rs * stt;
#pragma unroll
            for (int j = 0; j < 8; ++j) xv[j] += yv[j] * rs;
        }
        if (final_) {
            float* o = P.out + (size_t)row * DM;
#pragma unroll
            for (int j = 0; j < 8; ++j) *(f32x4*)(o + 4 * lane + 256 * j) = xv[j];
            continue;
        }
        {
            float* xr = X + (size_t)row * DM; float ss = 0.f;
#pragma unroll
            for (int j = 0; j < 8; ++j) { if (!first) *(f32x4*)(xr + 4 * lane + 256 * j) = xv[j]; else ss += dot4(xv[j]); }
            if (first) ss = wave_sum(ss); else ss = ss_new;
            const float rs = rsqrtf(ss * (1.f / DM) + EPS);
            const float* gp = P.norm_pre + (size_t)(l_pre * 3 + j_pre) * DM; const float* mb = MOD + (size_t)(l_pre * 5 + b) * NMODV;
            bf16* hr = H + (size_t)row * DM;
#pragma unroll
            for (int j = 0; j < 8; ++j) { const int c = 4 * lane + 256 * j; const f32x4 g4 = *(const f32x4*)(gp + c), sh = *(const f32x4*)(mb + shift_idx * DM + c), scl = *(const f32x4*)(mb + scale_idx * DM + c);
                const f32x4 h = (xv[j] * rs) * g4 * (scl + 1.f) + sh; u32x2 w; w.x = pk2(h.x, h.y); w.y = pk2(h.z, h.w); *(u32x2*)(hr + c) = w; }
        }
    }
}

__device__ __forceinline__ f32x4 conv4(const float* __restrict__ U, int row, int col, const float* __restrict__ cw, int C, const float* __restrict__ cb) {
    int t, len; if (row < MLAT) { t = row & (TL - 1); len = TL; } else { t = (row - MLAT) & (TC - 1); len = TC; }
    f32x4 acc = *(const f32x4*)cb;
#pragma unroll
    for (int j = 0; j < 4; ++j) { const int tt = t + j - 1; if (tt >= 0 && tt < len) { const f32x4 xx = *(const f32x4*)(U + (size_t)(row + j - 1) * NUF + col); const f32x4 w = *(const f32x4*)(cw + j * C); acc += xx * w; } }
    return acc;
}
__device__ __forceinline__ void prep_phase(const Params& P, float* L, int l) {
    const int tid = tid_();
    const float* U = (const float*)(P.ws + WS_U); bf16* XBC = (bf16*)(P.ws + WS_XBC); float* LA = (float*)(P.ws + WS_LA); bf16* LB = (bf16*)(P.ws + WS_LB);
    { const float* cw = P.ssd_conv_w + (size_t)l * 4 * 768; const float* cb = P.ssd_conv_b + (size_t)l * 768;
      for (int idx = bid_() * 512 + tid; idx < (MALL / 16) * 192; idx += gridDim.x * 512) {
          const int chunk = idx / 192, c4 = (idx - chunk * 192) << 2, row0 = chunk * 16;
          int t0, len; if (row0 < MLAT) { t0 = row0 & (TL - 1); len = TL; } else { t0 = (row0 - MLAT) & (TC - 1); len = TC; }
          const f32x4 w0 = *(const f32x4*)(cw + c4), w1 = *(const f32x4*)(cw + 768 + c4), w2 = *(const f32x4*)(cw + 2 * 768 + c4), w3 = *(const f32x4*)(cw + 3 * 768 + c4), bb = *(const f32x4*)(cb + c4);
          const float* up = U + (size_t)row0 * NUF + U_SSD_XBC + c4;
          const f32x4 z4 = {0.f, 0.f, 0.f, 0.f};
          f32x4 xm1 = (t0 > 0) ? *(const f32x4*)(up - NUF) : z4, x0 = *(const f32x4*)up, x1 = *(const f32x4*)(up + NUF);
#pragma unroll
          for (int r = 0; r < 16; ++r) {
              const f32x4 x2 = (t0 + r + 2 < len) ? *(const f32x4*)(up + (size_t)(r + 2) * NUF) : z4;
              f32x4 v = bb + xm1 * w0 + x0 * w1 + x1 * w2 + x2 * w3;
              v.x = silu_(v.x); v.y = silu_(v.y); v.z = silu_(v.z); v.w = silu_(v.w);
              { u32x2 w_; w_.x = pk2(v.x, v.y); w_.y = pk2(v.z, v.w); *(u32x2*)(XBC + (size_t)(row0 + r) * 768 + c4) = w_; }
              xm1 = x0; x0 = x1; x1 = x2;
          } } }
    unsigned short* WT = (unsigned short*)L;
    unsigned short* xb = WT + 4 * 64 * 72;
    float* xs = (float*)(xb + 64 * 72);
    const float* cw = P.lru_conv_w + (size_t)l * 4 * 512; const float* cb = P.lru_conv_b + (size_t)l * 512;
    const int lane = tid & 63, wave = __builtin_amdgcn_readfirstlane(tid >> 6), fr = lane & 15, fq = lane >> 4;
    int cur_h = -1;
    for (int it = bid_(); it < 144 * 8; it += gridDim.x) {
        const int h = it & 7, row0 = (it >> 3) * 64;
        __syncthreads();
        if (h != cur_h) {
            for (int i = tid; i < 4 * 4096; i += 512) { const int m = i >> 12, ii = (i >> 6) & 63, j = i & 63, d = m >> 1; const float* src = (m & 1) ? P.lru_wx : P.lru_wa;
                WT[(m * 64 + j) * 72 + ii] = (unsigned short)f2bf(src[((size_t)(l * 2 + d) * 8 + h) * 4096 + ii * 64 + j]); }
            cur_h = h;
        }
        for (int i = tid; i < 1024; i += 512) { const int r = i >> 4, c4 = (i & 15) << 2;
            const f32x4 v = conv4(U, row0 + r, U_LRU_X + h * 64 + c4, cw + h * 64 + c4, 512, cb + h * 64 + c4);
            *(f32x4*)&xs[r * 68 + c4] = v; u32x2 w; w.x = pk2(v.x, v.y); w.y = pk2(v.z, v.w); *(u32x2*)&xb[r * 72 + c4] = w; }
        __syncthreads();
        {
            const int tt = wave & 3, d = wave >> 2;
            f32x4 acc[2][4];
#pragma unroll
            for (int g2 = 0; g2 < 2; ++g2)
#pragma unroll
                for (int jt = 0; jt < 4; ++jt) acc[g2][jt] = (f32x4){0.f, 0.f, 0.f, 0.f};
#pragma unroll
            for (int ks = 0; ks < 2; ++ks) {
                const bf16x8_t a = *(const bf16x8_t*)&xb[(tt * 16 + fr) * 72 + ks * 32 + fq * 8];
#pragma unroll
                for (int g2 = 0; g2 < 2; ++g2)
#pragma unroll
                    for (int jt = 0; jt < 4; ++jt) { const bf16x8_t bq = *(const bf16x8_t*)&WT[((d * 2 + g2) * 64 + jt * 16 + fr) * 72 + ks * 32 + fq * 8];
                        acc[g2][jt] = __builtin_amdgcn_mfma_f32_16x16x32_bf16(a, bq, acc[g2][jt], 0, 0, 0); }
            }
#pragma unroll
            for (int jt = 0; jt < 4; ++jt) {
                const int j = jt * 16 + fr, c = h * 64 + j;
                const float ba1 = P.lru_ba[(size_t)(l * 2 + d) * 512 + c], bx1 = P.lru_bx[(size_t)(l * 2 + d) * 512 + c], sp = softplus_(-P.lru_lambda[(size_t)(l * 2 + d) * 512 + c]);
#pragma unroll
                for (int jj = 0; jj < 4; ++jj) {
                    const int t = tt * 16 + 4 * fq + jj, row = row0 + t;
                    const float rg = sigmoid_(acc[0][jt][jj] + ba1), ig = sigmoid_(acc[1][jt][jj] + bx1);
                    const float la = -8.f * rg * sp;
                    const float a_ = __expf(la); LA[((size_t)d * MALL + row) * 512 + c] = a_;
                    LB[((size_t)d * MALL + row) * 512 + c] = (bf16)f2bf(sqrtf(fmaxf(1.f - a_ * a_, 1e-12f)) * (ig * xs[t * 68 + j]));
                }
            }
        }
    }
}


#define MEMFENCE() asm volatile("" ::: "memory")
struct StepOps { f32x4 k0, k1, q0, q1; float v, a; };
__device__ __forceinline__ void ssd_core(const float* __restrict__ qs, const float* __restrict__ ks, const float* __restrict__ vs, const float* __restrict__ as, const float* __restrict__ la, const float* __restrict__ lb,
                                         float* __restrict__ lo, float* __restrict__ yp, f32x2& S0, f32x2& S1, f32x2& S2, f32x2& S3, float& hl, int tid, int p, int sl, float dsk, bool has_a) {
    StepOps c, n;
#define LD_OPS(o, s_) do { (o).k0 = *(const f32x4*)&ks[(s_) * 64 + sl * 8]; (o).k1 = *(const f32x4*)&ks[(s_) * 64 + sl * 8 + 4]; (o).q0 = *(const f32x4*)&qs[(s_) * 64 + sl * 8]; (o).q1 = *(const f32x4*)&qs[(s_) * 64 + sl * 8 + 4]; \
        (o).v = vs[(s_) * 64 + p]; (o).a = has_a ? as[(s_)] : dsk; } while (0)
#define DO_STEP(o, s_) do { const float a_ = has_a ? (o).a : dsk; const float v_ = (o).v; \
        S0 = S0 * a_ + (f32x2){(o).k0.x, (o).k0.y} * v_; S1 = S1 * a_ + (f32x2){(o).k0.z, (o).k0.w} * v_; S2 = S2 * a_ + (f32x2){(o).k1.x, (o).k1.y} * v_; S3 = S3 * a_ + (f32x2){(o).k1.z, (o).k1.w} * v_; \
        const f32x2 y2_ = ((f32x2){(o).q0.x, (o).q0.y} * S0 + (f32x2){(o).q0.z, (o).q0.w} * S1) + ((f32x2){(o).q1.x, (o).q1.y} * S2 + (f32x2){(o).q1.z, (o).q1.w} * S3); \
        float y_ = y2_.x + y2_.y; if (has_a && sl == 0) y_ += dsk * v_; yp[(s_) * 512 + tid] = y_; } while (0)
    LD_OPS(c, 0); MEMFENCE();
#pragma unroll 2
    for (int s = 0; s < 32; s += 2) {
        LD_OPS(n, s + 1); MEMFENCE();
        DO_STEP(c, s); MEMFENCE();
        if (s + 2 < 32) { LD_OPS(c, s + 2); } MEMFENCE();
        DO_STEP(n, s + 1); MEMFENCE();
    }
#undef LD_OPS
#undef DO_STEP
    if (has_a && tid < 64) {
#pragma unroll 8
        for (int s = 0; s < 32; ++s) { hl = la[s * 64 + tid] * hl + lb[s * 64 + tid]; lo[s * 64 + tid] = hl; }
    }
}
__device__ __forceinline__ void hgrn_core(const float* __restrict__ qs, const float* __restrict__ fs, const float* __restrict__ vs, float* __restrict__ yp, f32x2& S0, f32x2& S1, f32x2& S2, f32x2& S3, int tid, int p, int sl) {
    StepOps c, n;
#define LD_OPS(o, s_) do { (o).k0 = *(const f32x4*)&fs[(s_) * 128 + sl * 4]; (o).k1 = *(const f32x4*)&fs[(s_) * 128 + 64 + sl * 4]; (o).q0 = *(const f32x4*)&qs[(s_) * 128 + sl * 4]; (o).q1 = *(const f32x4*)&qs[(s_) * 128 + 64 + sl * 4]; \
        (o).v = vs[(s_) * 32 + p]; } while (0)
#define DO_STEP(o, s_) do { const f32x2 v2_ = {(o).v, (o).v}; \
        S0 = v2_ + (f32x2){(o).k0.x, (o).k0.y} * (S0 - v2_); S1 = v2_ + (f32x2){(o).k0.z, (o).k0.w} * (S1 - v2_); S2 = v2_ + (f32x2){(o).k1.x, (o).k1.y} * (S2 - v2_); S3 = v2_ + (f32x2){(o).k1.z, (o).k1.w} * (S3 - v2_); \
        const f32x2 y2_ = ((f32x2){(o).q0.x, (o).q0.y} * S0 + (f32x2){(o).q0.z, (o).q0.w} * S1) + ((f32x2){(o).q1.x, (o).q1.y} * S2 + (f32x2){(o).q1.z, (o).q1.w} * S3); \
        yp[(s_) * 512 + tid] = y2_.x + y2_.y; } while (0)
    LD_OPS(c, 0); MEMFENCE();
#pragma unroll 2
    for (int s = 0; s < 32; s += 2) {
        LD_OPS(n, s + 1); MEMFENCE();
        DO_STEP(c, s); MEMFENCE();
        if (s + 2 < 32) { LD_OPS(c, s + 2); } MEMFENCE();
        DO_STEP(n, s + 1); MEMFENCE();
    }
#undef LD_OPS
#undef DO_STEP
}
constexpr int L_YP = 12544;
__device__ __forceinline__ void scan_ssd(const Params& P, float* L, int l, int c) {
    const int tid = tid_(), b = c >> 4, d = (c >> 3) & 1, h = c & 7, g = h >> 2;
    const float* U = (const float*)(P.ws + WS_U); const float* XBC = (const float*)(P.ws + WS_XBC); const float* LA = (const float*)(P.ws + WS_LA); const float* LB = (const float*)(P.ws + WS_LB);
    bf16* YD = (bf16*)(P.ws + WS_YD);
    float* qs = L; float* ks = L + 2048; float* vs = L + 4096; float* as = L + 6144; float* la = L + 6400; float* lb = L + 8448; float* lo = L + 10496; float* yp = L + L_YP;
    const float dtb = P.ssd_dt_bias[(l * 2 + d) * 8 + h], aneg = -__expf(P.ssd_a_log[(l * 2 + d) * 8 + h]), dsk = (d == 0) ? P.ssd_d[l * 8 + h] : 0.f;
    const int st = tid >> 4, sc4 = (tid & 15) << 2, p = tid >> 3, sl = tid & 7;
    f32x2 S0 = {0.f, 0.f}, S1 = {0.f, 0.f}, S2 = {0.f, 0.f}, S3 = {0.f, 0.f}; float hl = 0.f;
    f32x4 rx, rB, rC, ra, rb; float rdt;
#define SSD_LOAD(tile) do { const int row_ = scan_row(b, d, (tile) * 32 + st); const float* xr_ = XBC + (size_t)row_ * 768; \
        rx = *(const f32x4*)(xr_ + h * 64 + sc4); rB = *(const f32x4*)(xr_ + 512 + g * 64 + sc4); rC = *(const f32x4*)(xr_ + 640 + g * 64 + sc4); \
        rdt = U[(size_t)row_ * NUF + U_SSD_DT + d * 8 + h]; \
        ra = *(const f32x4*)(LA + ((size_t)d * MALL + row_) * 512 + h * 64 + sc4); rb = *(const f32x4*)(LB + ((size_t)d * MALL + row_) * 512 + h * 64 + sc4); } while (0)
    __syncthreads();
    SSD_LOAD(0);
    for (int tile = 0; tile < NTILES; ++tile) {
        { const float delta = softplus_(rdt + dtb);
          *(f32x4*)&vs[st * 64 + sc4] = rx; *(f32x4*)&ks[st * 64 + sc4] = rB * delta; *(f32x4*)&qs[st * 64 + sc4] = rC;
          if ((tid & 15) == 0) as[st] = __expf(aneg * delta);
          *(f32x4*)&la[st * 64 + sc4] = ra; *(f32x4*)&lb[st * 64 + sc4] = rb; }
        __syncthreads();
        if (tile + 1 < NTILES) SSD_LOAD(tile + 1);
        ssd_core(qs, ks, vs, as, la, lb, lo, yp, S0, S1, S2, S3, hl, tid, p, sl, dsk, true);
        __syncthreads();
#pragma unroll
        for (int j = 0; j < 4; ++j) {
            const int idx = tid + 512 * j, t = idx >> 6, pp = idx & 63;
            const f32x4 a0 = *(const f32x4*)&yp[t * 512 + pp * 8], a1 = *(const f32x4*)&yp[t * 512 + pp * 8 + 4];
            const int row = scan_row(b, d, tile * 32 + t);
            YD[((size_t)(0 * 2 + d) * MALL + row) * 512 + h * 64 + pp] = ((a0.x + a0.y) + (a0.z + a0.w)) + ((a1.x + a1.y) + (a1.z + a1.w));
            YD[((size_t)(1 * 2 + d) * MALL + row) * 512 + h * 64 + pp] = lo[t * 64 + pp];
        }
    }
#undef SSD_LOAD
}
__device__ __forceinline__ void scan_ret(const Params& P, float* L, int c) {
    const int tid = tid_(), b = c >> 4, h = (c >> 2) & 3, d = (c >> 1) & 1, vh = c & 1;
    const float* U = (const float*)(P.ws + WS_U); bf16* YD = (bf16*)(P.ws + WS_YD);
    float* qs = L; float* ks = L + 2048; float* vs = L + 4096; float* rope = L + 6400; float* yp = L + L_YP;
    const float a = 1.f - exp2f(-5.f - (float)h);
    const int st = tid >> 4, rem = tid & 15, sc4 = rem << 2, isk = rem >> 3, hs = (rem >> 2) & 1, cc = rem & 3, p = tid >> 3, sl = tid & 7;
    __syncthreads();
    for (int i = tid; i < 1024; i += 512) { const int pos = i >> 4, fi = i & 15; const float inv = exp2f(-(float)fi * 0.83048202372184f); const float rev = ((float)pos * inv) * 0.15915494309189535f;
        rope[2 * i] = __builtin_amdgcn_cosf(rev); rope[2 * i + 1] = __builtin_amdgcn_sinf(rev); }
    f32x2 S0 = {0.f, 0.f}, S1 = {0.f, 0.f}, S2 = {0.f, 0.f}, S3 = {0.f, 0.f};
    f32x4 r1, r2, rv;
    const int qkbase = (isk ? U_RT_K : U_RT_Q) + h * 64 + hs * 32 + 4 * cc;
#define RET_LOAD(tile) do { const float* ur_ = U + (size_t)scan_row(b, d, (tile) * 32 + st) * NUF; r1 = *(const f32x4*)(ur_ + qkbase); r2 = *(const f32x4*)(ur_ + qkbase + 16); \
        rv = *(const f32x4*)(ur_ + U_RT_V + h * 128 + vh * 64 + sc4); } while (0)
    RET_LOAD(0);
    for (int tile = 0; tile < NTILES; ++tile) {
        { f32x4 o1 = r1, o2 = r2;
          if (tile >= TC / 32) {
              const int tok = scan_row(b, d, tile * 32 + st) & (TL - 1); const int pos = hs ? (tok & 63) : (tok >> 6);
              const f32x4 cs0 = *(const f32x4*)&rope[(pos * 16 + 4 * cc) * 2], cs1 = *(const f32x4*)&rope[(pos * 16 + 4 * cc) * 2 + 4];
              const f32x4 cv = {cs0.x, cs0.z, cs1.x, cs1.z}, sv = {cs0.y, cs0.w, cs1.y, cs1.w};
              o1 = r1 * cv - r2 * sv; o2 = r1 * sv + r2 * cv;
          }
          float* dst = isk ? ks : qs; const float scl = isk ? 0.125f : 1.f;
          *(f32x4*)&dst[st * 64 + hs * 32 + 4 * cc] = o1 * scl; *(f32x4*)&dst[st * 64 + hs * 32 + 16 + 4 * cc] = o2 * scl;
          *(f32x4*)&vs[st * 64 + sc4] = rv; }
        __syncthreads();
        if (tile + 1 < NTILES) RET_LOAD(tile + 1);
        { float hl_ = 0.f; ssd_core(qs, ks, vs, vs, vs, vs, yp, yp, S0, S1, S2, S3, hl_, tid, p, sl, a, false); }
        __syncthreads();
#pragma unroll
        for (int j = 0; j < 4; ++j) {
            const int idx = tid + 512 * j, t = idx >> 6, pp = idx & 63;
            const f32x4 a0 = *(const f32x4*)&yp[t * 512 + pp * 8], a1 = *(const f32x4*)&yp[t * 512 + pp * 8 + 4];
            const int row = scan_row(b, d, tile * 32 + t);
            YD[((size_t)(3 * 2 + d) * MALL + row) * 512 + h * 128 + vh * 64 + pp] = ((a0.x + a0.y) + (a0.z + a0.w)) + ((a1.x + a1.y) + (a1.z + a1.w));
        }
    }
#undef RET_LOAD
}
__device__ __forceinline__ void scan_hgrn(const Params& P, float* L, int l, int c) {
    const int tid = tid_(), b = c >> 5, h = (c >> 3) & 3, d = (c >> 2) & 1, vq = c & 3;
    const float* U = (const float*)(P.ws + WS_U); bf16* YD = (bf16*)(P.ws + WS_YD);
    float* qs = L; float* fs = L + 4096; float* vs = L + 8192; float* yp = L + L_YP;
    const int st = tid >> 5, sc4 = (tid & 31) << 2, p = tid >> 4, sl = tid & 15;
    f32x4 lbv = {0.f, 0.f, 0.f, 0.f};
    if (l == 1) { const f32x4 g0 = *(const f32x4*)(P.hgrn_lb_logits + (size_t)(d * 2 + 0) * 512 + h * 128 + sc4), g1 = *(const f32x4*)(P.hgrn_lb_logits + (size_t)(d * 2 + 1) * 512 + h * 128 + sc4);
        lbv.x = sigmoid_(g1.x - g0.x); lbv.y = sigmoid_(g1.y - g0.y); lbv.z = sigmoid_(g1.z - g0.z); lbv.w = sigmoid_(g1.w - g0.w); }
    f32x2 S0 = {0.f, 0.f}, S1 = {0.f, 0.f}, S2 = {0.f, 0.f}, S3 = {0.f, 0.f};
    f32x4 rq0, rq1, rf0, rf1, rv = {0.f, 0.f, 0.f, 0.f};
#define HG_LOAD(tile) do { const float* u0_ = U + (size_t)scan_row(b, d, (tile) * 32 + st) * NUF; const float* u1_ = U + (size_t)scan_row(b, d, (tile) * 32 + st + 16) * NUF; \
        rq0 = *(const f32x4*)(u0_ + U_HG_Q + h * 128 + sc4); rq1 = *(const f32x4*)(u1_ + U_HG_Q + h * 128 + sc4); \
        rf0 = *(const f32x4*)(u0_ + U_HG_F + d * 512 + h * 128 + sc4); rf1 = *(const f32x4*)(u1_ + U_HG_F + d * 512 + h * 128 + sc4); \
        if (tid < 256) rv = *(const f32x4*)(U + (size_t)scan_row(b, d, (tile) * 32 + (tid >> 3)) * NUF + U_HG_I + h * 128 + vq * 32 + ((tid & 7) << 2)); } while (0)
    __syncthreads();
    HG_LOAD(0);
    for (int tile = 0; tile < NTILES; ++tile) {
        { f32x4 q, f;
#pragma unroll
          for (int e = 0; e < 4; ++e) { q[e] = silu_(rq0[e]) * 0.08838834764831845f; f[e] = lbv[e] + (1.f - lbv[e]) * sigmoid_(rf0[e]); }
          *(f32x4*)&qs[st * 128 + sc4] = q; *(f32x4*)&fs[st * 128 + sc4] = f;
#pragma unroll
          for (int e = 0; e < 4; ++e) { q[e] = silu_(rq1[e]) * 0.08838834764831845f; f[e] = lbv[e] + (1.f - lbv[e]) * sigmoid_(rf1[e]); }
          *(f32x4*)&qs[(st + 16) * 128 + sc4] = q; *(f32x4*)&fs[(st + 16) * 128 + sc4] = f;
          if (tid < 256) *(f32x4*)&vs[(tid >> 3) * 32 + ((tid & 7) << 2)] = rv; }
        __syncthreads();
        if (tile + 1 < NTILES) HG_LOAD(tile + 1);
        hgrn_core(qs, fs, vs, yp, S0, S1, S2, S3, tid, p, sl);
        __syncthreads();
#pragma unroll
        for (int j = 0; j < 2; ++j) {
            const int idx = tid + 512 * j, t = idx >> 5, pp = idx & 31;
            const f32x4 a0 = *(const f32x4*)&yp[t * 512 + pp * 16], a1 = *(const f32x4*)&yp[t * 512 + pp * 16 + 4], a2 = *(const f32x4*)&yp[t * 512 + pp * 16 + 8], a3 = *(const f32x4*)&yp[t * 512 + pp * 16 + 12];
            const int row = scan_row(b, d, tile * 32 + t);
            YD[((size_t)(2 * 2 + d) * MALL + row) * 512 + h * 128 + vq * 32 + pp] =
                (((a0.x + a0.y) + (a0.z + a0.w)) + ((a1.x + a1.y) + (a1.z + a1.w))) + (((a2.x + a2.y) + (a2.z + a2.w)) + ((a3.x + a3.y) + (a3.z + a3.w)));
        }
    }
#undef HG_LOAD
}

typedef __bf16 bf16x2_n __attribute__((ext_vector_type(2)));
__device__ __forceinline__ unsigned cvtpk(float lo, float hi) { f32x2 v = {lo, hi}; bf16x2_n b = __builtin_convertvector(v, bf16x2_n); return __builtin_bit_cast(unsigned, b); }
template <int KD, int VN> struct ChunkLds {
    static constexpr int PQ = (KD + 8) * 2;
    static constexpr int PT = 80;
    static constexpr int KM = 0, QM = KM + 16 * PQ, QE = QM + 16 * PQ, KWT = QE + 16 * PQ, G = KWT + KD * PT, VT = G + KD * 4, SIZE = VT + VN * PT;
};
template <int KD, int VN>
__device__ __forceinline__ f32x4 chunk_step(const unsigned char* C, int v0, int fr, int fq, f32x4 (&S)[KD / 16]) {
    using CL = ChunkLds<KD, VN>;
    f32x4 mt = {0.f, 0.f, 0.f, 0.f}, mt1 = {0.f, 0.f, 0.f, 0.f};
#pragma unroll
    for (int ks = 0; ks < KD / 32; ks += 2) {
        const bf16x8_t a = *(const bf16x8_t*)(C + CL::KM + fr * CL::PQ + (32 * ks + 8 * fq) * 2);
        const bf16x8_t b = *(const bf16x8_t*)(C + CL::QM + fr * CL::PQ + (32 * ks + 8 * fq) * 2);
        mt = __builtin_amdgcn_mfma_f32_16x16x32_bf16(a, b, mt, 0, 0, 0);
        const bf16x8_t a1 = *(const bf16x8_t*)(C + CL::KM + fr * CL::PQ + (32 * ks + 32 + 8 * fq) * 2);
        const bf16x8_t b1 = *(const bf16x8_t*)(C + CL::QM + fr * CL::PQ + (32 * ks + 32 + 8 * fq) * 2);
        mt1 = __builtin_amdgcn_mfma_f32_16x16x32_bf16(a1, b1, mt1, 0, 0, 0);
    }
    mt += mt1;
#pragma unroll
    for (int j = 0; j < 4; ++j) if (4 * fq + j > fr) mt[j] = 0.f;
    u32x4 bw; bw.x = cvtpk(mt[0], mt[1]); bw.y = cvtpk(mt[2], mt[3]); bw.z = 0u; bw.w = 0u;
    const u32x2 va = *(const u32x2*)(C + CL::VT + (v0 + fr) * CL::PT + (4 * fq) * 2);
    u32x4 aw; aw.x = va.x; aw.y = va.y; aw.z = 0u; aw.w = 0u;
    f32x4 yi = __builtin_amdgcn_mfma_f32_16x16x32_bf16(__builtin_bit_cast(bf16x8_t, aw), __builtin_bit_cast(bf16x8_t, bw), (f32x4){0.f, 0.f, 0.f, 0.f}, 0, 0, 0);
    f32x4 y = {0.f, 0.f, 0.f, 0.f};
#pragma unroll
    for (int i = 0; i < KD / 32; ++i) {
        u32x4 sa; sa.x = cvtpk(S[2 * i][0], S[2 * i][1]); sa.y = cvtpk(S[2 * i][2], S[2 * i][3]); sa.z = cvtpk(S[2 * i + 1][0], S[2 * i + 1][1]); sa.w = cvtpk(S[2 * i + 1][2], S[2 * i + 1][3]);
        const u32x2 lo = *(const u32x2*)(C + CL::QE + fr * CL::PQ + (32 * i + 4 * fq) * 2), hi = *(const u32x2*)(C + CL::QE + fr * CL::PQ + (32 * i + 16 + 4 * fq) * 2);
        u32x4 qb; qb.x = lo.x; qb.y = lo.y; qb.z = hi.x; qb.w = hi.y;
        y = __builtin_amdgcn_mfma_f32_16x16x32_bf16(__builtin_bit_cast(bf16x8_t, sa), __builtin_bit_cast(bf16x8_t, qb), y, 0, 0, 0);
    }
    y += yi;
    const bf16x8_t bv = *(const bf16x8_t*)(C + CL::VT + (v0 + fr) * CL::PT + (8 * fq) * 2);
#pragma unroll
    for (int i = 0; i < KD / 16; ++i) {
        const f32x4 g4 = *(const f32x4*)(C + CL::G + (16 * i + 4 * fq) * 4);
        const bf16x8_t ak = *(const bf16x8_t*)(C + CL::KWT + (16 * i + fr) * CL::PT + (8 * fq) * 2);
        S[i] = __builtin_amdgcn_mfma_f32_16x16x32_bf16(ak, bv, S[i] * g4, 0, 0, 0);
    }
    return y;
}
template <int KD, int VN, bool LVEC>
__device__ __forceinline__ void build_operands(const float* __restrict__ rq, const float* __restrict__ rk, const float* __restrict__ rL, const float* __restrict__ rv, unsigned char* __restrict__ OP, int t0, int nthr) {
    using CL = ChunkLds<KD, VN>;
    for (int idx = t0; idx < 8 * KD; idx += nthr) {
        const int kq = idx % (KD / 4), t = (idx / (KD / 4)) & 15, c = idx / (4 * KD), k = 4 * kq, row = c * 16 + t;
        const f32x4 q4 = *(const f32x4*)&rq[row * KD + k], k4 = *(const f32x4*)&rk[row * KD + k];
        f32x4 Lt, Lm;
        if (LVEC) { Lt = *(const f32x4*)&rL[row * KD + k]; Lm = *(const f32x4*)&rL[(c * 16 + 7) * KD + k]; } else { const float a_ = rL[row], b_ = rL[c * 16 + 7]; Lt = (f32x4){a_, a_, a_, a_}; Lm = (f32x4){b_, b_, b_, b_}; }
        f32x4 qe, qm, km;
#pragma unroll
        for (int e = 0; e < 4; ++e) { qe[e] = q4[e] * __expf(Lt[e]); qm[e] = q4[e] * __expf(fminf(Lt[e] - Lm[e], 80.f)); km[e] = k4[e] * __expf(fminf(Lm[e] - Lt[e], 80.f)); }
        unsigned char* base = OP + c * CL::SIZE + t * CL::PQ + k * 2;
        u32x2 w; w.x = cvtpk(qe[0], qe[1]); w.y = cvtpk(qe[2], qe[3]); *(u32x2*)(base + CL::QE) = w;
        w.x = cvtpk(qm[0], qm[1]); w.y = cvtpk(qm[2], qm[3]); *(u32x2*)(base + CL::QM) = w;
        w.x = cvtpk(km[0], km[1]); w.y = cvtpk(km[2], km[3]); *(u32x2*)(base + CL::KM) = w;
    }
    for (int idx = t0; idx < 4 * KD; idx += nthr) {
        const int k = idx % KD, oc = (idx / KD) & 1, c = idx / (2 * KD);
        const float Le = LVEC ? rL[(c * 16 + 15) * KD + k] : rL[c * 16 + 15];
        float w[8];
#pragma unroll
        for (int e = 0; e < 8; ++e) { const int row = c * 16 + 8 * oc + e; const float Lt = LVEC ? rL[row * KD + k] : rL[row]; w[e] = rk[row * KD + k] * __expf(Le - Lt); }
        u32x4 o; o.x = cvtpk(w[0], w[1]); o.y = cvtpk(w[2], w[3]); o.z = cvtpk(w[4], w[5]); o.w = cvtpk(w[6], w[7]);
        *(u32x4*)(OP + c * CL::SIZE + CL::KWT + k * CL::PT + oc * 16) = o;
        if (oc == 0) *(float*)(OP + c * CL::SIZE + CL::G + k * 4) = __expf(Le);
    }
    for (int idx = t0; idx < 4 * VN; idx += nthr) {
        const int v = idx % VN, oc = (idx / VN) & 1, c = idx / (2 * VN);
        float w[8];
#pragma unroll
        for (int e = 0; e < 8; ++e) w[e] = rv[(c * 16 + 8 * oc + e) * VN + v];
        u32x4 o; o.x = cvtpk(w[0], w[1]); o.y = cvtpk(w[2], w[3]); o.z = cvtpk(w[4], w[5]); o.w = cvtpk(w[6], w[7]);
        *(u32x4*)(OP + c * CL::SIZE + CL::VT + v * CL::PT + oc * 16) = o;
    }
}
template <int KD, int VN>
__device__ __forceinline__ void zero_operand_pads(unsigned char* OP, int t0, int nthr) {
    using CL = ChunkLds<KD, VN>;
    for (int idx = t0; idx < 2 * (KD + VN) * 2; idx += nthr) {
        const int half = idx & 1, r = (idx >> 1) % (KD + VN), c = (idx >> 1) / (KD + VN);
        unsigned char* row = OP + c * CL::SIZE + (r < KD ? CL::KWT + r * CL::PT : CL::VT + (r - KD) * CL::PT);
        *(u32x4*)(row + 32 + half * 16) = (u32x4){0u, 0u, 0u, 0u};
    }
}
constexpr int L_RAW_Q = 0, L_RAW_K = 16384, L_RAW_L = 32768, L_RAW_V = 49152, L_OP = 65536;

__device__ __forceinline__ void scan_ret_mfma(const Params& P, unsigned char* LB, int c) {
    const int tid = tid_(), lane = tid & 63, wave = __builtin_amdgcn_readfirstlane(tid >> 6), fr = lane & 15, fq = lane >> 4;
    const int vh = c & 1, b = c >> 4, h = (c >> 2) & 3, d = (c >> 1) & 1;
    const float* U = (const float*)(P.ws + WS_U); bf16* YD = (bf16*)(P.ws + WS_YD);
    float* rq = (float*)(LB + L_RAW_Q); float* rk = (float*)(LB + L_RAW_K); float* rL = (float*)(LB + L_RAW_L); float* rv = (float*)(LB + L_RAW_V);
    float* rope = (float*)(LB + L_RAW_L + 1024);
    unsigned char* OP = LB + L_OP;
    const float la = __logf(1.f - exp2f(-5.f - (float)h));
    const int st = tid >> 4, rem = tid & 15, isk = rem >> 3, hs = (rem >> 2) & 1, cc = rem & 3;
    __syncthreads();
    for (int i = tid; i < 1024; i += 512) { const int pos = i >> 4, fi = i & 15; const float inv = exp2f(-(float)fi * 0.83048202372184f); const float rev = ((float)pos * inv) * 0.15915494309189535f;
        rope[2 * i] = __builtin_amdgcn_cosf(rev); rope[2 * i + 1] = __builtin_amdgcn_sinf(rev); }
    if (tid < 32) rL[tid] = (float)((tid & 15) + 1) * la;
    zero_operand_pads<64, 64>(OP, tid, 512);
    f32x4 S[4];
#pragma unroll
    for (int i = 0; i < 4; ++i) S[i] = (f32x4){0.f, 0.f, 0.f, 0.f};
    f32x4 r1, r2, rv0;
    const int qkbase = (isk ? U_RT_K : U_RT_Q) + h * 64 + hs * 32 + 4 * cc;
#define RETM_LOAD(tile) do { const float* ur_ = U + (size_t)scan_row(b, d, (tile) * 32 + st) * NUF; r1 = *(const f32x4*)(ur_ + qkbase); r2 = *(const f32x4*)(ur_ + qkbase + 16); \
        rv0 = *(const f32x4*)(ur_ + U_RT_V + h * 128 + vh * 64 + rem * 4); } while (0)
    RETM_LOAD(0);
    for (int tile = 0; tile < NTILES; ++tile) {
        { f32x4 o1 = r1, o2 = r2;
          if (tile >= TC / 32) {
              const int tok = scan_row(b, d, tile * 32 + st) & (TL - 1); const int pos = hs ? (tok & 63) : (tok >> 6);
              const f32x4 cs0 = *(const f32x4*)&rope[(pos * 16 + 4 * cc) * 2], cs1 = *(const f32x4*)&rope[(pos * 16 + 4 * cc) * 2 + 4];
              const f32x4 cv = {cs0.x, cs0.z, cs1.x, cs1.z}, sv = {cs0.y, cs0.w, cs1.y, cs1.w};
              o1 = r1 * cv - r2 * sv; o2 = r1 * sv + r2 * cv;
          }
          float* dst = isk ? rk : rq; const float scl = isk ? 0.125f : 1.f;
          *(f32x4*)&dst[st * 64 + hs * 32 + 4 * cc] = o1 * scl; *(f32x4*)&dst[st * 64 + hs * 32 + 16 + 4 * cc] = o2 * scl;
          *(f32x4*)&rv[st * 64 + rem * 4] = rv0; }
        __syncthreads();
        if (tile + 1 < NTILES) RETM_LOAD(tile + 1);
        build_operands<64, 64, false>(rq, rk, rL, rv, OP, tid, 512);
        __syncthreads();
        if (wave < 4) {
#pragma unroll
        for (int ch = 0; ch < 2; ++ch) {
            const f32x4 y = chunk_step<64, 64>(OP + ch * ChunkLds<64, 64>::SIZE, wave * 16, fr, fq, S);
            const int row = scan_row(b, d, tile * 32 + ch * 16 + fr);
            { u32x2 w_; w_.x = cvtpk(y[0], y[1]); w_.y = cvtpk(y[2], y[3]); *(u32x2*)(YD + ((size_t)(3 * 2 + d) * MALL + row) * 512 + h * 128 + vh * 64 + wave * 16 + 4 * fq) = w_; }
        }
        }
    }
#undef RETM_LOAD
}

__device__ __forceinline__ void scan_hgrn_mfma(const Params& P, unsigned char* LB, int l, int c) {
    using CL = ChunkLds<128, 64>;
    const int tid = tid_(), lane = tid & 63, wave = __builtin_amdgcn_readfirstlane(tid >> 6), fr = lane & 15, fq = lane >> 4;
    const int vq = c & 1, b = c >> 4, h = (c >> 2) & 3, d = (c >> 1) & 1;
    const float* U = (const float*)(P.ws + WS_U); bf16* YD = (bf16*)(P.ws + WS_YD);
    unsigned char* OP = LB;
    float* tot = (float*)(LB + 58368);
    const int k = 2 * lane, qt = wave & 3, cb = wave >> 2;
    const int vv_ = tid & 63, vqt = wave & 3, vc = wave >> 2;
    f32x2 lb2 = {0.f, 0.f};
    if (l == 1) { const f32x2 g0 = *(const f32x2*)(P.hgrn_lb_logits + (size_t)(d * 2 + 0) * 512 + h * 128 + k), g1 = *(const f32x2*)(P.hgrn_lb_logits + (size_t)(d * 2 + 1) * 512 + h * 128 + k);
        lb2.x = sigmoid_(g1.x - g0.x); lb2.y = sigmoid_(g1.y - g0.y); }
    __syncthreads();
    zero_operand_pads<128, 64>(OP, tid, 512);
    f32x4 S[8];
#pragma unroll
    for (int i = 0; i < 8; ++i) S[i] = (f32x4){0.f, 0.f, 0.f, 0.f};
    f32x2 pq[4], pf[4]; float pv[4] = {0.f, 0.f, 0.f, 0.f};
#define HGM_LOAD(tile) do { _Pragma("unroll") for (int r_ = 0; r_ < 4; ++r_) { const float* u_ = U + (size_t)scan_row(b, d, (tile) * 32 + cb * 16 + qt * 4 + r_) * NUF; \
        pq[r_] = *(const f32x2*)(u_ + U_HG_Q + h * 128 + k); pf[r_] = *(const f32x2*)(u_ + U_HG_F + d * 512 + h * 128 + k); } \
        { _Pragma("unroll") for (int r_ = 0; r_ < 4; ++r_) pv[r_] = U[(size_t)scan_row(b, d, (tile) * 32 + vc * 16 + vqt * 4 + r_) * NUF + U_HG_I + h * 128 + vq * 64 + vv_]; } } while (0)
    HGM_LOAD(0);
    for (int tile = 0; tile < NTILES; ++tile) {
        f32x2 q[4], kk[4], pre[4], suf[4]; float vv[4];
        { f32x2 fc[4];
#pragma unroll
          for (int r = 0; r < 4; ++r) {
              const float eq0 = 1.f + __expf(fminf(-pq[r].x, 40.f)), ef0 = 1.f + __expf(fminf(-pf[r].x, 40.f)), r0_ = __builtin_amdgcn_rcpf(eq0 * ef0);
              const float eq1 = 1.f + __expf(fminf(-pq[r].y, 40.f)), ef1 = 1.f + __expf(fminf(-pf[r].y, 40.f)), r1_ = __builtin_amdgcn_rcpf(eq1 * ef1);
              q[r].x = pq[r].x * (ef0 * r0_) * 0.08838834764831845f; q[r].y = pq[r].y * (ef1 * r1_) * 0.08838834764831845f;
              const float f0 = lb2.x + (1.f - lb2.x) * (eq0 * r0_), f1 = lb2.y + (1.f - lb2.y) * (eq1 * r1_);
              kk[r].x = 1.f - f0; kk[r].y = 1.f - f1; fc[r].x = fmaxf(f0, 1e-4f); fc[r].y = fmaxf(f1, 1e-4f); vv[r] = pv[r];
          }
          pre[0] = fc[0]; pre[1] = pre[0] * fc[1]; pre[2] = pre[1] * fc[2]; pre[3] = pre[2] * fc[3];
          suf[3] = (f32x2){1.f, 1.f}; suf[2] = fc[3]; suf[1] = suf[2] * fc[2]; suf[0] = suf[1] * fc[1]; }
        *(f32x2*)&tot[(cb * 4 + qt) * 128 + k] = pre[3];
        __syncthreads();
        if (tile + 1 < NTILES) HGM_LOAD(tile + 1);
        {
            const f32x2 t0 = *(const f32x2*)&tot[(cb * 4 + 0) * 128 + k], t1 = *(const f32x2*)&tot[(cb * 4 + 1) * 128 + k], t2 = *(const f32x2*)&tot[(cb * 4 + 2) * 128 + k], t3 = *(const f32x2*)&tot[(cb * 4 + 3) * 128 + k];
            const f32x2 Pm = t0 * t1, T23 = t2 * t3;
            unsigned char* C = OP + cb * CL::SIZE;
            float kw0[4], kw1[4];
#pragma unroll
            for (int r = 0; r < 4; ++r) {
                const int t = qt * 4 + r;
                f32x2 R, iR;
                if (qt >= 2) { R = pre[r]; if (qt == 3) R *= t2; iR.x = __builtin_amdgcn_rcpf(R.x); iR.y = __builtin_amdgcn_rcpf(R.y); }
                else { iR = suf[r]; if (qt == 0) iR *= t1; R.x = __builtin_amdgcn_rcpf(iR.x); R.y = __builtin_amdgcn_rcpf(iR.y); }
                const f32x2 Pt = Pm * R;
                unsigned char* p = C + t * CL::PQ + k * 2;
                *(unsigned*)(p + CL::QE) = cvtpk(q[r].x * Pt.x, q[r].y * Pt.y);
                *(unsigned*)(p + CL::QM) = cvtpk(q[r].x * R.x, q[r].y * R.y);
                *(unsigned*)(p + CL::KM) = cvtpk(kk[r].x * iR.x, kk[r].y * iR.y);
                kw0[r] = kk[r].x * T23.x * iR.x; kw1[r] = kk[r].y * T23.y * iR.y;
            }
            u32x2 w; w.x = cvtpk(kw0[0], kw0[1]); w.y = cvtpk(kw0[2], kw0[3]); *(u32x2*)(C + CL::KWT + k * CL::PT + qt * 8) = w;
            w.x = cvtpk(kw1[0], kw1[1]); w.y = cvtpk(kw1[2], kw1[3]); *(u32x2*)(C + CL::KWT + (k + 1) * CL::PT + qt * 8) = w;
            if (qt == 0) *(f32x2*)(C + CL::G + k * 4) = Pm * T23;
            { u32x2 wv; wv.x = cvtpk(vv[0], vv[1]); wv.y = cvtpk(vv[2], vv[3]); *(u32x2*)(OP + vc * CL::SIZE + CL::VT + vv_ * CL::PT + vqt * 8) = wv; }
        }
        __syncthreads();
        if (wave < 4) {
#pragma unroll
            for (int ch = 0; ch < 2; ++ch) {
                const f32x4 y = chunk_step<128, 64>(OP + ch * CL::SIZE, wave * 16, fr, fq, S);
                const int row = scan_row(b, d, tile * 32 + ch * 16 + fr);
                { u32x2 w_; w_.x = cvtpk(y[0], y[1]); w_.y = cvtpk(y[2], y[3]); *(u32x2*)(YD + ((size_t)(2 * 2 + d) * MALL + row) * 512 + h * 128 + vq * 64 + wave * 16 + 4 * fq) = w_; }
            }
        }
    }
#undef HGM_LOAD
}
__device__ __forceinline__ void scan_ssd_mfma(const Params& P, unsigned char* LB, int l, int c) {
    const int tid = tid_(), lane = tid & 63, wave = __builtin_amdgcn_readfirstlane(tid >> 6), fr = lane & 15, fq = lane >> 4;
    const int b = c >> 4, d = (c >> 3) & 1, h = c & 7, g = h >> 2;
    const float* U = (const float*)(P.ws + WS_U); const bf16* XBC = (const bf16*)(P.ws + WS_XBC); bf16* YD = (bf16*)(P.ws + WS_YD);
    float* rq = (float*)(LB + L_RAW_Q); float* rk = (float*)(LB + L_RAW_K); float* rL = (float*)(LB + L_RAW_L); float* lg = (float*)(LB + L_RAW_L + 256); float* rv = (float*)(LB + L_RAW_V);
    unsigned char* OP = LB + L_OP;
    const float dtb = P.ssd_dt_bias[(l * 2 + d) * 8 + h], aneg = -__expf(P.ssd_a_log[(l * 2 + d) * 8 + h]);
    const int st = tid >> 4, sc4 = (tid & 15) << 2;
    __syncthreads();
    zero_operand_pads<64, 64>(OP, tid, 512);
    f32x4 S[4];
#pragma unroll
    for (int i = 0; i < 4; ++i) S[i] = (f32x4){0.f, 0.f, 0.f, 0.f};
    f32x4 px, pB, pC; float pdt;
#define SSM_LOAD(tile) do { const int row_ = scan_row(b, d, (tile) * 32 + st); const bf16* xr_ = XBC + (size_t)row_ * 768; \
        px = ld_bf4(xr_ + h * 64 + sc4); pB = ld_bf4(xr_ + 512 + g * 64 + sc4); pC = ld_bf4(xr_ + 640 + g * 64 + sc4); pdt = U[(size_t)row_ * NUF + U_SSD_DT + d * 8 + h]; } while (0)
    SSM_LOAD(0);
    for (int tile = 0; tile < NTILES; ++tile) {
        { const float delta = softplus_(pdt + dtb); const int o = st * 64 + sc4;
          *(f32x4*)&rv[o] = px; *(f32x4*)&rk[o] = pB * delta; *(f32x4*)&rq[o] = pC;
          if ((tid & 15) == 0) lg[st] = aneg * delta; }
        __syncthreads();
        if (tile + 1 < NTILES) SSM_LOAD(tile + 1);
        if (tid < 32) { const int c0 = tid & 16; float acc = 0.f;
#pragma unroll
            for (int t = 0; t < 16; ++t) { const float v_ = lg[c0 + t]; acc += (c0 + t <= tid) ? v_ : 0.f; }
            rL[tid] = acc; }
        __syncthreads();
        build_operands<64, 64, false>(rq, rk, rL, rv, OP, tid, 512);
        __syncthreads();
        if (wave < 4) {
#pragma unroll
            for (int ch = 0; ch < 2; ++ch) {
                const f32x4 y = chunk_step<64, 64>(OP + ch * ChunkLds<64, 64>::SIZE, wave * 16, fr, fq, S);
                const int row = scan_row(b, d, tile * 32 + ch * 16 + fr);
                { u32x2 w_; w_.x = cvtpk(y[0], y[1]); w_.y = cvtpk(y[2], y[3]); *(u32x2*)(YD + ((size_t)(0 * 2 + d) * MALL + row) * 512 + h * 64 + wave * 16 + 4 * fq) = w_; }
            }
        }
    }
#undef SSM_LOAD
}
__device__ __forceinline__ void scan_lru(const Params& P, float* L, int c) {
    const int tid = tid_(), ch = tid & 63, seg = __builtin_amdgcn_readfirstlane(tid >> 6), b = c >> 3, d = (c >> 2) & 1, cgp = c & 3;
    const float* LA = (const float*)(P.ws + WS_LA) + (size_t)d * MALL * 512 + cgp * 128 + ch; const bf16* LBp = (const bf16*)(P.ws + WS_LB) + (size_t)d * MALL * 512 + cgp * 128 + ch;
    bf16* YD = (bf16*)(P.ws + WS_YD) + (size_t)(1 * 2 + d) * MALL * 512 + cgp * 128 + ch;
    float* car = L;
    const int s0 = seg * 288;
    __syncthreads();
    float h0 = 0.f, h1 = 0.f, ap0 = 1.f, ap1 = 1.f;
#pragma unroll 1
    for (int pass = 0; pass < 2; ++pass) {
        float a0[16], b0[16], c0[16], d0[16];
#pragma unroll
        for (int s = 0; s < 16; ++s) { const size_t r = (size_t)scan_row(b, d, s0 + s) * 512; a0[s] = LA[r]; b0[s] = __builtin_bit_cast(float, (unsigned)LBp[r] << 16); c0[s] = LA[r + 64]; d0[s] = __builtin_bit_cast(float, (unsigned)LBp[r + 64] << 16); }
#pragma unroll 1
        for (int tile = 0; tile < 18; ++tile) {
            float a1[16], b1[16], c1[16], d1[16];
            if (tile + 1 < 18) {
#pragma unroll
                for (int s = 0; s < 16; ++s) { const size_t r = (size_t)scan_row(b, d, s0 + (tile + 1) * 16 + s) * 512; a1[s] = LA[r]; b1[s] = __builtin_bit_cast(float, (unsigned)LBp[r] << 16); c1[s] = LA[r + 64]; d1[s] = __builtin_bit_cast(float, (unsigned)LBp[r + 64] << 16); }
            }
            if (pass == 0) {
#pragma unroll
                for (int s = 0; s < 16; ++s) { h0 = a0[s] * h0 + b0[s]; ap0 *= a0[s]; h1 = c0[s] * h1 + d0[s]; ap1 *= c0[s]; }
            } else {
#pragma unroll
                for (int s = 0; s < 16; ++s) { h0 = a0[s] * h0 + b0[s]; h1 = c0[s] * h1 + d0[s]; const size_t r = (size_t)scan_row(b, d, s0 + tile * 16 + s) * 512; YD[r] = (bf16)f2bf(h0); YD[r + 64] = (bf16)f2bf(h1); }
            }
#pragma unroll
            for (int s = 0; s < 16; ++s) { a0[s] = a1[s]; b0[s] = b1[s]; c0[s] = c1[s]; d0[s] = d1[s]; }
        }
        if (pass == 0) {
            car[(seg * 128 + ch) * 2] = ap0; car[(seg * 128 + ch) * 2 + 1] = h0; car[(seg * 128 + 64 + ch) * 2] = ap1; car[(seg * 128 + 64 + ch) * 2 + 1] = h1;
            __syncthreads();
            float hin0 = 0.f, hin1 = 0.f;
            for (int sg = 0; sg < seg; ++sg) { hin0 = car[(sg * 128 + ch) * 2] * hin0 + car[(sg * 128 + ch) * 2 + 1]; hin1 = car[(sg * 128 + 64 + ch) * 2] * hin1 + car[(sg * 128 + 64 + ch) * 2 + 1]; }
            h0 = hin0; h1 = hin1;
        }
    }
}
__device__ __forceinline__ void scan_phase(const Params& P, float* L, int l) {
    for (int it = bid_(); it < 224; it += gridDim.x) {
        if (it < 64) scan_hgrn_mfma(P, (unsigned char*)L, l, it);
        else if (it < 128) scan_ssd_mfma(P, (unsigned char*)L, l, it - 64);
        else if (it < 192) scan_ret_mfma(P, (unsigned char*)L, it - 128);
        else scan_lru(P, L, it - 192);
    }
}

__device__ __forceinline__ void post_phase(const Params& P, int l, int mrows) {
    const int tid = tid_(), lane = tid & 63, wave = __builtin_amdgcn_readfirstlane(tid >> 6);
    const int gw = bid_() * 8 + wave, NGW = gridDim.x * 8;
    const float* U = (const float*)(P.ws + WS_U); const bf16* YD = (const bf16*)(P.ws + WS_YD); bf16* YC = (bf16*)(P.ws + WS_H);
    for (int row = gw; row < mrows; row += NGW) {
        const bf16* ug = (const bf16*)(P.ws + WS_UG) + (size_t)row * NUG; bf16* yc = YC + (size_t)row * DM;
#define YDP(m, d) (YD + ((size_t)((m) * 2 + (d)) * MALL + row) * 512)
#define LDY(p) ld_bf4(p)
        {
            f32x4 gg[2]; float ss = 0.f;
#pragma unroll
            for (int j = 0; j < 2; ++j) { const int c = 4 * lane + 256 * j; const float dsk = P.ssd_d[l * 8 + (c >> 6)]; const f32x4 y = LDY(YDP(0, 0) + c) + LDY(YDP(0, 1) + c) + ld_bf4((const bf16*)(P.ws + WS_XBC) + (size_t)row * 768 + c) * dsk; const f32x4 z = ld_bf4(ug + G_SSD_Z + c);
                f32x4 t; t.x = y.x * silu_(z.x); t.y = y.y * silu_(z.y); t.z = y.z * silu_(z.z); t.w = y.w * silu_(z.w); gg[j] = t; ss += dot4(t); }
            const float rs = rsqrtf(wave_sum(ss) * (1.f / 512.f) + EPS);
#pragma unroll
            for (int j = 0; j < 2; ++j) { const int c = 4 * lane + 256 * j; const f32x4 w = *(const f32x4*)(P.ssd_norm_w + (size_t)l * 512 + c); const f32x4 o = gg[j] * rs * w;
                u32x2 pk; pk.x = pk2(o.x, o.y); pk.y = pk2(o.z, o.w); *(u32x2*)(yc + c) = pk; }
        }
        {
#pragma unroll
            for (int j = 0; j < 2; ++j) { const int c = 4 * lane + 256 * j; const f32x4 hh = LDY(YDP(1, 0) + c) + LDY(YDP(1, 1) + c); const f32x4 gb = ld_bf4(ug + G_LRU_G + c);
                f32x4 o; o.x = hh.x * gelu_tanh_(gb.x); o.y = hh.y * gelu_tanh_(gb.y); o.z = hh.z * gelu_tanh_(gb.z); o.w = hh.w * gelu_tanh_(gb.w);
                u32x2 pk; pk.x = pk2(o.x, o.y); pk.y = pk2(o.z, o.w); *(u32x2*)(yc + 512 + c) = pk; }
        }
        {
#pragma unroll
            for (int j = 0; j < 2; ++j) { const int c = 4 * lane + 256 * j; const f32x4 o = LDY(YDP(2, 0) + c) + LDY(YDP(2, 1) + c);
                const float rs = rsqrtf(half_sum(dot4(o)) * (1.f / 128.f) + EPS); const f32x4 w = *(const f32x4*)(P.hgrn_norm_w + (size_t)l * 128 + (c & 127)); const f32x4 gt = ld_bf4(ug + G_HG_G + c);
                f32x4 r; r.x = o.x * rs * w.x * silu_(gt.x); r.y = o.y * rs * w.y * silu_(gt.y); r.z = o.z * rs * w.z * silu_(gt.z); r.w = o.w * rs * w.w * silu_(gt.w);
                u32x2 pk; pk.x = pk2(r.x, r.y); pk.y = pk2(r.z, r.w); *(u32x2*)(yc + 1024 + c) = pk; }
        }
        {
#pragma unroll
            for (int j = 0; j < 2; ++j) { const int c = 4 * lane + 256 * j; const f32x4 o = LDY(YDP(3, 0) + c) + LDY(YDP(3, 1) + c);
                const float rs = rsqrtf(half_sum(dot4(o)) * (1.f / 128.f) + EPS); const f32x4 gt = ld_bf4(ug + G_RT_G + c);
                f32x4 r; r.x = o.x * rs * silu_(gt.x); r.y = o.y * rs * silu_(gt.y); r.z = o.z * rs * silu_(gt.z); r.w = o.w * rs * silu_(gt.w);
                u32x2 pk; pk.x = pk2(r.x, r.y); pk.y = pk2(r.z, r.w); *(u32x2*)(yc + 1536 + c) = pk; }
        }
#undef YDP
    }
}

__global__ void __launch_bounds__(512, 2) mk_fwd(Params Pkarg) {
    extern __shared__ __attribute__((aligned(16))) unsigned char lds_raw[];
    float* L = (float*)lds_raw;
    const __attribute__((address_space(4))) Params* kp = (const __attribute__((address_space(4))) Params*)__builtin_amdgcn_kernarg_segment_ptr();
    const int ph_lo = kp->ph_lo, ph_hi = kp->ph_hi;
    {
        volatile LAS unsigned* st0 = (volatile LAS unsigned*)((LAS unsigned char*)lds_raw + (LDS_BYTES - 128));
        if (threadIdx.x == 0) { st0[0] = 0u; st0[1] = 0u; }
        __syncthreads();
        (void)xcd_barrier_post((unsigned*)kp->ws, st0);
    }
    for (int ph = ph_lo; ph < ph_hi; ++ph) {
        asm volatile("" : "+s"(kp));
#if defined(__HIP_DEVICE_COMPILE__)
        const Params P = *kp;
#else
        const Params P = Pkarg;
#endif
        unsigned char* ws = P.ws;
#ifdef PROBE_DUP
        const int kk_ = ph < 2 ? 100 + ph : (ph - 2) % 12;
        const int nrep_ = (kk_ == PROBE_DUP || kk_ == PROBE_DUP2) ? 2 : 1;
        for (int rep_ = 0; rep_ < nrep_; ++rep_) { if (rep_) cg::this_grid().sync();
#endif
        if (ph == 0) prologue_phase(P, L);
        else if (ph == 1) rowwise_phase(P, MALL, true, 0, 0, 0, 0.f, false, 0, 0, 0, 1);
        else {
            const int q = ph - 2, l = q / 12, k = q % 12;
            const int Mg = (l == 1 && k >= 6) ? MLAT : MALL;
            if (k == 0 || k == 9) {
                const int lf = l * 2 + (k == 9);
                pg8::Gemm g{(const pg8::bf16_t*)(ws + WS_H), (const pg8::bf16_t*)(ws + WS_W13) + (size_t)lf * NUP * DM, Mg, NUP, DM, DM};
                pg8::StaticOrder S; S.init(Mg, NUP, (int)gridDim.x, bid_());
                pg8::EpiSwiGLU E{(pg8::bf16_t*)(ws + WS_U), FF};
                pg8::gemm_phase<pg8::EpiSwiGLU, pg8::StaticOrder, true, true>((LAS unsigned char*)lds_raw, g, S, E);
            } else if (k == 1 || k == 10 || k == 3 || k == 7) {
                const pg8::bf16_t* A; const pg8::bf16_t* Bt; int N, K; float* O;
                if (k == 3) { A = (const pg8::bf16_t*)(ws + WS_H); Bt = (const pg8::bf16_t*)(ws + WS_WIN) + (size_t)l * NINP_W * DM; N = NINP_W; K = DM; O = (float*)(ws + WS_U); }
                else if (k == 7) { A = (const pg8::bf16_t*)(ws + WS_H); Bt = (const pg8::bf16_t*)(ws + WS_WOUT) + (size_t)l * DM * DM; N = DM; K = DM; O = (float*)(ws + WS_Y); }
                else { const int lf = l * 2 + (k == 10); A = (const pg8::bf16_t*)(ws + WS_U); Bt = (const pg8::bf16_t*)(ws + WS_W2) + (size_t)lf * DM * FF; N = DM; K = FF; O = (float*)(ws + WS_Y); }
                const bool splitk = (k != 3) && (Mg == MALL);
                const int M1 = splitk ? MLAT : Mg;
                { pg8::Gemm g{A, Bt, M1, N, K, K};
                  pg8::Order2 S; S.so.init(M1, N, (int)gridDim.x, bid_()); S.one = 0; S.valid = 1; S.u1.pm = 0; S.u1.pn = 0;
                  pg8::EpiF32 E{O, (k == 3) ? NUF : N, (k != 3) ? 1 : 0, (pg8::bf16_t*)(ws + WS_UG), NUG, (k == 3) ? NUF / 256 : 0};
                  pg8::gemm_phase<pg8::EpiF32, pg8::Order2, true, true>((LAS unsigned char*)lds_raw, g, S, E); }
                if (splitk) {
                    for (int c = bid_(); c < 256; c += (int)gridDim.x) {
                        const int u = c >> 3, ks = c & 7, nt2 = K >> 7;
                        const int kt0 = 2 * ((ks * nt2) >> 3), kt1 = 2 * (((ks + 1) * nt2) >> 3);
                        pg8::Gemm g{A + kt0 * 64, Bt + kt0 * 64, MALL, N, (kt1 - kt0) * 64, K};
                        pg8::Order2 S; S.so.init(MALL, N, 1, 0); S.one = 1; S.valid = 1; S.u1.pm = 32 + (u >> 3); S.u1.pn = u & 7;
                        pg8::EpiF32 E{(float*)((bf16*)(ws + WS_YD) + (size_t)ks * MCTX * DM - (size_t)MLAT * DM), N, 1, nullptr, 0, 0};
                        pg8::gemm_phase<pg8::EpiF32, pg8::Order2, true, true>((LAS unsigned char*)lds_raw, g, S, E);
                    }
                }
            } else if (k == 2) rowwise_phase(P, MALL, false, l, 0, 2, 0.5f, false, l, 1, 3, 4);
            else if (k == 8) rowwise_phase(P, Mg, false, l, 1, 5, 1.0f, false, l, 2, 6, 7);
            else if (k == 11) rowwise_phase(P, Mg, false, l, 2, 8, 0.5f, l == 1, l + 1, 0, 0, 1);
            else if (k == 4) prep_phase(P, L, l);
            else if (k == 5) scan_phase(P, L, l);
            else post_phase(P, l, Mg);
        }
#ifdef PROBE_DUP
        }
#endif
        if (ph + 1 < ph_hi) {
            if (ph == 0) cg::this_grid().sync();
            else { XcdBarrier xb; xb.bar = (unsigned*)ws; xb.x = xb_xcc_id(); xb.st = (volatile LAS unsigned*)((LAS unsigned char*)lds_raw + (LDS_BYTES - 128)); xcd_barrier(xb); }
        }
    }
}

extern "C" void kernel_launch(void* const* d_in, const int* in_sizes, int n_in, void* d_out, int out_size, void* d_ws, size_t ws_size, hipStream_t stream) {
    static int grid = 0;
    if (grid == 0) {
        if (n_in != 28 || out_size != MLAT * DM || ws_size < WS_END) { fprintf(stderr, "kernel_launch: unexpected shapes (n_in %d out %d ws %zu need %zu)\n", n_in, out_size, ws_size, (size_t)WS_END); grid = -1; return; }
        int dev = 0, cus = 0, per_cu = 0;
        (void)hipGetDevice(&dev); (void)hipDeviceGetAttribute(&cus, hipDeviceAttributeMultiprocessorCount, dev);
        if (hipFuncSetAttribute((const void*)mk_fwd, hipFuncAttributeMaxDynamicSharedMemorySize, LDS_BYTES) != hipSuccess) { fprintf(stderr, "kernel_launch: hipFuncSetAttribute failed\n"); grid = -1; return; }
        if (hipOccupancyMaxActiveBlocksPerMultiprocessor(&per_cu, (const void*)mk_fwd, 512, LDS_BYTES) != hipSuccess || per_cu < 1) { fprintf(stderr, "kernel_launch: occupancy query says %d\n", per_cu); per_cu = 1; }
        (void)hipGetLastError();
        grid = cus * per_cu;
    }
    if (grid < 0) return;
    (void)hipMemsetAsync(d_ws, 0, 16384, stream);
    Params p{};
    const float** pp = (const float**)&p;
    for (int i = 0; i < 28; ++i) pp[i] = (const float*)d_in[i];
    p.out = (float*)d_out; p.ws = (unsigned char*)d_ws;
#if MK_SINGLE
    p.ph_lo = 0; p.ph_hi = NPHASES;
    void* args[] = {&p};
    hipError_t e = hipLaunchCooperativeKernel((const void*)mk_fwd, dim3(grid), dim3(512), args, LDS_BYTES, stream);
    if (e != hipSuccess) fprintf(stderr, "cooperative launch failed: %s (grid %d)\n", hipGetErrorString(e), grid);
#else
    for (int ph = 0; ph < NPHASES; ++ph) { p.ph_lo = ph; p.ph_hi = ph + 1; hipLaunchKernelGGL(mk_fwd, dim3(grid), dim3(512), LDS_BYTES, stream, p); }
#endif
}
```

```cpp
#include <hip/hip_runtime.h>
#include <hip/hip_cooperative_groups.h>
#include <cstdio>
#include <cstdint>
namespace cg = cooperative_groups;
#ifndef MK_SINGLE
#define MK_SINGLE 1
#endif
namespace pg8 {
#define PG8_LAS __attribute__((address_space(3)))
typedef unsigned short bf16_t;
typedef short bf16x8 __attribute__((ext_vector_type(8)));
typedef float f32x4 __attribute__((ext_vector_type(4)));
typedef unsigned u32x4 __attribute__((ext_vector_type(4)));
constexpr int BM = 256, BK = 64, HALF = 128, HTB = HALF * BK * 2  , STAGE_BYTES = 8 * HTB, NXCD = 8, WGM = 8;

__host__ __device__ __forceinline__ int lds_byte(int r, int c) { const int st = (r >> 4) * 2 + (c >> 5), rr = r & 15, cc = c & 31, ob = rr * 64 + cc * 2; return st * 1024 + (ob ^ (((ob >> 9) & 1) << 5)); }
__host__ __device__ __forceinline__ void stage_rc(int b, int& R, int& C) { const int st = b / 1024, sb = b % 1024, swz = sb ^ (((sb >> 9) & 1) << 5); R = (st >> 1) * 16 + swz / 64; C = (st & 1) * 32 + (swz % 64) / 2; }
__host__ __device__ __forceinline__ int perm32(int rho) { const int n = rho >> 4, i = rho & 15; return 8 * (i >> 2) + 4 * n + (i & 3); }

struct Unit { int pm, pn; };
struct Gemm { const bf16_t* A; const bf16_t* Bt; int M, N, K, ld; };

struct StaticOrder {
    int nM, nN, nwg, G, c;
    __host__ __device__ void init(int M, int N, int G_, int c_) { nM = M / BM; nN = N / BM; nwg = nM * nN; G = G_; c = c_; }
    __host__ __device__ bool next(int i, Unit& u) const {
        const long L = (long)i * G + c; if (L >= nwg) return false;
        int wgid = (int)L; { const int q = nwg / NXCD, r = nwg % NXCD, xcd = wgid % NXCD, off = wgid / NXCD; wgid = (xcd < r ? xcd * (q + 1) : r * (q + 1) + (xcd - r) * q) + off; }
        const int nig = WGM * nN, gid = wgid / nig, fm = gid * WGM, gsz = (nM - fm) < WGM ? (nM - fm) : WGM;
        u.pm = fm + ((wgid % nig) % gsz); u.pn = (wgid % nig) / gsz; return true;
    }
    __device__ __forceinline__ void a_ready(const Unit&) const {}
    __device__ __forceinline__ void done(const Unit&) const {}
};

__device__ __forceinline__ unsigned cvt_pk_bf16(float lo, float hi) { unsigned r; asm volatile("v_cvt_pk_bf16_f32 %0, %1, %2" : "=v"(r) : "v"(lo), "v"(hi)); return r; }
template <class Epi, class Sched, bool ALIGN_EPI = false, bool SP2 = false>
__device__ __forceinline__ void gemm_phase(PG8_LAS unsigned char* lds, const Gemm g, const Sched& S, const Epi& E) {
    int tid_l = threadIdx.x; asm volatile("" : "+v"(tid_l)); const int tid = tid_l, wid = __builtin_amdgcn_readfirstlane(tid >> 6), lane = tid & 63, wr = wid >> 2, wc = wid & 3, fr = lane & 15, fq = lane >> 4;
    const int K = g.ld, nt = g.K / BK;
    unsigned voffA[2], voffB[2];
#pragma unroll
    for (int i = 0; i < 2; ++i) { int R, C; stage_rc(tid * 16 + i * 8192, R, C); const int Rb = Epi::PERM ? ((R & ~31) + perm32(R & 31)) : R;
        voffA[i] = (unsigned)(R * K + C) * 2u; voffB[i] = (unsigned)(Rb * K + C) * 2u; }
    const size_t kstep = (size_t)(BK * 2);
    const size_t hstep = (size_t)HALF * K * 2;
    const size_t tstep = 2 * hstep;
    const unsigned ldsw = (unsigned)wid * 1024u;
    const int aoff = lds_byte(wr * 64 + fr, fq * 8), boff = lds_byte(wc * 32 + fr, fq * 8);
#define PG8_SA(b, h) (((b) * 2 + (h)) * HTB)
#define PG8_SB(b, h) ((4 + (b) * 2 + (h)) * HTB)
#define PG8_STAGE(bufoff, gbase, voff) do { _Pragma("unroll") for (int _i = 0; _i < 2; ++_i) \
        __builtin_amdgcn_global_load_lds((const unsigned*)((const char*)(gbase) + (voff)[_i]), (PG8_LAS unsigned*)(lds + (bufoff) + ldsw + _i * 8192), 16, 0, 0); } while (0)
#define PG8_LDA(dst, b, h) do { _Pragma("unroll") for (int m = 0; m < 4; ++m) _Pragma("unroll") for (int k = 0; k < 2; ++k) dst[m][k] = *(const PG8_LAS bf16x8*)(lds + PG8_SA(b, h) + aoff + m * 2048 + k * 1024); } while (0)
#define PG8_LDB(dst, b, h) do { _Pragma("unroll") for (int n = 0; n < 2; ++n) _Pragma("unroll") for (int k = 0; k < 2; ++k) dst[n][k] = *(const PG8_LAS bf16x8*)(lds + PG8_SB(b, h) + boff + n * 2048 + k * 1024); } while (0)
#define PG8_MMA(ai, bj, At, Bt) do { __builtin_amdgcn_s_setprio(1); _Pragma("unroll") for (int m = 0; m < 4; ++m) _Pragma("unroll") for (int n = 0; n < 2; ++n) _Pragma("unroll") for (int k = 0; k < 2; ++k) \
        acc[ai][bj][m][n] = __builtin_amdgcn_mfma_f32_16x16x32_bf16(Bt[n][k], At[m][k], acc[ai][bj][m][n], 0, 0, 0); __builtin_amdgcn_s_setprio(0); } while (0)
#define PG8_WAIT_V(n) asm volatile("s_waitcnt vmcnt(" #n ")" ::: "memory")
#define PG8_WAIT_L(n) asm volatile("s_waitcnt lgkmcnt(" #n ")" ::: "memory")
#define PG8_BAR __builtin_amdgcn_s_barrier()
#define PG8_SCHED __builtin_amdgcn_sched_barrier(0)
    Unit cur, nxt; int ui = 0;
    if (!S.next(0, cur)) return;
    f32x4 acc[2][2][4][2];
#pragma unroll
    for (int a = 0; a < 2; ++a)
#pragma unroll
        for (int b = 0; b < 2; ++b)
#pragma unroll
            for (int m = 0; m < 4; ++m)
#pragma unroll
                for (int n = 0; n < 2; ++n) acc[a][b][m][n] = (f32x4){0.f, 0.f, 0.f, 0.f};
    bf16x8 At[4][2], B0[2][2], B1[2][2];
    const char* cA = (const char*)g.A + (size_t)cur.pm * tstep; const char* cB = (const char*)g.Bt + (size_t)cur.pn * tstep;
    S.a_ready(cur);
    if constexpr (SP2) {
        PG8_STAGE(PG8_SB(0, 0), cB, voffB); PG8_STAGE(PG8_SB(0, 1), cB + hstep, voffB); PG8_STAGE(PG8_SA(0, 0), cA, voffA); PG8_STAGE(PG8_SA(0, 1), cA + hstep, voffA);
        if (wr == 1) PG8_BAR;
        PG8_WAIT_V(2); PG8_BAR;
        PG8_STAGE(PG8_SB(1, 0), cB + kstep, voffB); PG8_STAGE(PG8_SA(1, 0), cA + kstep, voffA); PG8_STAGE(PG8_SB(1, 1), cB + hstep + kstep, voffB);
        PG8_WAIT_V(6); PG8_BAR;
    } else {
        PG8_STAGE(PG8_SB(0, 0), cB, voffB); PG8_STAGE(PG8_SA(0, 0), cA, voffA); PG8_STAGE(PG8_SB(0, 1), cB + hstep, voffB); PG8_STAGE(PG8_SA(0, 1), cA + hstep, voffA);
        if (wr == 1) PG8_BAR;
        PG8_WAIT_V(4); PG8_BAR;
        PG8_STAGE(PG8_SB(1, 0), cB + kstep, voffB); PG8_STAGE(PG8_SA(1, 0), cA + kstep, voffA); PG8_STAGE(PG8_SB(1, 1), cB + hstep + kstep, voffB);
        PG8_WAIT_V(6); PG8_BAR;
    }
    for (;;) {
        const bool has_next = S.next(ui + 1, nxt);
        const char* nA = has_next ? (const char*)g.A + (size_t)nxt.pm * tstep : cA; const char* nB = has_next ? (const char*)g.Bt + (size_t)nxt.pn * tstep : cB;
        for (int t = 0; t < nt; t += 2) {
            const bool last = (t == nt - 2);
            const char* a1 = cA + (size_t)(t + 1) * kstep;
            const char* a2 = last ? nA : cA + (size_t)(t + 2) * kstep; const char* b2 = last ? nB : cB + (size_t)(t + 2) * kstep;
            const char* a3 = a2 + kstep; const char* b3 = b2 + kstep;
            if (last && has_next) S.a_ready(nxt);
            if constexpr (SP2) {
            PG8_LDB(B0, 0, 0); PG8_LDB(B1, 0, 1); PG8_SCHED; PG8_LDA(At, 0, 0); PG8_STAGE(PG8_SA(1, 1), a1 + hstep, voffA);
            PG8_WAIT_V(8); PG8_WAIT_L(0); PG8_BAR; PG8_MMA(0, 0, At, B0); PG8_MMA(0, 1, At, B1); PG8_BAR; PG8_SCHED;
            PG8_LDA(At, 0, 1); PG8_STAGE(PG8_SB(0, 0), b2, voffB); PG8_STAGE(PG8_SB(0, 1), b2 + hstep, voffB); PG8_STAGE(PG8_SA(0, 0), a2, voffA);
            PG8_WAIT_V(8); PG8_WAIT_L(0); PG8_BAR; PG8_MMA(1, 0, At, B0); PG8_MMA(1, 1, At, B1); PG8_BAR; PG8_SCHED;
            PG8_LDB(B0, 1, 0); PG8_LDB(B1, 1, 1); PG8_SCHED; PG8_LDA(At, 1, 0); PG8_STAGE(PG8_SA(0, 1), a2 + hstep, voffA);
            PG8_WAIT_V(8); PG8_WAIT_L(0); PG8_BAR; PG8_MMA(0, 0, At, B0); PG8_MMA(0, 1, At, B1); PG8_BAR; PG8_SCHED;
            PG8_LDA(At, 1, 1); PG8_STAGE(PG8_SB(1, 0), b3, voffB); PG8_STAGE(PG8_SB(1, 1), b3 + hstep, voffB); PG8_STAGE(PG8_SA(1, 0), a3, voffA);
            PG8_WAIT_V(8); PG8_WAIT_L(0); PG8_BAR; PG8_MMA(1, 0, At, B0); PG8_MMA(1, 1, At, B1); PG8_BAR; PG8_SCHED;
            } else {
            PG8_LDB(B0, 0, 0); PG8_SCHED; PG8_LDA(At, 0, 0); PG8_STAGE(PG8_SA(1, 1), a1 + hstep, voffA);
            PG8_WAIT_L(8); PG8_BAR; PG8_WAIT_L(0); PG8_MMA(0, 0, At, B0); PG8_BAR; PG8_SCHED;
            PG8_LDB(B1, 0, 1); PG8_STAGE(PG8_SB(0, 0), b2, voffB);
            PG8_BAR; PG8_WAIT_L(0); PG8_MMA(0, 1, At, B1); PG8_BAR;
            PG8_LDA(At, 0, 1); PG8_STAGE(PG8_SA(0, 0), a2, voffA);
            PG8_BAR; PG8_WAIT_L(0); PG8_MMA(1, 0, At, B0); PG8_BAR; PG8_SCHED;
            PG8_STAGE(PG8_SB(0, 1), b2 + hstep, voffB);
            PG8_WAIT_V(6); PG8_BAR; PG8_MMA(1, 1, At, B1); PG8_BAR;
            PG8_LDB(B0, 1, 0); PG8_SCHED; PG8_LDA(At, 1, 0); PG8_STAGE(PG8_SA(0, 1), a2 + hstep, voffA);
            PG8_WAIT_L(8); PG8_BAR; PG8_WAIT_L(0); PG8_MMA(0, 0, At, B0); PG8_BAR; PG8_SCHED;
            PG8_LDB(B1, 1, 1); PG8_STAGE(PG8_SB(1, 0), b3, voffB);
            PG8_BAR; PG8_WAIT_L(0); PG8_MMA(0, 1, At, B1); PG8_BAR;
            PG8_LDA(At, 1, 1); PG8_STAGE(PG8_SA(1, 0), a3, voffA);
            PG8_BAR; PG8_WAIT_L(0); PG8_MMA(1, 0, At, B0); PG8_BAR; PG8_SCHED;
            PG8_STAGE(PG8_SB(1, 1), b3 + hstep, voffB);
            PG8_WAIT_V(6); PG8_BAR; PG8_MMA(1, 1, At, B1); PG8_BAR;
            }
        }
        if constexpr (ALIGN_EPI) { if (wr == 0) PG8_BAR; }
        if constexpr (!Epi::AFTER_DRAIN) { E(acc, cur, wr, wc, fr, fq); S.done(cur); }
        if (!has_next) break;
#pragma unroll
        for (int a = 0; a < 2; ++a)
#pragma unroll
            for (int b = 0; b < 2; ++b)
#pragma unroll
                for (int m = 0; m < 4; ++m)
#pragma unroll
                    for (int n = 0; n < 2; ++n) acc[a][b][m][n] = (f32x4){0.f, 0.f, 0.f, 0.f};
        cur = nxt; cA = nA; cB = nB; ++ui;
        if constexpr (ALIGN_EPI) { if (wr == 1) PG8_BAR; }
    }
    PG8_WAIT_V(0);
    if constexpr (!ALIGN_EPI) { if (wr == 0) PG8_BAR; }
    PG8_BAR;
    if constexpr (Epi::AFTER_DRAIN) { E.fused(acc, cur, wr, wc, fr, fq, lds, wid, lane); S.done(cur); }
#undef PG8_SA
#undef PG8_SB
#undef PG8_STAGE
#undef PG8_LDA
#undef PG8_LDB
#undef PG8_MMA
#undef PG8_WAIT_V
#undef PG8_WAIT_L
#undef PG8_BAR
#undef PG8_SCHED
}
}

#define LAS __attribute__((address_space(3)))
typedef unsigned short bf16;
typedef float f32x4 __attribute__((ext_vector_type(4)));
typedef float f32x2 __attribute__((ext_vector_type(2)));
typedef unsigned u32x4 __attribute__((ext_vector_type(4)));
typedef unsigned u32x2 __attribute__((ext_vector_type(2)));
typedef short bf16x8_t __attribute__((ext_vector_type(8)));
constexpr int DM = 2048, NB = 4, TL = 2048, TC = 256, MLAT = NB * TL, MCTX = NB * TC, MALL = MLAT + MCTX;
constexpr int FF = 5632, NUP = 2 * FF, NIN = 6416, NINP_W = 6656, NMODV = 9 * DM;
constexpr int TSTEPS = TL + TC, NTILES = TSTEPS / 32;
constexpr float EPS = 1e-6f;
constexpr int NUF = 3584, NUG = 3072;
constexpr int U_SSD_XBC = 0, U_SSD_DT = 768, U_LRU_X = 784;
constexpr int U_HG_Q = 1296, U_HG_F = 1808;
constexpr int U_RT_Q = 2832, U_RT_K = 3088;
constexpr int G_SSD_Z = 0, G_LRU_G = 512, G_HG_G = 1024, G_RT_G = 1536, G_HG_I = 2048, G_RT_V = 2560;
constexpr int U_LRU_G = 0, U_HG_G = 0, U_RT_G = 0, U_HG_I = 0, U_RT_V = 0;
__host__ __device__ constexpr int u_newpos(int n) {
    return n < 512 ? NUF + G_SSD_Z + n : n < 1296 ? n - 512 : n < 1808 ? U_LRU_X + (n - 1296) : n < 2320 ? NUF + G_LRU_G + (n - 1808) : n < 3856 ? U_HG_Q + (n - 2320)
         : n < 4368 ? NUF + G_HG_I + (n - 3856) : n < 4880 ? NUF + G_HG_G + (n - 4368) : n < 5392 ? U_RT_Q + (n - 4880) : n < 5904 ? NUF + G_RT_V + (n - 5392)
         : n < 6416 ? NUF + G_RT_G + (n - 5904) : 3344 + (n - 6416); }
constexpr int NPHASES = 26;
constexpr int LDS_BYTES = 147456;
constexpr size_t MiB = 1u << 20;
constexpr size_t WS_MOD = 1 * MiB, WS_W13 = 2 * MiB, WS_W2 = 178 * MiB, WS_WIN = 266 * MiB, WS_WOUT = 318 * MiB, WS_X = 334 * MiB, WS_H = 406 * MiB,
                 WS_Y = 442 * MiB, WS_U = 514 * MiB, WS_XBC = 748 * MiB, WS_LA = 775 * MiB, WS_LB = 811 * MiB, WS_YD = 847 * MiB, WS_END = 991 * MiB, WS_UG = 682 * MiB;

struct Params {
    const float *x, *c, *ctx, *c_ctx, *w_mod, *b_mod, *norm_pre, *norm_post, *ffn_w1, *ffn_w3, *ffn_w2, *w_in, *w_out,
        *ssd_conv_w, *ssd_conv_b, *ssd_dt_bias, *ssd_a_log, *ssd_d, *ssd_norm_w, *lru_conv_w, *lru_conv_b, *lru_wa, *lru_ba, *lru_wx, *lru_bx, *lru_lambda,
        *hgrn_lb_logits, *hgrn_norm_w;
    float* out; unsigned char* ws; int ph_lo, ph_hi;
};

__device__ __forceinline__ float sigmoid_(float x) { return __builtin_amdgcn_rcpf(1.f + __expf(-x)); }
__device__ __forceinline__ float silu_(float x) { return x * sigmoid_(x); }
__device__ __forceinline__ float softplus_(float x) { return fmaxf(x, 0.f) + log1pf(__expf(-fabsf(x))); }
__device__ __forceinline__ float gelu_tanh_(float x) { const float z = 0.7978845608f * (x + 0.044715f * x * x * x); const float t = 1.f - 2.f * __builtin_amdgcn_rcpf(1.f + __expf(2.f * z)); return 0.5f * x * (1.f + t); }
__device__ __forceinline__ unsigned f2bf(float f) { unsigned u = __builtin_bit_cast(unsigned, f); return (u + 0x7fffu + ((u >> 16) & 1u)) >> 16; }
__device__ __forceinline__ unsigned pk2(float lo, float hi) { return f2bf(lo) | (f2bf(hi) << 16); }
__device__ __forceinline__ float wave_sum(float v) {
#pragma unroll
    for (int o = 1; o < 64; o <<= 1) v += __shfl_xor(v, o);
    return v;
}
__device__ __forceinline__ float half_sum(float v) {
#pragma unroll
    for (int o = 1; o < 32; o <<= 1) v += __shfl_xor(v, o);
    return v;
}
__device__ __forceinline__ float dot4(f32x4 a) { return (a.x * a.x + a.y * a.y) + (a.z * a.z + a.w * a.w); }
__device__ __forceinline__ f32x4 ld_bf4(const bf16* p) { const u32x2 w = *(const u32x2*)p; return (f32x4){__builtin_bit_cast(float, w.x << 16), __builtin_bit_cast(float, w.x & 0xffff0000u), __builtin_bit_cast(float, w.y << 16), __builtin_bit_cast(float, w.y & 0xffff0000u)}; }
#define LDS_WAIT() asm volatile("s_waitcnt lgkmcnt(0)" ::: "memory")
__device__ __forceinline__ int tid_() { int t = threadIdx.x; asm volatile("" : "+v"(t)); return t; }
__device__ __forceinline__ int bid_() { int t = blockIdx.x; asm volatile("" : "+s"(t)); return t; }
__device__ __forceinline__ int scan_row(int b, int d, int i) {
    if (i < TC) { const int t = d ? (TC - 1 - i) : i; return MLAT + b * TC + t; }
    int t = i - TC; if (d) t = TL - 1 - t; return b * TL + t;
}

#define XB_TMO      128
#define XB_XCNT(j)  (256  + 64 * (j))
#define XB_XSUB(j)  (1280 + 64 * (j))
#define XB_XGEN(j)  (2304 + 64 * (j))
#define XB_TOP      3328
#define XB_TOPGEN   3392
#define XCD_BAR_WORDS 3456
#define XB_SPIN_CAP (1u << 18)

__device__ __forceinline__ unsigned xb_ld(unsigned* p)              { return __hip_atomic_load(p, __ATOMIC_RELAXED, __HIP_MEMORY_SCOPE_AGENT); }
__device__ __forceinline__ unsigned xb_add(unsigned* p, unsigned v) { return __hip_atomic_fetch_add(p, v, __ATOMIC_RELAXED, __HIP_MEMORY_SCOPE_AGENT); }
__device__ __forceinline__ unsigned xb_xcc_id() { return (unsigned)__builtin_amdgcn_s_getreg((3 << 11) | 20) & 0xFu; }
#define XB_SPIN(cond, bar) do { unsigned _sp = 0; while (cond) { __builtin_amdgcn_s_sleep(1); \
    if ((++_sp & 255u) == 0u) { if (xb_ld(&(bar)[XB_TMO])) break; if (_sp > XB_SPIN_CAP) { atomicAdd(&(bar)[XB_TMO], 1u); break; } } } } while (0)

struct XcdBarrier {
    unsigned* bar; unsigned x;
    volatile LAS unsigned* st;
};

__device__ __forceinline__ XcdBarrier xcd_barrier_post(unsigned* bar, volatile LAS unsigned* st) {
    XcdBarrier b; b.bar = bar; b.x = xb_xcc_id(); b.st = st;
    if (threadIdx.x == 0) (void)xb_add(&bar[XB_XCNT(b.x)], 1u);
    return b;
}
__device__ __forceinline__ void xcd_barrier_complete(unsigned* bar, unsigned x, unsigned& nloc, unsigned& nx) {
    const unsigned G = gridDim.x * gridDim.y * gridDim.z;
    unsigned sum, cnt, mine, sp = 0u;
    for (;;) {
        sum = 0u; cnt = 0u; mine = 0u;
#pragma unroll
        for (unsigned j = 0; j < 16; ++j) { const unsigned c = xb_ld(&bar[XB_XCNT(j)]); sum += c; cnt += (c > 0u) ? 1u : 0u; mine = (j == x) ? c : mine; }
        if (sum == G) break;
        __builtin_amdgcn_s_sleep(1);
        if ((++sp & 255u) == 0u) { if (xb_ld(&bar[XB_TMO])) break; if (sp > XB_SPIN_CAP) { atomicAdd(&bar[XB_TMO], 1u); break; } }
    }
    nloc = mine > 0u ? mine : 1u; nx = cnt > 0u ? cnt : 1u;
}

__device__ __forceinline__ void xcd_barrier(const XcdBarrier& b) {
    asm volatile("s_waitcnt vmcnt(0)" ::: "memory");
    __syncthreads();
    if (threadIdx.x == 0) {
        unsigned* bar = b.bar;
        __builtin_amdgcn_s_waitcnt(0);
        unsigned nloc = b.st[0], nx = b.st[1];
        if (nloc == 0u) { xcd_barrier_complete(bar, b.x, nloc, nx); b.st[0] = nloc; b.st[1] = nx; }
        const unsigned old = xb_add(&bar[XB_XSUB(b.x)], 1u);
        const unsigned gen = old / nloc;
        if (old + 1u == (gen + 1u) * nloc) {
            __builtin_amdgcn_fence(__ATOMIC_RELEASE, "agent");
            asm volatile("s_waitcnt vmcnt(0)" ::: "memory");
            const unsigned og = xb_add(&bar[XB_TOP], 1u);
            const unsigned tg = og / nx;
            if (og + 1u == (tg + 1u) * nx) xb_add(&bar[XB_TOPGEN], 1u);
            else XB_SPIN(xb_ld(&bar[XB_TOPGEN]) == tg, bar);
            __builtin_amdgcn_fence(__ATOMIC_ACQUIRE, "agent");
            xb_add(&bar[XB_XGEN(b.x)], 1u);
            asm volatile("s_waitcnt vmcnt(0)" ::: "memory");
        } else {
            XB_SPIN(xb_ld(&bar[XB_XGEN(b.x)]) == gen, bar);
            __builtin_amdgcn_fence(__ATOMIC_ACQUIRE, "agent");
            asm volatile("s_waitcnt vmcnt(0)" ::: "memory");
        }
    }
    __syncthreads();
}

namespace pg8 {
struct EpiSwiGLU {
    static constexpr bool PERM = true, AFTER_DRAIN = false;
    bf16_t* O; int ldc;
    __device__ __forceinline__ void operator()(const f32x4 (&acc)[2][2][4][2], const Unit& u, int wr, int wc, int fr, int fq) const {
        const int row0 = u.pm * BM + wr * 64 + fr, col0 = u.pn * HALF + wc * 32 + 8 * fq;
#pragma unroll
        for (int ai = 0; ai < 2; ++ai)
#pragma unroll
            for (int m = 0; m < 4; ++m) {
                bf16_t* rowp = O + (size_t)(row0 + ai * HALF + m * 16) * ldc + col0;
                const f32x4 a0 = acc[ai][0][m][0], a1 = acc[ai][0][m][1], b0 = acc[ai][1][m][0], b1 = acc[ai][1][m][1];
                float r[8];
#pragma unroll
                for (int j = 0; j < 4; ++j) { r[j] = a0[j] * __builtin_amdgcn_rcpf(1.f + __expf(-a0[j])) * b0[j]; r[4 + j] = a1[j] * __builtin_amdgcn_rcpf(1.f + __expf(-a1[j])) * b1[j]; }
                u32x4 w; w.x = cvt_pk_bf16(r[0], r[1]); w.y = cvt_pk_bf16(r[2], r[3]); w.z = cvt_pk_bf16(r[4], r[5]); w.w = cvt_pk_bf16(r[6], r[7]);
                *(u32x4*)rowp = w;
                asm volatile("" ::: "memory");
            }
    }
};
struct EpiF32 {
    static constexpr bool PERM = false, AFTER_DRAIN = false;
    float* O; int ldc; int asbf; bf16_t* O2; int ldc2, split_pn;
    __device__ __forceinline__ void operator()(const f32x4 (&acc)[2][2][4][2], const Unit& u, int wr, int wc, int fr, int fq) const {
        const bool sec = split_pn > 0 && u.pn >= split_pn;
        const int row0 = u.pm * BM + wr * 64 + fr, col0 = (sec ? u.pn - split_pn : u.pn) * BM + wc * 32 + 4 * fq;
        if (asbf || sec) {
            bf16_t* Ob = sec ? O2 : (bf16_t*)O; const int ldc = sec ? ldc2 : this->ldc;
#pragma unroll
            for (int ai = 0; ai < 2; ++ai)
#pragma unroll
                for (int m = 0; m < 4; ++m) {
                    bf16_t* rowp = Ob + (size_t)(row0 + ai * HALF + m * 16) * ldc + col0;
#pragma unroll
                    for (int bj = 0; bj < 2; ++bj)
#pragma unroll
                        for (int n = 0; n < 2; ++n) { const f32x4 v = acc[ai][bj][m][n]; u32x2 w; w.x = cvt_pk_bf16(v[0], v[1]); w.y = cvt_pk_bf16(v[2], v[3]); *(u32x2*)(rowp + bj * HALF + n * 16) = w; }
                }
            return;
        }
#pragma unroll
        for (int ai = 0; ai < 2; ++ai)
#pragma unroll
            for (int m = 0; m < 4; ++m) {
                float* rowp = O + (size_t)(row0 + ai * HALF + m * 16) * ldc + col0;
#pragma unroll
                for (int bj = 0; bj < 2; ++bj)
#pragma unroll
                    for (int n = 0; n < 2; ++n) *(f32x4*)(rowp + bj * HALF + n * 16) = acc[ai][bj][m][n];
            }
    }
};
}


namespace pg8 {
struct Order2 {
    StaticOrder so; int one, valid; Unit u1;
    __device__ bool next(int i, Unit& u) const { if (one) { if (i > 0 || !valid) return false; u = u1; return true; } return so.next(i, u); }
    __device__ __forceinline__ void a_ready(const Unit&) const {}
    __device__ __forceinline__ void done(const Unit&) const {}
};
}
__device__ __forceinline__ void transpose_item64(const float* __restrict__ W, int K, int N, bf16* __restrict__ WT, int mode, float* scr, int item, int lane) {
    const int nblk = (N + 63) >> 6, kb = item / nblk, nb = item - kb * nblk, k0 = kb << 6, n0 = nb << 6;
    const int lr = lane >> 4, lc = (lane & 15) << 2;
    const bool ok = (n0 + lc) < N;
#pragma unroll
    for (int i = 0; i < 16; ++i) {
        const int kk = 4 * i + lr; f32x4 v = {0.f, 0.f, 0.f, 0.f};
        if (ok) v = __builtin_nontemporal_load((const f32x4*)(W + (size_t)(k0 + kk) * N + n0 + lc));
        float* s = scr + kk * 65 + lc; s[0] = v.x; s[1] = v.y; s[2] = v.z; s[3] = v.w;
    }
    LDS_WAIT();
    const int c = lane & 7;
#pragma unroll
    for (int j = 0; j < 8; ++j) {
        const int n = (lane >> 3) + 8 * j; const float* s = scr + (8 * c) * 65 + n;
        u32x4 o; o.x = pk2(s[0], s[65]); o.y = pk2(s[2 * 65], s[3 * 65]); o.z = pk2(s[4 * 65], s[5 * 65]); o.w = pk2(s[6 * 65], s[7 * 65]);
        const int dn = n0 + n; int row = dn; if (mode == 3) row = u_newpos(dn); else if (mode) row = ((dn >> 7) << 8) + (dn & 127) + (mode == 2 ? 128 : 0);
        *(u32x4*)(WT + (size_t)row * K + k0 + 8 * c) = o;
    }
    LDS_WAIT();
}

__device__ __forceinline__ void prologue_phase(const Params& P, float* L) {
    const int tid = tid_(), lane = tid & 63, wave = __builtin_amdgcn_readfirstlane(tid >> 6);
    unsigned char* ws = P.ws;
    float* MOD = (float*)(ws + WS_MOD);
    float* sc = L;
    float* red = L + 5 * DM;
    for (int i = tid; i < 5 * DM; i += 512) { const int r = i >> 11, k = i & (DM - 1); const float v = r < 4 ? P.c[r * DM + k] : P.c_ctx[k]; sc[i] = silu_(v); }
    __syncthreads();
    for (int it = bid_(); it < 1152; it += gridDim.x) {
        const int l = it / 576, j0 = (it % 576) * 32;
        const float* Wm = P.w_mod + (size_t)l * DM * NMODV;
        const int kr = lane >> 3, c4 = (lane & 7) << 2;
        f32x4 acc[5];
#pragma unroll
        for (int r = 0; r < 5; ++r) acc[r] = (f32x4){0.f, 0.f, 0.f, 0.f};
        const int kbase = wave * 256 + kr;
#pragma unroll 16
        for (int kk = 0; kk < 256; kk += 8) {
            const int k = kbase + kk; const f32x4 w = __builtin_nontemporal_load((const f32x4*)(Wm + (size_t)k * NMODV + j0 + c4));
#pragma unroll
            for (int r = 0; r < 5; ++r) acc[r] += w * sc[r * DM + k];
        }
#pragma unroll
        for (int r = 0; r < 5; ++r)
#pragma unroll
            for (int e = 0; e < 4; ++e) { float v = acc[r][e]; v += __shfl_xor(v, 8); v += __shfl_xor(v, 16); v += __shfl_xor(v, 32); acc[r][e] = v; }
        if (lane < 8) {
#pragma unroll
            for (int r = 0; r < 5; ++r) *(f32x4*)&red[(wave * 5 + r) * 32 + c4] = acc[r];
        }
        __syncthreads();
        if (tid < 160) { const int r = tid >> 5, j = tid & 31; float s_ = 0.f;
#pragma unroll
            for (int w = 0; w < 8; ++w) s_ += red[(w * 5 + r) * 32 + j];
            MOD[(size_t)(l * 5 + r) * NMODV + j0 + j] = s_ + P.b_mod[l * NMODV + j0 + j]; }
        __syncthreads();
    }
    bf16* W13 = (bf16*)(ws + WS_W13); bf16* W2 = (bf16*)(ws + WS_W2); bf16* WIN = (bf16*)(ws + WS_WIN); bf16* WOUT = (bf16*)(ws + WS_WOUT);
    float* scr = L + wave * (64 * 65);
    const int gw = bid_() * 8 + wave, NGW = gridDim.x * 8;
    constexpr int I_F = 2816, I_LF = 3 * I_F, I_FFN = 4 * I_LF, I_IN = 32 * 101, I_OUT = 32 * 32, I_ALL = I_FFN + 2 * I_IN + 2 * I_OUT;
    for (int it = gw; it < I_ALL; it += NGW) {
        int r = it;
        if (r < I_FFN) {
            const int lf = r / I_LF, q = r % I_LF, which = q / I_F, item = q % I_F;
            if (which == 0) transpose_item64(P.ffn_w1 + (size_t)lf * DM * FF, DM, FF, W13 + (size_t)lf * NUP * DM, 1, scr, item, lane);
            else if (which == 1) transpose_item64(P.ffn_w3 + (size_t)lf * DM * FF, DM, FF, W13 + (size_t)lf * NUP * DM, 2, scr, item, lane);
            else transpose_item64(P.ffn_w2 + (size_t)lf * FF * DM, FF, DM, W2 + (size_t)lf * DM * FF, 0, scr, item, lane);
        } else {
            r -= I_FFN;
            if (r < 2 * I_IN) { const int l = r / I_IN, item = r % I_IN; transpose_item64(P.w_in + (size_t)l * DM * NIN, DM, NIN, WIN + (size_t)l * NINP_W * DM, 3, scr, item, lane); }
            else { r -= 2 * I_IN; const int l = r / I_OUT, item = r % I_OUT; transpose_item64(P.w_out + (size_t)l * DM * DM, DM, DM, WOUT + (size_t)l * DM * DM, 0, scr, item, lane); }
        }
    }
}

__device__ __forceinline__ void rowwise_phase(const Params& P, int mrows, bool first, int l_post, int j_post, int gate_idx, float coef, bool final_, int l_pre, int j_pre, int shift_idx, int scale_idx) {
    const int tid = tid_(), lane = tid & 63, wave = __builtin_amdgcn_readfirstlane(tid >> 6);
    const int gw = bid_() * 8 + wave, NGW = gridDim.x * 8;
    const float* MOD = (const float*)(P.ws + WS_MOD);
    float* X = (float*)(P.ws + WS_X); const float* Y = (const float*)(P.ws + WS_Y); bf16* H = (bf16*)(P.ws + WS_H);
    for (int row = gw; row < mrows; row += NGW) {
        const int b = row < MLAT ? (row >> 11) : 4;
        f32x4 xv[8]; float ss_new = 0.f;
        if (first) {
            const float* src = row < MLAT ? P.x + (size_t)row * DM : P.ctx + (size_t)(row - MLAT) * DM;
#pragma unroll
            for (int j = 0; j < 8; ++j) xv[j] = *(const f32x4*)(src + 4 * lane + 256 * j);
        } else {
            const float* xr = (l_post == 0 && j_post == 0) ? (row < MLAT ? P.x + (size_t)row * DM : P.ctx + (size_t)(row - MLAT) * DM) : X + (size_t)row * DM;
            f32x4 yv[8]; float ss = 0.f;
            if (row < MLAT) {
                const bf16* yb = (const bf16*)Y + (size_t)row * DM;
#pragma unroll
                for (int j = 0; j < 8; ++j) { const u32x2 w = *(const u32x2*)(yb + 4 * lane + 256 * j);
                    yv[j] = (f32x4){__builtin_bit_cast(float, w.x << 16), __builtin_bit_cast(float, w.x & 0xffff0000u), __builtin_bit_cast(float, w.y << 16), __builtin_bit_cast(float, w.y & 0xffff0000u)}; }
            } else {
                const bf16* pr = (const bf16*)(P.ws + WS_YD) + (size_t)(row - MLAT) * DM;
#pragma unroll
                for (int j = 0; j < 8; ++j) yv[j] = ld_bf4(pr + 4 * lane + 256 * j);
                for (int ks = 1; ks < 8; ++ks) {
#pragma unroll
                    for (int j = 0; j < 8; ++j) yv[j] += ld_bf4(pr + (size_t)ks * MCTX * DM + 4 * lane + 256 * j);
                }
            }
            const float* gp = P.norm_post + (size_t)(l_post * 3 + j_post) * DM; const float* mg = MOD + (size_t)(l_post * 5 + b) * NMODV + gate_idx * DM;
            float sxx = 0.f, sxt = 0.f, stt = 0.f;
#pragma unroll
            for (int j = 0; j < 8; ++j) { const int c = 4 * lane + 256 * j; xv[j] = *(const f32x4*)(xr + c); const f32x4 g4 = *(const f32x4*)(gp + c), m4 = *(const f32x4*)(mg + c);
                ss += dot4(yv[j]); yv[j] = yv[j] * g4 * m4; sxx += dot4(xv[j]); stt += dot4(yv[j]);
                const f32x4 xt = xv[j] * yv[j]; sxt += (xt.x + xt.y) + (xt.z + xt.w); }
#pragma unroll
            for (int o = 1; o < 64; o <<= 1) { ss += __shfl_xor(ss, o); sxx += __shfl_xor(sxx, o); sxt += __shfl_xor(sxt, o); stt += __shfl_xor(stt, o); }
            const float rs = rsqrtf(ss * (1.f / DM) + EPS) * coef;
            ss_new = sxx + 2.f * rs * sxt + rs * rs * stt;
#pragma unroll
            for (int j = 0; j < 8; ++j) xv[j] += yv[j] * rs;
        }
        if (final_) {
            float* o = P.out + (size_t)row * DM;
#pragma unroll
            for (int j = 0; j < 8; ++j) *(f32x4*)(o + 4 * lane + 256 * j) = xv[j];
            continue;
        }
        {
            float* xr = X + (size_t)row * DM; float ss = 0.f;
#pragma unroll
            for (int j = 0; j < 8; ++j) { if (!first) *(f32x4*)(xr + 4 * lane + 256 * j) = xv[j]; else ss += dot4(xv[j]); }
            if (first) ss = wave_sum(ss); else ss = ss_new;
            const float rs = rsqrtf(ss * (1.f / DM) + EPS);
            const float* gp = P.norm_pre + (size_t)(l_pre * 3 + j_pre) * DM; const float* mb = MOD + (size_t)(l_pre * 5 + b) * NMODV;
            bf16* hr = H + (size_t)row * DM;
#pragma unroll
            for (int j = 0; j < 8; ++j) { const int c = 4 * lane + 256 * j; const f32x4 g4 = *(const f32x4*)(gp + c), sh = *(const f32x4*)(mb + shift_idx * DM + c), scl = *(const f32x4*)(mb + scale_idx * DM + c);
                const f32x4 h = (xv[j] * rs) * g4 * (scl + 1.f) + sh; u32x2 w; w.x = pk2(h.x, h.y); w.y = pk2(h.z, h.w); *(u32x2*)(hr + c) = w; }
        }
    }
}

__device__ __forceinline__ f32x4 conv4(const float* __restrict__ U, int row, int col, const float* __restrict__ cw, int C, const float* __restrict__ cb) {
    int t, len; if (row < MLAT) { t = row & (TL - 1); len = TL; } else { t = (row - MLAT) & (TC - 1); len = TC; }
    f32x4 acc = *(const f32x4*)cb;
#pragma unroll
    for (int j = 0; j < 4; ++j) { const int tt = t + j - 1; if (tt >= 0 && tt < len) { const f32x4 xx = *(const f32x4*)(U + (size_t)(row + j - 1) * NUF + col); const f32x4 w = *(const f32x4*)(cw + j * C); acc += xx * w; } }
    return acc;
}
__device__ __forceinline__ void prep_phase(const Params& P, float* L, int l) {
    const int tid = tid_();
    const float* U = (const float*)(P.ws + WS_U); bf16* XBC = (bf16*)(P.ws + WS_XBC); float* LA = (float*)(P.ws + WS_LA); bf16* LB = (bf16*)(P.ws + WS_LB);
    { const float* cw = P.ssd_conv_w + (size_t)l * 4 * 768; const float* cb = P.ssd_conv_b + (size_t)l * 768;
      for (int idx = bid_() * 512 + tid; idx < (MALL / 16) * 192; idx += gridDim.x * 512) {
          const int chunk = idx / 192, c4 = (idx - chunk * 192) << 2, row0 = chunk * 16;
          int t0, len; if (row0 < MLAT) { t0 = row0 & (TL - 1); len = TL; } else { t0 = (row0 - MLAT) & (TC - 1); len = TC; }
          const f32x4 w0 = *(const f32x4*)(cw + c4), w1 = *(const f32x4*)(cw + 768 + c4), w2 = *(const f32x4*)(cw + 2 * 768 + c4), w3 = *(const f32x4*)(cw + 3 * 768 + c4), bb = *(const f32x4*)(cb + c4);
          const float* up = U + (size_t)row0 * NUF + U_SSD_XBC + c4;
          const f32x4 z4 = {0.f, 0.f, 0.f, 0.f};
          f32x4 xm1 = (t0 > 0) ? *(const f32x4*)(up - NUF) : z4, x0 = *(const f32x4*)up, x1 = *(const f32x4*)(up + NUF);
#pragma unroll
          for (int r = 0; r < 16; ++r) {
              const f32x4 x2 = (t0 + r + 2 < len) ? *(const f32x4*)(up + (size_t)(r + 2) * NUF) : z4;
              f32x4 v = bb + xm1 * w0 + x0 * w1 + x1 * w2 + x2 * w3;
              v.x = silu_(v.x); v.y = silu_(v.y); v.z = silu_(v.z); v.w = silu_(v.w);
              { u32x2 w_; w_.x = pk2(v.x, v.y); w_.y = pk2(v.z, v.w); *(u32x2*)(XBC + (size_t)(row0 + r) * 768 + c4) = w_; }
              xm1 = x0; x0 = x1; x1 = x2;
          } } }
    unsigned short* WT = (unsigned short*)L;
    unsigned short* xb = WT + 4 * 64 * 72;
    float* xs = (float*)(xb + 64 * 72);
    const float* cw = P.lru_conv_w + (size_t)l * 4 * 512; const float* cb = P.lru_conv_b + (size_t)l * 512;
    const int lane = tid & 63, wave = __builtin_amdgcn_readfirstlane(tid >> 6), fr = lane & 15, fq = lane >> 4;
    int cur_h = -1;
    for (int it = bid_(); it < 144 * 8; it += gridDim.x) {
        const int h = it & 7, row0 = (it >> 3) * 64;
        __syncthreads();
        if (h != cur_h) {
            for (int i = tid; i < 4 * 4096; i += 512) { const int m = i >> 12, ii = (i >> 6) & 63, j = i & 63, d = m >> 1; const float* src = (m & 1) ? P.lru_wx : P.lru_wa;
                WT[(m * 64 + j) * 72 + ii] = (unsigned short)f2bf(src[((size_t)(l * 2 + d) * 8 + h) * 4096 + ii * 64 + j]); }
            cur_h = h;
        }
        for (int i = tid; i < 1024; i += 512) { const int r = i >> 4, c4 = (i & 15) << 2;
            const f32x4 v = conv4(U, row0 + r, U_LRU_X + h * 64 + c4, cw + h * 64 + c4, 512, cb + h * 64 + c4);
            *(f32x4*)&xs[r * 68 + c4] = v; u32x2 w; w.x = pk2(v.x, v.y); w.y = pk2(v.z, v.w); *(u32x2*)&xb[r * 72 + c4] = w; }
        __syncthreads();
        {
            const int tt = wave & 3, d = wave >> 2;
            f32x4 acc[2][4];
#pragma unroll
            for (int g2 = 0; g2 < 2; ++g2)
#pragma unroll
                for (int jt = 0; jt < 4; ++jt) acc[g2][jt] = (f32x4){0.f, 0.f, 0.f, 0.f};
#pragma unroll
            for (int ks = 0; ks < 2; ++ks) {
                const bf16x8_t a = *(const bf16x8_t*)&xb[(tt * 16 + fr) * 72 + ks * 32 + fq * 8];
#pragma unroll
                for (int g2 = 0; g2 < 2; ++g2)
#pragma unroll
                    for (int jt = 0; jt < 4; ++jt) { const bf16x8_t bq = *(const bf16x8_t*)&WT[((d * 2 + g2) * 64 + jt * 16 + fr) * 72 + ks * 32 + fq * 8];
                        acc[g2][jt] = __builtin_amdgcn_mfma_f32_16x16x32_bf16(a, bq, acc[g2][jt], 0, 0, 0); }
            }
#pragma unroll
            for (int jt = 0; jt < 4; ++jt) {
                const int j = jt * 16 + fr, c = h * 64 + j;
                const float ba1 = P.lru_ba[(size_t)(l * 2 + d) * 512 + c], bx1 = P.lru_bx[(size_t)(l * 2 + d) * 512 + c], sp = softplus_(-P.lru_lambda[(size_t)(l * 2 + d) * 512 + c]);
#pragma unroll
                for (int jj = 0; jj < 4; ++jj) {
                    const int t = tt * 16 + 4 * fq + jj, row = row0 + t;
                    const float rg = sigmoid_(acc[0][jt][jj] + ba1), ig = sigmoid_(acc[1][jt][jj] + bx1);
                    const float la = -8.f * rg * sp;
                    const float a_ = __expf(la); LA[((size_t)d * MALL + row) * 512 + c] = a_;
                    LB[((size_t)d * MALL + row) * 512 + c] = (bf16)f2bf(sqrtf(fmaxf(1.f - a_ * a_, 1e-12f)) * (ig * xs[t * 68 + j]));
                }
            }
        }
    }
}


#define MEMFENCE() asm volatile("" ::: "memory")
struct StepOps { f32x4 k0, k1, q0, q1; float v, a; };
__device__ __forceinline__ void ssd_core(const float* __restrict__ qs, const float* __restrict__ ks, const float* __restrict__ vs, const float* __restrict__ as, const float* __restrict__ la, const float* __restrict__ lb,
                                         float* __restrict__ lo, float* __restrict__ yp, f32x2& S0, f32x2& S1, f32x2& S2, f32x2& S3, float& hl, int tid, int p, int sl, float dsk, bool has_a) {
    StepOps c, n;
#define LD_OPS(o, s_) do { (o).k0 = *(const f32x4*)&ks[(s_) * 64 + sl * 8]; (o).k1 = *(const f32x4*)&ks[(s_) * 64 + sl * 8 + 4]; (o).q0 = *(const f32x4*)&qs[(s_) * 64 + sl * 8]; (o).q1 = *(const f32x4*)&qs[(s_) * 64 + sl * 8 + 4]; \
        (o).v = vs[(s_) * 64 + p]; (o).a = has_a ? as[(s_)] : dsk; } while (0)
#define DO_STEP(o, s_) do { const float a_ = has_a ? (o).a : dsk; const float v_ = (o).v; \
        S0 = S0 * a_ + (f32x2){(o).k0.x, (o).k0.y} * v_; S1 = S1 * a_ + (f32x2){(o).k0.z, (o).k0.w} * v_; S2 = S2 * a_ + (f32x2){(o).k1.x, (o).k1.y} * v_; S3 = S3 * a_ + (f32x2){(o).k1.z, (o).k1.w} * v_; \
        const f32x2 y2_ = ((f32x2){(o).q0.x, (o).q0.y} * S0 + (f32x2){(o).q0.z, (o).q0.w} * S1) + ((f32x2){(o).q1.x, (o).q1.y} * S2 + (f32x2){(o).q1.z, (o).q1.w} * S3); \
        float y_ = y2_.x + y2_.y; if (has_a && sl == 0) y_ += dsk * v_; yp[(s_) * 512 + tid] = y_; } while (0)
    LD_OPS(c, 0); MEMFENCE();
#pragma unroll 2
    for (int s = 0; s < 32; s += 2) {
        LD_OPS(n, s + 1); MEMFENCE();
        DO_STEP(c, s); MEMFENCE();
        if (s + 2 < 32) { LD_OPS(c, s + 2); } MEMFENCE();
        DO_STEP(n, s + 1); MEMFENCE();
    }
#undef LD_OPS
#undef DO_STEP
    if (has_a && tid < 64) {
#pragma unroll 8
        for (int s = 0; s < 32; ++s) { hl = la[s * 64 + tid] * hl + lb[s * 64 + tid]; lo[s * 64 + tid] = hl; }
    }
}
__device__ __forceinline__ void hgrn_core(const float* __restrict__ qs, const float* __restrict__ fs, const float* __restrict__ vs, float* __restrict__ yp, f32x2& S0, f32x2& S1, f32x2& S2, f32x2& S3, int tid, int p, int sl) {
    StepOps c, n;
#define LD_OPS(o, s_) do { (o).k0 = *(const f32x4*)&fs[(s_) * 128 + sl * 4]; (o).k1 = *(const f32x4*)&fs[(s_) * 128 + 64 + sl * 4]; (o).q0 = *(const f32x4*)&qs[(s_) * 128 + sl * 4]; (o).q1 = *(const f32x4*)&qs[(s_) * 128 + 64 + sl * 4]; \
        (o).v = vs[(s_) * 32 + p]; } while (0)
#define DO_STEP(o, s_) do { const f32x2 v2_ = {(o).v, (o).v}; \
        S0 = v2_ + (f32x2){(o).k0.x, (o).k0.y} * (S0 - v2_); S1 = v2_ + (f32x2){(o).k0.z, (o).k0.w} * (S1 - v2_); S2 = v2_ + (f32x2){(o).k1.x, (o).k1.y} * (S2 - v2_); S3 = v2_ + (f32x2){(o).k1.z, (o).k1.w} * (S3 - v2_); \
        const f32x2 y2_ = ((f32x2){(o).q0.x, (o).q0.y} * S0 + (f32x2){(o).q0.z, (o).q0.w} * S1) + ((f32x2){(o).q1.x, (o).q1.y} * S2 + (f32x2){(o).q1.z, (o).q1.w} * S3); \
        yp[(s_) * 512 + tid] = y2_.x + y2_.y; } while (0)
    LD_OPS(c, 0); MEMFENCE();
#pragma unroll 2
    for (int s = 0; s < 32; s += 2) {
        LD_OPS(n, s + 1); MEMFENCE();
        DO_STEP(c, s); MEMFENCE();
        if (s + 2 < 32) { LD_OPS(c, s + 2); } MEMFENCE();
        DO_STEP(n, s + 1); MEMFENCE();
    }
#undef LD_OPS
#undef DO_STEP
}
constexpr int L_YP = 12544;
__device__ __forceinline__ void scan_ssd(const Params& P, float* L, int l, int c) {
    const int tid = tid_(), b = c >> 4, d = (c >> 3) & 1, h = c & 7, g = h >> 2;
    const float* U = (const float*)(P.ws + WS_U); const float* XBC = (const float*)(P.ws + WS_XBC); const float* LA = (const float*)(P.ws + WS_LA); const float* LB = (const float*)(P.ws + WS_LB);
    bf16* YD = (bf16*)(P.ws + WS_YD);
    float* qs = L; float* ks = L + 2048; float* vs = L + 4096; float* as = L + 6144; float* la = L + 6400; float* lb = L + 8448; float* lo = L + 10496; float* yp = L + L_YP;
    const float dtb = P.ssd_dt_bias[(l * 2 + d) * 8 + h], aneg = -__expf(P.ssd_a_log[(l * 2 + d) * 8 + h]), dsk = (d == 0) ? P.ssd_d[l * 8 + h] : 0.f;
    const int st = tid >> 4, sc4 = (tid & 15) << 2, p = tid >> 3, sl = tid & 7;
    f32x2 S0 = {0.f, 0.f}, S1 = {0.f, 0.f}, S2 = {0.f, 0.f}, S3 = {0.f, 0.f}; float hl = 0.f;
    f32x4 rx, rB, rC, ra, rb; float rdt;
#define SSD_LOAD(tile) do { const int row_ = scan_row(b, d, (tile) * 32 + st); const float* xr_ = XBC + (size_t)row_ * 768; \
        rx = *(const f32x4*)(xr_ + h * 64 + sc4); rB = *(const f32x4*)(xr_ + 512 + g * 64 + sc4); rC = *(const f32x4*)(xr_ + 640 + g * 64 + sc4); \
        rdt = U[(size_t)row_ * NUF + U_SSD_DT + d * 8 + h]; \
        ra = *(const f32x4*)(LA + ((size_t)d * MALL + row_) * 512 + h * 64 + sc4); rb = *(const f32x4*)(LB + ((size_t)d * MALL + row_) * 512 + h * 64 + sc4); } while (0)
    __syncthreads();
    SSD_LOAD(0);
    for (int tile = 0; tile < NTILES; ++tile) {
        { const float delta = softplus_(rdt + dtb);
          *(f32x4*)&vs[st * 64 + sc4] = rx; *(f32x4*)&ks[st * 64 + sc4] = rB * delta; *(f32x4*)&qs[st * 64 + sc4] = rC;
          if ((tid & 15) == 0) as[st] = __expf(aneg * delta);
          *(f32x4*)&la[st * 64 + sc4] = ra; *(f32x4*)&lb[st * 64 + sc4] = rb; }
        __syncthreads();
        if (tile + 1 < NTILES) SSD_LOAD(tile + 1);
        ssd_core(qs, ks, vs, as, la, lb, lo, yp, S0, S1, S2, S3, hl, tid, p, sl, dsk, true);
        __syncthreads();
#pragma unroll
        for (int j = 0; j < 4; ++j) {
            const int idx = tid + 512 * j, t = idx >> 6, pp = idx & 63;
            const f32x4 a0 = *(const f32x4*)&yp[t * 512 + pp * 8], a1 = *(const f32x4*)&yp[t * 512 + pp * 8 + 4];
            const int row = scan_row(b, d, tile * 32 + t);
            YD[((size_t)(0 * 2 + d) * MALL + row) * 512 + h * 64 + pp] = ((a0.x + a0.y) + (a0.z + a0.w)) + ((a1.x + a1.y) + (a1.z + a1.w));
            YD[((size_t)(1 * 2 + d) * MALL + row) * 512 + h * 64 + pp] = lo[t * 64 + pp];
        }
    }
#undef SSD_LOAD
}
__device__ __forceinline__ void scan_ret(const Params& P, float* L, int c) {
    const int tid = tid_(), b = c >> 4, h = (c >> 2) & 3, d = (c >> 1) & 1, vh = c & 1;
    const float* U = (const float*)(P.ws + WS_U); bf16* YD = (bf16*)(P.ws + WS_YD);
    float* qs = L; float* ks = L + 2048; float* vs = L + 4096; float* rope = L + 6400; float* yp = L + L_YP;
    const float a = 1.f - exp2f(-5.f - (float)h);
    const int st = tid >> 4, rem = tid & 15, sc4 = rem << 2, isk = rem >> 3, hs = (rem >> 2) & 1, cc = rem & 3, p = tid >> 3, sl = tid & 7;
    __syncthreads();
    for (int i = tid; i < 1024; i += 512) { const int pos = i >> 4, fi = i & 15; const float inv = exp2f(-(float)fi * 0.83048202372184f); const float rev = ((float)pos * inv) * 0.15915494309189535f;
        rope[2 * i] = __builtin_amdgcn_cosf(rev); rope[2 * i + 1] = __builtin_amdgcn_sinf(rev); }
    f32x2 S0 = {0.f, 0.f}, S1 = {0.f, 0.f}, S2 = {0.f, 0.f}, S3 = {0.f, 0.f};
    f32x4 r1, r2, rv;
    const int qkbase = (isk ? U_RT_K : U_RT_Q) + h * 64 + hs * 32 + 4 * cc;
#define RET_LOAD(tile) do { const float* ur_ = U + (size_t)scan_row(b, d, (tile) * 32 + st) * NUF; r1 = *(const f32x4*)(ur_ + qkbase); r2 = *(const f32x4*)(ur_ + qkbase + 16); \
        rv = *(const f32x4*)(ur_ + U_RT_V + h * 128 + vh * 64 + sc4); } while (0)
    RET_LOAD(0);
    for (int tile = 0; tile < NTILES; ++tile) {
        { f32x4 o1 = r1, o2 = r2;
          if (tile >= TC / 32) {
              const int tok = scan_row(b, d, tile * 32 + st) & (TL - 1); const int pos = hs ? (tok & 63) : (tok >> 6);
              const f32x4 cs0 = *(const f32x4*)&rope[(pos * 16 + 4 * cc) * 2], cs1 = *(const f32x4*)&rope[(pos * 16 + 4 * cc) * 2 + 4];
              const f32x4 cv = {cs0.x, cs0.z, cs1.x, cs1.z}, sv = {cs0.y, cs0.w, cs1.y, cs1.w};
              o1 = r1 * cv - r2 * sv; o2 = r1 * sv + r2 * cv;
          }
          float* dst = isk ? ks : qs; const float scl = isk ? 0.125f : 1.f;
          *(f32x4*)&dst[st * 64 + hs * 32 + 4 * cc] = o1 * scl; *(f32x4*)&dst[st * 64 + hs * 32 + 16 + 4 * cc] = o2 * scl;
          *(f32x4*)&vs[st * 64 + sc4] = rv; }
        __syncthreads();
        if (tile + 1 < NTILES) RET_LOAD(tile + 1);
        { float hl_ = 0.f; ssd_core(qs, ks, vs, vs, vs, vs, yp, yp, S0, S1, S2, S3, hl_, tid, p, sl, a, false); }
        __syncthreads();
#pragma unroll
        for (int j = 0; j < 4; ++j) {
            const int idx = tid + 512 * j, t = idx >> 6, pp = idx & 63;
            const f32x4 a0 = *(const f32x4*)&yp[t * 512 + pp * 8], a1 = *(const f32x4*)&yp[t * 512 + pp * 8 + 4];
            const int row = scan_row(b, d, tile * 32 + t);
            YD[((size_t)(3 * 2 + d) * MALL + row) * 512 + h * 128 + vh * 64 + pp] = ((a0.x + a0.y) + (a0.z + a0.w)) + ((a1.x + a1.y) + (a1.z + a1.w));
        }
    }
#undef RET_LOAD
}
__device__ __forceinline__ void scan_hgrn(const Params& P, float* L, int l, int c) {
    const int tid = tid_(), b = c >> 5, h = (c >> 3) & 3, d = (c >> 2) & 1, vq = c & 3;
    const float* U = (const float*)(P.ws + WS_U); bf16* YD = (bf16*)(P.ws + WS_YD);
    float* qs = L; float* fs = L + 4096; float* vs = L + 8192; float* yp = L + L_YP;
    const int st = tid >> 5, sc4 = (tid & 31) << 2, p = tid >> 4, sl = tid & 15;
    f32x4 lbv = {0.f, 0.f, 0.f, 0.f};
    if (l == 1) { const f32x4 g0 = *(const f32x4*)(P.hgrn_lb_logits + (size_t)(d * 2 + 0) * 512 + h * 128 + sc4), g1 = *(const f32x4*)(P.hgrn_lb_logits + (size_t)(d * 2 + 1) * 512 + h * 128 + sc4);
        lbv.x = sigmoid_(g1.x - g0.x); lbv.y = sigmoid_(g1.y - g0.y); lbv.z = sigmoid_(g1.z - g0.z); lbv.w = sigmoid_(g1.w - g0.w); }
    f32x2 S0 = {0.f, 0.f}, S1 = {0.f, 0.f}, S2 = {0.f, 0.f}, S3 = {0.f, 0.f};
    f32x4 rq0, rq1, rf0, rf1, rv = {0.f, 0.f, 0.f, 0.f};
#define HG_LOAD(tile) do { const float* u0_ = U + (size_t)scan_row(b, d, (tile) * 32 + st) * NUF; const float* u1_ = U + (size_t)scan_row(b, d, (tile) * 32 + st + 16) * NUF; \
        rq0 = *(const f32x4*)(u0_ + U_HG_Q + h * 128 + sc4); rq1 = *(const f32x4*)(u1_ + U_HG_Q + h * 128 + sc4); \
        rf0 = *(const f32x4*)(u0_ + U_HG_F + d * 512 + h * 128 + sc4); rf1 = *(const f32x4*)(u1_ + U_HG_F + d * 512 + h * 128 + sc4); \
        if (tid < 256) rv = *(const f32x4*)(U + (size_t)scan_row(b, d, (tile) * 32 + (tid >> 3)) * NUF + U_HG_I + h * 128 + vq * 32 + ((tid & 7) << 2)); } while (0)
    __syncthreads();
    HG_LOAD(0);
    for (int tile = 0; tile < NTILES; ++tile) {
        { f32x4 q, f;
#pragma unroll
          for (int e = 0; e < 4; ++e) { q[e] = silu_(rq0[e]) * 0.08838834764831845f; f[e] = lbv[e] + (1.f - lbv[e]) * sigmoid_(rf0[e]); }
          *(f32x4*)&qs[st * 128 + sc4] = q; *(f32x4*)&fs[st * 128 + sc4] = f;
#pragma unroll
          for (int e = 0; e < 4; ++e) { q[e] = silu_(rq1[e]) * 0.08838834764831845f; f[e] = lbv[e] + (1.f - lbv[e]) * sigmoid_(rf1[e]); }
          *(f32x4*)&qs[(st + 16) * 128 + sc4] = q; *(f32x4*)&fs[(st + 16) * 128 + sc4] = f;
          if (tid < 256) *(f32x4*)&vs[(tid >> 3) * 32 + ((tid & 7) << 2)] = rv; }
        __syncthreads();
        if (tile + 1 < NTILES) HG_LOAD(tile + 1);
        hgrn_core(qs, fs, vs, yp, S0, S1, S2, S3, tid, p, sl);
        __syncthreads();
#pragma unroll
        for (int j = 0; j < 2; ++j) {
            const int idx = tid + 512 * j, t = idx >> 5, pp = idx & 31;
            const f32x4 a0 = *(const f32x4*)&yp[t * 512 + pp * 16], a1 = *(const f32x4*)&yp[t * 512 + pp * 16 + 4], a2 = *(const f32x4*)&yp[t * 512 + pp * 16 + 8], a3 = *(const f32x4*)&yp[t * 512 + pp * 16 + 12];
            const int row = scan_row(b, d, tile * 32 + t);
            YD[((size_t)(2 * 2 + d) * MALL + row) * 512 + h * 128 + vq * 32 + pp] =
                (((a0.x + a0.y) + (a0.z + a0.w)) + ((a1.x + a1.y) + (a1.z + a1.w))) + (((a2.x + a2.y) + (a2.z + a2.w)) + ((a3.x + a3.y) + (a3.z + a3.w)));
        }
    }
#undef HG_LOAD
}

typedef __bf16 bf16x2_n __attribute__((ext_vector_type(2)));
__device__ __forceinline__ unsigned cvtpk(float lo, float hi) { f32x2 v = {lo, hi}; bf16x2_n b = __builtin_convertvector(v, bf16x2_n); return __builtin_bit_cast(unsigned, b); }
template <int KD, int VN> struct ChunkLds {
    static constexpr int PQ = (KD + 8) * 2;
    static constexpr int PT = 80;
    static constexpr int KM = 0, QM = KM + 16 * PQ, QE = QM + 16 * PQ, KWT = QE + 16 * PQ, G = KWT + KD * PT, VT = G + KD * 4, SIZE = VT + VN * PT;
};
template <int KD, int VN>
__device__ __forceinline__ f32x4 chunk_step(const unsigned char* C, int v0, int fr, int fq, f32x4 (&S)[KD / 16]) {
    using CL = ChunkLds<KD, VN>;
    f32x4 mt = {0.f, 0.f, 0.f, 0.f}, mt1 = {0.f, 0.f, 0.f, 0.f};
#pragma unroll
    for (int ks = 0; ks < KD / 32; ks += 2) {
        const bf16x8_t a = *(const bf16x8_t*)(C + CL::KM + fr * CL::PQ + (32 * ks + 8 * fq) * 2);
        const bf16x8_t b = *(const bf16x8_t*)(C + CL::QM + fr * CL::PQ + (32 * ks + 8 * fq) * 2);
        mt = __builtin_amdgcn_mfma_f32_16x16x32_bf16(a, b, mt, 0, 0, 0);
        const bf16x8_t a1 = *(const bf16x8_t*)(C + CL::KM + fr * CL::PQ + (32 * ks + 32 + 8 * fq) * 2);
        const bf16x8_t b1 = *(const bf16x8_t*)(C + CL::QM + fr * CL::PQ + (32 * ks + 32 + 8 * fq) * 2);
        mt1 = __builtin_amdgcn_mfma_f32_16x16x32_bf16(a1, b1, mt1, 0, 0, 0);
    }
    mt += mt1;
#pragma unroll
    for (int j = 0; j < 4; ++j) if (4 * fq + j > fr) mt[j] = 0.f;
    u32x4 bw; bw.x = cvtpk(mt[0], mt[1]); bw.y = cvtpk(mt[2], mt[3]); bw.z = 0u; bw.w = 0u;
    const u32x2 va = *(const u32x2*)(C + CL::VT + (v0 + fr) * CL::PT + (4 * fq) * 2);
    u32x4 aw; aw.x = va.x; aw.y = va.y; aw.z = 0u; aw.w = 0u;
    f32x4 yi = __builtin_amdgcn_mfma_f32_16x16x32_bf16(__builtin_bit_cast(bf16x8_t, aw), __builtin_bit_cast(bf16x8_t, bw), (f32x4){0.f, 0.f, 0.f, 0.f}, 0, 0, 0);
    f32x4 y = {0.f, 0.f, 0.f, 0.f};
#pragma unroll
    for (int i = 0; i < KD / 32; ++i) {
        u32x4 sa; sa.x = cvtpk(S[2 * i][0], S[2 * i][1]); sa.y = cvtpk(S[2 * i][2], S[2 * i][3]); sa.z = cvtpk(S[2 * i + 1][0], S[2 * i + 1][1]); sa.w = cvtpk(S[2 * i + 1][2], S[2 * i + 1][3]);
        const u32x2 lo = *(const u32x2*)(C + CL::QE + fr * CL::PQ + (32 * i + 4 * fq) * 2), hi = *(const u32x2*)(C + CL::QE + fr * CL::PQ + (32 * i + 16 + 4 * fq) * 2);
        u32x4 qb; qb.x = lo.x; qb.y = lo.y; qb.z = hi.x; qb.w = hi.y;
        y = __builtin_amdgcn_mfma_f32_16x16x32_bf16(__builtin_bit_cast(bf16x8_t, sa), __builtin_bit_cast(bf16x8_t, qb), y, 0, 0, 0);
    }
    y += yi;
    const bf16x8_t bv = *(const bf16x8_t*)(C + CL::VT + (v0 + fr) * CL::PT + (8 * fq) * 2);
#pragma unroll
    for (int i = 0; i < KD / 16; ++i) {
        const f32x4 g4 = *(const f32x4*)(C + CL::G + (16 * i + 4 * fq) * 4);
        const bf16x8_t ak = *(const bf16x8_t*)(C + CL::KWT + (16 * i + fr) * CL::PT + (8 * fq) * 2);
        S[i] = __builtin_amdgcn_mfma_f32_16x16x32_bf16(ak, bv, S[i] * g4, 0, 0, 0);
    }
    return y;
}
template <int KD, int VN, bool LVEC>
__device__ __forceinline__ void build_operands(const float* __restrict__ rq, const float* __restrict__ rk, const float* __restrict__ rL, const float* __restrict__ rv, unsigned char* __restrict__ OP, int t0, int nthr) {
    using CL = ChunkLds<KD, VN>;
    for (int idx = t0; idx < 8 * KD; idx += nthr) {
        const int kq = idx % (KD / 4), t = (idx / (KD / 4)) & 15, c = idx / (4 * KD), k = 4 * kq, row = c * 16 + t;
        const f32x4 q4 = *(const f32x4*)&rq[row * KD + k], k4 = *(const f32x4*)&rk[row * KD + k];
        f32x4 Lt, Lm;
        if (LVEC) { Lt = *(const f32x4*)&rL[row * KD + k]; Lm = *(const f32x4*)&rL[(c * 16 + 7) * KD + k]; } else { const float a_ = rL[row], b_ = rL[c * 16 + 7]; Lt = (f32x4){a_, a_, a_, a_}; Lm = (f32x4){b_, b_, b_, b_}; }
        f32x4 qe, qm, km;
#pragma unroll
        for (int e = 0; e < 4; ++e) { qe[e] = q4[e] * __expf(Lt[e]); qm[e] = q4[e] * __expf(fminf(Lt[e] - Lm[e], 80.f)); km[e] = k4[e] * __expf(fminf(Lm[e] - Lt[e], 80.f)); }
        unsigned char* base = OP + c * CL::SIZE + t * CL::PQ + k * 2;
        u32x2 w; w.x = cvtpk(qe[0], qe[1]); w.y = cvtpk(qe[2], qe[3]); *(u32x2*)(base + CL::QE) = w;
        w.x = cvtpk(qm[0], qm[1]); w.y = cvtpk(qm[2], qm[3]); *(u32x2*)(base + CL::QM) = w;
        w.x = cvtpk(km[0], km[1]); w.y = cvtpk(km[2], km[3]); *(u32x2*)(base + CL::KM) = w;
    }
    for (int idx = t0; idx < 4 * KD; idx += nthr) {
        const int k = idx % KD, oc = (idx / KD) & 1, c = idx / (2 * KD);
        const float Le = LVEC ? rL[(c * 16 + 15) * KD + k] : rL[c * 16 + 15];
        float w[8];
#pragma unroll
        for (int e = 0; e < 8; ++e) { const int row = c * 16 + 8 * oc + e; const float Lt = LVEC ? rL[row * KD + k] : rL[row]; w[e] = rk[row * KD + k] * __expf(Le - Lt); }
        u32x4 o; o.x = cvtpk(w[0], w[1]); o.y = cvtpk(w[2], w[3]); o.z = cvtpk(w[4], w[5]); o.w = cvtpk(w[6], w[7]);
        *(u32x4*)(OP + c * CL::SIZE + CL::KWT + k * CL::PT + oc * 16) = o;
        if (oc == 0) *(float*)(OP + c * CL::SIZE + CL::G + k * 4) = __expf(Le);
    }
    for (int idx = t0; idx < 4 * VN; idx += nthr) {
        const int v = idx % VN, oc = (idx / VN) & 1, c = idx / (2 * VN);
        float w[8];
#pragma unroll
        for (int e = 0; e < 8; ++e) w[e] = rv[(c * 16 + 8 * oc + e) * VN + v];
        u32x4 o; o.x = cvtpk(w[0], w[1]); o.y = cvtpk(w[2], w[3]); o.z = cvtpk(w[4], w[5]); o.w = cvtpk(w[6], w[7]);
        *(u32x4*)(OP + c * CL::SIZE + CL::VT + v * CL::PT + oc * 16) = o;
    }
}
template <int KD, int VN>
__device__ __forceinline__ void zero_operand_pads(unsigned char* OP, int t0, int nthr) {
    using CL = ChunkLds<KD, VN>;
    for (int idx = t0; idx < 2 * (KD + VN) * 2; idx += nthr) {
        const int half = idx & 1, r = (idx >> 1) % (KD + VN), c = (idx >> 1) / (KD + VN);
        unsigned char* row = OP + c * CL::SIZE + (r < KD ? CL::KWT + r * CL::PT : CL::VT + (r - KD) * CL::PT);
        *(u32x4*)(row + 32 + half * 16) = (u32x4){0u, 0u, 0u, 0u};
    }
}
constexpr int L_RAW_Q = 0, L_RAW_K = 16384, L_RAW_L = 32768, L_RAW_V = 49152, L_OP = 65536;

__device__ __forceinline__ void scan_ret_mfma(const Params& P, unsigned char* LB, int c) {
    const int tid = tid_(), lane = tid & 63, wave = __builtin_amdgcn_readfirstlane(tid >> 6), fr = lane & 15, fq = lane >> 4;
    const int vh = c & 1, b = c >> 4, h = (c >> 2) & 3, d = (c >> 1) & 1;
    const float* U = (const float*)(P.ws + WS_U); bf16* YD = (bf16*)(P.ws + WS_YD);
    float* rq = (float*)(LB + L_RAW_Q); float* rk = (float*)(LB + L_RAW_K); float* rL = (float*)(LB + L_RAW_L); float* rv = (float*)(LB + L_RAW_V);
    float* rope = (float*)(LB + L_RAW_L + 1024);
    unsigned char* OP = LB + L_OP;
    const float la = __logf(1.f - exp2f(-5.f - (float)h));
    const int st = tid >> 4, rem = tid & 15, isk = rem >> 3, hs = (rem >> 2) & 1, cc = rem & 3;
    __syncthreads();
    for (int i = tid; i < 1024; i += 512) { const int pos = i >> 4, fi = i & 15; const float inv = exp2f(-(float)fi * 0.83048202372184f); const float rev = ((float)pos * inv) * 0.15915494309189535f;
        rope[2 * i] = __builtin_amdgcn_cosf(rev); rope[2 * i + 1] = __builtin_amdgcn_sinf(rev); }
    if (tid < 32) rL[tid] = (float)((tid & 15) + 1) * la;
    zero_operand_pads<64, 64>(OP, tid, 512);
    f32x4 S[4];
#pragma unroll
    for (int i = 0; i < 4; ++i) S[i] = (f32x4){0.f, 0.f, 0.f, 0.f};
    f32x4 r1, r2, rv0;
    const int qkbase = (isk ? U_RT_K : U_RT_Q) + h * 64 + hs * 32 + 4 * cc;
#define RETM_LOAD(tile) do { const float* ur_ = U + (size_t)scan_row(b, d, (tile) * 32 + st) * NUF; r1 = *(const f32x4*)(ur_ + qkbase); r2 = *(const f32x4*)(ur_ + qkbase + 16); \
        rv0 = ld_bf4((const bf16*)(P.ws + WS_UG) + (size_t)scan_row(b, d, (tile) * 32 + st) * NUG + G_RT_V + h * 128 + vh * 64 + rem * 4); } while (0)
    RETM_LOAD(0);
    for (int tile = 0; tile < NTILES; ++tile) {
        { f32x4 o1 = r1, o2 = r2;
          if (tile >= TC / 32) {
              const int tok = scan_row(b, d, tile * 32 + st) & (TL - 1); const int pos = hs ? (tok & 63) : (tok >> 6);
              const f32x4 cs0 = *(const f32x4*)&rope[(pos * 16 + 4 * cc) * 2], cs1 = *(const f32x4*)&rope[(pos * 16 + 4 * cc) * 2 + 4];
              const f32x4 cv = {cs0.x, cs0.z, cs1.x, cs1.z}, sv = {cs0.y, cs0.w, cs1.y, cs1.w};
              o1 = r1 * cv - r2 * sv; o2 = r1 * sv + r2 * cv;
          }
          float* dst = isk ? rk : rq; const float scl = isk ? 0.125f : 1.f;
          *(f32x4*)&dst[st * 64 + hs * 32 + 4 * cc] = o1 * scl; *(f32x4*)&dst[st * 64 + hs * 32 + 16 + 4 * cc] = o2 * scl;
          *(f32x4*)&rv[st * 64 + rem * 4] = rv0; }
        __syncthreads();
        if (tile + 1 < NTILES) RETM_LOAD(tile + 1);
        build_operands<64, 64, false>(rq, rk, rL, rv, OP, tid, 512);
        __syncthreads();
        if (wave < 4) {
#pragma unroll
        for (int ch = 0; ch < 2; ++ch) {
            const f32x4 y = chunk_step<64, 64>(OP + ch * ChunkLds<64, 64>::SIZE, wave * 16, fr, fq, S);
            const int row = scan_row(b, d, tile * 32 + ch * 16 + fr);
            { u32x2 w_; w_.x = cvtpk(y[0], y[1]); w_.y = cvtpk(y[2], y[3]); *(u32x2*)(YD + ((size_t)(3 * 2 + d) * MALL + row) * 512 + h * 128 + vh * 64 + wave * 16 + 4 * fq) = w_; }
        }
        }
    }
#undef RETM_LOAD
}

__device__ __forceinline__ void scan_hgrn_mfma(const Params& P, unsigned char* LB, int l, int c) {
    using CL = ChunkLds<128, 64>;
    const int tid = tid_(), lane = tid & 63, wave = __builtin_amdgcn_readfirstlane(tid >> 6), fr = lane & 15, fq = lane >> 4;
    const int vq = c & 1, b = c >> 4, h = (c >> 2) & 3, d = (c >> 1) & 1;
    const float* U = (const float*)(P.ws + WS_U); bf16* YD = (bf16*)(P.ws + WS_YD);
    unsigned char* OP = LB;
    float* tot = (float*)(LB + 58368);
    const int k = 2 * lane, qt = wave & 3, cb = wave >> 2;
    const int vv_ = tid & 63, vqt = wave & 3, vc = wave >> 2;
    f32x2 lb2 = {0.f, 0.f};
    if (l == 1) { const f32x2 g0 = *(const f32x2*)(P.hgrn_lb_logits + (size_t)(d * 2 + 0) * 512 + h * 128 + k), g1 = *(const f32x2*)(P.hgrn_lb_logits + (size_t)(d * 2 + 1) * 512 + h * 128 + k);
        lb2.x = sigmoid_(g1.x - g0.x); lb2.y = sigmoid_(g1.y - g0.y); }
    __syncthreads();
    zero_operand_pads<128, 64>(OP, tid, 512);
    f32x4 S[8];
#pragma unroll
    for (int i = 0; i < 8; ++i) S[i] = (f32x4){0.f, 0.f, 0.f, 0.f};
    f32x2 pq[4], pf[4]; float pv[4] = {0.f, 0.f, 0.f, 0.f};
#define HGM_LOAD(tile) do { _Pragma("unroll") for (int r_ = 0; r_ < 4; ++r_) { const float* u_ = U + (size_t)scan_row(b, d, (tile) * 32 + cb * 16 + qt * 4 + r_) * NUF; \
        pq[r_] = *(const f32x2*)(u_ + U_HG_Q + h * 128 + k); pf[r_] = *(const f32x2*)(u_ + U_HG_F + d * 512 + h * 128 + k); } \
        { _Pragma("unroll") for (int r_ = 0; r_ < 4; ++r_) pv[r_] = __builtin_bit_cast(float, (unsigned)((const bf16*)(P.ws + WS_UG))[(size_t)scan_row(b, d, (tile) * 32 + vc * 16 + vqt * 4 + r_) * NUG + G_HG_I + h * 128 + vq * 64 + vv_] << 16); } } while (0)
    HGM_LOAD(0);
    for (int tile = 0; tile < NTILES; ++tile) {
        f32x2 q[4], kk[4], pre[4], suf[4]; float vv[4];
        { f32x2 fc[4];
#pragma unroll
          for (int r = 0; r < 4; ++r) {
              const float eq0 = 1.f + __expf(fminf(-pq[r].x, 40.f)), ef0 = 1.f + __expf(fminf(-pf[r].x, 40.f)), r0_ = __builtin_amdgcn_rcpf(eq0 * ef0);
              const float eq1 = 1.f + __expf(fminf(-pq[r].y, 40.f)), ef1 = 1.f + __expf(fminf(-pf[r].y, 40.f)), r1_ = __builtin_amdgcn_rcpf(eq1 * ef1);
              q[r].x = pq[r].x * (ef0 * r0_) * 0.08838834764831845f; q[r].y = pq[r].y * (ef1 * r1_) * 0.08838834764831845f;
              const float f0 = lb2.x + (1.f - lb2.x) * (eq0 * r0_), f1 = lb2.y + (1.f - lb2.y) * (eq1 * r1_);
              kk[r].x = 1.f - f0; kk[r].y = 1.f - f1; fc[r].x = fmaxf(f0, 1e-4f); fc[r].y = fmaxf(f1, 1e-4f); vv[r] = pv[r];
          }
          pre[0] = fc[0]; pre[1] = pre[0] * fc[1]; pre[2] = pre[1] * fc[2]; pre[3] = pre[2] * fc[3];
          suf[3] = (f32x2){1.f, 1.f}; suf[2] = fc[3]; suf[1] = suf[2] * fc[2]; suf[0] = suf[1] * fc[1]; }
        *(f32x2*)&tot[(cb * 4 + qt) * 128 + k] = pre[3];
        __syncthreads();
        if (tile + 1 < NTILES) HGM_LOAD(tile + 1);
        {
            const f32x2 t0 = *(const f32x2*)&tot[(cb * 4 + 0) * 128 + k], t1 = *(const f32x2*)&tot[(cb * 4 + 1) * 128 + k], t2 = *(const f32x2*)&tot[(cb * 4 + 2) * 128 + k], t3 = *(const f32x2*)&tot[(cb * 4 + 3) * 128 + k];
            const f32x2 Pm = t0 * t1, T23 = t2 * t3;
            unsigned char* C = OP + cb * CL::SIZE;
            float kw0[4], kw1[4];
#pragma unroll
            for (int r = 0; r < 4; ++r) {
                const int t = qt * 4 + r;
                f32x2 R, iR;
                if (qt >= 2) { R = pre[r]; if (qt == 3) R *= t2; iR.x = __builtin_amdgcn_rcpf(R.x); iR.y = __builtin_amdgcn_rcpf(R.y); }
                else { iR = suf[r]; if (qt == 0) iR *= t1; R.x = __builtin_amdgcn_rcpf(iR.x); R.y = __builtin_amdgcn_rcpf(iR.y); }
                const f32x2 Pt = Pm * R;
                unsigned char* p = C + t * CL::PQ + k * 2;
                *(unsigned*)(p + CL::QE) = cvtpk(q[r].x * Pt.x, q[r].y * Pt.y);
                *(unsigned*)(p + CL::QM) = cvtpk(q[r].x * R.x, q[r].y * R.y);
                *(unsigned*)(p + CL::KM) = cvtpk(kk[r].x * iR.x, kk[r].y * iR.y);
                kw0[r] = kk[r].x * T23.x * iR.x; kw1[r] = kk[r].y * T23.y * iR.y;
            }
            u32x2 w; w.x = cvtpk(kw0[0], kw0[1]); w.y = cvtpk(kw0[2], kw0[3]); *(u32x2*)(C + CL::KWT + k * CL::PT + qt * 8) = w;
            w.x = cvtpk(kw1[0], kw1[1]); w.y = cvtpk(kw1[2], kw1[3]); *(u32x2*)(C + CL::KWT + (k + 1) * CL::PT + qt * 8) = w;
            if (qt == 0) *(f32x2*)(C + CL::G + k * 4) = Pm * T23;
            { u32x2 wv; wv.x = cvtpk(vv[0], vv[1]); wv.y = cvtpk(vv[2], vv[3]); *(u32x2*)(OP + vc * CL::SIZE + CL::VT + vv_ * CL::PT + vqt * 8) = wv; }
        }
        __syncthreads();
        if (wave < 4) {
#pragma unroll
            for (int ch = 0; ch < 2; ++ch) {
                const f32x4 y = chunk_step<128, 64>(OP + ch * CL::SIZE, wave * 16, fr, fq, S);
                const int row = scan_row(b, d, tile * 32 + ch * 16 + fr);
                { u32x2 w_; w_.x = cvtpk(y[0], y[1]); w_.y = cvtpk(y[2], y[3]); *(u32x2*)(YD + ((size_t)(2 * 2 + d) * MALL + row) * 512 + h * 128 + vq * 64 + wave * 16 + 4 * fq) = w_; }
            }
        }
    }
#undef HGM_LOAD
}
__device__ __forceinline__ void scan_ssd_mfma(const Params& P, unsigned char* LB, int l, int c) {
    const int tid = tid_(), lane = tid & 63, wave = __builtin_amdgcn_readfirstlane(tid >> 6), fr = lane & 15, fq = lane >> 4;
    const int b = c >> 4, d = (c >> 3) & 1, h = c & 7, g = h >> 2;
    const float* U = (const float*)(P.ws + WS_U); const bf16* XBC = (const bf16*)(P.ws + WS_XBC); bf16* YD = (bf16*)(P.ws + WS_YD);
    float* rq = (float*)(LB + L_RAW_Q); float* rk = (float*)(LB + L_RAW_K); float* rL = (float*)(LB + L_RAW_L); float* lg = (float*)(LB + L_RAW_L + 256); float* rv = (float*)(LB + L_RAW_V);
    unsigned char* OP = LB + L_OP;
    const float dtb = P.ssd_dt_bias[(l * 2 + d) * 8 + h], aneg = -__expf(P.ssd_a_log[(l * 2 + d) * 8 + h]);
    const int st = tid >> 4, sc4 = (tid & 15) << 2;
    __syncthreads();
    zero_operand_pads<64, 64>(OP, tid, 512);
    f32x4 S[4];
#pragma unroll
    for (int i = 0; i < 4; ++i) S[i] = (f32x4){0.f, 0.f, 0.f, 0.f};
    f32x4 px, pB, pC; float pdt;
#define SSM_LOAD(tile) do { const int row_ = scan_row(b, d, (tile) * 32 + st); const bf16* xr_ = XBC + (size_t)row_ * 768; \
        px = ld_bf4(xr_ + h * 64 + sc4); pB = ld_bf4(xr_ + 512 + g * 64 + sc4); pC = ld_bf4(xr_ + 640 + g * 64 + sc4); pdt = U[(size_t)row_ * NUF + U_SSD_DT + d * 8 + h]; } while (0)
    SSM_LOAD(0);
    for (int tile = 0; tile < NTILES; ++tile) {
        { const float delta = softplus_(pdt + dtb); const int o = st * 64 + sc4;
          *(f32x4*)&rv[o] = px; *(f32x4*)&rk[o] = pB * delta; *(f32x4*)&rq[o] = pC;
          if ((tid & 15) == 0) lg[st] = aneg * delta; }
        __syncthreads();
        if (tile + 1 < NTILES) SSM_LOAD(tile + 1);
        if (tid < 32) { const int c0 = tid & 16; float acc = 0.f;
#pragma unroll
            for (int t = 0; t < 16; ++t) { const float v_ = lg[c0 + t]; acc += (c0 + t <= tid) ? v_ : 0.f; }
            rL[tid] = acc; }
        __syncthreads();
        build_operands<64, 64, false>(rq, rk, rL, rv, OP, tid, 512);
        __syncthreads();
        if (wave < 4) {
#pragma unroll
            for (int ch = 0; ch < 2; ++ch) {
                const f32x4 y = chunk_step<64, 64>(OP + ch * ChunkLds<64, 64>::SIZE, wave * 16, fr, fq, S);
                const int row = scan_row(b, d, tile * 32 + ch * 16 + fr);
                { u32x2 w_; w_.x = cvtpk(y[0], y[1]); w_.y = cvtpk(y[2], y[3]); *(u32x2*)(YD + ((size_t)(0 * 2 + d) * MALL + row) * 512 + h * 64 + wave * 16 + 4 * fq) = w_; }
            }
        }
    }
#undef SSM_LOAD
}
__device__ __forceinline__ void scan_lru(const Params& P, float* L, int c) {
    const int tid = tid_(), ch = tid & 63, seg = __builtin_amdgcn_readfirstlane(tid >> 6), b = c >> 3, d = (c >> 2) & 1, cgp = c & 3;
    const float* LA = (const float*)(P.ws + WS_LA) + (size_t)d * MALL * 512 + cgp * 128 + ch; const bf16* LBp = (const bf16*)(P.ws + WS_LB) + (size_t)d * MALL * 512 + cgp * 128 + ch;
    bf16* YD = (bf16*)(P.ws + WS_YD) + (size_t)(1 * 2 + d) * MALL * 512 + cgp * 128 + ch;
    float* car = L;
    const int s0 = seg * 288;
    __syncthreads();
    float h0 = 0.f, h1 = 0.f, ap0 = 1.f, ap1 = 1.f;
#pragma unroll 1
    for (int pass = 0; pass < 2; ++pass) {
        float a0[16], b0[16], c0[16], d0[16];
#pragma unroll
        for (int s = 0; s < 16; ++s) { const size_t r = (size_t)scan_row(b, d, s0 + s) * 512; a0[s] = LA[r]; b0[s] = __builtin_bit_cast(float, (unsigned)LBp[r] << 16); c0[s] = LA[r + 64]; d0[s] = __builtin_bit_cast(float, (unsigned)LBp[r + 64] << 16); }
#pragma unroll 1
        for (int tile = 0; tile < 18; ++tile) {
            float a1[16], b1[16], c1[16], d1[16];
            if (tile + 1 < 18) {
#pragma unroll
                for (int s = 0; s < 16; ++s) { const size_t r = (size_t)scan_row(b, d, s0 + (tile + 1) * 16 + s) * 512; a1[s] = LA[r]; b1[s] = __builtin_bit_cast(float, (unsigned)LBp[r] << 16); c1[s] = LA[r + 64]; d1[s] = __builtin_bit_cast(float, (unsigned)LBp[r + 64] << 16); }
            }
            if (pass == 0) {
#pragma unroll
                for (int s = 0; s < 16; ++s) { h0 = a0[s] * h0 + b0[s]; ap0 *= a0[s]; h1 = c0[s] * h1 + d0[s]; ap1 *= c0[s]; }
            } else {
#pragma unroll
                for (int s = 0; s < 16; ++s) { h0 = a0[s] * h0 + b0[s]; h1 = c0[s] * h1 + d0[s]; const size_t r = (size_t)scan_row(b, d, s0 + tile * 16 + s) * 512; YD[r] = (bf16)f2bf(h0); YD[r + 64] = (bf16)f2bf(h1); }
            }
#pragma unroll
            for (int s = 0; s < 16; ++s) { a0[s] = a1[s]; b0[s] = b1[s]; c0[s] = c1[s]; d0[s] = d1[s]; }
        }
        if (pass == 0) {
            car[(seg * 128 + ch) * 2] = ap0; car[(seg * 128 + ch) * 2 + 1] = h0; car[(seg * 128 + 64 + ch) * 2] = ap1; car[(seg * 128 + 64 + ch) * 2 + 1] = h1;
            __syncthreads();
            float hin0 = 0.f, hin1 = 0.f;
            for (int sg = 0; sg < seg; ++sg) { hin0 = car[(sg * 128 + ch) * 2] * hin0 + car[(sg * 128 + ch) * 2 + 1]; hin1 = car[(sg * 128 + 64 + ch) * 2] * hin1 + car[(sg * 128 + 64 + ch) * 2 + 1]; }
            h0 = hin0; h1 = hin1;
        }
    }
}
__device__ __forceinline__ void scan_phase(const Params& P, float* L, int l) {
    for (int it = bid_(); it < 224; it += gridDim.x) {
        if (it < 64) scan_hgrn_mfma(P, (unsigned char*)L, l, it);
        else if (it < 128) scan_ssd_mfma(P, (unsigned char*)L, l, it - 64);
        else if (it < 192) scan_ret_mfma(P, (unsigned char*)L, it - 128);
        else scan_lru(P, L, it - 192);
    }
}

__device__ __forceinline__ void post_phase(const Params& P, int l, int mrows) {
    const int tid = tid_(), lane = tid & 63, wave = __builtin_amdgcn_readfirstlane(tid >> 6);
    const int gw = bid_() * 8 + wave, NGW = gridDim.x * 8;
    const float* U = (const float*)(P.ws + WS_U); const bf16* YD = (const bf16*)(P.ws + WS_YD); bf16* YC = (bf16*)(P.ws + WS_H);
    for (int row = gw; row < mrows; row += NGW) {
        const bf16* ug = (const bf16*)(P.ws + WS_UG) + (size_t)row * NUG; bf16* yc = YC + (size_t)row * DM;
#define YDP(m, d) (YD + ((size_t)((m) * 2 + (d)) * MALL + row) * 512)
#define LDY(p) ld_bf4(p)
        {
            f32x4 gg[2]; float ss = 0.f;
#pragma unroll
            for (int j = 0; j < 2; ++j) { const int c = 4 * lane + 256 * j; const float dsk = P.ssd_d[l * 8 + (c >> 6)]; const f32x4 y = LDY(YDP(0, 0) + c) + LDY(YDP(0, 1) + c) + ld_bf4((const bf16*)(P.ws + WS_XBC) + (size_t)row * 768 + c) * dsk; const f32x4 z = ld_bf4(ug + G_SSD_Z + c);
                f32x4 t; t.x = y.x * silu_(z.x); t.y = y.y * silu_(z.y); t.z = y.z * silu_(z.z); t.w = y.w * silu_(z.w); gg[j] = t; ss += dot4(t); }
            const float rs = rsqrtf(wave_sum(ss) * (1.f / 512.f) + EPS);
#pragma unroll
            for (int j = 0; j < 2; ++j) { const int c = 4 * lane + 256 * j; const f32x4 w = *(const f32x4*)(P.ssd_norm_w + (size_t)l * 512 + c); const f32x4 o = gg[j] * rs * w;
                u32x2 pk; pk.x = pk2(o.x, o.y); pk.y = pk2(o.z, o.w); *(u32x2*)(yc + c) = pk; }
        }
        {
#pragma unroll
            for (int j = 0; j < 2; ++j) { const int c = 4 * lane + 256 * j; const f32x4 hh = LDY(YDP(1, 0) + c) + LDY(YDP(1, 1) + c); const f32x4 gb = ld_bf4(ug + G_LRU_G + c);
                f32x4 o; o.x = hh.x * gelu_tanh_(gb.x); o.y = hh.y * gelu_tanh_(gb.y); o.z = hh.z * gelu_tanh_(gb.z); o.w = hh.w * gelu_tanh_(gb.w);
                u32x2 pk; pk.x = pk2(o.x, o.y); pk.y = pk2(o.z, o.w); *(u32x2*)(yc + 512 + c) = pk; }
        }
        {
#pragma unroll
            for (int j = 0; j < 2; ++j) { const int c = 4 * lane + 256 * j; const f32x4 o = LDY(YDP(2, 0) + c) + LDY(YDP(2, 1) + c);
                const float rs = rsqrtf(half_sum(dot4(o)) * (1.f / 128.f) + EPS); const f32x4 w = *(const f32x4*)(P.hgrn_norm_w + (size_t)l * 128 + (c & 127)); const f32x4 gt = ld_bf4(ug + G_HG_G + c);
                f32x4 r; r.x = o.x * rs * w.x * silu_(gt.x); r.y = o.y * rs * w.y * silu_(gt.y); r.z = o.z * rs * w.z * silu_(gt.z); r.w = o.w * rs * w.w * silu_(gt.w);
                u32x2 pk; pk.x = pk2(r.x, r.y); pk.y = pk2(r.z, r.w); *(u32x2*)(yc + 1024 + c) = pk; }
        }
        {
#pragma unroll
            for (int j = 0; j < 2; ++j) { const int c = 4 * lane + 256 * j; const f32x4 o = LDY(YDP(3, 0) + c) + LDY(YDP(3, 1) + c);
                const float rs = rsqrtf(half_sum(dot4(o)) * (1.f / 128.f) + EPS); const f32x4 gt = ld_bf4(ug + G_RT_G + c);
                f32x4 r; r.x = o.x * rs * silu_(gt.x); r.y = o.y * rs * silu_(gt.y); r.z = o.z * rs * silu_(gt.z); r.w = o.w * rs * silu_(gt.w);
                u32x2 pk; pk.x = pk2(r.x, r.y); pk.y = pk2(r.z, r.w); *(u32x2*)(yc + 1536 + c) = pk; }
        }
#undef YDP
    }
}

__global__ void __launch_bounds__(512, 2) mk_fwd(Params Pkarg) {
    extern __shared__ __attribute__((aligned(16))) unsigned char lds_raw[];
    float* L = (float*)lds_raw;
    const __attribute__((address_space(4))) Params* kp = (const __attribute__((address_space(4))) Params*)__builtin_amdgcn_kernarg_segment_ptr();
    const int ph_lo = kp->ph_lo, ph_hi = kp->ph_hi;
    {
        volatile LAS unsigned* st0 = (volatile LAS unsigned*)((LAS unsigned char*)lds_raw + (LDS_BYTES - 128));
        if (threadIdx.x == 0) { st0[0] = 0u; st0[1] = 0u; }
        __syncthreads();
        (void)xcd_barrier_post((unsigned*)kp->ws, st0);
    }
    for (int ph = ph_lo; ph < ph_hi; ++ph) {
        asm volatile("" : "+s"(kp));
#if defined(__HIP_DEVICE_COMPILE__)
        const Params P = *kp;
#else
        const Params P = Pkarg;
#endif
        unsigned char* ws = P.ws;
#ifdef PROBE_DUP
        const int kk_ = ph < 2 ? 100 + ph : (ph - 2) % 12;
        const int nrep_ = (kk_ == PROBE_DUP || kk_ == PROBE_DUP2) ? 2 : 1;
        for (int rep_ = 0; rep_ < nrep_; ++rep_) { if (rep_) cg::this_grid().sync();
#endif
        if (ph == 0) prologue_phase(P, L);
        else if (ph == 1) rowwise_phase(P, MALL, true, 0, 0, 0, 0.f, false, 0, 0, 0, 1);
        else {
            const int q = ph - 2, l = q / 12, k = q % 12;
            const int Mg = (l == 1 && k >= 6) ? MLAT : MALL;
            if (k == 0 || k == 9) {
                const int lf = l * 2 + (k == 9);
                pg8::Gemm g{(const pg8::bf16_t*)(ws + WS_H), (const pg8::bf16_t*)(ws + WS_W13) + (size_t)lf * NUP * DM, Mg, NUP, DM, DM};
                pg8::StaticOrder S; S.init(Mg, NUP, (int)gridDim.x, bid_());
                pg8::EpiSwiGLU E{(pg8::bf16_t*)(ws + WS_U), FF};
                pg8::gemm_phase<pg8::EpiSwiGLU, pg8::StaticOrder, true, true>((LAS unsigned char*)lds_raw, g, S, E);
            } else if (k == 1 || k == 10 || k == 3 || k == 7) {
                const pg8::bf16_t* A; const pg8::bf16_t* Bt; int N, K; float* O;
                if (k == 3) { A = (const pg8::bf16_t*)(ws + WS_H); Bt = (const pg8::bf16_t*)(ws + WS_WIN) + (size_t)l * NINP_W * DM; N = NINP_W; K = DM; O = (float*)(ws + WS_U); }
                else if (k == 7) { A = (const pg8::bf16_t*)(ws + WS_H); Bt = (const pg8::bf16_t*)(ws + WS_WOUT) + (size_t)l * DM * DM; N = DM; K = DM; O = (float*)(ws + WS_Y); }
                else { const int lf = l * 2 + (k == 10); A = (const pg8::bf16_t*)(ws + WS_U); Bt = (const pg8::bf16_t*)(ws + WS_W2) + (size_t)lf * DM * FF; N = DM; K = FF; O = (float*)(ws + WS_Y); }
                const bool splitk = (k != 3) && (Mg == MALL);
                const int M1 = splitk ? MLAT : Mg;
                { pg8::Gemm g{A, Bt, M1, N, K, K};
                  pg8::Order2 S; S.so.init(M1, N, (int)gridDim.x, bid_()); S.one = 0; S.valid = 1; S.u1.pm = 0; S.u1.pn = 0;
                  pg8::EpiF32 E{O, (k == 3) ? NUF : N, (k != 3) ? 1 : 0, (pg8::bf16_t*)(ws + WS_UG), NUG, (k == 3) ? NUF / 256 : 0};
                  pg8::gemm_phase<pg8::EpiF32, pg8::Order2, true, true>((LAS unsigned char*)lds_raw, g, S, E); }
                if (splitk) {
                    for (int c = bid_(); c < 256; c += (int)gridDim.x) {
                        const int u = c >> 3, ks = c & 7, nt2 = K >> 7;
                        const int kt0 = 2 * ((ks * nt2) >> 3), kt1 = 2 * (((ks + 1) * nt2) >> 3);
                        pg8::Gemm g{A + kt0 * 64, Bt + kt0 * 64, MALL, N, (kt1 - kt0) * 64, K};
                        pg8::Order2 S; S.so.init(MALL, N, 1, 0); S.one = 1; S.valid = 1; S.u1.pm = 32 + (u >> 3); S.u1.pn = u & 7;
                        pg8::EpiF32 E{(float*)((bf16*)(ws + WS_YD) + (size_t)ks * MCTX * DM - (size_t)MLAT * DM), N, 1, nullptr, 0, 0};
                        pg8::gemm_phase<pg8::EpiF32, pg8::Order2, true, true>((LAS unsigned char*)lds_raw, g, S, E);
                    }
                }
            } else if (k == 2) rowwise_phase(P, MALL, false, l, 0, 2, 0.5f, false, l, 1, 3, 4);
            else if (k == 8) rowwise_phase(P, Mg, false, l, 1, 5, 1.0f, false, l, 2, 6, 7);
            else if (k == 11) rowwise_phase(P, Mg, false, l, 2, 8, 0.5f, l == 1, l + 1, 0, 0, 1);
            else if (k == 4) prep_phase(P, L, l);
            else if (k == 5) scan_phase(P, L, l);
            else post_phase(P, l, Mg);
        }
#ifdef PROBE_DUP
        }
#endif
        if (ph + 1 < ph_hi) {
            if (ph == 0) cg::this_grid().sync();
            else { XcdBarrier xb; xb.bar = (unsigned*)ws; xb.x = xb_xcc_id(); xb.st = (volatile LAS unsigned*)((LAS unsigned char*)lds_raw + (LDS_BYTES - 128)); xcd_barrier(xb); }
        }
    }
}

extern "C" void kernel_launch(void* const* d_in, const int* in_sizes, int n_in, void* d_out, int out_size, void* d_ws, size_t ws_size, hipStream_t stream) {
    static int grid = 0;
    if (grid == 0) {
        if (n_in != 28 || out_size != MLAT * DM || ws_size < WS_END) { fprintf(stderr, "kernel_launch: unexpected shapes (n_in %d out %d ws %zu need %zu)\n", n_in, out_size, ws_size, (size_t)WS_END); grid = -1; return; }
        int dev = 0, cus = 0, per_cu = 0;
        (void)hipGetDevice(&dev); (void)hipDeviceGetAttribute(&cus, hipDeviceAttributeMultiprocessorCount, dev);
        if (hipFuncSetAttribute((const void*)mk_fwd, hipFuncAttributeMaxDynamicSharedMemorySize, LDS_BYTES) != hipSuccess) { fprintf(stderr, "kernel_launch: hipFuncSetAttribute failed\n"); grid = -1; return; }
        if (hipOccupancyMaxActiveBlocksPerMultiprocessor(&per_cu, (const void*)mk_fwd, 512, LDS_BYTES) != hipSuccess || per_cu < 1) { fprintf(stderr, "kernel_launch: occupancy query says %d\n", per_cu); per_cu = 1; }
        (void)hipGetLastError();
        grid = cus * per_cu;
    }
    if (grid < 0) return;
    (void)hipMemsetAsync(d_ws, 0, 16384, stream);
    Params p{};
    const float** pp = (const float**)&p;
    for (int i = 0; i < 28; ++i) pp[i] = (const float*)d_in[i];
    p.out = (float*)d_out; p.ws = (unsigned char*)d_ws;
#if MK_SINGLE
    p.ph_lo = 0; p.ph_hi = NPHASES;
    void* args[] = {&p};
    hipError_t e = hipLaunchCooperativeKernel((const void*)mk_fwd, dim3(grid), dim3(512), args, LDS_BYTES, stream);
    if (e != hipSuccess) fprintf(stderr, "cooperative launch failed: %s (grid %d)\n", hipGetErrorString(e), grid);
#else
    for (int ph = 0; ph < NPHASES; ++ph) { p.ph_lo = ph; p.ph_hi = ph + 1; hipLaunchKernelGGL(mk_fwd, dim3(grid), dim3(512), LDS_BYTES, stream, p); }
#endif
}
```

```cpp
#include <hip/hip_runtime.h>
#include <hip/hip_cooperative_groups.h>
#include <cstdio>
#include <cstdint>
namespace cg = cooperative_groups;
#ifndef MK_SINGLE
#define MK_SINGLE 1
#endif
namespace pg8 {
#define PG8_LAS __attribute__((address_space(3)))
typedef unsigned short bf16_t;
typedef short bf16x8 __attribute__((ext_vector_type(8)));
typedef float f32x4 __attribute__((ext_vector_type(4)));
typedef unsigned u32x4 __attribute__((ext_vector_type(4)));
constexpr int BM = 256, BK = 64, HALF = 128, HTB = HALF * BK * 2  , STAGE_BYTES = 8 * HTB, NXCD = 8, WGM = 8;

__host__ __device__ __forceinline__ int lds_byte(int r, int c) { const int st = (r >> 4) * 2 + (c >> 5), rr = r & 15, cc = c & 31, ob = rr * 64 + cc * 2; return st * 1024 + (ob ^ (((ob >> 9) & 1) << 5)); }
__host__ __device__ __forceinline__ void stage_rc(int b, int& R, int& C) { const int st = b / 1024, sb = b % 1024, swz = sb ^ (((sb >> 9) & 1) << 5); R = (st >> 1) * 16 + swz / 64; C = (st & 1) * 32 + (swz % 64) / 2; }
__host__ __device__ __forceinline__ int perm32(int rho) { const int n = rho >> 4, i = rho & 15; return 8 * (i >> 2) + 4 * n + (i & 3); }

struct Unit { int pm, pn; };
struct Gemm { const bf16_t* A; const bf16_t* Bt; int M, N, K, ld; };

struct StaticOrder {
    int nM, nN, nwg, G, c;
    __host__ __device__ void init(int M, int N, int G_, int c_) { nM = M / BM; nN = N / BM; nwg = nM * nN; G = G_; c = c_; }
    __host__ __device__ bool next(int i, Unit& u) const {
        const long L = (long)i * G + c; if (L >= nwg) return false;
        int wgid = (int)L; { const int q = nwg / NXCD, r = nwg % NXCD, xcd = wgid % NXCD, off = wgid / NXCD; wgid = (xcd < r ? xcd * (q + 1) : r * (q + 1) + (xcd - r) * q) + off; }
        const int nig = WGM * nN, gid = wgid / nig, fm = gid * WGM, gsz = (nM - fm) < WGM ? (nM - fm) : WGM;
        u.pm = fm + ((wgid % nig) % gsz); u.pn = (wgid % nig) / gsz; return true;
    }
    __device__ __forceinline__ void a_ready(const Unit&) const {}
    __device__ __forceinline__ void done(const Unit&) const {}
};

__device__ __forceinline__ unsigned cvt_pk_bf16(float lo, float hi) { unsigned r; asm volatile("v_cvt_pk_bf16_f32 %0, %1, %2" : "=v"(r) : "v"(lo), "v"(hi)); return r; }
template <class Epi, class Sched, bool ALIGN_EPI = false, bool SP2 = false>
__device__ __forceinline__ void gemm_phase(PG8_LAS unsigned char* lds, const Gemm g, const Sched& S, const Epi& E) {
    int tid_l = threadIdx.x; asm volatile("" : "+v"(tid_l)); const int tid = tid_l, wid = __builtin_amdgcn_readfirstlane(tid >> 6), lane = tid & 63, wr = wid >> 2, wc = wid & 3, fr = lane & 15, fq = lane >> 4;
    const int K = g.ld, nt = g.K / BK;
    unsigned voffA[2], voffB[2];
#pragma unroll
    for (int i = 0; i < 2; ++i) { int R, C; stage_rc(tid * 16 + i * 8192, R, C); const int Rb = Epi::PERM ? ((R & ~31) + perm32(R & 31)) : R;
        voffA[i] = (unsigned)(R * K + C) * 2u; voffB[i] = (unsigned)(Rb * K + C) * 2u; }
    const size_t kstep = (size_t)(BK * 2);
    const size_t hstep = (size_t)HALF * K * 2;
    const size_t tstep = 2 * hstep;
    const unsigned ldsw = (unsigned)wid * 1024u;
    const int aoff = lds_byte(wr * 64 + fr, fq * 8), boff = lds_byte(wc * 32 + fr, fq * 8);
#define PG8_SA(b, h) (((b) * 2 + (h)) * HTB)
#define PG8_SB(b, h) ((4 + (b) * 2 + (h)) * HTB)
#define PG8_STAGE(bufoff, gbase, voff) do { _Pragma("unroll") for (int _i = 0; _i < 2; ++_i) \
        __builtin_amdgcn_global_load_lds((const unsigned*)((const char*)(gbase) + (voff)[_i]), (PG8_LAS unsigned*)(lds + (bufoff) + ldsw + _i * 8192), 16, 0, 0); } while (0)
#define PG8_LDA(dst, b, h) do { _Pragma("unroll") for (int m = 0; m < 4; ++m) _Pragma("unroll") for (int k = 0; k < 2; ++k) dst[m][k] = *(const PG8_LAS bf16x8*)(lds + PG8_SA(b, h) + aoff + m * 2048 + k * 1024); } while (0)
#define PG8_LDB(dst, b, h) do { _Pragma("unroll") for (int n = 0; n < 2; ++n) _Pragma("unroll") for (int k = 0; k < 2; ++k) dst[n][k] = *(const PG8_LAS bf16x8*)(lds + PG8_SB(b, h) + boff + n * 2048 + k * 1024); } while (0)
#define PG8_MMA(ai, bj, At, Bt) do { __builtin_amdgcn_s_setprio(1); _Pragma("unroll") for (int m = 0; m < 4; ++m) _Pragma("unroll") for (int n = 0; n < 2; ++n) _Pragma("unroll") for (int k = 0; k < 2; ++k) \
        acc[ai][bj][m][n] = __builtin_amdgcn_mfma_f32_16x16x32_bf16(Bt[n][k], At[m][k], acc[ai][bj][m][n], 0, 0, 0); __builtin_amdgcn_s_setprio(0); } while (0)
#define PG8_WAIT_V(n) asm volatile("s_waitcnt vmcnt(" #n ")" ::: "memory")
#define PG8_WAIT_L(n) asm volatile("s_waitcnt lgkmcnt(" #n ")" ::: "memory")
#define PG8_BAR __builtin_amdgcn_s_barrier()
#define PG8_SCHED __builtin_amdgcn_sched_barrier(0)
    Unit cur, nxt; int ui = 0;
    if (!S.next(0, cur)) return;
    f32x4 acc[2][2][4][2];
#pragma unroll
    for (int a = 0; a < 2; ++a)
#pragma unroll
        for (int b = 0; b < 2; ++b)
#pragma unroll
            for (int m = 0; m < 4; ++m)
#pragma unroll
                for (int n = 0; n < 2; ++n) acc[a][b][m][n] = (f32x4){0.f, 0.f, 0.f, 0.f};
    bf16x8 At[4][2], B0[2][2], B1[2][2];
    const char* cA = (const char*)g.A + (size_t)cur.pm * tstep; const char* cB = (const char*)g.Bt + (size_t)cur.pn * tstep;
    S.a_ready(cur);
    if constexpr (SP2) {
        PG8_STAGE(PG8_SB(0, 0), cB, voffB); PG8_STAGE(PG8_SB(0, 1), cB + hstep, voffB); PG8_STAGE(PG8_SA(0, 0), cA, voffA); PG8_STAGE(PG8_SA(0, 1), cA + hstep, voffA);
        if (wr == 1) PG8_BAR;
        PG8_WAIT_V(2); PG8_BAR;
        PG8_STAGE(PG8_SB(1, 0), cB + kstep, voffB); PG8_STAGE(PG8_SA(1, 0), cA + kstep, voffA); PG8_STAGE(PG8_SB(1, 1), cB + hstep + kstep, voffB);
        PG8_WAIT_V(6); PG8_BAR;
    } else {
        PG8_STAGE(PG8_SB(0, 0), cB, voffB); PG8_STAGE(PG8_SA(0, 0), cA, voffA); PG8_STAGE(PG8_SB(0, 1), cB + hstep, voffB); PG8_STAGE(PG8_SA(0, 1), cA + hstep, voffA);
        if (wr == 1) PG8_BAR;
        PG8_WAIT_V(4); PG8_BAR;
        PG8_STAGE(PG8_SB(1, 0), cB + kstep, voffB); PG8_STAGE(PG8_SA(1, 0), cA + kstep, voffA); PG8_STAGE(PG8_SB(1, 1), cB + hstep + kstep, voffB);
        PG8_WAIT_V(6); PG8_BAR;
    }
    for (;;) {
        const bool has_next = S.next(ui + 1, nxt);
        const char* nA = has_next ? (const char*)g.A + (size_t)nxt.pm * tstep : cA; const char* nB = has_next ? (const char*)g.Bt + (size_t)nxt.pn * tstep : cB;
        for (int t = 0; t < nt; t += 2) {
            const bool last = (t == nt - 2);
            const char* a1 = cA + (size_t)(t + 1) * kstep;
            const char* a2 = last ? nA : cA + (size_t)(t + 2) * kstep; const char* b2 = last ? nB : cB + (size_t)(t + 2) * kstep;
            const char* a3 = a2 + kstep; const char* b3 = b2 + kstep;
            if (last && has_next) S.a_ready(nxt);
            if constexpr (SP2) {
            PG8_LDB(B0, 0, 0); PG8_LDB(B1, 0, 1); PG8_SCHED; PG8_LDA(At, 0, 0); PG8_STAGE(PG8_SA(1, 1), a1 + hstep, voffA);
            PG8_WAIT_V(8); PG8_WAIT_L(0); PG8_BAR; PG8_MMA(0, 0, At, B0); PG8_MMA(0, 1, At, B1); PG8_BAR; PG8_SCHED;
            PG8_LDA(At, 0, 1); PG8_STAGE(PG8_SB(0, 0), b2, voffB); PG8_STAGE(PG8_SB(0, 1), b2 + hstep, voffB); PG8_STAGE(PG8_SA(0, 0), a2, voffA);
            PG8_WAIT_V(8); PG8_WAIT_L(0); PG8_BAR; PG8_MMA(1, 0, At, B0); PG8_MMA(1, 1, At, B1); PG8_BAR; PG8_SCHED;
            PG8_LDB(B0, 1, 0); PG8_LDB(B1, 1, 1); PG8_SCHED; PG8_LDA(At, 1, 0); PG8_STAGE(PG8_SA(0, 1), a2 + hstep, voffA);
            PG8_WAIT_V(8); PG8_WAIT_L(0); PG8_BAR; PG8_MMA(0, 0, At, B0); PG8_MMA(0, 1, At, B1); PG8_BAR; PG8_SCHED;
            PG8_LDA(At, 1, 1); PG8_STAGE(PG8_SB(1, 0), b3, voffB); PG8_STAGE(PG8_SB(1, 1), b3 + hstep, voffB); PG8_STAGE(PG8_SA(1, 0), a3, voffA);
            PG8_WAIT_V(8); PG8_WAIT_L(0); PG8_BAR; PG8_MMA(1, 0, At, B0); PG8_MMA(1, 1, At, B1); PG8_BAR; PG8_SCHED;
            } else {
            PG8_LDB(B0, 0, 0); PG8_SCHED; PG8_LDA(At, 0, 0); PG8_STAGE(PG8_SA(1, 1), a1 + hstep, voffA);
            PG8_WAIT_L(8); PG8_BAR; PG8_WAIT_L(0); PG8_MMA(0, 0, At, B0); PG8_BAR; PG8_SCHED;
            PG8_LDB(B1, 0, 1); PG8_STAGE(PG8_SB(0, 0), b2, voffB);
            PG8_BAR; PG8_WAIT_L(0); PG8_MMA(0, 1, At, B1); PG8_BAR;
            PG8_LDA(At, 0, 1); PG8_STAGE(PG8_SA(0, 0), a2, voffA);
            PG8_BAR; PG8_WAIT_L(0); PG8_MMA(1, 0, At, B0); PG8_BAR; PG8_SCHED;
            PG8_STAGE(PG8_SB(0, 1), b2 + hstep, voffB);
            PG8_WAIT_V(6); PG8_BAR; PG8_MMA(1, 1, At, B1); PG8_BAR;
            PG8_LDB(B0, 1, 0); PG8_SCHED; PG8_LDA(At, 1, 0); PG8_STAGE(PG8_SA(0, 1), a2 + hstep, voffA);
            PG8_WAIT_L(8); PG8_BAR; PG8_WAIT_L(0); PG8_MMA(0, 0, At, B0); PG8_BAR; PG8_SCHED;
            PG8_LDB(B1, 1, 1); PG8_STAGE(PG8_SB(1, 0), b3, voffB);
            PG8_BAR; PG8_WAIT_L(0); PG8_MMA(0, 1, At, B1); PG8_BAR;
            PG8_LDA(At, 1, 1); PG8_STAGE(PG8_SA(1, 0), a3, voffA);
            PG8_BAR; PG8_WAIT_L(0); PG8_MMA(1, 0, At, B0); PG8_BAR; PG8_SCHED;
            PG8_STAGE(PG8_SB(1, 1), b3 + hstep, voffB);
            PG8_WAIT_V(6); PG8_BAR; PG8_MMA(1, 1, At, B1); PG8_BAR;
            }
        }
        if constexpr (ALIGN_EPI) { if (wr == 0) PG8_BAR; }
        if constexpr (!Epi::AFTER_DRAIN) { E(acc, cur, wr, wc, fr, fq); S.done(cur); }
        if (!has_next) break;
#pragma unroll
        for (int a = 0; a < 2; ++a)
#pragma unroll
            for (int b = 0; b < 2; ++b)
#pragma unroll
                for (int m = 0; m < 4; ++m)
#pragma unroll
                    for (int n = 0; n < 2; ++n) acc[a][b][m][n] = (f32x4){0.f, 0.f, 0.f, 0.f};
        cur = nxt; cA = nA; cB = nB; ++ui;
        if constexpr (ALIGN_EPI) { if (wr == 1) PG8_BAR; }
    }
    PG8_WAIT_V(0);
    if constexpr (!ALIGN_EPI) { if (wr == 0) PG8_BAR; }
    PG8_BAR;
    if constexpr (Epi::AFTER_DRAIN) { E.fused(acc, cur, wr, wc, fr, fq, lds, wid, lane); S.done(cur); }
#undef PG8_SA
#undef PG8_SB
#undef PG8_STAGE
#undef PG8_LDA
#undef PG8_LDB
#undef PG8_MMA
#undef PG8_WAIT_V
#undef PG8_WAIT_L
#undef PG8_BAR
#undef PG8_SCHED
}
}

#define LAS __attribute__((address_space(3)))
typedef unsigned short bf16;
typedef float f32x4 __attribute__((ext_vector_type(4)));
typedef float f32x2 __attribute__((ext_vector_type(2)));
typedef unsigned u32x4 __attribute__((ext_vector_type(4)));
typedef unsigned u32x2 __attribute__((ext_vector_type(2)));
typedef short bf16x8_t __attribute__((ext_vector_type(8)));
constexpr int DM = 2048, NB = 4, TL = 2048, TC = 256, MLAT = NB * TL, MCTX = NB * TC, MALL = MLAT + MCTX;
constexpr int FF = 5632, NUP = 2 * FF, NIN = 6416, NINP_W = 6656, NMODV = 9 * DM;
constexpr int TSTEPS = TL + TC, NTILES = TSTEPS / 32;
constexpr float EPS = 1e-6f;
constexpr int NUF = 2560, NUG = 4096;
constexpr int U_SSD_XBC = 0, U_SSD_DT = 768, U_LRU_X = 784, U_HG_F = 1296;
constexpr int G_SSD_Z = 0, G_LRU_G = 512, G_HG_G = 1024, G_RT_G = 1536, G_HG_I = 2048, G_RT_V = 2560, G_HG_Q = 3072, G_RT_Q = 3584, G_RT_K = 3840;
constexpr int U_LRU_G = 0, U_HG_G = 0, U_RT_G = 0, U_HG_I = 0, U_RT_V = 0, U_HG_Q = 0, U_RT_Q = 0, U_RT_K = 0;
__host__ __device__ constexpr int u_newpos(int n) {
    return n < 512 ? NUF + G_SSD_Z + n : n < 1296 ? n - 512 : n < 1808 ? U_LRU_X + (n - 1296) : n < 2320 ? NUF + G_LRU_G + (n - 1808) : n < 2832 ? NUF + G_HG_Q + (n - 2320)
         : n < 3856 ? U_HG_F + (n - 2832) : n < 4368 ? NUF + G_HG_I + (n - 3856) : n < 4880 ? NUF + G_HG_G + (n - 4368) : n < 5136 ? NUF + G_RT_Q + (n - 4880)
         : n < 5392 ? NUF + G_RT_K + (n - 5136) : n < 5904 ? NUF + G_RT_V + (n - 5392) : n < 6416 ? NUF + G_RT_G + (n - 5904) : 2320 + (n - 6416); }
constexpr int NPHASES = 26;
constexpr int LDS_BYTES = 147456;
constexpr size_t MiB = 1u << 20;
constexpr size_t WS_MOD = 1 * MiB, WS_W13 = 2 * MiB, WS_W2 = 178 * MiB, WS_WIN = 266 * MiB, WS_WOUT = 318 * MiB, WS_X = 334 * MiB, WS_H = 406 * MiB,
                 WS_Y = 442 * MiB, WS_U = 514 * MiB, WS_XBC = 748 * MiB, WS_LA = 775 * MiB, WS_LB = 811 * MiB, WS_YD = 847 * MiB, WS_END = 991 * MiB, WS_UG = 610 * MiB;

struct Params {
    const float *x, *c, *ctx, *c_ctx, *w_mod, *b_mod, *norm_pre, *norm_post, *ffn_w1, *ffn_w3, *ffn_w2, *w_in, *w_out,
        *ssd_conv_w, *ssd_conv_b, *ssd_dt_bias, *ssd_a_log, *ssd_d, *ssd_norm_w, *lru_conv_w, *lru_conv_b, *lru_wa, *lru_ba, *lru_wx, *lru_bx, *lru_lambda,
        *hgrn_lb_logits, *hgrn_norm_w;
    float* out; unsigned char* ws; int ph_lo, ph_hi;
};

__device__ __forceinline__ float sigmoid_(float x) { return __builtin_amdgcn_rcpf(1.f + __expf(-x)); }
__device__ __forceinline__ float silu_(float x) { return x * sigmoid_(x); }
__device__ __forceinline__ float softplus_(float x) { return fmaxf(x, 0.f) + log1pf(__expf(-fabsf(x))); }
__device__ __forceinline__ float gelu_tanh_(float x) { const float z = 0.7978845608f * (x + 0.044715f * x * x * x); const float t = 1.f - 2.f * __builtin_amdgcn_rcpf(1.f + __expf(2.f * z)); return 0.5f * x * (1.f + t); }
__device__ __forceinline__ unsigned f2bf(float f) { unsigned u = __builtin_bit_cast(unsigned, f); return (u + 0x7fffu + ((u >> 16) & 1u)) >> 16; }
__device__ __forceinline__ unsigned pk2(float lo, float hi) { return f2bf(lo) | (f2bf(hi) << 16); }
__device__ __forceinline__ float wave_sum(float v) {
#pragma unroll
    for (int o = 1; o < 64; o <<= 1) v += __shfl_xor(v, o);
    return v;
}
__device__ __forceinline__ float half_sum(float v) {
#pragma unroll
    for (int o = 1; o < 32; o <<= 1) v += __shfl_xor(v, o);
    return v;
}
__device__ __forceinline__ float dot4(f32x4 a) { return (a.x * a.x + a.y * a.y) + (a.z * a.z + a.w * a.w); }
__device__ __forceinline__ f32x4 ld_bf4(const bf16* p) { const u32x2 w = *(const u32x2*)p; return (f32x4){__builtin_bit_cast(float, w.x << 16), __builtin_bit_cast(float, w.x & 0xffff0000u), __builtin_bit_cast(float, w.y << 16), __builtin_bit_cast(float, w.y & 0xffff0000u)}; }
#define LDS_WAIT() asm volatile("s_waitcnt lgkmcnt(0)" ::: "memory")
__device__ __forceinline__ int tid_() { int t = threadIdx.x; asm volatile("" : "+v"(t)); return t; }
__device__ __forceinline__ int bid_() { int t = blockIdx.x; asm volatile("" : "+s"(t)); return t; }
__device__ __forceinline__ int scan_row(int b, int d, int i) {
    if (i < TC) { const int t = d ? (TC - 1 - i) : i; return MLAT + b * TC + t; }
    int t = i - TC; if (d) t = TL - 1 - t; return b * TL + t;
}

#define XB_TMO      128
#define XB_XCNT(j)  (256  + 64 * (j))
#define XB_XSUB(j)  (1280 + 64 * (j))
#define XB_XGEN(j)  (2304 + 64 * (j))
#define XB_TOP      3328
#define XB_TOPGEN   3392
#define XCD_BAR_WORDS 3456
#define XB_SPIN_CAP (1u << 18)

__device__ __forceinline__ unsigned xb_ld(unsigned* p)              { return __hip_atomic_load(p, __ATOMIC_RELAXED, __HIP_MEMORY_SCOPE_AGENT); }
__device__ __forceinline__ unsigned xb_add(unsigned* p, unsigned v) { return __hip_atomic_fetch_add(p, v, __ATOMIC_RELAXED, __HIP_MEMORY_SCOPE_AGENT); }
__device__ __forceinline__ unsigned xb_xcc_id() { return (unsigned)__builtin_amdgcn_s_getreg((3 << 11) | 20) & 0xFu; }
#define XB_SPIN(cond, bar) do { unsigned _sp = 0; while (cond) { __builtin_amdgcn_s_sleep(1); \
    if ((++_sp & 255u) == 0u) { if (xb_ld(&(bar)[XB_TMO])) break; if (_sp > XB_SPIN_CAP) { atomicAdd(&(bar)[XB_TMO], 1u); break; } } } } while (0)

struct XcdBarrier {
    unsigned* bar; unsigned x;
    volatile LAS unsigned* st;
};

__device__ __forceinline__ XcdBarrier xcd_barrier_post(unsigned* bar, volatile LAS unsigned* st) {
    XcdBarrier b; b.bar = bar; b.x = xb_xcc_id(); b.st = st;
    if (threadIdx.x == 0) (void)xb_add(&bar[XB_XCNT(b.x)], 1u);
    return b;
}
__device__ __forceinline__ void xcd_barrier_complete(unsigned* bar, unsigned x, unsigned& nloc, unsigned& nx) {
    const unsigned G = gridDim.x * gridDim.y * gridDim.z;
    unsigned sum, cnt, mine, sp = 0u;
    for (;;) {
        sum = 0u; cnt = 0u; mine = 0u;
#pragma unroll
        for (unsigned j = 0; j < 16; ++j) { const unsigned c = xb_ld(&bar[XB_XCNT(j)]); sum += c; cnt += (c > 0u) ? 1u : 0u; mine = (j == x) ? c : mine; }
        if (sum == G) break;
        __builtin_amdgcn_s_sleep(1);
        if ((++sp & 255u) == 0u) { if (xb_ld(&bar[XB_TMO])) break; if (sp > XB_SPIN_CAP) { atomicAdd(&bar[XB_TMO], 1u); break; } }
    }
    nloc = mine > 0u ? mine : 1u; nx = cnt > 0u ? cnt : 1u;
}

__device__ __forceinline__ void xcd_barrier(const XcdBarrier& b) {
    asm volatile("s_waitcnt vmcnt(0)" ::: "memory");
    __syncthreads();
    if (threadIdx.x == 0) {
        unsigned* bar = b.bar;
        __builtin_amdgcn_s_waitcnt(0);
        unsigned nloc = b.st[0], nx = b.st[1];
        if (nloc == 0u) { xcd_barrier_complete(bar, b.x, nloc, nx); b.st[0] = nloc; b.st[1] = nx; }
        const unsigned old = xb_add(&bar[XB_XSUB(b.x)], 1u);
        const unsigned gen = old / nloc;
        if (old + 1u == (gen + 1u) * nloc) {
            __builtin_amdgcn_fence(__ATOMIC_RELEASE, "agent");
            asm volatile("s_waitcnt vmcnt(0)" ::: "memory");
            const unsigned og = xb_add(&bar[XB_TOP], 1u);
            const unsigned tg = og / nx;
            if (og + 1u == (tg + 1u) * nx) xb_add(&bar[XB_TOPGEN], 1u);
            else XB_SPIN(xb_ld(&bar[XB_TOPGEN]) == tg, bar);
            __builtin_amdgcn_fence(__ATOMIC_ACQUIRE, "agent");
            xb_add(&bar[XB_XGEN(b.x)], 1u);
            asm volatile("s_waitcnt vmcnt(0)" ::: "memory");
        } else {
            XB_SPIN(xb_ld(&bar[XB_XGEN(b.x)]) == gen, bar);
            __builtin_amdgcn_fence(__ATOMIC_ACQUIRE, "agent");
            asm volatile("s_waitcnt vmcnt(0)" ::: "memory");
        }
    }
    __syncthreads();
}

namespace pg8 {
struct EpiSwiGLU {
    static constexpr bool PERM = true, AFTER_DRAIN = false;
    bf16_t* O; int ldc;
    __device__ __forceinline__ void operator()(const f32x4 (&acc)[2][2][4][2], const Unit& u, int wr, int wc, int fr, int fq) const {
        const int row0 = u.pm * BM + wr * 64 + fr, col0 = u.pn * HALF + wc * 32 + 8 * fq;
#pragma unroll
        for (int ai = 0; ai < 2; ++ai)
#pragma unroll
            for (int m = 0; m < 4; ++m) {
                bf16_t* rowp = O + (size_t)(row0 + ai * HALF + m * 16) * ldc + col0;
                const f32x4 a0 = acc[ai][0][m][0], a1 = acc[ai][0][m][1], b0 = acc[ai][1][m][0], b1 = acc[ai][1][m][1];
                float r[8];
#pragma unroll
                for (int j = 0; j < 4; ++j) { r[j] = a0[j] * __builtin_amdgcn_rcpf(1.f + __expf(-a0[j])) * b0[j]; r[4 + j] = a1[j] * __builtin_amdgcn_rcpf(1.f + __expf(-a1[j])) * b1[j]; }
                u32x4 w; w.x = cvt_pk_bf16(r[0], r[1]); w.y = cvt_pk_bf16(r[2], r[3]); w.z = cvt_pk_bf16(r[4], r[5]); w.w = cvt_pk_bf16(r[6], r[7]);
                *(u32x4*)rowp = w;
                asm volatile("" ::: "memory");
            }
    }
};
struct EpiF32 {
    static constexpr bool PERM = false, AFTER_DRAIN = false;
    float* O; int ldc; int asbf; bf16_t* O2; int ldc2, split_pn;
    __device__ __forceinline__ void operator()(const f32x4 (&acc)[2][2][4][2], const Unit& u, int wr, int wc, int fr, int fq) const {
        const bool sec = split_pn > 0 && u.pn >= split_pn;
        const int row0 = u.pm * BM + wr * 64 + fr, col0 = (sec ? u.pn - split_pn : u.pn) * BM + wc * 32 + 4 * fq;
        if (asbf || sec) {
            bf16_t* Ob = sec ? O2 : (bf16_t*)O; const int ldc = sec ? ldc2 : this->ldc;
#pragma unroll
            for (int ai = 0; ai < 2; ++ai)
#pragma unroll
                for (int m = 0; m < 4; ++m) {
                    bf16_t* rowp = Ob + (size_t)(row0 + ai * HALF + m * 16) * ldc + col0;
#pragma unroll
                    for (int bj = 0; bj < 2; ++bj)
#pragma unroll
                        for (int n = 0; n < 2; ++n) { const f32x4 v = acc[ai][bj][m][n]; u32x2 w; w.x = cvt_pk_bf16(v[0], v[1]); w.y = cvt_pk_bf16(v[2], v[3]); *(u32x2*)(rowp + bj * HALF + n * 16) = w; }
                }
            return;
        }
#pragma unroll
        for (int ai = 0; ai < 2; ++ai)
#pragma unroll
            for (int m = 0; m < 4; ++m) {
                float* rowp = O + (size_t)(row0 + ai * HALF + m * 16) * ldc + col0;
#pragma unroll
                for (int bj = 0; bj < 2; ++bj)
#pragma unroll
                    for (int n = 0; n < 2; ++n) *(f32x4*)(rowp + bj * HALF + n * 16) = acc[ai][bj][m][n];
            }
    }
};
}


namespace pg8 {
struct Order2 {
    StaticOrder so; int one, valid; Unit u1;
    __device__ bool next(int i, Unit& u) const { if (one) { if (i > 0 || !valid) return false; u = u1; return true; } return so.next(i, u); }
    __device__ __forceinline__ void a_ready(const Unit&) const {}
    __device__ __forceinline__ void done(const Unit&) const {}
};
}
__device__ __forceinline__ void transpose_item64(const float* __restrict__ W, int K, int N, bf16* __restrict__ WT, int mode, float* scr, int item, int lane) {
    const int nblk = (N + 63) >> 6, kb = item / nblk, nb = item - kb * nblk, k0 = kb << 6, n0 = nb << 6;
    const int lr = lane >> 4, lc = (lane & 15) << 2;
    const bool ok = (n0 + lc) < N;
#pragma unroll
    for (int i = 0; i < 16; ++i) {
        const int kk = 4 * i + lr; f32x4 v = {0.f, 0.f, 0.f, 0.f};
        if (ok) v = __builtin_nontemporal_load((const f32x4*)(W + (size_t)(k0 + kk) * N + n0 + lc));
        float* s = scr + kk * 65 + lc; s[0] = v.x; s[1] = v.y; s[2] = v.z; s[3] = v.w;
    }
    LDS_WAIT();
    const int c = lane & 7;
#pragma unroll
    for (int j = 0; j < 8; ++j) {
        const int n = (lane >> 3) + 8 * j; const float* s = scr + (8 * c) * 65 + n;
        u32x4 o; o.x = pk2(s[0], s[65]); o.y = pk2(s[2 * 65], s[3 * 65]); o.z = pk2(s[4 * 65], s[5 * 65]); o.w = pk2(s[6 * 65], s[7 * 65]);
        const int dn = n0 + n; int row = dn; if (mode == 3) row = u_newpos(dn); else if (mode) row = ((dn >> 7) << 8) + (dn & 127) + (mode == 2 ? 128 : 0);
        *(u32x4*)(WT + (size_t)row * K + k0 + 8 * c) = o;
    }
    LDS_WAIT();
}

__device__ __forceinline__ void prologue_phase(const Params& P, float* L) {
    const int tid = tid_(), lane = tid & 63, wave = __builtin_amdgcn_readfirstlane(tid >> 6);
    unsigned char* ws = P.ws;
    float* MOD = (float*)(ws + WS_MOD);
    float* sc = L;
    float* red = L + 5 * DM;
    for (int i = tid; i < 5 * DM; i += 512) { const int r = i >> 11, k = i & (DM - 1); const float v = r < 4 ? P.c[r * DM + k] : P.c_ctx[k]; sc[i] = silu_(v); }
    __syncthreads();
    for (int it = bid_(); it < 1152; it += gridDim.x) {
        const int l = it / 576, j0 = (it % 576) * 32;
        const float* Wm = P.w_mod + (size_t)l * DM * NMODV;
        const int kr = lane >> 3, c4 = (lane & 7) << 2;
        f32x4 acc[5];
#pragma unroll
        for (int r = 0; r < 5; ++r) acc[r] = (f32x4){0.f, 0.f, 0.f, 0.f};
        const int kbase = wave * 256 + kr;
#pragma unroll 16
        for (int kk = 0; kk < 256; kk += 8) {
            const int k = kbase + kk; const f32x4 w = __builtin_nontemporal_load((const f32x4*)(Wm + (size_t)k * NMODV + j0 + c4));
#pragma unroll
            for (int r = 0; r < 5; ++r) acc[r] += w * sc[r * DM + k];
        }
#pragma unroll
        for (int r = 0; r < 5; ++r)
#pragma unroll
            for (int e = 0; e < 4; ++e) { float v = acc[r][e]; v += __shfl_xor(v, 8); v += __shfl_xor(v, 16); v += __shfl_xor(v, 32); acc[r][e] = v; }
        if (lane < 8) {
#pragma unroll
            for (int r = 0; r < 5; ++r) *(f32x4*)&red[(wave * 5 + r) * 32 + c4] = acc[r];
        }
        __syncthreads();
        if (tid < 160) { const int r = tid >> 5, j = tid & 31; float s_ = 0.f;
#pragma unroll
            for (int w = 0; w < 8; ++w) s_ += red[(w * 5 + r) * 32 + j];
            MOD[(size_t)(l * 5 + r) * NMODV + j0 + j] = s_ + P.b_mod[l * NMODV + j0 + j]; }
        __syncthreads();
    }
    bf16* W13 = (bf16*)(ws + WS_W13); bf16* W2 = (bf16*)(ws + WS_W2); bf16* WIN = (bf16*)(ws + WS_WIN); bf16* WOUT = (bf16*)(ws + WS_WOUT);
    float* scr = L + wave * (64 * 65);
    const int gw = bid_() * 8 + wave, NGW = gridDim.x * 8;
    constexpr int I_F = 2816, I_LF = 3 * I_F, I_FFN = 4 * I_LF, I_IN = 32 * 101, I_OUT = 32 * 32, I_ALL = I_FFN + 2 * I_IN + 2 * I_OUT;
    for (int it = gw; it < I_ALL; it += NGW) {
        int r = it;
        if (r < I_FFN) {
            const int lf = r / I_LF, q = r % I_LF, which = q / I_F, item = q % I_F;
            if (which == 0) transpose_item64(P.ffn_w1 + (size_t)lf * DM * FF, DM, FF, W13 + (size_t)lf * NUP * DM, 1, scr, item, lane);
            else if (which == 1) transpose_item64(P.ffn_w3 + (size_t)lf * DM * FF, DM, FF, W13 + (size_t)lf * NUP * DM, 2, scr, item, lane);
            else transpose_item64(P.ffn_w2 + (size_t)lf * FF * DM, FF, DM, W2 + (size_t)lf * DM * FF, 0, scr, item, lane);
        } else {
            r -= I_FFN;
            if (r < 2 * I_IN) { const int l = r / I_IN, item = r % I_IN; transpose_item64(P.w_in + (size_t)l * DM * NIN, DM, NIN, WIN + (size_t)l * NINP_W * DM, 3, scr, item, lane); }
            else { r -= 2 * I_IN; const int l = r / I_OUT, item = r % I_OUT; transpose_item64(P.w_out + (size_t)l * DM * DM, DM, DM, WOUT + (size_t)l * DM * DM, 0, scr, item, lane); }
        }
    }
}

__device__ __forceinline__ void rowwise_phase(const Params& P, int mrows, bool first, int l_post, int j_post, int gate_idx, float coef, bool final_, int l_pre, int j_pre, int shift_idx, int scale_idx) {
    const int tid = tid_(), lane = tid & 63, wave = __builtin_amdgcn_readfirstlane(tid >> 6);
    const int gw = bid_() * 8 + wave, NGW = gridDim.x * 8;
    const float* MOD = (const float*)(P.ws + WS_MOD);
    float* X = (float*)(P.ws + WS_X); const float* Y = (const float*)(P.ws + WS_Y); bf16* H = (bf16*)(P.ws + WS_H);
    for (int row = gw; row < mrows; row += NGW) {
        const int b = row < MLAT ? (row >> 11) : 4;
        f32x4 xv[8]; float ss_new = 0.f;
        if (first) {
            const float* src = row < MLAT ? P.x + (size_t)row * DM : P.ctx + (size_t)(row - MLAT) * DM;
#pragma unroll
            for (int j = 0; j < 8; ++j) xv[j] = *(const f32x4*)(src + 4 * lane + 256 * j);
        } else {
            const float* xr = (l_post == 0 && j_post == 0) ? (row < MLAT ? P.x + (size_t)row * DM : P.ctx + (size_t)(row - MLAT) * DM) : X + (size_t)row * DM;
            f32x4 yv[8]; float ss = 0.f;
            if (row < MLAT) {
                const bf16* yb = (const bf16*)Y + (size_t)row * DM;
#pragma unroll
                for (int j = 0; j < 8; ++j) { const u32x2 w = *(const u32x2*)(yb + 4 * lane + 256 * j);
                    yv[j] = (f32x4){__builtin_bit_cast(float, w.x << 16), __builtin_bit_cast(float, w.x & 0xffff0000u), __builtin_bit_cast(float, w.y << 16), __builtin_bit_cast(float, w.y & 0xffff0000u)}; }
            } else {
                const bf16* pr = (const bf16*)(P.ws + WS_YD) + (size_t)(row - MLAT) * DM;
#pragma unroll
                for (int j = 0; j < 8; ++j) yv[j] = ld_bf4(pr + 4 * lane + 256 * j);
                for (int ks = 1; ks < 8; ++ks) {
#pragma unroll
                    for (int j = 0; j < 8; ++j) yv[j] += ld_bf4(pr + (size_t)ks * MCTX * DM + 4 * lane + 256 * j);
                }
            }
            const float* gp = P.norm_post + (size_t)(l_post * 3 + j_post) * DM; const float* mg = MOD + (size_t)(l_post * 5 + b) * NMODV + gate_idx * DM;
            float sxx = 0.f, sxt = 0.f, stt = 0.f;
#pragma unroll
            for (int j = 0; j < 8; ++j) { const int c = 4 * lane + 256 * j; xv[j] = *(const f32x4*)(xr + c); const f32x4 g4 = *(const f32x4*)(gp + c), m4 = *(const f32x4*)(mg + c);
                ss += dot4(yv[j]); yv[j] = yv[j] * g4 * m4; sxx += dot4(xv[j]); stt += dot4(yv[j]);
                const f32x4 xt = xv[j] * yv[j]; sxt += (xt.x + xt.y) + (xt.z + xt.w); }
#pragma unroll
            for (int o = 1; o < 64; o <<= 1) { ss += __shfl_xor(ss, o); sxx += __shfl_xor(sxx, o); sxt += __shfl_xor(sxt, o); stt += __shfl_xor(stt, o); }
            const float rs = rsqrtf(ss * (1.f / DM) + EPS) * coef;
            ss_new = sxx + 2.f * rs * sxt + rs * rs * stt;
#pragma unroll
            for (int j = 0; j < 8; ++j) xv[j] += yv[j] * rs;
        }
        if (final_) {
            float* o = P.out + (size_t)row * DM;
#pragma unroll
            for (int j = 0; j < 8; ++j) *(f32x4*)(o + 4 * lane + 256 * j) = xv[j];
            continue;
        }
        {
            float* xr = X + (size_t)row * DM; float ss = 0.f;
#pragma unroll
            for (int j = 0; j < 8; ++j) { if (!first) *(f32x4*)(xr + 4 * lane + 256 * j) = xv[j]; else ss += dot4(xv[j]); }
            if (first) ss = wave_sum(ss); else ss = ss_new;
            const float rs = rsqrtf(ss * (1.f / DM) + EPS);
            const float* gp = P.norm_pre + (size_t)(l_pre * 3 + j_pre) * DM; const float* mb = MOD + (size_t)(l_pre * 5 + b) * NMODV;
            bf16* hr = H + (size_t)row * DM;
#pragma unroll
            for (int j = 0; j < 8; ++j) { const int c = 4 * lane + 256 * j; const f32x4 g4 = *(const f32x4*)(gp + c), sh = *(const f32x4*)(mb + shift_idx * DM + c), scl = *(const f32x4*)(mb + scale_idx * DM + c);
                const f32x4 h = (xv[j] * rs) * g4 * (scl + 1.f) + sh; u32x2 w; w.x = pk2(h.x, h.y); w.y = pk2(h.z, h.w); *(u32x2*)(hr + c) = w; }
        }
    }
}

__device__ __forceinline__ f32x4 conv4(const float* __restrict__ U, int row, int col, const float* __restrict__ cw, int C, const float* __restrict__ cb) {
    int t, len; if (row < MLAT) { t = row & (TL - 1); len = TL; } else { t = (row - MLAT) & (TC - 1); len = TC; }
    f32x4 acc = *(const f32x4*)cb;
#pragma unroll
    for (int j = 0; j < 4; ++j) { const int tt = t + j - 1; if (tt >= 0 && tt < len) { const f32x4 xx = *(const f32x4*)(U + (size_t)(row + j - 1) * NUF + col); const f32x4 w = *(const f32x4*)(cw + j * C); acc += xx * w; } }
    return acc;
}
__device__ __forceinline__ void prep_phase(const Params& P, float* L, int l) {
    const int tid = tid_();
    const float* U = (const float*)(P.ws + WS_U); bf16* XBC = (bf16*)(P.ws + WS_XBC); float* LA = (float*)(P.ws + WS_LA); bf16* LB = (bf16*)(P.ws + WS_LB);
    { const float* cw = P.ssd_conv_w + (size_t)l * 4 * 768; const float* cb = P.ssd_conv_b + (size_t)l * 768;
      for (int idx = bid_() * 512 + tid; idx < (MALL / 16) * 192; idx += gridDim.x * 512) {
          const int chunk = idx / 192, c4 = (idx - chunk * 192) << 2, row0 = chunk * 16;
          int t0, len; if (row0 < MLAT) { t0 = row0 & (TL - 1); len = TL; } else { t0 = (row0 - MLAT) & (TC - 1); len = TC; }
          const f32x4 w0 = *(const f32x4*)(cw + c4), w1 = *(const f32x4*)(cw + 768 + c4), w2 = *(const f32x4*)(cw + 2 * 768 + c4), w3 = *(const f32x4*)(cw + 3 * 768 + c4), bb = *(const f32x4*)(cb + c4);
          const float* up = U + (size_t)row0 * NUF + U_SSD_XBC + c4;
          const f32x4 z4 = {0.f, 0.f, 0.f, 0.f};
          f32x4 xm1 = (t0 > 0) ? *(const f32x4*)(up - NUF) : z4, x0 = *(const f32x4*)up, x1 = *(const f32x4*)(up + NUF);
#pragma unroll
          for (int r = 0; r < 16; ++r) {
              const f32x4 x2 = (t0 + r + 2 < len) ? *(const f32x4*)(up + (size_t)(r + 2) * NUF) : z4;
              f32x4 v = bb + xm1 * w0 + x0 * w1 + x1 * w2 + x2 * w3;
              v.x = silu_(v.x); v.y = silu_(v.y); v.z = silu_(v.z); v.w = silu_(v.w);
              { u32x2 w_; w_.x = pk2(v.x, v.y); w_.y = pk2(v.z, v.w); *(u32x2*)(XBC + (size_t)(row0 + r) * 768 + c4) = w_; }
              xm1 = x0; x0 = x1; x1 = x2;
          } } }
    unsigned short* WT = (unsigned short*)L;
    unsigned short* xb = WT + 4 * 64 * 72;
    float* xs = (float*)(xb + 64 * 72);
    const float* cw = P.lru_conv_w + (size_t)l * 4 * 512; const float* cb = P.lru_conv_b + (size_t)l * 512;
    const int lane = tid & 63, wave = __builtin_amdgcn_readfirstlane(tid >> 6), fr = lane & 15, fq = lane >> 4;
    int cur_h = -1;
    for (int it = bid_(); it < 144 * 8; it += gridDim.x) {
        const int h = it & 7, row0 = (it >> 3) * 64;
        __syncthreads();
        if (h != cur_h) {
            for (int i = tid; i < 4 * 4096; i += 512) { const int m = i >> 12, ii = (i >> 6) & 63, j = i & 63, d = m >> 1; const float* src = (m & 1) ? P.lru_wx : P.lru_wa;
                WT[(m * 64 + j) * 72 + ii] = (unsigned short)f2bf(src[((size_t)(l * 2 + d) * 8 + h) * 4096 + ii * 64 + j]); }
            cur_h = h;
        }
        for (int i = tid; i < 1024; i += 512) { const int r = i >> 4, c4 = (i & 15) << 2;
            const f32x4 v = conv4(U, row0 + r, U_LRU_X + h * 64 + c4, cw + h * 64 + c4, 512, cb + h * 64 + c4);
            *(f32x4*)&xs[r * 68 + c4] = v; u32x2 w; w.x = pk2(v.x, v.y); w.y = pk2(v.z, v.w); *(u32x2*)&xb[r * 72 + c4] = w; }
        __syncthreads();
        {
            const int tt = wave & 3, d = wave >> 2;
            f32x4 acc[2][4];
#pragma unroll
            for (int g2 = 0; g2 < 2; ++g2)
#pragma unroll
                for (int jt = 0; jt < 4; ++jt) acc[g2][jt] = (f32x4){0.f, 0.f, 0.f, 0.f};
#pragma unroll
            for (int ks = 0; ks < 2; ++ks) {
                const bf16x8_t a = *(const bf16x8_t*)&xb[(tt * 16 + fr) * 72 + ks * 32 + fq * 8];
#pragma unroll
                for (int g2 = 0; g2 < 2; ++g2)
#pragma unroll
                    for (int jt = 0; jt < 4; ++jt) { const bf16x8_t bq = *(const bf16x8_t*)&WT[((d * 2 + g2) * 64 + jt * 16 + fr) * 72 + ks * 32 + fq * 8];
                        acc[g2][jt] = __builtin_amdgcn_mfma_f32_16x16x32_bf16(a, bq, acc[g2][jt], 0, 0, 0); }
            }
#pragma unroll
            for (int jt = 0; jt < 4; ++jt) {
                const int j = jt * 16 + fr, c = h * 64 + j;
                const float ba1 = P.lru_ba[(size_t)(l * 2 + d) * 512 + c], bx1 = P.lru_bx[(size_t)(l * 2 + d) * 512 + c], sp = softplus_(-P.lru_lambda[(size_t)(l * 2 + d) * 512 + c]);
#pragma unroll
                for (int jj = 0; jj < 4; ++jj) {
                    const int t = tt * 16 + 4 * fq + jj, row = row0 + t;
                    const float rg = sigmoid_(acc[0][jt][jj] + ba1), ig = sigmoid_(acc[1][jt][jj] + bx1);
                    const float la = -8.f * rg * sp;
                    const float a_ = __expf(la); LA[((size_t)d * MALL + row) * 512 + c] = a_;
                    LB[((size_t)d * MALL + row) * 512 + c] = (bf16)f2bf(sqrtf(fmaxf(1.f - a_ * a_, 1e-12f)) * (ig * xs[t * 68 + j]));
                }
            }
        }
    }
}


#define MEMFENCE() asm volatile("" ::: "memory")
struct StepOps { f32x4 k0, k1, q0, q1; float v, a; };
__device__ __forceinline__ void ssd_core(const float* __restrict__ qs, const float* __restrict__ ks, const float* __restrict__ vs, const float* __restrict__ as, const float* __restrict__ la, const float* __restrict__ lb,
                                         float* __restrict__ lo, float* __restrict__ yp, f32x2& S0, f32x2& S1, f32x2& S2, f32x2& S3, float& hl, int tid, int p, int sl, float dsk, bool has_a) {
    StepOps c, n;
#define LD_OPS(o, s_) do { (o).k0 = *(const f32x4*)&ks[(s_) * 64 + sl * 8]; (o).k1 = *(const f32x4*)&ks[(s_) * 64 + sl * 8 + 4]; (o).q0 = *(const f32x4*)&qs[(s_) * 64 + sl * 8]; (o).q1 = *(const f32x4*)&qs[(s_) * 64 + sl * 8 + 4]; \
        (o).v = vs[(s_) * 64 + p]; (o).a = has_a ? as[(s_)] : dsk; } while (0)
#define DO_STEP(o, s_) do { const float a_ = has_a ? (o).a : dsk; const float v_ = (o).v; \
        S0 = S0 * a_ + (f32x2){(o).k0.x, (o).k0.y} * v_; S1 = S1 * a_ + (f32x2){(o).k0.z, (o).k0.w} * v_; S2 = S2 * a_ + (f32x2){(o).k1.x, (o).k1.y} * v_; S3 = S3 * a_ + (f32x2){(o).k1.z, (o).k1.w} * v_; \
        const f32x2 y2_ = ((f32x2){(o).q0.x, (o).q0.y} * S0 + (f32x2){(o).q0.z, (o).q0.w} * S1) + ((f32x2){(o).q1.x, (o).q1.y} * S2 + (f32x2){(o).q1.z, (o).q1.w} * S3); \
        float y_ = y2_.x + y2_.y; if (has_a && sl == 0) y_ += dsk * v_; yp[(s_) * 512 + tid] = y_; } while (0)
    LD_OPS(c, 0); MEMFENCE();
#pragma unroll 2
    for (int s = 0; s < 32; s += 2) {
        LD_OPS(n, s + 1); MEMFENCE();
        DO_STEP(c, s); MEMFENCE();
        if (s + 2 < 32) { LD_OPS(c, s + 2); } MEMFENCE();
        DO_STEP(n, s + 1); MEMFENCE();
    }
#undef LD_OPS
#undef DO_STEP
    if (has_a && tid < 64) {
#pragma unroll 8
        for (int s = 0; s < 32; ++s) { hl = la[s * 64 + tid] * hl + lb[s * 64 + tid]; lo[s * 64 + tid] = hl; }
    }
}
__device__ __forceinline__ void hgrn_core(const float* __restrict__ qs, const float* __restrict__ fs, const float* __restrict__ vs, float* __restrict__ yp, f32x2& S0, f32x2& S1, f32x2& S2, f32x2& S3, int tid, int p, int sl) {
    StepOps c, n;
#define LD_OPS(o, s_) do { (o).k0 = *(const f32x4*)&fs[(s_) * 128 + sl * 4]; (o).k1 = *(const f32x4*)&fs[(s_) * 128 + 64 + sl * 4]; (o).q0 = *(const f32x4*)&qs[(s_) * 128 + sl * 4]; (o).q1 = *(const f32x4*)&qs[(s_) * 128 + 64 + sl * 4]; \
        (o).v = vs[(s_) * 32 + p]; } while (0)
#define DO_STEP(o, s_) do { const f32x2 v2_ = {(o).v, (o).v}; \
        S0 = v2_ + (f32x2){(o).k0.x, (o).k0.y} * (S0 - v2_); S1 = v2_ + (f32x2){(o).k0.z, (o).k0.w} * (S1 - v2_); S2 = v2_ + (f32x2){(o).k1.x, (o).k1.y} * (S2 - v2_); S3 = v2_ + (f32x2){(o).k1.z, (o).k1.w} * (S3 - v2_); \
        const f32x2 y2_ = ((f32x2){(o).q0.x, (o).q0.y} * S0 + (f32x2){(o).q0.z, (o).q0.w} * S1) + ((f32x2){(o).q1.x, (o).q1.y} * S2 + (f32x2){(o).q1.z, (o).q1.w} * S3); \
        yp[(s_) * 512 + tid] = y2_.x + y2_.y; } while (0)
    LD_OPS(c, 0); MEMFENCE();
#pragma unroll 2
    for (int s = 0; s < 32; s += 2) {
        LD_OPS(n, s + 1); MEMFENCE();
        DO_STEP(c, s); MEMFENCE();
        if (s + 2 < 32) { LD_OPS(c, s + 2); } MEMFENCE();
        DO_STEP(n, s + 1); MEMFENCE();
    }
#undef LD_OPS
#undef DO_STEP
}
constexpr int L_YP = 12544;
__device__ __forceinline__ void scan_ssd(const Params& P, float* L, int l, int c) {
    const int tid = tid_(), b = c >> 4, d = (c >> 3) & 1, h = c & 7, g = h >> 2;
    const float* U = (const float*)(P.ws + WS_U); const float* XBC = (const float*)(P.ws + WS_XBC); const float* LA = (const float*)(P.ws + WS_LA); const float* LB = (const float*)(P.ws + WS_LB);
    bf16* YD = (bf16*)(P.ws + WS_YD);
    float* qs = L; float* ks = L + 2048; float* vs = L + 4096; float* as = L + 6144; float* la = L + 6400; float* lb = L + 8448; float* lo = L + 10496; float* yp = L + L_YP;
    const float dtb = P.ssd_dt_bias[(l * 2 + d) * 8 + h], aneg = -__expf(P.ssd_a_log[(l * 2 + d) * 8 + h]), dsk = (d == 0) ? P.ssd_d[l * 8 + h] : 0.f;
    const int st = tid >> 4, sc4 = (tid & 15) << 2, p = tid >> 3, sl = tid & 7;
    f32x2 S0 = {0.f, 0.f}, S1 = {0.f, 0.f}, S2 = {0.f, 0.f}, S3 = {0.f, 0.f}; float hl = 0.f;
    f32x4 rx, rB, rC, ra, rb; float rdt;
#define SSD_LOAD(tile) do { const int row_ = scan_row(b, d, (tile) * 32 + st); const float* xr_ = XBC + (size_t)row_ * 768; \
        rx = *(const f32x4*)(xr_ + h * 64 + sc4); rB = *(const f32x4*)(xr_ + 512 + g * 64 + sc4); rC = *(const f32x4*)(xr_ + 640 + g * 64 + sc4); \
        rdt = U[(size_t)row_ * NUF + U_SSD_DT + d * 8 + h]; \
        ra = *(const f32x4*)(LA + ((size_t)d * MALL + row_) * 512 + h * 64 + sc4); rb = *(const f32x4*)(LB + ((size_t)d * MALL + row_) * 512 + h * 64 + sc4); } while (0)
    __syncthreads();
    SSD_LOAD(0);
    for (int tile = 0; tile < NTILES; ++tile) {
        { const float delta = softplus_(rdt + dtb);
          *(f32x4*)&vs[st * 64 + sc4] = rx; *(f32x4*)&ks[st * 64 + sc4] = rB * delta; *(f32x4*)&qs[st * 64 + sc4] = rC;
          if ((tid & 15) == 0) as[st] = __expf(aneg * delta);
          *(f32x4*)&la[st * 64 + sc4] = ra; *(f32x4*)&lb[st * 64 + sc4] = rb; }
        __syncthreads();
        if (tile + 1 < NTILES) SSD_LOAD(tile + 1);
        ssd_core(qs, ks, vs, as, la, lb, lo, yp, S0, S1, S2, S3, hl, tid, p, sl, dsk, true);
        __syncthreads();
#pragma unroll
        for (int j = 0; j < 4; ++j) {
            const int idx = tid + 512 * j, t = idx >> 6, pp = idx & 63;
            const f32x4 a0 = *(const f32x4*)&yp[t * 512 + pp * 8], a1 = *(const f32x4*)&yp[t * 512 + pp * 8 + 4];
            const int row = scan_row(b, d, tile * 32 + t);
            YD[((size_t)(0 * 2 + d) * MALL + row) * 512 + h * 64 + pp] = ((a0.x + a0.y) + (a0.z + a0.w)) + ((a1.x + a1.y) + (a1.z + a1.w));
            YD[((size_t)(1 * 2 + d) * MALL + row) * 512 + h * 64 + pp] = lo[t * 64 + pp];
        }
    }
#undef SSD_LOAD
}
__device__ __forceinline__ void scan_ret(const Params& P, float* L, int c) {
    const int tid = tid_(), b = c >> 4, h = (c >> 2) & 3, d = (c >> 1) & 1, vh = c & 1;
    const float* U = (const float*)(P.ws + WS_U); bf16* YD = (bf16*)(P.ws + WS_YD);
    float* qs = L; float* ks = L + 2048; float* vs = L + 4096; float* rope = L + 6400; float* yp = L + L_YP;
    const float a = 1.f - exp2f(-5.f - (float)h);
    const int st = tid >> 4, rem = tid & 15, sc4 = rem << 2, isk = rem >> 3, hs = (rem >> 2) & 1, cc = rem & 3, p = tid >> 3, sl = tid & 7;
    __syncthreads();
    for (int i = tid; i < 1024; i += 512) { const int pos = i >> 4, fi = i & 15; const float inv = exp2f(-(float)fi * 0.83048202372184f); const float rev = ((float)pos * inv) * 0.15915494309189535f;
        rope[2 * i] = __builtin_amdgcn_cosf(rev); rope[2 * i + 1] = __builtin_amdgcn_sinf(rev); }
    f32x2 S0 = {0.f, 0.f}, S1 = {0.f, 0.f}, S2 = {0.f, 0.f}, S3 = {0.f, 0.f};
    f32x4 r1, r2, rv;
    const int qkbase = (isk ? U_RT_K : U_RT_Q) + h * 64 + hs * 32 + 4 * cc;
#define RET_LOAD(tile) do { const float* ur_ = U + (size_t)scan_row(b, d, (tile) * 32 + st) * NUF; r1 = *(const f32x4*)(ur_ + qkbase); r2 = *(const f32x4*)(ur_ + qkbase + 16); \
        rv = *(const f32x4*)(ur_ + U_RT_V + h * 128 + vh * 64 + sc4); } while (0)
    RET_LOAD(0);
    for (int tile = 0; tile < NTILES; ++tile) {
        { f32x4 o1 = r1, o2 = r2;
          if (tile >= TC / 32) {
              const int tok = scan_row(b, d, tile * 32 + st) & (TL - 1); const int pos = hs ? (tok & 63) : (tok >> 6);
              const f32x4 cs0 = *(const f32x4*)&rope[(pos * 16 + 4 * cc) * 2], cs1 = *(const f32x4*)&rope[(pos * 16 + 4 * cc) * 2 + 4];
              const f32x4 cv = {cs0.x, cs0.z, cs1.x, cs1.z}, sv = {cs0.y, cs0.w, cs1.y, cs1.w};
              o1 = r1 * cv - r2 * sv; o2 = r1 * sv + r2 * cv;
          }
          float* dst = isk ? ks : qs; const float scl = isk ? 0.125f : 1.f;
          *(f32x4*)&dst[st * 64 + hs * 32 + 4 * cc] = o1 * scl; *(f32x4*)&dst[st * 64 + hs * 32 + 16 + 4 * cc] = o2 * scl;
          *(f32x4*)&vs[st * 64 + sc4] = rv; }
        __syncthreads();
        if (tile + 1 < NTILES) RET_LOAD(tile + 1);
        { float hl_ = 0.f; ssd_core(qs, ks, vs, vs, vs, vs, yp, yp, S0, S1, S2, S3, hl_, tid, p, sl, a, false); }
        __syncthreads();
#pragma unroll
        for (int j = 0; j < 4; ++j) {
            const int idx = tid + 512 * j, t = idx >> 6, pp = idx & 63;
            const f32x4 a0 = *(const f32x4*)&yp[t * 512 + pp * 8], a1 = *(const f32x4*)&yp[t * 512 + pp * 8 + 4];
            const int row = scan_row(b, d, tile * 32 + t);
            YD[((size_t)(3 * 2 + d) * MALL + row) * 512 + h * 128 + vh * 64 + pp] = ((a0.x + a0.y) + (a0.z + a0.w)) + ((a1.x + a1.y) + (a1.z + a1.w));
        }
    }
#undef RET_LOAD
}
__device__ __forceinline__ void scan_hgrn(const Params& P, float* L, int l, int c) {
    const int tid = tid_(), b = c >> 5, h = (c >> 3) & 3, d = (c >> 2) & 1, vq = c & 3;
    const float* U = (const float*)(P.ws + WS_U); bf16* YD = (bf16*)(P.ws + WS_YD);
    float* qs = L; float* fs = L + 4096; float* vs = L + 8192; float* yp = L + L_YP;
    const int st = tid >> 5, sc4 = (tid & 31) << 2, p = tid >> 4, sl = tid & 15;
    f32x4 lbv = {0.f, 0.f, 0.f, 0.f};
    if (l == 1) { const f32x4 g0 = *(const f32x4*)(P.hgrn_lb_logits + (size_t)(d * 2 + 0) * 512 + h * 128 + sc4), g1 = *(const f32x4*)(P.hgrn_lb_logits + (size_t)(d * 2 + 1) * 512 + h * 128 + sc4);
        lbv.x = sigmoid_(g1.x - g0.x); lbv.y = sigmoid_(g1.y - g0.y); lbv.z = sigmoid_(g1.z - g0.z); lbv.w = sigmoid_(g1.w - g0.w); }
    f32x2 S0 = {0.f, 0.f}, S1 = {0.f, 0.f}, S2 = {0.f, 0.f}, S3 = {0.f, 0.f};
    f32x4 rq0, rq1, rf0, rf1, rv = {0.f, 0.f, 0.f, 0.f};
#define HG_LOAD(tile) do { const float* u0_ = U + (size_t)scan_row(b, d, (tile) * 32 + st) * NUF; const float* u1_ = U + (size_t)scan_row(b, d, (tile) * 32 + st + 16) * NUF; \
        rq0 = *(const f32x4*)(u0_ + U_HG_Q + h * 128 + sc4); rq1 = *(const f32x4*)(u1_ + U_HG_Q + h * 128 + sc4); \
        rf0 = *(const f32x4*)(u0_ + U_HG_F + d * 512 + h * 128 + sc4); rf1 = *(const f32x4*)(u1_ + U_HG_F + d * 512 + h * 128 + sc4); \
        if (tid < 256) rv = *(const f32x4*)(U + (size_t)scan_row(b, d, (tile) * 32 + (tid >> 3)) * NUF + U_HG_I + h * 128 + vq * 32 + ((tid & 7) << 2)); } while (0)
    __syncthreads();
    HG_LOAD(0);
    for (int tile = 0; tile < NTILES; ++tile) {
        { f32x4 q, f;
#pragma unroll
          for (int e = 0; e < 4; ++e) { q[e] = silu_(rq0[e]) * 0.08838834764831845f; f[e] = lbv[e] + (1.f - lbv[e]) * sigmoid_(rf0[e]); }
          *(f32x4*)&qs[st * 128 + sc4] = q; *(f32x4*)&fs[st * 128 + sc4] = f;
#pragma unroll
          for (int e = 0; e < 4; ++e) { q[e] = silu_(rq1[e]) * 0.08838834764831845f; f[e] = lbv[e] + (1.f - lbv[e]) * sigmoid_(rf1[e]); }
          *(f32x4*)&qs[(st + 16) * 128 + sc4] = q; *(f32x4*)&fs[(st + 16) * 128 + sc4] = f;
          if (tid < 256) *(f32x4*)&vs[(tid >> 3) * 32 + ((tid & 7) << 2)] = rv; }
        __syncthreads();
        if (tile + 1 < NTILES) HG_LOAD(tile + 1);
        hgrn_core(qs, fs, vs, yp, S0, S1, S2, S3, tid, p, sl);
        __syncthreads();
#pragma unroll
        for (int j = 0; j < 2; ++j) {
            const int idx = tid + 512 * j, t = idx >> 5, pp = idx & 31;
            const f32x4 a0 = *(const f32x4*)&yp[t * 512 + pp * 16], a1 = *(const f32x4*)&yp[t * 512 + pp * 16 + 4], a2 = *(const f32x4*)&yp[t * 512 + pp * 16 + 8], a3 = *(const f32x4*)&yp[t * 512 + pp * 16 + 12];
            const int row = scan_row(b, d, tile * 32 + t);
            YD[((size_t)(2 * 2 + d) * MALL + row) * 512 + h * 128 + vq * 32 + pp] =
                (((a0.x + a0.y) + (a0.z + a0.w)) + ((a1.x + a1.y) + (a1.z + a1.w))) + (((a2.x + a2.y) + (a2.z + a2.w)) + ((a3.x + a3.y) + (a3.z + a3.w)));
        }
    }
#undef HG_LOAD
}

typedef __bf16 bf16x2_n __attribute__((ext_vector_type(2)));
__device__ __forceinline__ unsigned cvtpk(float lo, float hi) { f32x2 v = {lo, hi}; bf16x2_n b = __builtin_convertvector(v, bf16x2_n); return __builtin_bit_cast(unsigned, b); }
template <int KD, int VN> struct ChunkLds {
    static constexpr int PQ = (KD + 8) * 2;
    static constexpr int PT = 80;
    static constexpr int KM = 0, QM = KM + 16 * PQ, QE = QM + 16 * PQ, KWT = QE + 16 * PQ, G = KWT + KD * PT, VT = G + KD * 4, SIZE = VT + VN * PT;
};
template <int KD, int VN>
__device__ __forceinline__ f32x4 chunk_step(const unsigned char* C, int v0, int fr, int fq, f32x4 (&S)[KD / 16]) {
    using CL = ChunkLds<KD, VN>;
    f32x4 mt = {0.f, 0.f, 0.f, 0.f}, mt1 = {0.f, 0.f, 0.f, 0.f};
#pragma unroll
    for (int ks = 0; ks < KD / 32; ks += 2) {
        const bf16x8_t a = *(const bf16x8_t*)(C + CL::KM + fr * CL::PQ + (32 * ks + 8 * fq) * 2);
        const bf16x8_t b = *(const bf16x8_t*)(C + CL::QM + fr * CL::PQ + (32 * ks + 8 * fq) * 2);
        mt = __builtin_amdgcn_mfma_f32_16x16x32_bf16(a, b, mt, 0, 0, 0);
        const bf16x8_t a1 = *(const bf16x8_t*)(C + CL::KM + fr * CL::PQ + (32 * ks + 32 + 8 * fq) * 2);
        const bf16x8_t b1 = *(const bf16x8_t*)(C + CL::QM + fr * CL::PQ + (32 * ks + 32 + 8 * fq) * 2);
        mt1 = __builtin_amdgcn_mfma_f32_16x16x32_bf16(a1, b1, mt1, 0, 0, 0);
    }
    mt += mt1;
#pragma unroll
    for (int j = 0; j < 4; ++j) if (4 * fq + j > fr) mt[j] = 0.f;
    u32x4 bw; bw.x = cvtpk(mt[0], mt[1]); bw.y = cvtpk(mt[2], mt[3]); bw.z = 0u; bw.w = 0u;
    const u32x2 va = *(const u32x2*)(C + CL::VT + (v0 + fr) * CL::PT + (4 * fq) * 2);
    u32x4 aw; aw.x = va.x; aw.y = va.y; aw.z = 0u; aw.w = 0u;
    f32x4 yi = __builtin_amdgcn_mfma_f32_16x16x32_bf16(__builtin_bit_cast(bf16x8_t, aw), __builtin_bit_cast(bf16x8_t, bw), (f32x4){0.f, 0.f, 0.f, 0.f}, 0, 0, 0);
    f32x4 y = {0.f, 0.f, 0.f, 0.f};
#pragma unroll
    for (int i = 0; i < KD / 32; ++i) {
        u32x4 sa; sa.x = cvtpk(S[2 * i][0], S[2 * i][1]); sa.y = cvtpk(S[2 * i][2], S[2 * i][3]); sa.z = cvtpk(S[2 * i + 1][0], S[2 * i + 1][1]); sa.w = cvtpk(S[2 * i + 1][2], S[2 * i + 1][3]);
        const u32x2 lo = *(const u32x2*)(C + CL::QE + fr * CL::PQ + (32 * i + 4 * fq) * 2), hi = *(const u32x2*)(C + CL::QE + fr * CL::PQ + (32 * i + 16 + 4 * fq) * 2);
        u32x4 qb; qb.x = lo.x; qb.y = lo.y; qb.z = hi.x; qb.w = hi.y;
        y = __builtin_amdgcn_mfma_f32_16x16x32_bf16(__builtin_bit_cast(bf16x8_t, sa), __builtin_bit_cast(bf16x8_t, qb), y, 0, 0, 0);
    }
    y += yi;
    const bf16x8_t bv = *(const bf16x8_t*)(C + CL::VT + (v0 + fr) * CL::PT + (8 * fq) * 2);
#pragma unroll
    for (int i = 0; i < KD / 16; ++i) {
        const f32x4 g4 = *(const f32x4*)(C + CL::G + (16 * i + 4 * fq) * 4);
        const bf16x8_t ak = *(const bf16x8_t*)(C + CL::KWT + (16 * i + fr) * CL::PT + (8 * fq) * 2);
        S[i] = __builtin_amdgcn_mfma_f32_16x16x32_bf16(ak, bv, S[i] * g4, 0, 0, 0);
    }
    return y;
}
template <int KD, int VN, bool LVEC>
__device__ __forceinline__ void build_operands(const float* __restrict__ rq, const float* __restrict__ rk, const float* __restrict__ rL, const float* __restrict__ rv, unsigned char* __restrict__ OP, int t0, int nthr) {
    using CL = ChunkLds<KD, VN>;
    for (int idx = t0; idx < 8 * KD; idx += nthr) {
        const int kq = idx % (KD / 4), t = (idx / (KD / 4)) & 15, c = idx / (4 * KD), k = 4 * kq, row = c * 16 + t;
        const f32x4 q4 = *(const f32x4*)&rq[row * KD + k], k4 = *(const f32x4*)&rk[row * KD + k];
        f32x4 Lt, Lm;
        if (LVEC) { Lt = *(const f32x4*)&rL[row * KD + k]; Lm = *(const f32x4*)&rL[(c * 16 + 7) * KD + k]; } else { const float a_ = rL[row], b_ = rL[c * 16 + 7]; Lt = (f32x4){a_, a_, a_, a_}; Lm = (f32x4){b_, b_, b_, b_}; }
        f32x4 qe, qm, km;
#pragma unroll
        for (int e = 0; e < 4; ++e) { qe[e] = q4[e] * __expf(Lt[e]); qm[e] = q4[e] * __expf(fminf(Lt[e] - Lm[e], 80.f)); km[e] = k4[e] * __expf(fminf(Lm[e] - Lt[e], 80.f)); }
        unsigned char* base = OP + c * CL::SIZE + t * CL::PQ + k * 2;
        u32x2 w; w.x = cvtpk(qe[0], qe[1]); w.y = cvtpk(qe[2], qe[3]); *(u32x2*)(base + CL::QE) = w;
        w.x = cvtpk(qm[0], qm[1]); w.y = cvtpk(qm[2], qm[3]); *(u32x2*)(base + CL::QM) = w;
        w.x = cvtpk(km[0], km[1]); w.y = cvtpk(km[2], km[3]); *(u32x2*)(base + CL::KM) = w;
    }
    for (int idx = t0; idx < 4 * KD; idx += nthr) {
        const int k = idx % KD, oc = (idx / KD) & 1, c = idx / (2 * KD);
        const float Le = LVEC ? rL[(c * 16 + 15) * KD + k] : rL[c * 16 + 15];
        float w[8];
#pragma unroll
        for (int e = 0; e < 8; ++e) { const int row = c * 16 + 8 * oc + e; const float Lt = LVEC ? rL[row * KD + k] : rL[row]; w[e] = rk[row * KD + k] * __expf(Le - Lt); }
        u32x4 o; o.x = cvtpk(w[0], w[1]); o.y = cvtpk(w[2], w[3]); o.z = cvtpk(w[4], w[5]); o.w = cvtpk(w[6], w[7]);
        *(u32x4*)(OP + c * CL::SIZE + CL::KWT + k * CL::PT + oc * 16) = o;
        if (oc == 0) *(float*)(OP + c * CL::SIZE + CL::G + k * 4) = __expf(Le);
    }
    for (int idx = t0; idx < 4 * VN; idx += nthr) {
        const int v = idx % VN, oc = (idx / VN) & 1, c = idx / (2 * VN);
        float w[8];
#pragma unroll
        for (int e = 0; e < 8; ++e) w[e] = rv[(c * 16 + 8 * oc + e) * VN + v];
        u32x4 o; o.x = cvtpk(w[0], w[1]); o.y = cvtpk(w[2], w[3]); o.z = cvtpk(w[4], w[5]); o.w = cvtpk(w[6], w[7]);
        *(u32x4*)(OP + c * CL::SIZE + CL::VT + v * CL::PT + oc * 16) = o;
    }
}
template <int KD, int VN>
__device__ __forceinline__ void zero_operand_pads(unsigned char* OP, int t0, int nthr) {
    using CL = ChunkLds<KD, VN>;
    for (int idx = t0; idx < 2 * (KD + VN) * 2; idx += nthr) {
        const int half = idx & 1, r = (idx >> 1) % (KD + VN), c = (idx >> 1) / (KD + VN);
        unsigned char* row = OP + c * CL::SIZE + (r < KD ? CL::KWT + r * CL::PT : CL::VT + (r - KD) * CL::PT);
        *(u32x4*)(row + 32 + half * 16) = (u32x4){0u, 0u, 0u, 0u};
    }
}
constexpr int L_RAW_Q = 0, L_RAW_K = 16384, L_RAW_L = 32768, L_RAW_V = 49152, L_OP = 65536;

__device__ __forceinline__ void scan_ret_mfma(const Params& P, unsigned char* LB, int c) {
    const int tid = tid_(), lane = tid & 63, wave = __builtin_amdgcn_readfirstlane(tid >> 6), fr = lane & 15, fq = lane >> 4;
    const int vh = c & 1, b = c >> 4, h = (c >> 2) & 3, d = (c >> 1) & 1;
    const float* U = (const float*)(P.ws + WS_U); bf16* YD = (bf16*)(P.ws + WS_YD);
    float* rq = (float*)(LB + L_RAW_Q); float* rk = (float*)(LB + L_RAW_K); float* rL = (float*)(LB + L_RAW_L); float* rv = (float*)(LB + L_RAW_V);
    float* rope = (float*)(LB + L_RAW_L + 1024);
    unsigned char* OP = LB + L_OP;
    const float la = __logf(1.f - exp2f(-5.f - (float)h));
    const int st = tid >> 4, rem = tid & 15, isk = rem >> 3, hs = (rem >> 2) & 1, cc = rem & 3;
    __syncthreads();
    for (int i = tid; i < 1024; i += 512) { const int pos = i >> 4, fi = i & 15; const float inv = exp2f(-(float)fi * 0.83048202372184f); const float rev = ((float)pos * inv) * 0.15915494309189535f;
        rope[2 * i] = __builtin_amdgcn_cosf(rev); rope[2 * i + 1] = __builtin_amdgcn_sinf(rev); }
    if (tid < 32) rL[tid] = (float)((tid & 15) + 1) * la;
    zero_operand_pads<64, 64>(OP, tid, 512);
    f32x4 S[4];
#pragma unroll
    for (int i = 0; i < 4; ++i) S[i] = (f32x4){0.f, 0.f, 0.f, 0.f};
    f32x4 r1, r2, rv0;
    const int qkbase = (isk ? G_RT_K : G_RT_Q) + h * 64 + hs * 32 + 4 * cc;
#define RETM_LOAD(tile) do { const bf16* ur_ = (const bf16*)(P.ws + WS_UG) + (size_t)scan_row(b, d, (tile) * 32 + st) * NUG; r1 = ld_bf4(ur_ + qkbase); r2 = ld_bf4(ur_ + qkbase + 16); \
        rv0 = ld_bf4((const bf16*)(P.ws + WS_UG) + (size_t)scan_row(b, d, (tile) * 32 + st) * NUG + G_RT_V + h * 128 + vh * 64 + rem * 4); } while (0)
    RETM_LOAD(0);
    for (int tile = 0; tile < NTILES; ++tile) {
        { f32x4 o1 = r1, o2 = r2;
          if (tile >= TC / 32) {
              const int tok = scan_row(b, d, tile * 32 + st) & (TL - 1); const int pos = hs ? (tok & 63) : (tok >> 6);
              const f32x4 cs0 = *(const f32x4*)&rope[(pos * 16 + 4 * cc) * 2], cs1 = *(const f32x4*)&rope[(pos * 16 + 4 * cc) * 2 + 4];
              const f32x4 cv = {cs0.x, cs0.z, cs1.x, cs1.z}, sv = {cs0.y, cs0.w, cs1.y, cs1.w};
              o1 = r1 * cv - r2 * sv; o2 = r1 * sv + r2 * cv;
          }
          float* dst = isk ? rk : rq; const float scl = isk ? 0.125f : 1.f;
          *(f32x4*)&dst[st * 64 + hs * 32 + 4 * cc] = o1 * scl; *(f32x4*)&dst[st * 64 + hs * 32 + 16 + 4 * cc] = o2 * scl;
          *(f32x4*)&rv[st * 64 + rem * 4] = rv0; }
        __syncthreads();
        if (tile + 1 < NTILES) RETM_LOAD(tile + 1);
        build_operands<64, 64, false>(rq, rk, rL, rv, OP, tid, 512);
        __syncthreads();
        if (wave < 4) {
#pragma unroll
        for (int ch = 0; ch < 2; ++ch) {
            const f32x4 y = chunk_step<64, 64>(OP + ch * ChunkLds<64, 64>::SIZE, wave * 16, fr, fq, S);
            const int row = scan_row(b, d, tile * 32 + ch * 16 + fr);
            { u32x2 w_; w_.x = cvtpk(y[0], y[1]); w_.y = cvtpk(y[2], y[3]); *(u32x2*)(YD + ((size_t)(3 * 2 + d) * MALL + row) * 512 + h * 128 + vh * 64 + wave * 16 + 4 * fq) = w_; }
        }
        }
    }
#undef RETM_LOAD
}

__device__ __forceinline__ void scan_hgrn_mfma(const Params& P, unsigned char* LB, int l, int c) {
    using CL = ChunkLds<128, 64>;
    const int tid = tid_(), lane = tid & 63, wave = __builtin_amdgcn_readfirstlane(tid >> 6), fr = lane & 15, fq = lane >> 4;
    const int vq = c & 1, b = c >> 4, h = (c >> 2) & 3, d = (c >> 1) & 1;
    const float* U = (const float*)(P.ws + WS_U); bf16* YD = (bf16*)(P.ws + WS_YD);
    unsigned char* OP = LB;
    float* tot = (float*)(LB + 58368);
    const int k = 2 * lane, qt = wave & 3, cb = wave >> 2;
    const int vv_ = tid & 63, vqt = wave & 3, vc = wave >> 2;
    f32x2 lb2 = {0.f, 0.f};
    if (l == 1) { const f32x2 g0 = *(const f32x2*)(P.hgrn_lb_logits + (size_t)(d * 2 + 0) * 512 + h * 128 + k), g1 = *(const f32x2*)(P.hgrn_lb_logits + (size_t)(d * 2 + 1) * 512 + h * 128 + k);
        lb2.x = sigmoid_(g1.x - g0.x); lb2.y = sigmoid_(g1.y - g0.y); }
    __syncthreads();
    zero_operand_pads<128, 64>(OP, tid, 512);
    f32x4 S[8];
#pragma unroll
    for (int i = 0; i < 8; ++i) S[i] = (f32x4){0.f, 0.f, 0.f, 0.f};
    f32x2 pq[4], pf[4]; float pv[4] = {0.f, 0.f, 0.f, 0.f};
#define HGM_LOAD(tile) do { _Pragma("unroll") for (int r_ = 0; r_ < 4; ++r_) { const float* u_ = U + (size_t)scan_row(b, d, (tile) * 32 + cb * 16 + qt * 4 + r_) * NUF; \
        { const unsigned qw_ = *(const unsigned*)((const bf16*)(P.ws + WS_UG) + (size_t)scan_row(b, d, (tile) * 32 + cb * 16 + qt * 4 + r_) * NUG + G_HG_Q + h * 128 + k); pq[r_] = (f32x2){__builtin_bit_cast(float, qw_ << 16), __builtin_bit_cast(float, qw_ & 0xffff0000u)}; } \
        pf[r_] = *(const f32x2*)(u_ + U_HG_F + d * 512 + h * 128 + k); } \
        { _Pragma("unroll") for (int r_ = 0; r_ < 4; ++r_) pv[r_] = __builtin_bit_cast(float, (unsigned)((const bf16*)(P.ws + WS_UG))[(size_t)scan_row(b, d, (tile) * 32 + vc * 16 + vqt * 4 + r_) * NUG + G_HG_I + h * 128 + vq * 64 + vv_] << 16); } } while (0)
    HGM_LOAD(0);
    for (int tile = 0; tile < NTILES; ++tile) {
        f32x2 q[4], kk[4], pre[4], suf[4]; float vv[4];
        { f32x2 fc[4];
#pragma unroll
          for (int r = 0; r < 4; ++r) {
              const float eq0 = 1.f + __expf(fminf(-pq[r].x, 40.f)), ef0 = 1.f + __expf(fminf(-pf[r].x, 40.f)), r0_ = __builtin_amdgcn_rcpf(eq0 * ef0);
              const float eq1 = 1.f + __expf(fminf(-pq[r].y, 40.f)), ef1 = 1.f + __expf(fminf(-pf[r].y, 40.f)), r1_ = __builtin_amdgcn_rcpf(eq1 * ef1);
              q[r].x = pq[r].x * (ef0 * r0_) * 0.08838834764831845f; q[r].y = pq[r].y * (ef1 * r1_) * 0.08838834764831845f;
              const float f0 = lb2.x + (1.f - lb2.x) * (eq0 * r0_), f1 = lb2.y + (1.f - lb2.y) * (eq1 * r1_);
              kk[r].x = 1.f - f0; kk[r].y = 1.f - f1; fc[r].x = fmaxf(f0, 1e-4f); fc[r].y = fmaxf(f1, 1e-4f); vv[r] = pv[r];
          }
          pre[0] = fc[0]; pre[1] = pre[0] * fc[1]; pre[2] = pre[1] * fc[2]; pre[3] = pre[2] * fc[3];
          suf[3] = (f32x2){1.f, 1.f}; suf[2] = fc[3]; suf[1] = suf[2] * fc[2]; suf[0] = suf[1] * fc[1]; }
        *(f32x2*)&tot[(cb * 4 + qt) * 128 + k] = pre[3];
        __syncthreads();
        if (tile + 1 < NTILES) HGM_LOAD(tile + 1);
        {
            const f32x2 t0 = *(const f32x2*)&tot[(cb * 4 + 0) * 128 + k], t1 = *(const f32x2*)&tot[(cb * 4 + 1) * 128 + k], t2 = *(const f32x2*)&tot[(cb * 4 + 2) * 128 + k], t3 = *(const f32x2*)&tot[(cb * 4 + 3) * 128 + k];
            const f32x2 Pm = t0 * t1, T23 = t2 * t3;
            unsigned char* C = OP + cb * CL::SIZE;
            float kw0[4], kw1[4];
#pragma unroll
            for (int r = 0; r < 4; ++r) {
                const int t = qt * 4 + r;
                f32x2 R, iR;
                if (qt >= 2) { R = pre[r]; if (qt == 3) R *= t2; iR.x = __builtin_amdgcn_rcpf(R.x); iR.y = __builtin_amdgcn_rcpf(R.y); }
                else { iR = suf[r]; if (qt == 0) iR *= t1; R.x = __builtin_amdgcn_rcpf(iR.x); R.y = __builtin_amdgcn_rcpf(iR.y); }
                const f32x2 Pt = Pm * R;
                unsigned char* p = C + t * CL::PQ + k * 2;
                *(unsigned*)(p + CL::QE) = cvtpk(q[r].x * Pt.x, q[r].y * Pt.y);
                *(unsigned*)(p + CL::QM) = cvtpk(q[r].x * R.x, q[r].y * R.y);
                *(unsigned*)(p + CL::KM) = cvtpk(kk[r].x * iR.x, kk[r].y * iR.y);
                kw0[r] = kk[r].x * T23.x * iR.x; kw1[r] = kk[r].y * T23.y * iR.y;
            }
            u32x2 w; w.x = cvtpk(kw0[0], kw0[1]); w.y = cvtpk(kw0[2], kw0[3]); *(u32x2*)(C + CL::KWT + k * CL::PT + qt * 8) = w;
            w.x = cvtpk(kw1[0], kw1[1]); w.y = cvtpk(kw1[2], kw1[3]); *(u32x2*)(C + CL::KWT + (k + 1) * CL::PT + qt * 8) = w;
            if (qt == 0) *(f32x2*)(C + CL::G + k * 4) = Pm * T23;
            { u32x2 wv; wv.x = cvtpk(vv[0], vv[1]); wv.y = cvtpk(vv[2], vv[3]); *(u32x2*)(OP + vc * CL::SIZE + CL::VT + vv_ * CL::PT + vqt * 8) = wv; }
        }
        __syncthreads();
        if (wave < 4) {
#pragma unroll
            for (int ch = 0; ch < 2; ++ch) {
                const f32x4 y = chunk_step<128, 64>(OP + ch * CL::SIZE, wave * 16, fr, fq, S);
                const int row = scan_row(b, d, tile * 32 + ch * 16 + fr);
                { u32x2 w_; w_.x = cvtpk(y[0], y[1]); w_.y = cvtpk(y[2], y[3]); *(u32x2*)(YD + ((size_t)(2 * 2 + d) * MALL + row) * 512 + h * 128 + vq * 64 + wave * 16 + 4 * fq) = w_; }
            }
        }
    }
#undef HGM_LOAD
}
__device__ __forceinline__ void scan_ssd_mfma(const Params& P, unsigned char* LB, int l, int c) {
    const int tid = tid_(), lane = tid & 63, wave = __builtin_amdgcn_readfirstlane(tid >> 6), fr = lane & 15, fq = lane >> 4;
    const int b = c >> 4, d = (c >> 3) & 1, h = c & 7, g = h >> 2;
    const float* U = (const float*)(P.ws + WS_U); const bf16* XBC = (const bf16*)(P.ws + WS_XBC); bf16* YD = (bf16*)(P.ws + WS_YD);
    float* rq = (float*)(LB + L_RAW_Q); float* rk = (float*)(LB + L_RAW_K); float* rL = (float*)(LB + L_RAW_L); float* lg = (float*)(LB + L_RAW_L + 256); float* rv = (float*)(LB + L_RAW_V);
    unsigned char* OP = LB + L_OP;
    const float dtb = P.ssd_dt_bias[(l * 2 + d) * 8 + h], aneg = -__expf(P.ssd_a_log[(l * 2 + d) * 8 + h]);
    const int st = tid >> 4, sc4 = (tid & 15) << 2;
    __syncthreads();
    zero_operand_pads<64, 64>(OP, tid, 512);
    f32x4 S[4];
#pragma unroll
    for (int i = 0; i < 4; ++i) S[i] = (f32x4){0.f, 0.f, 0.f, 0.f};
    f32x4 px, pB, pC; float pdt;
#define SSM_LOAD(tile) do { const int row_ = scan_row(b, d, (tile) * 32 + st); const bf16* xr_ = XBC + (size_t)row_ * 768; \
        px = ld_bf4(xr_ + h * 64 + sc4); pB = ld_bf4(xr_ + 512 + g * 64 + sc4); pC = ld_bf4(xr_ + 640 + g * 64 + sc4); pdt = U[(size_t)row_ * NUF + U_SSD_DT + d * 8 + h]; } while (0)
    SSM_LOAD(0);
    for (int tile = 0; tile < NTILES; ++tile) {
        { const float delta = softplus_(pdt + dtb); const int o = st * 64 + sc4;
          *(f32x4*)&rv[o] = px; *(f32x4*)&rk[o] = pB * delta; *(f32x4*)&rq[o] = pC;
          if ((tid & 15) == 0) lg[st] = aneg * delta; }
        __syncthreads();
        if (tile + 1 < NTILES) SSM_LOAD(tile + 1);
        if (tid < 32) { const int c0 = tid & 16; float acc = 0.f;
#pragma unroll
            for (int t = 0; t < 16; ++t) { const float v_ = lg[c0 + t]; acc += (c0 + t <= tid) ? v_ : 0.f; }
            rL[tid] = acc; }
        __syncthreads();
        build_operands<64, 64, false>(rq, rk, rL, rv, OP, tid, 512);
        __syncthreads();
        if (wave < 4) {
#pragma unroll
            for (int ch = 0; ch < 2; ++ch) {
                const f32x4 y = chunk_step<64, 64>(OP + ch * ChunkLds<64, 64>::SIZE, wave * 16, fr, fq, S);
                const int row = scan_row(b, d, tile * 32 + ch * 16 + fr);
                { u32x2 w_; w_.x = cvtpk(y[0], y[1]); w_.y = cvtpk(y[2], y[3]); *(u32x2*)(YD + ((size_t)(0 * 2 + d) * MALL + row) * 512 + h * 64 + wave * 16 + 4 * fq) = w_; }
            }
        }
    }
#undef SSM_LOAD
}
__device__ __forceinline__ void scan_lru(const Params& P, float* L, int c) {
    const int tid = tid_(), ch = tid & 63, seg = __builtin_amdgcn_readfirstlane(tid >> 6), b = c >> 3, d = (c >> 2) & 1, cgp = c & 3;
    const float* LA = (const float*)(P.ws + WS_LA) + (size_t)d * MALL * 512 + cgp * 128 + ch; const bf16* LBp = (const bf16*)(P.ws + WS_LB) + (size_t)d * MALL * 512 + cgp * 128 + ch;
    bf16* YD = (bf16*)(P.ws + WS_YD) + (size_t)(1 * 2 + d) * MALL * 512 + cgp * 128 + ch;
    float* car = L;
    const int s0 = seg * 288;
    __syncthreads();
    float h0 = 0.f, h1 = 0.f, ap0 = 1.f, ap1 = 1.f;
#pragma unroll 1
    for (int pass = 0; pass < 2; ++pass) {
        float a0[16], b0[16], c0[16], d0[16];
#pragma unroll
        for (int s = 0; s < 16; ++s) { const size_t r = (size_t)scan_row(b, d, s0 + s) * 512; a0[s] = LA[r]; b0[s] = __builtin_bit_cast(float, (unsigned)LBp[r] << 16); c0[s] = LA[r + 64]; d0[s] = __builtin_bit_cast(float, (unsigned)LBp[r + 64] << 16); }
#pragma unroll 1
        for (int tile = 0; tile < 18; ++tile) {
            float a1[16], b1[16], c1[16], d1[16];
            if (tile + 1 < 18) {
#pragma unroll
                for (int s = 0; s < 16; ++s) { const size_t r = (size_t)scan_row(b, d, s0 + (tile + 1) * 16 + s) * 512; a1[s] = LA[r]; b1[s] = __builtin_bit_cast(float, (unsigned)LBp[r] << 16); c1[s] = LA[r + 64]; d1[s] = __builtin_bit_cast(float, (unsigned)LBp[r + 64] << 16); }
            }
            if (pass == 0) {
#pragma unroll
                for (int s = 0; s < 16; ++s) { h0 = a0[s] * h0 + b0[s]; ap0 *= a0[s]; h1 = c0[s] * h1 + d0[s]; ap1 *= c0[s]; }
            } else {
#pragma unroll
                for (int s = 0; s < 16; ++s) { h0 = a0[s] * h0 + b0[s]; h1 = c0[s] * h1 + d0[s]; const size_t r = (size_t)scan_row(b, d, s0 + tile * 16 + s) * 512; YD[r] = (bf16)f2bf(h0); YD[r + 64] = (bf16)f2bf(h1); }
            }
#pragma unroll
            for (int s = 0; s < 16; ++s) { a0[s] = a1[s]; b0[s] = b1[s]; c0[s] = c1[s]; d0[s] = d1[s]; }
        }
        if (pass == 0) {
            car[(seg * 128 + ch) * 2] = ap0; car[(seg * 128 + ch) * 2 + 1] = h0; car[(seg * 128 + 64 + ch) * 2] = ap1; car[(seg * 128 + 64 + ch) * 2 + 1] = h1;
            __syncthreads();
            float hin0 = 0.f, hin1 = 0.f;
            for (int sg = 0; sg < seg; ++sg) { hin0 = car[(sg * 128 + ch) * 2] * hin0 + car[(sg * 128 + ch) * 2 + 1]; hin1 = car[(sg * 128 + 64 + ch) * 2] * hin1 + car[(sg * 128 + 64 + ch) * 2 + 1]; }
            h0 = hin0; h1 = hin1;
        }
    }
}
__device__ __forceinline__ void scan_phase(const Params& P, float* L, int l) {
    for (int it = bid_(); it < 224; it += gridDim.x) {
        if (it < 64) scan_hgrn_mfma(P, (unsigned char*)L, l, it);
        else if (it < 128) scan_ssd_mfma(P, (unsigned char*)L, l, it - 64);
        else if (it < 192) scan_ret_mfma(P, (unsigned char*)L, it - 128);
        else scan_lru(P, L, it - 192);
    }
}

__device__ __forceinline__ void post_phase(const Params& P, int l, int mrows) {
    const int tid = tid_(), lane = tid & 63, wave = __builtin_amdgcn_readfirstlane(tid >> 6);
    const int gw = bid_() * 8 + wave, NGW = gridDim.x * 8;
    const float* U = (const float*)(P.ws + WS_U); const bf16* YD = (const bf16*)(P.ws + WS_YD); bf16* YC = (bf16*)(P.ws + WS_H);
    for (int row = gw; row < mrows; row += NGW) {
        const bf16* ug = (const bf16*)(P.ws + WS_UG) + (size_t)row * NUG; bf16* yc = YC + (size_t)row * DM;
#define YDP(m, d) (YD + ((size_t)((m) * 2 + (d)) * MALL + row) * 512)
#define LDY(p) ld_bf4(p)
        {
            f32x4 gg[2]; float ss = 0.f;
#pragma unroll
            for (int j = 0; j < 2; ++j) { const int c = 4 * lane + 256 * j; const float dsk = P.ssd_d[l * 8 + (c >> 6)]; const f32x4 y = LDY(YDP(0, 0) + c) + LDY(YDP(0, 1) + c) + ld_bf4((const bf16*)(P.ws + WS_XBC) + (size_t)row * 768 + c) * dsk; const f32x4 z = ld_bf4(ug + G_SSD_Z + c);
                f32x4 t; t.x = y.x * silu_(z.x); t.y = y.y * silu_(z.y); t.z = y.z * silu_(z.z); t.w = y.w * silu_(z.w); gg[j] = t; ss += dot4(t); }
            const float rs = rsqrtf(wave_sum(ss) * (1.f / 512.f) + EPS);
#pragma unroll
            for (int j = 0; j < 2; ++j) { const int c = 4 * lane + 256 * j; const f32x4 w = *(const f32x4*)(P.ssd_norm_w + (size_t)l * 512 + c); const f32x4 o = gg[j] * rs * w;
                u32x2 pk; pk.x = pk2(o.x, o.y); pk.y = pk2(o.z, o.w); *(u32x2*)(yc + c) = pk; }
        }
        {
#pragma unroll
            for (int j = 0; j < 2; ++j) { const int c = 4 * lane + 256 * j; const f32x4 hh = LDY(YDP(1, 0) + c) + LDY(YDP(1, 1) + c); const f32x4 gb = ld_bf4(ug + G_LRU_G + c);
                f32x4 o; o.x = hh.x * gelu_tanh_(gb.x); o.y = hh.y * gelu_tanh_(gb.y); o.z = hh.z * gelu_tanh_(gb.z); o.w = hh.w * gelu_tanh_(gb.w);
                u32x2 pk; pk.x = pk2(o.x, o.y); pk.y = pk2(o.z, o.w); *(u32x2*)(yc + 512 + c) = pk; }
        }
        {
#pragma unroll
            for (int j = 0; j < 2; ++j) { const int c = 4 * lane + 256 * j; const f32x4 o = LDY(YDP(2, 0) + c) + LDY(YDP(2, 1) + c);
                const float rs = rsqrtf(half_sum(dot4(o)) * (1.f / 128.f) + EPS); const f32x4 w = *(const f32x4*)(P.hgrn_norm_w + (size_t)l * 128 + (c & 127)); const f32x4 gt = ld_bf4(ug + G_HG_G + c);
                f32x4 r; r.x = o.x * rs * w.x * silu_(gt.x); r.y = o.y * rs * w.y * silu_(gt.y); r.z = o.z * rs * w.z * silu_(gt.z); r.w = o.w * rs * w.w * silu_(gt.w);
                u32x2 pk; pk.x = pk2(r.x, r.y); pk.y = pk2(r.z, r.w); *(u32x2*)(yc + 1024 + c) = pk; }
        }
        {
#pragma unroll
            for (int j = 0; j < 2; ++j) { const int c = 4 * lane + 256 * j; const f32x4 o = LDY(YDP(3, 0) + c) + LDY(YDP(3, 1) + c);
                const float rs = rsqrtf(half_sum(dot4(o)) * (1.f / 128.f) + EPS); const f32x4 gt = ld_bf4(ug + G_RT_G + c);
                f32x4 r; r.x = o.x * rs * silu_(gt.x); r.y = o.y * rs * silu_(gt.y); r.z = o.z * rs * silu_(gt.z); r.w = o.w * rs * silu_(gt.w);
                u32x2 pk; pk.x = pk2(r.x, r.y); pk.y = pk2(r.z, r.w); *(u32x2*)(yc + 1536 + c) = pk; }
        }
#undef YDP
    }
}

__global__ void __launch_bounds__(512, 2) mk_fwd(Params Pkarg) {
    extern __shared__ __attribute__((aligned(16))) unsigned char lds_raw[];
    float* L = (float*)lds_raw;
    const __attribute__((address_space(4))) Params* kp = (const __attribute__((address_space(4))) Params*)__builtin_amdgcn_kernarg_segment_ptr();
    const int ph_lo = kp->ph_lo, ph_hi = kp->ph_hi;
    {
        volatile LAS unsigned* st0 = (volatile LAS unsigned*)((LAS unsigned char*)lds_raw + (LDS_BYTES - 128));
        if (threadIdx.x == 0) { st0[0] = 0u; st0[1] = 0u; }
        __syncthreads();
        (void)xcd_barrier_post((unsigned*)kp->ws, st0);
    }
    for (int ph = ph_lo; ph < ph_hi; ++ph) {
        asm volatile("" : "+s"(kp));
#if defined(__HIP_DEVICE_COMPILE__)
        const Params P = *kp;
#else
        const Params P = Pkarg;
#endif
        unsigned char* ws = P.ws;
#ifdef PROBE_DUP
        const int kk_ = ph < 2 ? 100 + ph : (ph - 2) % 12;
        const int nrep_ = (kk_ == PROBE_DUP || kk_ == PROBE_DUP2) ? 2 : 1;
        for (int rep_ = 0; rep_ < nrep_; ++rep_) { if (rep_) cg::this_grid().sync();
#endif
        if (ph == 0) prologue_phase(P, L);
        else if (ph == 1) rowwise_phase(P, MALL, true, 0, 0, 0, 0.f, false, 0, 0, 0, 1);
        else {
            const int q = ph - 2, l = q / 12, k = q % 12;
            const int Mg = (l == 1 && k >= 6) ? MLAT : MALL;
            if (k == 0 || k == 9) {
                const int lf = l * 2 + (k == 9);
                pg8::Gemm g{(const pg8::bf16_t*)(ws + WS_H), (const pg8::bf16_t*)(ws + WS_W13) + (size_t)lf * NUP * DM, Mg, NUP, DM, DM};
                pg8::StaticOrder S; S.init(Mg, NUP, (int)gridDim.x, bid_());
                pg8::EpiSwiGLU E{(pg8::bf16_t*)(ws + WS_U), FF};
                pg8::gemm_phase<pg8::EpiSwiGLU, pg8::StaticOrder, true, true>((LAS unsigned char*)lds_raw, g, S, E);
            } else if (k == 1 || k == 10 || k == 3 || k == 7) {
                const pg8::bf16_t* A; const pg8::bf16_t* Bt; int N, K; float* O;
                if (k == 3) { A = (const pg8::bf16_t*)(ws + WS_H); Bt = (const pg8::bf16_t*)(ws + WS_WIN) + (size_t)l * NINP_W * DM; N = NINP_W; K = DM; O = (float*)(ws + WS_U); }
                else if (k == 7) { A = (const pg8::bf16_t*)(ws + WS_H); Bt = (const pg8::bf16_t*)(ws + WS_WOUT) + (size_t)l * DM * DM; N = DM; K = DM; O = (float*)(ws + WS_Y); }
                else { const int lf = l * 2 + (k == 10); A = (const pg8::bf16_t*)(ws + WS_U); Bt = (const pg8::bf16_t*)(ws + WS_W2) + (size_t)lf * DM * FF; N = DM; K = FF; O = (float*)(ws + WS_Y); }
                const bool splitk = (k != 3) && (Mg == MALL);
                const int M1 = splitk ? MLAT : Mg;
                { pg8::Gemm g{A, Bt, M1, N, K, K};
                  pg8::Order2 S; S.so.init(M1, N, (int)gridDim.x, bid_()); S.one = 0; S.valid = 1; S.u1.pm = 0; S.u1.pn = 0;
                  pg8::EpiF32 E{O, (k == 3) ? NUF : N, (k != 3) ? 1 : 0, (pg8::bf16_t*)(ws + WS_UG), NUG, (k == 3) ? NUF / 256 : 0};
                  pg8::gemm_phase<pg8::EpiF32, pg8::Order2, true, true>((LAS unsigned char*)lds_raw, g, S, E); }
                if (splitk) {
                    for (int c = bid_(); c < 256; c += (int)gridDim.x) {
                        const int u = c >> 3, ks = c & 7, nt2 = K >> 7;
                        const int kt0 = 2 * ((ks * nt2) >> 3), kt1 = 2 * (((ks + 1) * nt2) >> 3);
                        pg8::Gemm g{A + kt0 * 64, Bt + kt0 * 64, MALL, N, (kt1 - kt0) * 64, K};
                        pg8::Order2 S; S.so.init(MALL, N, 1, 0); S.one = 1; S.valid = 1; S.u1.pm = 32 + (u >> 3); S.u1.pn = u & 7;
                        pg8::EpiF32 E{(float*)((bf16*)(ws + WS_YD) + (size_t)ks * MCTX * DM - (size_t)MLAT * DM), N, 1, nullptr, 0, 0};
                        pg8::gemm_phase<pg8::EpiF32, pg8::Order2, true, true>((LAS unsigned char*)lds_raw, g, S, E);
                    }
                }
            } else if (k == 2) rowwise_phase(P, MALL, false, l, 0, 2, 0.5f, false, l, 1, 3, 4);
            else if (k == 8) rowwise_phase(P, Mg, false, l, 1, 5, 1.0f, false, l, 2, 6, 7);
            else if (k == 11) rowwise_phase(P, Mg, false, l, 2, 8, 0.5f, l == 1, l + 1, 0, 0, 1);
            else if (k == 4) prep_phase(P, L, l);
            else if (k == 5) scan_phase(P, L, l);
            else post_phase(P, l, Mg);
        }
#ifdef PROBE_DUP
        }
#endif
        if (ph + 1 < ph_hi) {
            if (ph == 0) cg::this_grid().sync();
            else { XcdBarrier xb; xb.bar = (unsigned*)ws; xb.x = xb_xcc_id(); xb.st = (volatile LAS unsigned*)((LAS unsigned char*)lds_raw + (LDS_BYTES - 128)); xcd_barrier(xb); }
        }
    }
}

extern "C" void kernel_launch(void* const* d_in, const int* in_sizes, int n_in, void* d_out, int out_size, void* d_ws, size_t ws_size, hipStream_t stream) {
    static int grid = 0;
    if (grid == 0) {
        if (n_in != 28 || out_size != MLAT * DM || ws_size < WS_END) { fprintf(stderr, "kernel_launch: unexpected shapes (n_in %d out %d ws %zu need %zu)\n", n_in, out_size, ws_size, (size_t)WS_END); grid = -1; return; }
        int dev = 0, cus = 0, per_cu = 0;
        (void)hipGetDevice(&dev); (void)hipDeviceGetAttribute(&cus, hipDeviceAttributeMultiprocessorCount, dev);
        if (hipFuncSetAttribute((const void*)mk_fwd, hipFuncAttributeMaxDynamicSharedMemorySize, LDS_BYTES) != hipSuccess) { fprintf(stderr, "kernel_launch: hipFuncSetAttribute failed\n"); grid = -1; return; }
        if (hipOccupancyMaxActiveBlocksPerMultiprocessor(&per_cu, (const void*)mk_fwd, 512, LDS_BYTES) != hipSuccess || per_cu < 1) { fprintf(stderr, "kernel_launch: occupancy query says %d\n", per_cu); per_cu = 1; }
        (void)hipGetLastError();
        grid = cus * per_cu;
    }
    if (grid < 0) return;
    (void)hipMemsetAsync(d_ws, 0, 16384, stream);
    Params p{};
    const float** pp = (const float**)&p;
    for (int i = 0; i < 28; ++i) pp[i] = (const float*)d_in[i];
    p.out = (float*)d_out; p.ws = (unsigned char*)d_ws;
#if MK_SINGLE
    p.ph_lo = 0; p.ph_hi = NPHASES;
    void* args[] = {&p};
    hipError_t e = hipLaunchCooperativeKernel((const void*)mk_fwd, dim3(grid), dim3(512), args, LDS_BYTES, stream);
    if (e != hipSuccess) fprintf(stderr, "cooperative launch failed: %s (grid %d)\n", hipGetErrorString(e), grid);
#else
    for (int ph = 0; ph < NPHASES; ++ph) { p.ph_lo = ph; p.ph_hi = ph + 1; hipLaunchKernelGGL(mk_fwd, dim3(grid), dim3(512), LDS_BYTES, stream, p); }
#endif
}
```

```cpp
#include <hip/hip_runtime.h>
#include <hip/hip_cooperative_groups.h>
#include <cstdio>
#include <cstdint>
namespace cg = cooperative_groups;
#ifndef MK_SINGLE
#define MK_SINGLE 1
#endif
namespace pg8 {
#define PG8_LAS __attribute__((address_space(3)))
typedef unsigned short bf16_t;
typedef short bf16x8 __attribute__((ext_vector_type(8)));
typedef float f32x4 __attribute__((ext_vector_type(4)));
typedef unsigned u32x4 __attribute__((ext_vector_type(4)));
constexpr int BM = 256, BK = 64, HALF = 128, HTB = HALF * BK * 2  , STAGE_BYTES = 8 * HTB, NXCD = 8, WGM = 8;

__host__ __device__ __forceinline__ int lds_byte(int r, int c) { const int st = (r >> 4) * 2 + (c >> 5), rr = r & 15, cc = c & 31, ob = rr * 64 + cc * 2; return st * 1024 + (ob ^ (((ob >> 9) & 1) << 5)); }
__host__ __device__ __forceinline__ void stage_rc(int b, int& R, int& C) { const int st = b / 1024, sb = b % 1024, swz = sb ^ (((sb >> 9) & 1) << 5); R = (st >> 1) * 16 + swz / 64; C = (st & 1) * 32 + (swz % 64) / 2; }
__host__ __device__ __forceinline__ int perm32(int rho) { const int n = rho >> 4, i = rho & 15; return 8 * (i >> 2) + 4 * n + (i & 3); }

struct Unit { int pm, pn; };
struct Gemm { const bf16_t* A; const bf16_t* Bt; int M, N, K, ld; };

struct StaticOrder {
    int nM, nN, nwg, G, c;
    __host__ __device__ void init(int M, int N, int G_, int c_) { nM = M / BM; nN = N / BM; nwg = nM * nN; G = G_; c = c_; }
    __host__ __device__ bool next(int i, Unit& u) const {
        const long L = (long)i * G + c; if (L >= nwg) return false;
        int wgid = (int)L; { const int q = nwg / NXCD, r = nwg % NXCD, xcd = wgid % NXCD, off = wgid / NXCD; wgid = (xcd < r ? xcd * (q + 1) : r * (q + 1) + (xcd - r) * q) + off; }
        const int nig = WGM * nN, gid = wgid / nig, fm = gid * WGM, gsz = (nM - fm) < WGM ? (nM - fm) : WGM;
        u.pm = fm + ((wgid % nig) % gsz); u.pn = (wgid % nig) / gsz; return true;
    }
    __device__ __forceinline__ void a_ready(const Unit&) const {}
    __device__ __forceinline__ void done(const Unit&) const {}
};

__device__ __forceinline__ unsigned cvt_pk_bf16(float lo, float hi) { unsigned r; asm volatile("v_cvt_pk_bf16_f32 %0, %1, %2" : "=v"(r) : "v"(lo), "v"(hi)); return r; }
template <class Epi, class Sched, bool ALIGN_EPI = false, bool SP2 = false>
__device__ __forceinline__ void gemm_phase(PG8_LAS unsigned char* lds, const Gemm g, const Sched& S, const Epi& E) {
    int tid_l = threadIdx.x; asm volatile("" : "+v"(tid_l)); const int tid = tid_l, wid = __builtin_amdgcn_readfirstlane(tid >> 6), lane = tid & 63, wr = wid >> 2, wc = wid & 3, fr = lane & 15, fq = lane >> 4;
    const int K = g.ld, nt = g.K / BK;
    unsigned voffA[2], voffB[2];
#pragma unroll
    for (int i = 0; i < 2; ++i) { int R, C; stage_rc(tid * 16 + i * 8192, R, C); const int Rb = Epi::PERM ? ((R & ~31) + perm32(R & 31)) : R;
        voffA[i] = (unsigned)(R * K + C) * 2u; voffB[i] = (unsigned)(Rb * K + C) * 2u; }
    const size_t kstep = (size_t)(BK * 2);
    const size_t hstep = (size_t)HALF * K * 2;
    const size_t tstep = 2 * hstep;
    const unsigned ldsw = (unsigned)wid * 1024u;
    const int aoff = lds_byte(wr * 64 + fr, fq * 8), boff = lds_byte(wc * 32 + fr, fq * 8);
#define PG8_SA(b, h) (((b) * 2 + (h)) * HTB)
#define PG8_SB(b, h) ((4 + (b) * 2 + (h)) * HTB)
#define PG8_STAGE(bufoff, gbase, voff) do { _Pragma("unroll") for (int _i = 0; _i < 2; ++_i) \
        __builtin_amdgcn_global_load_lds((const unsigned*)((const char*)(gbase) + (voff)[_i]), (PG8_LAS unsigned*)(lds + (bufoff) + ldsw + _i * 8192), 16, 0, 0); } while (0)
#define PG8_LDA(dst, b, h) do { _Pragma("unroll") for (int m = 0; m < 4; ++m) _Pragma("unroll") for (int k = 0; k < 2; ++k) dst[m][k] = *(const PG8_LAS bf16x8*)(lds + PG8_SA(b, h) + aoff + m * 2048 + k * 1024); } while (0)
#define PG8_LDB(dst, b, h) do { _Pragma("unroll") for (int n = 0; n < 2; ++n) _Pragma("unroll") for (int k = 0; k < 2; ++k) dst[n][k] = *(const PG8_LAS bf16x8*)(lds + PG8_SB(b, h) + boff + n * 2048 + k * 1024); } while (0)
#define PG8_MMA(ai, bj, At, Bt) do { __builtin_amdgcn_s_setprio(1); _Pragma("unroll") for (int m = 0; m < 4; ++m) _Pragma("unroll") for (int n = 0; n < 2; ++n) _Pragma("unroll") for (int k = 0; k < 2; ++k) \
        acc[ai][bj][m][n] = __builtin_amdgcn_mfma_f32_16x16x32_bf16(Bt[n][k], At[m][k], acc[ai][bj][m][n], 0, 0, 0); __builtin_amdgcn_s_setprio(0); } while (0)
#define PG8_WAIT_V(n) asm volatile("s_waitcnt vmcnt(" #n ")" ::: "memory")
#define PG8_WAIT_L(n) asm volatile("s_waitcnt lgkmcnt(" #n ")" ::: "memory")
#define PG8_BAR __builtin_amdgcn_s_barrier()
#define PG8_SCHED __builtin_amdgcn_sched_barrier(0)
    Unit cur, nxt; int ui = 0;
    if (!S.next(0, cur)) return;
    f32x4 acc[2][2][4][2];
#pragma unroll
    for (int a = 0; a < 2; ++a)
#pragma unroll
        for (int b = 0; b < 2; ++b)
#pragma unroll
            for (int m = 0; m < 4; ++m)
#pragma unroll
                for (int n = 0; n < 2; ++n) acc[a][b][m][n] = (f32x4){0.f, 0.f, 0.f, 0.f};
    bf16x8 At[4][2], B0[2][2], B1[2][2];
    const char* cA = (const char*)g.A + (size_t)cur.pm * tstep; const char* cB = (const char*)g.Bt + (size_t)cur.pn * tstep;
    S.a_ready(cur);
    if constexpr (SP2) {
        PG8_STAGE(PG8_SB(0, 0), cB, voffB); PG8_STAGE(PG8_SB(0, 1), cB + hstep, voffB); PG8_STAGE(PG8_SA(0, 0), cA, voffA); PG8_STAGE(PG8_SA(0, 1), cA + hstep, voffA);
        if (wr == 1) PG8_BAR;
        PG8_WAIT_V(2); PG8_BAR;
        PG8_STAGE(PG8_SB(1, 0), cB + kstep, voffB); PG8_STAGE(PG8_SA(1, 0), cA + kstep, voffA); PG8_STAGE(PG8_SB(1, 1), cB + hstep + kstep, voffB);
        PG8_WAIT_V(6); PG8_BAR;
    } else {
        PG8_STAGE(PG8_SB(0, 0), cB, voffB); PG8_STAGE(PG8_SA(0, 0), cA, voffA); PG8_STAGE(PG8_SB(0, 1), cB + hstep, voffB); PG8_STAGE(PG8_SA(0, 1), cA + hstep, voffA);
        if (wr == 1) PG8_BAR;
        PG8_WAIT_V(4); PG8_BAR;
        PG8_STAGE(PG8_SB(1, 0), cB + kstep, voffB); PG8_STAGE(PG8_SA(1, 0), cA + kstep, voffA); PG8_STAGE(PG8_SB(1, 1), cB + hstep + kstep, voffB);
        PG8_WAIT_V(6); PG8_BAR;
    }
    for (;;) {
        const bool has_next = S.next(ui + 1, nxt);
        const char* nA = has_next ? (const char*)g.A + (size_t)nxt.pm * tstep : cA; const char* nB = has_next ? (const char*)g.Bt + (size_t)nxt.pn * tstep : cB;
        for (int t = 0; t < nt; t += 2) {
            const bool last = (t == nt - 2);
            const char* a1 = cA + (size_t)(t + 1) * kstep;
            const char* a2 = last ? nA : cA + (size_t)(t + 2) * kstep; const char* b2 = last ? nB : cB + (size_t)(t + 2) * kstep;
            const char* a3 = a2 + kstep; const char* b3 = b2 + kstep;
            if (last && has_next) S.a_ready(nxt);
            if constexpr (SP2) {
            PG8_LDB(B0, 0, 0); PG8_LDB(B1, 0, 1); PG8_SCHED; PG8_LDA(At, 0, 0); PG8_STAGE(PG8_SA(1, 1), a1 + hstep, voffA);
            PG8_WAIT_V(8); PG8_WAIT_L(0); PG8_BAR; PG8_MMA(0, 0, At, B0); PG8_MMA(0, 1, At, B1); PG8_BAR; PG8_SCHED;
            PG8_LDA(At, 0, 1); PG8_STAGE(PG8_SB(0, 0), b2, voffB); PG8_STAGE(PG8_SB(0, 1), b2 + hstep, voffB); PG8_STAGE(PG8_SA(0, 0), a2, voffA);
            PG8_WAIT_V(8); PG8_WAIT_L(0); PG8_BAR; PG8_MMA(1, 0, At, B0); PG8_MMA(1, 1, At, B1); PG8_BAR; PG8_SCHED;
            PG8_LDB(B0, 1, 0); PG8_LDB(B1, 1, 1); PG8_SCHED; PG8_LDA(At, 1, 0); PG8_STAGE(PG8_SA(0, 1), a2 + hstep, voffA);
            PG8_WAIT_V(8); PG8_WAIT_L(0); PG8_BAR; PG8_MMA(0, 0, At, B0); PG8_MMA(0, 1, At, B1); PG8_BAR; PG8_SCHED;
            PG8_LDA(At, 1, 1); PG8_STAGE(PG8_SB(1, 0), b3, voffB); PG8_STAGE(PG8_SB(1, 1), b3 + hstep, voffB); PG8_STAGE(PG8_SA(1, 0), a3, voffA);
            PG8_WAIT_V(8); PG8_WAIT_L(0); PG8_BAR; PG8_MMA(1, 0, At, B0); PG8_MMA(1, 1, At, B1); PG8_BAR; PG8_SCHED;
            } else {
            PG8_LDB(B0, 0, 0); PG8_SCHED; PG8_LDA(At, 0, 0); PG8_STAGE(PG8_SA(1, 1), a1 + hstep, voffA);
            PG8_WAIT_L(8); PG8_BAR; PG8_WAIT_L(0); PG8_MMA(0, 0, At, B0); PG8_BAR; PG8_SCHED;
            PG8_LDB(B1, 0, 1); PG8_STAGE(PG8_SB(0, 0), b2, voffB);
            PG8_BAR; PG8_WAIT_L(0); PG8_MMA(0, 1, At, B1); PG8_BAR;
            PG8_LDA(At, 0, 1); PG8_STAGE(PG8_SA(0, 0), a2, voffA);
            PG8_BAR; PG8_WAIT_L(0); PG8_MMA(1, 0, At, B0); PG8_BAR; PG8_SCHED;
            PG8_STAGE(PG8_SB(0, 1), b2 + hstep, voffB);
            PG8_WAIT_V(6); PG8_BAR; PG8_MMA(1, 1, At, B1); PG8_BAR;
            PG8_LDB(B0, 1, 0); PG8_SCHED; PG8_LDA(At, 1, 0); PG8_STAGE(PG8_SA(0, 1), a2 + hstep, voffA);
            PG8_WAIT_L(8); PG8_BAR; PG8_WAIT_L(0); PG8_MMA(0, 0, At, B0); PG8_BAR; PG8_SCHED;
            PG8_LDB(B1, 1, 1); PG8_STAGE(PG8_SB(1, 0), b3, voffB);
            PG8_BAR; PG8_WAIT_L(0); PG8_MMA(0, 1, At, B1); PG8_BAR;
            PG8_LDA(At, 1, 1); PG8_STAGE(PG8_SA(1, 0), a3, voffA);
            PG8_BAR; PG8_WAIT_L(0); PG8_MMA(1, 0, At, B0); PG8_BAR; PG8_SCHED;
            PG8_STAGE(PG8_SB(1, 1), b3 + hstep, voffB);
            PG8_WAIT_V(6); PG8_BAR; PG8_MMA(1, 1, At, B1); PG8_BAR;
            }
        }
        if constexpr (ALIGN_EPI) { if (wr == 0) PG8_BAR; }
        if constexpr (!Epi::AFTER_DRAIN) { E(acc, cur, wr, wc, fr, fq); S.done(cur); }
        if (!has_next) break;
#pragma unroll
        for (int a = 0; a < 2; ++a)
#pragma unroll
            for (int b = 0; b < 2; ++b)
#pragma unroll
                for (int m = 0; m < 4; ++m)
#pragma unroll
                    for (int n = 0; n < 2; ++n) acc[a][b][m][n] = (f32x4){0.f, 0.f, 0.f, 0.f};
        cur = nxt; cA = nA; cB = nB; ++ui;
        if constexpr (ALIGN_EPI) { if (wr == 1) PG8_BAR; }
    }
    PG8_WAIT_V(0);
    if constexpr (!ALIGN_EPI) { if (wr == 0) PG8_BAR; }
    PG8_BAR;
    if constexpr (Epi::AFTER_DRAIN) { E.fused(acc, cur, wr, wc, fr, fq, lds, wid, lane); S.done(cur); }
#undef PG8_SA
#undef PG8_SB
#undef PG8_STAGE
#undef PG8_LDA
#undef PG8_LDB
#undef PG8_MMA
#undef PG8_WAIT_V
#undef PG8_WAIT_L
#undef PG8_BAR
#undef PG8_SCHED
}
}

#define LAS __attribute__((address_space(3)))
typedef unsigned short bf16;
typedef float f32x4 __attribute__((ext_vector_type(4)));
typedef float f32x2 __attribute__((ext_vector_type(2)));
typedef unsigned u32x4 __attribute__((ext_vector_type(4)));
typedef unsigned u32x2 __attribute__((ext_vector_type(2)));
typedef short bf16x8_t __attribute__((ext_vector_type(8)));
constexpr int DM = 2048, NB = 4, TL = 2048, TC = 256, MLAT = NB * TL, MCTX = NB * TC, MALL = MLAT + MCTX;
constexpr int FF = 5632, NUP = 2 * FF, NIN = 6416, NINP_W = 6656, NMODV = 9 * DM;
constexpr int TSTEPS = TL + TC, NTILES = TSTEPS / 32;
constexpr float EPS = 1e-6f;
constexpr int NUF = 1280, NUG = 5376;
constexpr int U_SSD_DT = 0, U_HG_F = 16;
constexpr int G_SSD_Z = 0, G_LRU_G = 512, G_HG_G = 1024, G_RT_G = 1536, G_HG_I = 2048, G_RT_V = 2560, G_HG_Q = 3072, G_RT_Q = 3584, G_RT_K = 3840, G_SSD_XBC = 4096, G_LRU_X = 4864;
constexpr int U_LRU_G = 0, U_HG_G = 0, U_RT_G = 0, U_HG_I = 0, U_RT_V = 0, U_HG_Q = 0, U_RT_Q = 0, U_RT_K = 0, U_SSD_XBC = 0, U_LRU_X = 0;
__host__ __device__ constexpr int u_newpos(int n) {
    return n < 512 ? NUF + G_SSD_Z + n : n < 1280 ? NUF + G_SSD_XBC + (n - 512) : n < 1296 ? U_SSD_DT + (n - 1280) : n < 1808 ? NUF + G_LRU_X + (n - 1296) : n < 2320 ? NUF + G_LRU_G + (n - 1808)
         : n < 2832 ? NUF + G_HG_Q + (n - 2320) : n < 3856 ? U_HG_F + (n - 2832) : n < 4368 ? NUF + G_HG_I + (n - 3856) : n < 4880 ? NUF + G_HG_G + (n - 4368) : n < 5136 ? NUF + G_RT_Q + (n - 4880)
         : n < 5392 ? NUF + G_RT_K + (n - 5136) : n < 5904 ? NUF + G_RT_V + (n - 5392) : n < 6416 ? NUF + G_RT_G + (n - 5904) : 1040 + (n - 6416); }
constexpr int NPHASES = 26;
constexpr int LDS_BYTES = 147456;
constexpr size_t MiB = 1u << 20;
constexpr size_t WS_MOD = 1 * MiB, WS_W13 = 2 * MiB, WS_W2 = 178 * MiB, WS_WIN = 266 * MiB, WS_WOUT = 318 * MiB, WS_X = 334 * MiB, WS_H = 406 * MiB,
                 WS_Y = 442 * MiB, WS_U = 514 * MiB, WS_XBC = 748 * MiB, WS_LA = 775 * MiB, WS_LB = 811 * MiB, WS_YD = 847 * MiB, WS_END = 991 * MiB, WS_UG = 610 * MiB;

struct Params {
    const float *x, *c, *ctx, *c_ctx, *w_mod, *b_mod, *norm_pre, *norm_post, *ffn_w1, *ffn_w3, *ffn_w2, *w_in, *w_out,
        *ssd_conv_w, *ssd_conv_b, *ssd_dt_bias, *ssd_a_log, *ssd_d, *ssd_norm_w, *lru_conv_w, *lru_conv_b, *lru_wa, *lru_ba, *lru_wx, *lru_bx, *lru_lambda,
        *hgrn_lb_logits, *hgrn_norm_w;
    float* out; unsigned char* ws; int ph_lo, ph_hi;
};

__device__ __forceinline__ float sigmoid_(float x) { return __builtin_amdgcn_rcpf(1.f + __expf(-x)); }
__device__ __forceinline__ float silu_(float x) { return x * sigmoid_(x); }
__device__ __forceinline__ float softplus_(float x) { return fmaxf(x, 0.f) + log1pf(__expf(-fabsf(x))); }
__device__ __forceinline__ float gelu_tanh_(float x) { const float z = 0.7978845608f * (x + 0.044715f * x * x * x); const float t = 1.f - 2.f * __builtin_amdgcn_rcpf(1.f + __expf(2.f * z)); return 0.5f * x * (1.f + t); }
__device__ __forceinline__ unsigned f2bf(float f) { unsigned u = __builtin_bit_cast(unsigned, f); return (u + 0x7fffu + ((u >> 16) & 1u)) >> 16; }
__device__ __forceinline__ unsigned pk2(float lo, float hi) { return f2bf(lo) | (f2bf(hi) << 16); }
__device__ __forceinline__ float wave_sum(float v) {
#pragma unroll
    for (int o = 1; o < 64; o <<= 1) v += __shfl_xor(v, o);
    return v;
}
__device__ __forceinline__ float half_sum(float v) {
#pragma unroll
    for (int o = 1; o < 32; o <<= 1) v += __shfl_xor(v, o);
    return v;
}
__device__ __forceinline__ float dot4(f32x4 a) { return (a.x * a.x + a.y * a.y) + (a.z * a.z + a.w * a.w); }
__device__ __forceinline__ f32x4 ld_bf4(const bf16* p) { const u32x2 w = *(const u32x2*)p; return (f32x4){__builtin_bit_cast(float, w.x << 16), __builtin_bit_cast(float, w.x & 0xffff0000u), __builtin_bit_cast(float, w.y << 16), __builtin_bit_cast(float, w.y & 0xffff0000u)}; }
#define LDS_WAIT() asm volatile("s_waitcnt lgkmcnt(0)" ::: "memory")
__device__ __forceinline__ int tid_() { int t = threadIdx.x; asm volatile("" : "+v"(t)); return t; }
__device__ __forceinline__ int bid_() { int t = blockIdx.x; asm volatile("" : "+s"(t)); return t; }
__device__ __forceinline__ int scan_row(int b, int d, int i) {
    if (i < TC) { const int t = d ? (TC - 1 - i) : i; return MLAT + b * TC + t; }
    int t = i - TC; if (d) t = TL - 1 - t; return b * TL + t;
}

#define XB_TMO      128
#define XB_XCNT(j)  (256  + 64 * (j))
#define XB_XSUB(j)  (1280 + 64 * (j))
#define XB_XGEN(j)  (2304 + 64 * (j))
#define XB_TOP      3328
#define XB_TOPGEN   3392
#define XCD_BAR_WORDS 3456
#define XB_SPIN_CAP (1u << 18)

__device__ __forceinline__ unsigned xb_ld(unsigned* p)              { return __hip_atomic_load(p, __ATOMIC_RELAXED, __HIP_MEMORY_SCOPE_AGENT); }
__device__ __forceinline__ unsigned xb_add(unsigned* p, unsigned v) { return __hip_atomic_fetch_add(p, v, __ATOMIC_RELAXED, __HIP_MEMORY_SCOPE_AGENT); }
__device__ __forceinline__ unsigned xb_xcc_id() { return (unsigned)__builtin_amdgcn_s_getreg((3 << 11) | 20) & 0xFu; }
#define XB_SPIN(cond, bar) do { unsigned _sp = 0; while (cond) { __builtin_amdgcn_s_sleep(1); \
    if ((++_sp & 255u) == 0u) { if (xb_ld(&(bar)[XB_TMO])) break; if (_sp > XB_SPIN_CAP) { atomicAdd(&(bar)[XB_TMO], 1u); break; } } } } while (0)

struct XcdBarrier {
    unsigned* bar; unsigned x;
    volatile LAS unsigned* st;
};

__device__ __forceinline__ XcdBarrier xcd_barrier_post(unsigned* bar, volatile LAS unsigned* st) {
    XcdBarrier b; b.bar = bar; b.x = xb_xcc_id(); b.st = st;
    if (threadIdx.x == 0) (void)xb_add(&bar[XB_XCNT(b.x)], 1u);
    return b;
}
__device__ __forceinline__ void xcd_barrier_complete(unsigned* bar, unsigned x, unsigned& nloc, unsigned& nx) {
    const unsigned G = gridDim.x * gridDim.y * gridDim.z;
    unsigned sum, cnt, mine, sp = 0u;
    for (;;) {
        sum = 0u; cnt = 0u; mine = 0u;
#pragma unroll
        for (unsigned j = 0; j < 16; ++j) { const unsigned c = xb_ld(&bar[XB_XCNT(j)]); sum += c; cnt += (c > 0u) ? 1u : 0u; mine = (j == x) ? c : mine; }
        if (sum == G) break;
        __builtin_amdgcn_s_sleep(1);
        if ((++sp & 255u) == 0u) { if (xb_ld(&bar[XB_TMO])) break; if (sp > XB_SPIN_CAP) { atomicAdd(&bar[XB_TMO], 1u); break; } }
    }
    nloc = mine > 0u ? mine : 1u; nx = cnt > 0u ? cnt : 1u;
}

__device__ __forceinline__ void xcd_barrier(const XcdBarrier& b) {
    asm volatile("s_waitcnt vmcnt(0)" ::: "memory");
    __syncthreads();
    if (threadIdx.x == 0) {
        unsigned* bar = b.bar;
        __builtin_amdgcn_s_waitcnt(0);
        unsigned nloc = b.st[0], nx = b.st[1];
        if (nloc == 0u) { xcd_barrier_complete(bar, b.x, nloc, nx); b.st[0] = nloc; b.st[1] = nx; }
        const unsigned old = xb_add(&bar[XB_XSUB(b.x)], 1u);
        const unsigned gen = old / nloc;
        if (old + 1u == (gen + 1u) * nloc) {
            __builtin_amdgcn_fence(__ATOMIC_RELEASE, "agent");
            asm volatile("s_waitcnt vmcnt(0)" ::: "memory");
            const unsigned og = xb_add(&bar[XB_TOP], 1u);
            const unsigned tg = og / nx;
            if (og + 1u == (tg + 1u) * nx) xb_add(&bar[XB_TOPGEN], 1u);
            else XB_SPIN(xb_ld(&bar[XB_TOPGEN]) == tg, bar);
            __builtin_amdgcn_fence(__ATOMIC_ACQUIRE, "agent");
            xb_add(&bar[XB_XGEN(b.x)], 1u);
            asm volatile("s_waitcnt vmcnt(0)" ::: "memory");
        } else {
            XB_SPIN(xb_ld(&bar[XB_XGEN(b.x)]) == gen, bar);
            __builtin_amdgcn_fence(__ATOMIC_ACQUIRE, "agent");
            asm volatile("s_waitcnt vmcnt(0)" ::: "memory");
        }
    }
    __syncthreads();
}

namespace pg8 {
struct EpiSwiGLU {
    static constexpr bool PERM = true, AFTER_DRAIN = false;
    bf16_t* O; int ldc;
    __device__ __forceinline__ void operator()(const f32x4 (&acc)[2][2][4][2], const Unit& u, int wr, int wc, int fr, int fq) const {
        const int row0 = u.pm * BM + wr * 64 + fr, col0 = u.pn * HALF + wc * 32 + 8 * fq;
#pragma unroll
        for (int ai = 0; ai < 2; ++ai)
#pragma unroll
            for (int m = 0; m < 4; ++m) {
                bf16_t* rowp = O + (size_t)(row0 + ai * HALF + m * 16) * ldc + col0;
                const f32x4 a0 = acc[ai][0][m][0], a1 = acc[ai][0][m][1], b0 = acc[ai][1][m][0], b1 = acc[ai][1][m][1];
                float r[8];
#pragma unroll
                for (int j = 0; j < 4; ++j) { r[j] = a0[j] * __builtin_amdgcn_rcpf(1.f + __expf(-a0[j])) * b0[j]; r[4 + j] = a1[j] * __builtin_amdgcn_rcpf(1.f + __expf(-a1[j])) * b1[j]; }
                u32x4 w; w.x = cvt_pk_bf16(r[0], r[1]); w.y = cvt_pk_bf16(r[2], r[3]); w.z = cvt_pk_bf16(r[4], r[5]); w.w = cvt_pk_bf16(r[6], r[7]);
                *(u32x4*)rowp = w;
                asm volatile("" ::: "memory");
            }
    }
};
struct EpiF32 {
    static constexpr bool PERM = false, AFTER_DRAIN = false;
    float* O; int ldc; int asbf; bf16_t* O2; int ldc2, split_pn;
    __device__ __forceinline__ void operator()(const f32x4 (&acc)[2][2][4][2], const Unit& u, int wr, int wc, int fr, int fq) const {
        const bool sec = split_pn > 0 && u.pn >= split_pn;
        const int row0 = u.pm * BM + wr * 64 + fr, col0 = (sec ? u.pn - split_pn : u.pn) * BM + wc * 32 + 4 * fq;
        if (asbf || sec) {
            bf16_t* Ob = sec ? O2 : (bf16_t*)O; const int ldc = sec ? ldc2 : this->ldc;
#pragma unroll
            for (int ai = 0; ai < 2; ++ai)
#pragma unroll
                for (int m = 0; m < 4; ++m) {
                    bf16_t* rowp = Ob + (size_t)(row0 + ai * HALF + m * 16) * ldc + col0;
#pragma unroll
                    for (int bj = 0; bj < 2; ++bj)
#pragma unroll
                        for (int n = 0; n < 2; ++n) { const f32x4 v = acc[ai][bj][m][n]; u32x2 w; w.x = cvt_pk_bf16(v[0], v[1]); w.y = cvt_pk_bf16(v[2], v[3]); *(u32x2*)(rowp + bj * HALF + n * 16) = w; }
                }
            return;
        }
#pragma unroll
        for (int ai = 0; ai < 2; ++ai)
#pragma unroll
            for (int m = 0; m < 4; ++m) {
                float* rowp = O + (size_t)(row0 + ai * HALF + m * 16) * ldc + col0;
#pragma unroll
                for (int bj = 0; bj < 2; ++bj)
#pragma unroll
                    for (int n = 0; n < 2; ++n) *(f32x4*)(rowp + bj * HALF + n * 16) = acc[ai][bj][m][n];
            }
    }
};
}


namespace pg8 {
struct Order2 {
    StaticOrder so; int one, valid; Unit u1;
    __device__ bool next(int i, Unit& u) const { if (one) { if (i > 0 || !valid) return false; u = u1; return true; } return so.next(i, u); }
    __device__ __forceinline__ void a_ready(const Unit&) const {}
    __device__ __forceinline__ void done(const Unit&) const {}
};
}
__device__ __forceinline__ void transpose_item64(const float* __restrict__ W, int K, int N, bf16* __restrict__ WT, int mode, float* scr, int item, int lane) {
    const int nblk = (N + 63) >> 6, kb = item / nblk, nb = item - kb * nblk, k0 = kb << 6, n0 = nb << 6;
    const int lr = lane >> 4, lc = (lane & 15) << 2;
    const bool ok = (n0 + lc) < N;
#pragma unroll
    for (int i = 0; i < 16; ++i) {
        const int kk = 4 * i + lr; f32x4 v = {0.f, 0.f, 0.f, 0.f};
        if (ok) v = __builtin_nontemporal_load((const f32x4*)(W + (size_t)(k0 + kk) * N + n0 + lc));
        float* s = scr + kk * 65 + lc; s[0] = v.x; s[1] = v.y; s[2] = v.z; s[3] = v.w;
    }
    LDS_WAIT();
    const int c = lane & 7;
#pragma unroll
    for (int j = 0; j < 8; ++j) {
        const int n = (lane >> 3) + 8 * j; const float* s = scr + (8 * c) * 65 + n;
        u32x4 o; o.x = pk2(s[0], s[65]); o.y = pk2(s[2 * 65], s[3 * 65]); o.z = pk2(s[4 * 65], s[5 * 65]); o.w = pk2(s[6 * 65], s[7 * 65]);
        const int dn = n0 + n; int row = dn; if (mode == 3) row = u_newpos(dn); else if (mode) row = ((dn >> 7) << 8) + (dn & 127) + (mode == 2 ? 128 : 0);
        *(u32x4*)(WT + (size_t)row * K + k0 + 8 * c) = o;
    }
    LDS_WAIT();
}

__device__ __forceinline__ void prologue_phase(const Params& P, float* L) {
    const int tid = tid_(), lane = tid & 63, wave = __builtin_amdgcn_readfirstlane(tid >> 6);
    unsigned char* ws = P.ws;
    float* MOD = (float*)(ws + WS_MOD);
    float* sc = L;
    float* red = L + 5 * DM;
    for (int i = tid; i < 5 * DM; i += 512) { const int r = i >> 11, k = i & (DM - 1); const float v = r < 4 ? P.c[r * DM + k] : P.c_ctx[k]; sc[i] = silu_(v); }
    __syncthreads();
    for (int it = bid_(); it < 1152; it += gridDim.x) {
        const int l = it / 576, j0 = (it % 576) * 32;
        const float* Wm = P.w_mod + (size_t)l * DM * NMODV;
        const int kr = lane >> 3, c4 = (lane & 7) << 2;
        f32x4 acc[5];
#pragma unroll
        for (int r = 0; r < 5; ++r) acc[r] = (f32x4){0.f, 0.f, 0.f, 0.f};
        const int kbase = wave * 256 + kr;
#pragma unroll 16
        for (int kk = 0; kk < 256; kk += 8) {
            const int k = kbase + kk; const f32x4 w = __builtin_nontemporal_load((const f32x4*)(Wm + (size_t)k * NMODV + j0 + c4));
#pragma unroll
            for (int r = 0; r < 5; ++r) acc[r] += w * sc[r * DM + k];
        }
#pragma unroll
        for (int r = 0; r < 5; ++r)
#pragma unroll
            for (int e = 0; e < 4; ++e) { float v = acc[r][e]; v += __shfl_xor(v, 8); v += __shfl_xor(v, 16); v += __shfl_xor(v, 32); acc[r][e] = v; }
        if (lane < 8) {
#pragma unroll
            for (int r = 0; r < 5; ++r) *(f32x4*)&red[(wave * 5 + r) * 32 + c4] = acc[r];
        }
        __syncthreads();
        if (tid < 160) { const int r = tid >> 5, j = tid & 31; float s_ = 0.f;
#pragma unroll
            for (int w = 0; w < 8; ++w) s_ += red[(w * 5 + r) * 32 + j];
            MOD[(size_t)(l * 5 + r) * NMODV + j0 + j] = s_ + P.b_mod[l * NMODV + j0 + j]; }
        __syncthreads();
    }
    bf16* W13 = (bf16*)(ws + WS_W13); bf16* W2 = (bf16*)(ws + WS_W2); bf16* WIN = (bf16*)(ws + WS_WIN); bf16* WOUT = (bf16*)(ws + WS_WOUT);
    float* scr = L + wave * (64 * 65);
    const int gw = bid_() * 8 + wave, NGW = gridDim.x * 8;
    constexpr int I_F = 2816, I_LF = 3 * I_F, I_FFN = 4 * I_LF, I_IN = 32 * 101, I_OUT = 32 * 32, I_ALL = I_FFN + 2 * I_IN + 2 * I_OUT;
    for (int it = gw; it < I_ALL; it += NGW) {
        int r = it;
        if (r < I_FFN) {
            const int lf = r / I_LF, q = r % I_LF, which = q / I_F, item = q % I_F;
            if (which == 0) transpose_item64(P.ffn_w1 + (size_t)lf * DM * FF, DM, FF, W13 + (size_t)lf * NUP * DM, 1, scr, item, lane);
            else if (which == 1) transpose_item64(P.ffn_w3 + (size_t)lf * DM * FF, DM, FF, W13 + (size_t)lf * NUP * DM, 2, scr, item, lane);
            else transpose_item64(P.ffn_w2 + (size_t)lf * FF * DM, FF, DM, W2 + (size_t)lf * DM * FF, 0, scr, item, lane);
        } else {
            r -= I_FFN;
            if (r < 2 * I_IN) { const int l = r / I_IN, item = r % I_IN; transpose_item64(P.w_in + (size_t)l * DM * NIN, DM, NIN, WIN + (size_t)l * NINP_W * DM, 3, scr, item, lane); }
            else { r -= 2 * I_IN; const int l = r / I_OUT, item = r % I_OUT; transpose_item64(P.w_out + (size_t)l * DM * DM, DM, DM, WOUT + (size_t)l * DM * DM, 0, scr, item, lane); }
        }
    }
}

__device__ __forceinline__ void rowwise_phase(const Params& P, int mrows, bool first, int l_post, int j_post, int gate_idx, float coef, bool final_, int l_pre, int j_pre, int shift_idx, int scale_idx) {
    const int tid = tid_(), lane = tid & 63, wave = __builtin_amdgcn_readfirstlane(tid >> 6);
    const int gw = bid_() * 8 + wave, NGW = gridDim.x * 8;
    const float* MOD = (const float*)(P.ws + WS_MOD);
    float* X = (float*)(P.ws + WS_X); const float* Y = (const float*)(P.ws + WS_Y); bf16* H = (bf16*)(P.ws + WS_H);
    for (int row = gw; row < mrows; row += NGW) {
        const int b = row < MLAT ? (row >> 11) : 4;
        f32x4 xv[8]; float ss_new = 0.f;
        if (first) {
            const float* src = row < MLAT ? P.x + (size_t)row * DM : P.ctx + (size_t)(row - MLAT) * DM;
#pragma unroll
            for (int j = 0; j < 8; ++j) xv[j] = *(const f32x4*)(src + 4 * lane + 256 * j);
        } else {
            const float* xr = (l_post == 0 && j_post == 0) ? (row < MLAT ? P.x + (size_t)row * DM : P.ctx + (size_t)(row - MLAT) * DM) : X + (size_t)row * DM;
            f32x4 yv[8]; float ss = 0.f;
            if (row < MLAT) {
                const bf16* yb = (const bf16*)Y + (size_t)row * DM;
#pragma unroll
                for (int j = 0; j < 8; ++j) { const u32x2 w = *(const u32x2*)(yb + 4 * lane + 256 * j);
                    yv[j] = (f32x4){__builtin_bit_cast(float, w.x << 16), __builtin_bit_cast(float, w.x & 0xffff0000u), __builtin_bit_cast(float, w.y << 16), __builtin_bit_cast(float, w.y & 0xffff0000u)}; }
            } else {
                const bf16* pr = (const bf16*)(P.ws + WS_YD) + (size_t)(row - MLAT) * DM;
#pragma unroll
                for (int j = 0; j < 8; ++j) yv[j] = ld_bf4(pr + 4 * lane + 256 * j);
                for (int ks = 1; ks < 8; ++ks) {
#pragma unroll
                    for (int j = 0; j < 8; ++j) yv[j] += ld_bf4(pr + (size_t)ks * MCTX * DM + 4 * lane + 256 * j);
                }
            }
            const float* gp = P.norm_post + (size_t)(l_post * 3 + j_post) * DM; const float* mg = MOD + (size_t)(l_post * 5 + b) * NMODV + gate_idx * DM;
            float sxx = 0.f, sxt = 0.f, stt = 0.f;
#pragma unroll
            for (int j = 0; j < 8; ++j) { const int c = 4 * lane + 256 * j; xv[j] = *(const f32x4*)(xr + c); const f32x4 g4 = *(const f32x4*)(gp + c), m4 = *(const f32x4*)(mg + c);
                ss += dot4(yv[j]); yv[j] = yv[j] * g4 * m4; sxx += dot4(xv[j]); stt += dot4(yv[j]);
                const f32x4 xt = xv[j] * yv[j]; sxt += (xt.x + xt.y) + (xt.z + xt.w); }
#pragma unroll
            for (int o = 1; o < 64; o <<= 1) { ss += __shfl_xor(ss, o); sxx += __shfl_xor(sxx, o); sxt += __shfl_xor(sxt, o); stt += __shfl_xor(stt, o); }
            const float rs = rsqrtf(ss * (1.f / DM) + EPS) * coef;
            ss_new = sxx + 2.f * rs * sxt + rs * rs * stt;
#pragma unroll
            for (int j = 0; j < 8; ++j) xv[j] += yv[j] * rs;
        }
        if (final_) {
            float* o = P.out + (size_t)row * DM;
#pragma unroll
            for (int j = 0; j < 8; ++j) *(f32x4*)(o + 4 * lane + 256 * j) = xv[j];
            continue;
        }
        {
            float* xr = X + (size_t)row * DM; float ss = 0.f;
#pragma unroll
            for (int j = 0; j < 8; ++j) { if (!first) *(f32x4*)(xr + 4 * lane + 256 * j) = xv[j]; else ss += dot4(xv[j]); }
            if (first) ss = wave_sum(ss); else ss = ss_new;
            const float rs = rsqrtf(ss * (1.f / DM) + EPS);
            const float* gp = P.norm_pre + (size_t)(l_pre * 3 + j_pre) * DM; const float* mb = MOD + (size_t)(l_pre * 5 + b) * NMODV;
            bf16* hr = H + (size_t)row * DM;
#pragma unroll
            for (int j = 0; j < 8; ++j) { const int c = 4 * lane + 256 * j; const f32x4 g4 = *(const f32x4*)(gp + c), sh = *(const f32x4*)(mb + shift_idx * DM + c), scl = *(const f32x4*)(mb + scale_idx * DM + c);
                const f32x4 h = (xv[j] * rs) * g4 * (scl + 1.f) + sh; u32x2 w; w.x = pk2(h.x, h.y); w.y = pk2(h.z, h.w); *(u32x2*)(hr + c) = w; }
        }
    }
}

__device__ __forceinline__ f32x4 conv4(const bf16* __restrict__ U, int row, int col, const float* __restrict__ cw, int C, const float* __restrict__ cb) {
    int t, len; if (row < MLAT) { t = row & (TL - 1); len = TL; } else { t = (row - MLAT) & (TC - 1); len = TC; }
    f32x4 acc = *(const f32x4*)cb;
#pragma unroll
    for (int j = 0; j < 4; ++j) { const int tt = t + j - 1; if (tt >= 0 && tt < len) { const f32x4 xx = ld_bf4(U + (size_t)(row + j - 1) * NUG + col); const f32x4 w = *(const f32x4*)(cw + j * C); acc += xx * w; } }
    return acc;
}
__device__ __forceinline__ void prep_phase(const Params& P, float* L, int l) {
    const int tid = tid_();
    const float* U = (const float*)(P.ws + WS_U); bf16* XBC = (bf16*)(P.ws + WS_XBC); float* LA = (float*)(P.ws + WS_LA); bf16* LB = (bf16*)(P.ws + WS_LB);
    { const float* cw = P.ssd_conv_w + (size_t)l * 4 * 768; const float* cb = P.ssd_conv_b + (size_t)l * 768;
      for (int idx = bid_() * 512 + tid; idx < (MALL / 16) * 192; idx += gridDim.x * 512) {
          const int chunk = idx / 192, c4 = (idx - chunk * 192) << 2, row0 = chunk * 16;
          int t0, len; if (row0 < MLAT) { t0 = row0 & (TL - 1); len = TL; } else { t0 = (row0 - MLAT) & (TC - 1); len = TC; }
          const f32x4 w0 = *(const f32x4*)(cw + c4), w1 = *(const f32x4*)(cw + 768 + c4), w2 = *(const f32x4*)(cw + 2 * 768 + c4), w3 = *(const f32x4*)(cw + 3 * 768 + c4), bb = *(const f32x4*)(cb + c4);
          const bf16* up = (const bf16*)(P.ws + WS_UG) + (size_t)row0 * NUG + G_SSD_XBC + c4;
          const f32x4 z4 = {0.f, 0.f, 0.f, 0.f};
          f32x4 xm1 = (t0 > 0) ? ld_bf4(up - NUG) : z4, x0 = ld_bf4(up), x1 = ld_bf4(up + NUG);
#pragma unroll
          for (int r = 0; r < 16; ++r) {
              const f32x4 x2 = (t0 + r + 2 < len) ? ld_bf4(up + (size_t)(r + 2) * NUG) : z4;
              f32x4 v = bb + xm1 * w0 + x0 * w1 + x1 * w2 + x2 * w3;
              v.x = silu_(v.x); v.y = silu_(v.y); v.z = silu_(v.z); v.w = silu_(v.w);
              { u32x2 w_; w_.x = pk2(v.x, v.y); w_.y = pk2(v.z, v.w); *(u32x2*)(XBC + (size_t)(row0 + r) * 768 + c4) = w_; }
              xm1 = x0; x0 = x1; x1 = x2;
          } } }
    unsigned short* WT = (unsigned short*)L;
    unsigned short* xb = WT + 4 * 64 * 72;
    float* xs = (float*)(xb + 64 * 72);
    const float* cw = P.lru_conv_w + (size_t)l * 4 * 512; const float* cb = P.lru_conv_b + (size_t)l * 512;
    const int lane = tid & 63, wave = __builtin_amdgcn_readfirstlane(tid >> 6), fr = lane & 15, fq = lane >> 4;
    int cur_h = -1;
    for (int it = bid_(); it < 144 * 8; it += gridDim.x) {
        const int h = it & 7, row0 = (it >> 3) * 64;
        __syncthreads();
        if (h != cur_h) {
            for (int i = tid; i < 4 * 4096; i += 512) { const int m = i >> 12, ii = (i >> 6) & 63, j = i & 63, d = m >> 1; const float* src = (m & 1) ? P.lru_wx : P.lru_wa;
                WT[(m * 64 + j) * 72 + ii] = (unsigned short)f2bf(src[((size_t)(l * 2 + d) * 8 + h) * 4096 + ii * 64 + j]); }
            cur_h = h;
        }
        for (int i = tid; i < 1024; i += 512) { const int r = i >> 4, c4 = (i & 15) << 2;
            const f32x4 v = conv4((const bf16*)(P.ws + WS_UG), row0 + r, G_LRU_X + h * 64 + c4, cw + h * 64 + c4, 512, cb + h * 64 + c4);
            *(f32x4*)&xs[r * 68 + c4] = v; u32x2 w; w.x = pk2(v.x, v.y); w.y = pk2(v.z, v.w); *(u32x2*)&xb[r * 72 + c4] = w; }
        __syncthreads();
        {
            const int tt = wave & 3, d = wave >> 2;
            f32x4 acc[2][4];
#pragma unroll
            for (int g2 = 0; g2 < 2; ++g2)
#pragma unroll
                for (int jt = 0; jt < 4; ++jt) acc[g2][jt] = (f32x4){0.f, 0.f, 0.f, 0.f};
#pragma unroll
            for (int ks = 0; ks < 2; ++ks) {
                const bf16x8_t a = *(const bf16x8_t*)&xb[(tt * 16 + fr) * 72 + ks * 32 + fq * 8];
#pragma unroll
                for (int g2 = 0; g2 < 2; ++g2)
#pragma unroll
                    for (int jt = 0; jt < 4; ++jt) { const bf16x8_t bq = *(const bf16x8_t*)&WT[((d * 2 + g2) * 64 + jt * 16 + fr) * 72 + ks * 32 + fq * 8];
                        acc[g2][jt] = __builtin_amdgcn_mfma_f32_16x16x32_bf16(a, bq, acc[g2][jt], 0, 0, 0); }
            }
#pragma unroll
            for (int jt = 0; jt < 4; ++jt) {
                const int j = jt * 16 + fr, c = h * 64 + j;
                const float ba1 = P.lru_ba[(size_t)(l * 2 + d) * 512 + c], bx1 = P.lru_bx[(size_t)(l * 2 + d) * 512 + c], sp = softplus_(-P.lru_lambda[(size_t)(l * 2 + d) * 512 + c]);
#pragma unroll
                for (int jj = 0; jj < 4; ++jj) {
                    const int t = tt * 16 + 4 * fq + jj, row = row0 + t;
                    const float rg = sigmoid_(acc[0][jt][jj] + ba1), ig = sigmoid_(acc[1][jt][jj] + bx1);
                    const float la = -8.f * rg * sp;
                    const float a_ = __expf(la); LA[((size_t)d * MALL + row) * 512 + c] = a_;
                    LB[((size_t)d * MALL + row) * 512 + c] = (bf16)f2bf(sqrtf(fmaxf(1.f - a_ * a_, 1e-12f)) * (ig * xs[t * 68 + j]));
                }
            }
        }
    }
}


#define MEMFENCE() asm volatile("" ::: "memory")
struct StepOps { f32x4 k0, k1, q0, q1; float v, a; };
__device__ __forceinline__ void ssd_core(const float* __restrict__ qs, const float* __restrict__ ks, const float* __restrict__ vs, const float* __restrict__ as, const float* __restrict__ la, const float* __restrict__ lb,
                                         float* __restrict__ lo, float* __restrict__ yp, f32x2& S0, f32x2& S1, f32x2& S2, f32x2& S3, float& hl, int tid, int p, int sl, float dsk, bool has_a) {
    StepOps c, n;
#define LD_OPS(o, s_) do { (o).k0 = *(const f32x4*)&ks[(s_) * 64 + sl * 8]; (o).k1 = *(const f32x4*)&ks[(s_) * 64 + sl * 8 + 4]; (o).q0 = *(const f32x4*)&qs[(s_) * 64 + sl * 8]; (o).q1 = *(const f32x4*)&qs[(s_) * 64 + sl * 8 + 4]; \
        (o).v = vs[(s_) * 64 + p]; (o).a = has_a ? as[(s_)] : dsk; } while (0)
#define DO_STEP(o, s_) do { const float a_ = has_a ? (o).a : dsk; const float v_ = (o).v; \
        S0 = S0 * a_ + (f32x2){(o).k0.x, (o).k0.y} * v_; S1 = S1 * a_ + (f32x2){(o).k0.z, (o).k0.w} * v_; S2 = S2 * a_ + (f32x2){(o).k1.x, (o).k1.y} * v_; S3 = S3 * a_ + (f32x2){(o).k1.z, (o).k1.w} * v_; \
        const f32x2 y2_ = ((f32x2){(o).q0.x, (o).q0.y} * S0 + (f32x2){(o).q0.z, (o).q0.w} * S1) + ((f32x2){(o).q1.x, (o).q1.y} * S2 + (f32x2){(o).q1.z, (o).q1.w} * S3); \
        float y_ = y2_.x + y2_.y; if (has_a && sl == 0) y_ += dsk * v_; yp[(s_) * 512 + tid] = y_; } while (0)
    LD_OPS(c, 0); MEMFENCE();
#pragma unroll 2
    for (int s = 0; s < 32; s += 2) {
        LD_OPS(n, s + 1); MEMFENCE();
        DO_STEP(c, s); MEMFENCE();
        if (s + 2 < 32) { LD_OPS(c, s + 2); } MEMFENCE();
        DO_STEP(n, s + 1); MEMFENCE();
    }
#undef LD_OPS
#undef DO_STEP
    if (has_a && tid < 64) {
#pragma unroll 8
        for (int s = 0; s < 32; ++s) { hl = la[s * 64 + tid] * hl + lb[s * 64 + tid]; lo[s * 64 + tid] = hl; }
    }
}
__device__ __forceinline__ void hgrn_core(const float* __restrict__ qs, const float* __restrict__ fs, const float* __restrict__ vs, float* __restrict__ yp, f32x2& S0, f32x2& S1, f32x2& S2, f32x2& S3, int tid, int p, int sl) {
    StepOps c, n;
#define LD_OPS(o, s_) do { (o).k0 = *(const f32x4*)&fs[(s_) * 128 + sl * 4]; (o).k1 = *(const f32x4*)&fs[(s_) * 128 + 64 + sl * 4]; (o).q0 = *(const f32x4*)&qs[(s_) * 128 + sl * 4]; (o).q1 = *(const f32x4*)&qs[(s_) * 128 + 64 + sl * 4]; \
        (o).v = vs[(s_) * 32 + p]; } while (0)
#define DO_STEP(o, s_) do { const f32x2 v2_ = {(o).v, (o).v}; \
        S0 = v2_ + (f32x2){(o).k0.x, (o).k0.y} * (S0 - v2_); S1 = v2_ + (f32x2){(o).k0.z, (o).k0.w} * (S1 - v2_); S2 = v2_ + (f32x2){(o).k1.x, (o).k1.y} * (S2 - v2_); S3 = v2_ + (f32x2){(o).k1.z, (o).k1.w} * (S3 - v2_); \
        const f32x2 y2_ = ((f32x2){(o).q0.x, (o).q0.y} * S0 + (f32x2){(o).q0.z, (o).q0.w} * S1) + ((f32x2){(o).q1.x, (o).q1.y} * S2 + (f32x2){(o).q1.z, (o).q1.w} * S3); \
        yp[(s_) * 512 + tid] = y2_.x + y2_.y; } while (0)
    LD_OPS(c, 0); MEMFENCE();
#pragma unroll 2
    for (int s = 0; s < 32; s += 2) {
        LD_OPS(n, s + 1); MEMFENCE();
        DO_STEP(c, s); MEMFENCE();
        if (s + 2 < 32) { LD_OPS(c, s + 2); } MEMFENCE();
        DO_STEP(n, s + 1); MEMFENCE();
    }
#undef LD_OPS
#undef DO_STEP
}
constexpr int L_YP = 12544;
__device__ __forceinline__ void scan_ssd(const Params& P, float* L, int l, int c) {
    const int tid = tid_(), b = c >> 4, d = (c >> 3) & 1, h = c & 7, g = h >> 2;
    const float* U = (const float*)(P.ws + WS_U); const float* XBC = (const float*)(P.ws + WS_XBC); const float* LA = (const float*)(P.ws + WS_LA); const float* LB = (const float*)(P.ws + WS_LB);
    bf16* YD = (bf16*)(P.ws + WS_YD);
    float* qs = L; float* ks = L + 2048; float* vs = L + 4096; float* as = L + 6144; float* la = L + 6400; float* lb = L + 8448; float* lo = L + 10496; float* yp = L + L_YP;
    const float dtb = P.ssd_dt_bias[(l * 2 + d) * 8 + h], aneg = -__expf(P.ssd_a_log[(l * 2 + d) * 8 + h]), dsk = (d == 0) ? P.ssd_d[l * 8 + h] : 0.f;
    const int st = tid >> 4, sc4 = (tid & 15) << 2, p = tid >> 3, sl = tid & 7;
    f32x2 S0 = {0.f, 0.f}, S1 = {0.f, 0.f}, S2 = {0.f, 0.f}, S3 = {0.f, 0.f}; float hl = 0.f;
    f32x4 rx, rB, rC, ra, rb; float rdt;
#define SSD_LOAD(tile) do { const int row_ = scan_row(b, d, (tile) * 32 + st); const float* xr_ = XBC + (size_t)row_ * 768; \
        rx = *(const f32x4*)(xr_ + h * 64 + sc4); rB = *(const f32x4*)(xr_ + 512 + g * 64 + sc4); rC = *(const f32x4*)(xr_ + 640 + g * 64 + sc4); \
        rdt = U[(size_t)row_ * NUF + U_SSD_DT + d * 8 + h]; \
        ra = *(const f32x4*)(LA + ((size_t)d * MALL + row_) * 512 + h * 64 + sc4); rb = *(const f32x4*)(LB + ((size_t)d * MALL + row_) * 512 + h * 64 + sc4); } while (0)
    __syncthreads();
    SSD_LOAD(0);
    for (int tile = 0; tile < NTILES; ++tile) {
        { const float delta = softplus_(rdt + dtb);
          *(f32x4*)&vs[st * 64 + sc4] = rx; *(f32x4*)&ks[st * 64 + sc4] = rB * delta; *(f32x4*)&qs[st * 64 + sc4] = rC;
          if ((tid & 15) == 0) as[st] = __expf(aneg * delta);
          *(f32x4*)&la[st * 64 + sc4] = ra; *(f32x4*)&lb[st * 64 + sc4] = rb; }
        __syncthreads();
        if (tile + 1 < NTILES) SSD_LOAD(tile + 1);
        ssd_core(qs, ks, vs, as, la, lb, lo, yp, S0, S1, S2, S3, hl, tid, p, sl, dsk, true);
        __syncthreads();
#pragma unroll
        for (int j = 0; j < 4; ++j) {
            const int idx = tid + 512 * j, t = idx >> 6, pp = idx & 63;
            const f32x4 a0 = *(const f32x4*)&yp[t * 512 + pp * 8], a1 = *(const f32x4*)&yp[t * 512 + pp * 8 + 4];
            const int row = scan_row(b, d, tile * 32 + t);
            YD[((size_t)(0 * 2 + d) * MALL + row) * 512 + h * 64 + pp] = ((a0.x + a0.y) + (a0.z + a0.w)) + ((a1.x + a1.y) + (a1.z + a1.w));
            YD[((size_t)(1 * 2 + d) * MALL + row) * 512 + h * 64 + pp] = lo[t * 64 + pp];
        }
    }
#undef SSD_LOAD
}
__device__ __forceinline__ void scan_ret(const Params& P, float* L, int c) {
    const int tid = tid_(), b = c >> 4, h = (c >> 2) & 3, d = (c >> 1) & 1, vh = c & 1;
    const float* U = (const float*)(P.ws + WS_U); bf16* YD = (bf16*)(P.ws + WS_YD);
    float* qs = L; float* ks = L + 2048; float* vs = L + 4096; float* rope = L + 6400; float* yp = L + L_YP;
    const float a = 1.f - exp2f(-5.f - (float)h);
    const int st = tid >> 4, rem = tid & 15, sc4 = rem << 2, isk = rem >> 3, hs = (rem >> 2) & 1, cc = rem & 3, p = tid >> 3, sl = tid & 7;
    __syncthreads();
    for (int i = tid; i < 1024; i += 512) { const int pos = i >> 4, fi = i & 15; const float inv = exp2f(-(float)fi * 0.83048202372184f); const float rev = ((float)pos * inv) * 0.15915494309189535f;
        rope[2 * i] = __builtin_amdgcn_cosf(rev); rope[2 * i + 1] = __builtin_amdgcn_sinf(rev); }
    f32x2 S0 = {0.f, 0.f}, S1 = {0.f, 0.f}, S2 = {0.f, 0.f}, S3 = {0.f, 0.f};
    f32x4 r1, r2, rv;
    const int qkbase = (isk ? U_RT_K : U_RT_Q) + h * 64 + hs * 32 + 4 * cc;
#define RET_LOAD(tile) do { const float* ur_ = U + (size_t)scan_row(b, d, (tile) * 32 + st) * NUF; r1 = *(const f32x4*)(ur_ + qkbase); r2 = *(const f32x4*)(ur_ + qkbase + 16); \
        rv = *(const f32x4*)(ur_ + U_RT_V + h * 128 + vh * 64 + sc4); } while (0)
    RET_LOAD(0);
    for (int tile = 0; tile < NTILES; ++tile) {
        { f32x4 o1 = r1, o2 = r2;
          if (tile >= TC / 32) {
              const int tok = scan_row(b, d, tile * 32 + st) & (TL - 1); const int pos = hs ? (tok & 63) : (tok >> 6);
              const f32x4 cs0 = *(const f32x4*)&rope[(pos * 16 + 4 * cc) * 2], cs1 = *(const f32x4*)&rope[(pos * 16 + 4 * cc) * 2 + 4];
              const f32x4 cv = {cs0.x, cs0.z, cs1.x, cs1.z}, sv = {cs0.y, cs0.w, cs1.y, cs1.w};
              o1 = r1 * cv - r2 * sv; o2 = r1 * sv + r2 * cv;
          }
          float* dst = isk ? ks : qs; const float scl = isk ? 0.125f : 1.f;
          *(f32x4*)&dst[st * 64 + hs * 32 + 4 * cc] = o1 * scl; *(f32x4*)&dst[st * 64 + hs * 32 + 16 + 4 * cc] = o2 * scl;
          *(f32x4*)&vs[st * 64 + sc4] = rv; }
        __syncthreads();
        if (tile + 1 < NTILES) RET_LOAD(tile + 1);
        { float hl_ = 0.f; ssd_core(qs, ks, vs, vs, vs, vs, yp, yp, S0, S1, S2, S3, hl_, tid, p, sl, a, false); }
        __syncthreads();
#pragma unroll
        for (int j = 0; j < 4; ++j) {
            const int idx = tid + 512 * j, t = idx >> 6, pp = idx & 63;
            const f32x4 a0 = *(const f32x4*)&yp[t * 512 + pp * 8], a1 = *(const f32x4*)&yp[t * 512 + pp * 8 + 4];
            const int row = scan_row(b, d, tile * 32 + t);
            YD[((size_t)(3 * 2 + d) * MALL + row) * 512 + h * 128 + vh * 64 + pp] = ((a0.x + a0.y) + (a0.z + a0.w)) + ((a1.x + a1.y) + (a1.z + a1.w));
        }
    }
#undef RET_LOAD
}
__device__ __forceinline__ void scan_hgrn(const Params& P, float* L, int l, int c) {
    const int tid = tid_(), b = c >> 5, h = (c >> 3) & 3, d = (c >> 2) & 1, vq = c & 3;
    const float* U = (const float*)(P.ws + WS_U); bf16* YD = (bf16*)(P.ws + WS_YD);
    float* qs = L; float* fs = L + 4096; float* vs = L + 8192; float* yp = L + L_YP;
    const int st = tid >> 5, sc4 = (tid & 31) << 2, p = tid >> 4, sl = tid & 15;
    f32x4 lbv = {0.f, 0.f, 0.f, 0.f};
    if (l == 1) { const f32x4 g0 = *(const f32x4*)(P.hgrn_lb_logits + (size_t)(d * 2 + 0) * 512 + h * 128 + sc4), g1 = *(const f32x4*)(P.hgrn_lb_logits + (size_t)(d * 2 + 1) * 512 + h * 128 + sc4);
        lbv.x = sigmoid_(g1.x - g0.x); lbv.y = sigmoid_(g1.y - g0.y); lbv.z = sigmoid_(g1.z - g0.z); lbv.w = sigmoid_(g1.w - g0.w); }
    f32x2 S0 = {0.f, 0.f}, S1 = {0.f, 0.f}, S2 = {0.f, 0.f}, S3 = {0.f, 0.f};
    f32x4 rq0, rq1, rf0, rf1, rv = {0.f, 0.f, 0.f, 0.f};
#define HG_LOAD(tile) do { const float* u0_ = U + (size_t)scan_row(b, d, (tile) * 32 + st) * NUF; const float* u1_ = U + (size_t)scan_row(b, d, (tile) * 32 + st + 16) * NUF; \
        rq0 = *(const f32x4*)(u0_ + U_HG_Q + h * 128 + sc4); rq1 = *(const f32x4*)(u1_ + U_HG_Q + h * 128 + sc4); \
        rf0 = *(const f32x4*)(u0_ + U_HG_F + d * 512 + h * 128 + sc4); rf1 = *(const f32x4*)(u1_ + U_HG_F + d * 512 + h * 128 + sc4); \
        if (tid < 256) rv = *(const f32x4*)(U + (size_t)scan_row(b, d, (tile) * 32 + (tid >> 3)) * NUF + U_HG_I + h * 128 + vq * 32 + ((tid & 7) << 2)); } while (0)
    __syncthreads();
    HG_LOAD(0);
    for (int tile = 0; tile < NTILES; ++tile) {
        { f32x4 q, f;
#pragma unroll
          for (int e = 0; e < 4; ++e) { q[e] = silu_(rq0[e]) * 0.08838834764831845f; f[e] = lbv[e] + (1.f - lbv[e]) * sigmoid_(rf0[e]); }
          *(f32x4*)&qs[st * 128 + sc4] = q; *(f32x4*)&fs[st * 128 + sc4] = f;
#pragma unroll
          for (int e = 0; e < 4; ++e) { q[e] = silu_(rq1[e]) * 0.08838834764831845f; f[e] = lbv[e] + (1.f - lbv[e]) * sigmoid_(rf1[e]); }
          *(f32x4*)&qs[(st + 16) * 128 + sc4] = q; *(f32x4*)&fs[(st + 16) * 128 + sc4] = f;
          if (tid < 256) *(f32x4*)&vs[(tid >> 3) * 32 + ((tid & 7) << 2)] = rv; }
        __syncthreads();
        if (tile + 1 < NTILES) HG_LOAD(tile + 1);
        hgrn_core(qs, fs, vs, yp, S0, S1, S2, S3, tid, p, sl);
        __syncthreads();
#pragma unroll
        for (int j = 0; j < 2; ++j) {
            const int idx = tid + 512 * j, t = idx >> 5, pp = idx & 31;
            const f32x4 a0 = *(const f32x4*)&yp[t * 512 + pp * 16], a1 = *(const f32x4*)&yp[t * 512 + pp * 16 + 4], a2 = *(const f32x4*)&yp[t * 512 + pp * 16 + 8], a3 = *(const f32x4*)&yp[t * 512 + pp * 16 + 12];
            const int row = scan_row(b, d, tile * 32 + t);
            YD[((size_t)(2 * 2 + d) * MALL + row) * 512 + h * 128 + vq * 32 + pp] =
                (((a0.x + a0.y) + (a0.z + a0.w)) + ((a1.x + a1.y) + (a1.z + a1.w))) + (((a2.x + a2.y) + (a2.z + a2.w)) + ((a3.x + a3.y) + (a3.z + a3.w)));
        }
    }
#undef HG_LOAD
}

typedef __bf16 bf16x2_n __attribute__((ext_vector_type(2)));
__device__ __forceinline__ unsigned cvtpk(float lo, float hi) { f32x2 v = {lo, hi}; bf16x2_n b = __builtin_convertvector(v, bf16x2_n); return __builtin_bit_cast(unsigned, b); }
template <int KD, int VN> struct ChunkLds {
    static constexpr int PQ = (KD + 8) * 2;
    static constexpr int PT = 80;
    static constexpr int KM = 0, QM = KM + 16 * PQ, QE = QM + 16 * PQ, KWT = QE + 16 * PQ, G = KWT + KD * PT, VT = G + KD * 4, SIZE = VT + VN * PT;
};
template <int KD, int VN>
__device__ __forceinline__ f32x4 chunk_step(const unsigned char* C, int v0, int fr, int fq, f32x4 (&S)[KD / 16]) {
    using CL = ChunkLds<KD, VN>;
    f32x4 mt = {0.f, 0.f, 0.f, 0.f}, mt1 = {0.f, 0.f, 0.f, 0.f};
#pragma unroll
    for (int ks = 0; ks < KD / 32; ks += 2) {
        const bf16x8_t a = *(const bf16x8_t*)(C + CL::KM + fr * CL::PQ + (32 * ks + 8 * fq) * 2);
        const bf16x8_t b = *(const bf16x8_t*)(C + CL::QM + fr * CL::PQ + (32 * ks + 8 * fq) * 2);
        mt = __builtin_amdgcn_mfma_f32_16x16x32_bf16(a, b, mt, 0, 0, 0);
        const bf16x8_t a1 = *(const bf16x8_t*)(C + CL::KM + fr * CL::PQ + (32 * ks + 32 + 8 * fq) * 2);
        const bf16x8_t b1 = *(const bf16x8_t*)(C + CL::QM + fr * CL::PQ + (32 * ks + 32 + 8 * fq) * 2);
        mt1 = __builtin_amdgcn_mfma_f32_16x16x32_bf16(a1, b1, mt1, 0, 0, 0);
    }
    mt += mt1;
#pragma unroll
    for (int j = 0; j < 4; ++j) if (4 * fq + j > fr) mt[j] = 0.f;
    u32x4 bw; bw.x = cvtpk(mt[0], mt[1]); bw.y = cvtpk(mt[2], mt[3]); bw.z = 0u; bw.w = 0u;
    const u32x2 va = *(const u32x2*)(C + CL::VT + (v0 + fr) * CL::PT + (4 * fq) * 2);
    u32x4 aw; aw.x = va.x; aw.y = va.y; aw.z = 0u; aw.w = 0u;
    f32x4 yi = __builtin_amdgcn_mfma_f32_16x16x32_bf16(__builtin_bit_cast(bf16x8_t, aw), __builtin_bit_cast(bf16x8_t, bw), (f32x4){0.f, 0.f, 0.f, 0.f}, 0, 0, 0);
    f32x4 y = {0.f, 0.f, 0.f, 0.f};
#pragma unroll
    for (int i = 0; i < KD / 32; ++i) {
        u32x4 sa; sa.x = cvtpk(S[2 * i][0], S[2 * i][1]); sa.y = cvtpk(S[2 * i][2], S[2 * i][3]); sa.z = cvtpk(S[2 * i + 1][0], S[2 * i + 1][1]); sa.w = cvtpk(S[2 * i + 1][2], S[2 * i + 1][3]);
        const u32x2 lo = *(const u32x2*)(C + CL::QE + fr * CL::PQ + (32 * i + 4 * fq) * 2), hi = *(const u32x2*)(C + CL::QE + fr * CL::PQ + (32 * i + 16 + 4 * fq) * 2);
        u32x4 qb; qb.x = lo.x; qb.y = lo.y; qb.z = hi.x; qb.w = hi.y;
        y = __builtin_amdgcn_mfma_f32_16x16x32_bf16(__builtin_bit_cast(bf16x8_t, sa), __builtin_bit_cast(bf16x8_t, qb), y, 0, 0, 0);
    }
    y += yi;
    const bf16x8_t bv = *(const bf16x8_t*)(C + CL::VT + (v0 + fr) * CL::PT + (8 * fq) * 2);
#pragma unroll
    for (int i = 0; i < KD / 16; ++i) {
        const f32x4 g4 = *(const f32x4*)(C + CL::G + (16 * i + 4 * fq) * 4);
        const bf16x8_t ak = *(const bf16x8_t*)(C + CL::KWT + (16 * i + fr) * CL::PT + (8 * fq) * 2);
        S[i] = __builtin_amdgcn_mfma_f32_16x16x32_bf16(ak, bv, S[i] * g4, 0, 0, 0);
    }
    return y;
}
template <int KD, int VN, bool LVEC>
__device__ __forceinline__ void build_operands(const float* __restrict__ rq, const float* __restrict__ rk, const float* __restrict__ rL, const float* __restrict__ rv, unsigned char* __restrict__ OP, int t0, int nthr) {
    using CL = ChunkLds<KD, VN>;
    for (int idx = t0; idx < 8 * KD; idx += nthr) {
        const int kq = idx % (KD / 4), t = (idx / (KD / 4)) & 15, c = idx / (4 * KD), k = 4 * kq, row = c * 16 + t;
        const f32x4 q4 = *(const f32x4*)&rq[row * KD + k], k4 = *(const f32x4*)&rk[row * KD + k];
        f32x4 Lt, Lm;
        if (LVEC) { Lt = *(const f32x4*)&rL[row * KD + k]; Lm = *(const f32x4*)&rL[(c * 16 + 7) * KD + k]; } else { const float a_ = rL[row], b_ = rL[c * 16 + 7]; Lt = (f32x4){a_, a_, a_, a_}; Lm = (f32x4){b_, b_, b_, b_}; }
        f32x4 qe, qm, km;
#pragma unroll
        for (int e = 0; e < 4; ++e) { qe[e] = q4[e] * __expf(Lt[e]); qm[e] = q4[e] * __expf(fminf(Lt[e] - Lm[e], 80.f)); km[e] = k4[e] * __expf(fminf(Lm[e] - Lt[e], 80.f)); }
        unsigned char* base = OP + c * CL::SIZE + t * CL::PQ + k * 2;
        u32x2 w; w.x = cvtpk(qe[0], qe[1]); w.y = cvtpk(qe[2], qe[3]); *(u32x2*)(base + CL::QE) = w;
        w.x = cvtpk(qm[0], qm[1]); w.y = cvtpk(qm[2], qm[3]); *(u32x2*)(base + CL::QM) = w;
        w.x = cvtpk(km[0], km[1]); w.y = cvtpk(km[2], km[3]); *(u32x2*)(base + CL::KM) = w;
    }
    for (int idx = t0; idx < 4 * KD; idx += nthr) {
        const int k = idx % KD, oc = (idx / KD) & 1, c = idx / (2 * KD);
        const float Le = LVEC ? rL[(c * 16 + 15) * KD + k] : rL[c * 16 + 15];
        float w[8];
#pragma unroll
        for (int e = 0; e < 8; ++e) { const int row = c * 16 + 8 * oc + e; const float Lt = LVEC ? rL[row * KD + k] : rL[row]; w[e] = rk[row * KD + k] * __expf(Le - Lt); }
        u32x4 o; o.x = cvtpk(w[0], w[1]); o.y = cvtpk(w[2], w[3]); o.z = cvtpk(w[4], w[5]); o.w = cvtpk(w[6], w[7]);
        *(u32x4*)(OP + c * CL::SIZE + CL::KWT + k * CL::PT + oc * 16) = o;
        if (oc == 0) *(float*)(OP + c * CL::SIZE + CL::G + k * 4) = __expf(Le);
    }
    for (int idx = t0; idx < 4 * VN; idx += nthr) {
        const int v = idx % VN, oc = (idx / VN) & 1, c = idx / (2 * VN);
        float w[8];
#pragma unroll
        for (int e = 0; e < 8; ++e) w[e] = rv[(c * 16 + 8 * oc + e) * VN + v];
        u32x4 o; o.x = cvtpk(w[0], w[1]); o.y = cvtpk(w[2], w[3]); o.z = cvtpk(w[4], w[5]); o.w = cvtpk(w[6], w[7]);
        *(u32x4*)(OP + c * CL::SIZE + CL::VT + v * CL::PT + oc * 16) = o;
    }
}
template <int KD, int VN>
__device__ __forceinline__ void zero_operand_pads(unsigned char* OP, int t0, int nthr) {
    using CL = ChunkLds<KD, VN>;
    for (int idx = t0; idx < 2 * (KD + VN) * 2; idx += nthr) {
        const int half = idx & 1, r = (idx >> 1) % (KD + VN), c = (idx >> 1) / (KD + VN);
        unsigned char* row = OP + c * CL::SIZE + (r < KD ? CL::KWT + r * CL::PT : CL::VT + (r - KD) * CL::PT);
        *(u32x4*)(row + 32 + half * 16) = (u32x4){0u, 0u, 0u, 0u};
    }
}
constexpr int L_RAW_Q = 0, L_RAW_K = 16384, L_RAW_L = 32768, L_RAW_V = 49152, L_OP = 65536;

__device__ __forceinline__ void scan_ret_mfma(const Params& P, unsigned char* LB, int c) {
    const int tid = tid_(), lane = tid & 63, wave = __builtin_amdgcn_readfirstlane(tid >> 6), fr = lane & 15, fq = lane >> 4;
    const int vh = c & 1, b = c >> 4, h = (c >> 2) & 3, d = (c >> 1) & 1;
    const float* U = (const float*)(P.ws + WS_U); bf16* YD = (bf16*)(P.ws + WS_YD);
    float* rq = (float*)(LB + L_RAW_Q); float* rk = (float*)(LB + L_RAW_K); float* rL = (float*)(LB + L_RAW_L); float* rv = (float*)(LB + L_RAW_V);
    float* rope = (float*)(LB + L_RAW_L + 1024);
    unsigned char* OP = LB + L_OP;
    const float la = __logf(1.f - exp2f(-5.f - (float)h));
    const int st = tid >> 4, rem = tid & 15, isk = rem >> 3, hs = (rem >> 2) & 1, cc = rem & 3;
    __syncthreads();
    for (int i = tid; i < 1024; i += 512) { const int pos = i >> 4, fi = i & 15; const float inv = exp2f(-(float)fi * 0.83048202372184f); const float rev = ((float)pos * inv) * 0.15915494309189535f;
        rope[2 * i] = __builtin_amdgcn_cosf(rev); rope[2 * i + 1] = __builtin_amdgcn_sinf(rev); }
    if (tid < 32) rL[tid] = (float)((tid & 15) + 1) * la;
    zero_operand_pads<64, 64>(OP, tid, 512);
    f32x4 S[4];
#pragma unroll
    for (int i = 0; i < 4; ++i) S[i] = (f32x4){0.f, 0.f, 0.f, 0.f};
    f32x4 r1, r2, rv0;
    const int qkbase = (isk ? G_RT_K : G_RT_Q) + h * 64 + hs * 32 + 4 * cc;
#define RETM_LOAD(tile) do { const bf16* ur_ = (const bf16*)(P.ws + WS_UG) + (size_t)scan_row(b, d, (tile) * 32 + st) * NUG; r1 = ld_bf4(ur_ + qkbase); r2 = ld_bf4(ur_ + qkbase + 16); \
        rv0 = ld_bf4((const bf16*)(P.ws + WS_UG) + (size_t)scan_row(b, d, (tile) * 32 + st) * NUG + G_RT_V + h * 128 + vh * 64 + rem * 4); } while (0)
    RETM_LOAD(0);
    for (int tile = 0; tile < NTILES; ++tile) {
        { f32x4 o1 = r1, o2 = r2;
          if (tile >= TC / 32) {
              const int tok = scan_row(b, d, tile * 32 + st) & (TL - 1); const int pos = hs ? (tok & 63) : (tok >> 6);
              const f32x4 cs0 = *(const f32x4*)&rope[(pos * 16 + 4 * cc) * 2], cs1 = *(const f32x4*)&rope[(pos * 16 + 4 * cc) * 2 + 4];
              const f32x4 cv = {cs0.x, cs0.z, cs1.x, cs1.z}, sv = {cs0.y, cs0.w, cs1.y, cs1.w};
              o1 = r1 * cv - r2 * sv; o2 = r1 * sv + r2 * cv;
          }
          float* dst = isk ? rk : rq; const float scl = isk ? 0.125f : 1.f;
          *(f32x4*)&dst[st * 64 + hs * 32 + 4 * cc] = o1 * scl; *(f32x4*)&dst[st * 64 + hs * 32 + 16 + 4 * cc] = o2 * scl;
          *(f32x4*)&rv[st * 64 + rem * 4] = rv0; }
        __syncthreads();
        if (tile + 1 < NTILES) RETM_LOAD(tile + 1);
        build_operands<64, 64, false>(rq, rk, rL, rv, OP, tid, 512);
        __syncthreads();
        if (wave < 4) {
#pragma unroll
        for (int ch = 0; ch < 2; ++ch) {
            const f32x4 y = chunk_step<64, 64>(OP + ch * ChunkLds<64, 64>::SIZE, wave * 16, fr, fq, S);
            const int row = scan_row(b, d, tile * 32 + ch * 16 + fr);
            { u32x2 w_; w_.x = cvtpk(y[0], y[1]); w_.y = cvtpk(y[2], y[3]); *(u32x2*)(YD + ((size_t)(3 * 2 + d) * MALL + row) * 512 + h * 128 + vh * 64 + wave * 16 + 4 * fq) = w_; }
        }
        }
    }
#undef RETM_LOAD
}

__device__ __forceinline__ void scan_hgrn_mfma(const Params& P, unsigned char* LB, int l, int c) {
    using CL = ChunkLds<128, 64>;
    const int tid = tid_(), lane = tid & 63, wave = __builtin_amdgcn_readfirstlane(tid >> 6), fr = lane & 15, fq = lane >> 4;
    const int vq = c & 1, b = c >> 4, h = (c >> 2) & 3, d = (c >> 1) & 1;
    const float* U = (const float*)(P.ws + WS_U); bf16* YD = (bf16*)(P.ws + WS_YD);
    unsigned char* OP = LB;
    float* tot = (float*)(LB + 58368);
    const int k = 2 * lane, qt = wave & 3, cb = wave >> 2;
    const int vv_ = tid & 63, vqt = wave & 3, vc = wave >> 2;
    f32x2 lb2 = {0.f, 0.f};
    if (l == 1) { const f32x2 g0 = *(const f32x2*)(P.hgrn_lb_logits + (size_t)(d * 2 + 0) * 512 + h * 128 + k), g1 = *(const f32x2*)(P.hgrn_lb_logits + (size_t)(d * 2 + 1) * 512 + h * 128 + k);
        lb2.x = sigmoid_(g1.x - g0.x); lb2.y = sigmoid_(g1.y - g0.y); }
    __syncthreads();
    zero_operand_pads<128, 64>(OP, tid, 512);
    f32x4 S[8];
#pragma unroll
    for (int i = 0; i < 8; ++i) S[i] = (f32x4){0.f, 0.f, 0.f, 0.f};
    f32x2 pq[4], pf[4]; float pv[4] = {0.f, 0.f, 0.f, 0.f};
#define HGM_LOAD(tile) do { _Pragma("unroll") for (int r_ = 0; r_ < 4; ++r_) { const float* u_ = U + (size_t)scan_row(b, d, (tile) * 32 + cb * 16 + qt * 4 + r_) * NUF; \
        { const unsigned qw_ = *(const unsigned*)((const bf16*)(P.ws + WS_UG) + (size_t)scan_row(b, d, (tile) * 32 + cb * 16 + qt * 4 + r_) * NUG + G_HG_Q + h * 128 + k); pq[r_] = (f32x2){__builtin_bit_cast(float, qw_ << 16), __builtin_bit_cast(float, qw_ & 0xffff0000u)}; } \
        pf[r_] = *(const f32x2*)(u_ + U_HG_F + d * 512 + h * 128 + k); } \
        { _Pragma("unroll") for (int r_ = 0; r_ < 4; ++r_) pv[r_] = __builtin_bit_cast(float, (unsigned)((const bf16*)(P.ws + WS_UG))[(size_t)scan_row(b, d, (tile) * 32 + vc * 16 + vqt * 4 + r_) * NUG + G_HG_I + h * 128 + vq * 64 + vv_] << 16); } } while (0)
    HGM_LOAD(0);
    for (int tile = 0; tile < NTILES; ++tile) {
        f32x2 q[4], kk[4], pre[4], suf[4]; float vv[4];
        { f32x2 fc[4];
#pragma unroll
          for (int r = 0; r < 4; ++r) {
              const float eq0 = 1.f + __expf(fminf(-pq[r].x, 40.f)), ef0 = 1.f + __expf(fminf(-pf[r].x, 40.f)), r0_ = __builtin_amdgcn_rcpf(eq0 * ef0);
              const float eq1 = 1.f + __expf(fminf(-pq[r].y, 40.f)), ef1 = 1.f + __expf(fminf(-pf[r].y, 40.f)), r1_ = __builtin_amdgcn_rcpf(eq1 * ef1);
              q[r].x = pq[r].x * (ef0 * r0_) * 0.08838834764831845f; q[r].y = pq[r].y * (ef1 * r1_) * 0.08838834764831845f;
              const float f0 = lb2.x + (1.f - lb2.x) * (eq0 * r0_), f1 = lb2.y + (1.f - lb2.y) * (eq1 * r1_);
              kk[r].x = 1.f - f0; kk[r].y = 1.f - f1; fc[r].x = fmaxf(f0, 1e-4f); fc[r].y = fmaxf(f1, 1e-4f); vv[r] = pv[r];
          }
          pre[0] = fc[0]; pre[1] = pre[0] * fc[1]; pre[2] = pre[1] * fc[2]; pre[3] = pre[2] * fc[3];
          suf[3] = (f32x2){1.f, 1.f}; suf[2] = fc[3]; suf[1] = suf[2] * fc[2]; suf[0] = suf[1] * fc[1]; }
        *(f32x2*)&tot[(cb * 4 + qt) * 128 + k] = pre[3];
        __syncthreads();
        if (tile + 1 < NTILES) HGM_LOAD(tile + 1);
        {
            const f32x2 t0 = *(const f32x2*)&tot[(cb * 4 + 0) * 128 + k], t1 = *(const f32x2*)&tot[(cb * 4 + 1) * 128 + k], t2 = *(const f32x2*)&tot[(cb * 4 + 2) * 128 + k], t3 = *(const f32x2*)&tot[(cb * 4 + 3) * 128 + k];
            const f32x2 Pm = t0 * t1, T23 = t2 * t3;
            unsigned char* C = OP + cb * CL::SIZE;
            float kw0[4], kw1[4];
#pragma unroll
            for (int r = 0; r < 4; ++r) {
                const int t = qt * 4 + r;
                f32x2 R, iR;
                if (qt >= 2) { R = pre[r]; if (qt == 3) R *= t2; iR.x = __builtin_amdgcn_rcpf(R.x); iR.y = __builtin_amdgcn_rcpf(R.y); }
                else { iR = suf[r]; if (qt == 0) iR *= t1; R.x = __builtin_amdgcn_rcpf(iR.x); R.y = __builtin_amdgcn_rcpf(iR.y); }
                const f32x2 Pt = Pm * R;
                unsigned char* p = C + t * CL::PQ + k * 2;
                *(unsigned*)(p + CL::QE) = cvtpk(q[r].x * Pt.x, q[r].y * Pt.y);
                *(unsigned*)(p + CL::QM) = cvtpk(q[r].x * R.x, q[r].y * R.y);
                *(unsigned*)(p + CL::KM) = cvtpk(kk[r].x * iR.x, kk[r].y * iR.y);
                kw0[r] = kk[r].x * T23.x * iR.x; kw1[r] = kk[r].y * T23.y * iR.y;
            }
            u32x2 w; w.x = cvtpk(kw0[0], kw0[1]); w.y = cvtpk(kw0[2], kw0[3]); *(u32x2*)(C + CL::KWT + k * CL::PT + qt * 8) = w;
            w.x = cvtpk(kw1[0], kw1[1]); w.y = cvtpk(kw1[2], kw1[3]); *(u32x2*)(C + CL::KWT + (k + 1) * CL::PT + qt * 8) = w;
            if (qt == 0) *(f32x2*)(C + CL::G + k * 4) = Pm * T23;
            { u32x2 wv; wv.x = cvtpk(vv[0], vv[1]); wv.y = cvtpk(vv[2], vv[3]); *(u32x2*)(OP + vc * CL::SIZE + CL::VT + vv_ * CL::PT + vqt * 8) = wv; }
        }
        __syncthreads();
        if (wave < 4) {
#pragma unroll
            for (int ch = 0; ch < 2; ++ch) {
                const f32x4 y = chunk_step<128, 64>(OP + ch * CL::SIZE, wave * 16, fr, fq, S);
                const int row = scan_row(b, d, tile * 32 + ch * 16 + fr);
                { u32x2 w_; w_.x = cvtpk(y[0], y[1]); w_.y = cvtpk(y[2], y[3]); *(u32x2*)(YD + ((size_t)(2 * 2 + d) * MALL + row) * 512 + h * 128 + vq * 64 + wave * 16 + 4 * fq) = w_; }
            }
        }
    }
#undef HGM_LOAD
}
__device__ __forceinline__ void scan_ssd_mfma(const Params& P, unsigned char* LB, int l, int c) {
    const int tid = tid_(), lane = tid & 63, wave = __builtin_amdgcn_readfirstlane(tid >> 6), fr = lane & 15, fq = lane >> 4;
    const int b = c >> 4, d = (c >> 3) & 1, h = c & 7, g = h >> 2;
    const float* U = (const float*)(P.ws + WS_U); const bf16* XBC = (const bf16*)(P.ws + WS_XBC); bf16* YD = (bf16*)(P.ws + WS_YD);
    float* rq = (float*)(LB + L_RAW_Q); float* rk = (float*)(LB + L_RAW_K); float* rL = (float*)(LB + L_RAW_L); float* lg = (float*)(LB + L_RAW_L + 256); float* rv = (float*)(LB + L_RAW_V);
    unsigned char* OP = LB + L_OP;
    const float dtb = P.ssd_dt_bias[(l * 2 + d) * 8 + h], aneg = -__expf(P.ssd_a_log[(l * 2 + d) * 8 + h]);
    const int st = tid >> 4, sc4 = (tid & 15) << 2;
    __syncthreads();
    zero_operand_pads<64, 64>(OP, tid, 512);
    f32x4 S[4];
#pragma unroll
    for (int i = 0; i < 4; ++i) S[i] = (f32x4){0.f, 0.f, 0.f, 0.f};
    f32x4 px, pB, pC; float pdt;
#define SSM_LOAD(tile) do { const int row_ = scan_row(b, d, (tile) * 32 + st); const bf16* xr_ = XBC + (size_t)row_ * 768; \
        px = ld_bf4(xr_ + h * 64 + sc4); pB = ld_bf4(xr_ + 512 + g * 64 + sc4); pC = ld_bf4(xr_ + 640 + g * 64 + sc4); pdt = U[(size_t)row_ * NUF + U_SSD_DT + d * 8 + h]; } while (0)
    SSM_LOAD(0);
    for (int tile = 0; tile < NTILES; ++tile) {
        { const float delta = softplus_(pdt + dtb); const int o = st * 64 + sc4;
          *(f32x4*)&rv[o] = px; *(f32x4*)&rk[o] = pB * delta; *(f32x4*)&rq[o] = pC;
          if ((tid & 15) == 0) lg[st] = aneg * delta; }
        __syncthreads();
        if (tile + 1 < NTILES) SSM_LOAD(tile + 1);
        if (tid < 32) { const int c0 = tid & 16; float acc = 0.f;
#pragma unroll
            for (int t = 0; t < 16; ++t) { const float v_ = lg[c0 + t]; acc += (c0 + t <= tid) ? v_ : 0.f; }
            rL[tid] = acc; }
        __syncthreads();
        build_operands<64, 64, false>(rq, rk, rL, rv, OP, tid, 512);
        __syncthreads();
        if (wave < 4) {
#pragma unroll
            for (int ch = 0; ch < 2; ++ch) {
                const f32x4 y = chunk_step<64, 64>(OP + ch * ChunkLds<64, 64>::SIZE, wave * 16, fr, fq, S);
                const int row = scan_row(b, d, tile * 32 + ch * 16 + fr);
                { u32x2 w_; w_.x = cvtpk(y[0], y[1]); w_.y = cvtpk(y[2], y[3]); *(u32x2*)(YD + ((size_t)(0 * 2 + d) * MALL + row) * 512 + h * 64 + wave * 16 + 4 * fq) = w_; }
            }
        }
    }
#undef SSM_LOAD
}
__device__ __forceinline__ void scan_lru(const Params& P, float* L, int c) {
    const int tid = tid_(), ch = tid & 63, seg = __builtin_amdgcn_readfirstlane(tid >> 6), b = c >> 3, d = (c >> 2) & 1, cgp = c & 3;
    const float* LA = (const float*)(P.ws + WS_LA) + (size_t)d * MALL * 512 + cgp * 128 + ch; const bf16* LBp = (const bf16*)(P.ws + WS_LB) + (size_t)d * MALL * 512 + cgp * 128 + ch;
    bf16* YD = (bf16*)(P.ws + WS_YD) + (size_t)(1 * 2 + d) * MALL * 512 + cgp * 128 + ch;
    float* car = L;
    const int s0 = seg * 288;
    __syncthreads();
    float h0 = 0.f, h1 = 0.f, ap0 = 1.f, ap1 = 1.f;
#pragma unroll 1
    for (int pass = 0; pass < 2; ++pass) {
        float a0[16], b0[16], c0[16], d0[16];
#pragma unroll
        for (int s = 0; s < 16; ++s) { const size_t r = (size_t)scan_row(b, d, s0 + s) * 512; a0[s] = LA[r]; b0[s] = __builtin_bit_cast(float, (unsigned)LBp[r] << 16); c0[s] = LA[r + 64]; d0[s] = __builtin_bit_cast(float, (unsigned)LBp[r + 64] << 16); }
#pragma unroll 1
        for (int tile = 0; tile < 18; ++tile) {
            float a1[16], b1[16], c1[16], d1[16];
            if (tile + 1 < 18) {
#pragma unroll
                for (int s = 0; s < 16; ++s) { const size_t r = (size_t)scan_row(b, d, s0 + (tile + 1) * 16 + s) * 512; a1[s] = LA[r]; b1[s] = __builtin_bit_cast(float, (unsigned)LBp[r] << 16); c1[s] = LA[r + 64]; d1[s] = __builtin_bit_cast(float, (unsigned)LBp[r + 64] << 16); }
            }
            if (pass == 0) {
#pragma unroll
                for (int s = 0; s < 16; ++s) { h0 = a0[s] * h0 + b0[s]; ap0 *= a0[s]; h1 = c0[s] * h1 + d0[s]; ap1 *= c0[s]; }
            } else {
#pragma unroll
                for (int s = 0; s < 16; ++s) { h0 = a0[s] * h0 + b0[s]; h1 = c0[s] * h1 + d0[s]; const size_t r = (size_t)scan_row(b, d, s0 + tile * 16 + s) * 512; YD[r] = (bf16)f2bf(h0); YD[r + 64] = (bf16)f2bf(h1); }
            }
#pragma unroll
            for (int s = 0; s < 16; ++s) { a0[s] = a1[s]; b0[s] = b1[s]; c0[s] = c1[s]; d0[s] = d1[s]; }
        }
        if (pass == 0) {
            car[(seg * 128 + ch) * 2] = ap0; car[(seg * 128 + ch) * 2 + 1] = h0; car[(seg * 128 + 64 + ch) * 2] = ap1; car[(seg * 128 + 64 + ch) * 2 + 1] = h1;
            __syncthreads();
            float hin0 = 0.f, hin1 = 0.f;
            for (int sg = 0; sg < seg; ++sg) { hin0 = car[(sg * 128 + ch) * 2] * hin0 + car[(sg * 128 + ch) * 2 + 1]; hin1 = car[(sg * 128 + 64 + ch) * 2] * hin1 + car[(sg * 128 + 64 + ch) * 2 + 1]; }
            h0 = hin0; h1 = hin1;
        }
    }
}
__device__ __forceinline__ void scan_phase(const Params& P, float* L, int l) {
    for (int it = bid_(); it < 224; it += gridDim.x) {
        if (it < 64) scan_hgrn_mfma(P, (unsigned char*)L, l, it);
        else if (it < 128) scan_ssd_mfma(P, (unsigned char*)L, l, it - 64);
        else if (it < 192) scan_ret_mfma(P, (unsigned char*)L, it - 128);
        else scan_lru(P, L, it - 192);
    }
}

__device__ __forceinline__ void post_phase(const Params& P, int l, int mrows) {
    const int tid = tid_(), lane = tid & 63, wave = __builtin_amdgcn_readfirstlane(tid >> 6);
    const int gw = bid_() * 8 + wave, NGW = gridDim.x * 8;
    const float* U = (const float*)(P.ws + WS_U); const bf16* YD = (const bf16*)(P.ws + WS_YD); bf16* YC = (bf16*)(P.ws + WS_H);
    for (int row = gw; row < mrows; row += NGW) {
        const bf16* ug = (const bf16*)(P.ws + WS_UG) + (size_t)row * NUG; bf16* yc = YC + (size_t)row * DM;
#define YDP(m, d) (YD + ((size_t)((m) * 2 + (d)) * MALL + row) * 512)
#define LDY(p) ld_bf4(p)
        {
            f32x4 gg[2]; float ss = 0.f;
#pragma unroll
            for (int j = 0; j < 2; ++j) { const int c = 4 * lane + 256 * j; const float dsk = P.ssd_d[l * 8 + (c >> 6)]; const f32x4 y = LDY(YDP(0, 0) + c) + LDY(YDP(0, 1) + c) + ld_bf4((const bf16*)(P.ws + WS_XBC) + (size_t)row * 768 + c) * dsk; const f32x4 z = ld_bf4(ug + G_SSD_Z + c);
                f32x4 t; t.x = y.x * silu_(z.x); t.y = y.y * silu_(z.y); t.z = y.z * silu_(z.z); t.w = y.w * silu_(z.w); gg[j] = t; ss += dot4(t); }
            const float rs = rsqrtf(wave_sum(ss) * (1.f / 512.f) + EPS);
#pragma unroll
            for (int j = 0; j < 2; ++j) { const int c = 4 * lane + 256 * j; const f32x4 w = *(const f32x4*)(P.ssd_norm_w + (size_t)l * 512 + c); const f32x4 o = gg[j] * rs * w;
                u32x2 pk; pk.x = pk2(o.x, o.y); pk.y = pk2(o.z, o.w); *(u32x2*)(yc + c) = pk; }
        }
        {
#pragma unroll
            for (int j = 0; j < 2; ++j) { const int c = 4 * lane + 256 * j; const f32x4 hh = LDY(YDP(1, 0) + c) + LDY(YDP(1, 1) + c); const f32x4 gb = ld_bf4(ug + G_LRU_G + c);
                f32x4 o; o.x = hh.x * gelu_tanh_(gb.x); o.y = hh.y * gelu_tanh_(gb.y); o.z = hh.z * gelu_tanh_(gb.z); o.w = hh.w * gelu_tanh_(gb.w);
                u32x2 pk; pk.x = pk2(o.x, o.y); pk.y = pk2(o.z, o.w); *(u32x2*)(yc + 512 + c) = pk; }
        }
        {
#pragma unroll
            for (int j = 0; j < 2; ++j) { const int c = 4 * lane + 256 * j; const f32x4 o = LDY(YDP(2, 0) + c) + LDY(YDP(2, 1) + c);
                const float rs = rsqrtf(half_sum(dot4(o)) * (1.f / 128.f) + EPS); const f32x4 w = *(const f32x4*)(P.hgrn_norm_w + (size_t)l * 128 + (c & 127)); const f32x4 gt = ld_bf4(ug + G_HG_G + c);
                f32x4 r; r.x = o.x * rs * w.x * silu_(gt.x); r.y = o.y * rs * w.y * silu_(gt.y); r.z = o.z * rs * w.z * silu_(gt.z); r.w = o.w * rs * w.w * silu_(gt.w);
                u32x2 pk; pk.x = pk2(r.x, r.y); pk.y = pk2(r.z, r.w); *(u32x2*)(yc + 1024 + c) = pk; }
        }
        {
#pragma unroll
            for (int j = 0; j < 2; ++j) { const int c = 4 * lane + 256 * j; const f32x4 o = LDY(YDP(3, 0) + c) + LDY(YDP(3, 1) + c);
                const float rs = rsqrtf(half_sum(dot4(o)) * (1.f / 128.f) + EPS); const f32x4 gt = ld_bf4(ug + G_RT_G + c);
                f32x4 r; r.x = o.x * rs * silu_(gt.x); r.y = o.y * rs * silu_(gt.y); r.z = o.z * rs * silu_(gt.z); r.w = o.w * rs * silu_(gt.w);
                u32x2 pk; pk.x = pk2(r.x, r.y); pk.y = pk2(r.z, r.w); *(u32x2*)(yc + 1536 + c) = pk; }
        }
#undef YDP
    }
}

__global__ void __launch_bounds__(512, 2) mk_fwd(Params Pkarg) {
    extern __shared__ __attribute__((aligned(16))) unsigned char lds_raw[];
    float* L = (float*)lds_raw;
    const __attribute__((address_space(4))) Params* kp = (const __attribute__((address_space(4))) Params*)__builtin_amdgcn_kernarg_segment_ptr();
    const int ph_lo = kp->ph_lo, ph_hi = kp->ph_hi;
    {
        volatile LAS unsigned* st0 = (volatile LAS unsigned*)((LAS unsigned char*)lds_raw + (LDS_BYTES - 128));
        if (threadIdx.x == 0) { st0[0] = 0u; st0[1] = 0u; }
        __syncthreads();
        (void)xcd_barrier_post((unsigned*)kp->ws, st0);
    }
    for (int ph = ph_lo; ph < ph_hi; ++ph) {
        asm volatile("" : "+s"(kp));
#if defined(__HIP_DEVICE_COMPILE__)
        const Params P = *kp;
#else
        const Params P = Pkarg;
#endif
        unsigned char* ws = P.ws;
#ifdef PROBE_DUP
        const int kk_ = ph < 2 ? 100 + ph : (ph - 2) % 12;
        const int nrep_ = (kk_ == PROBE_DUP || kk_ == PROBE_DUP2) ? 2 : 1;
        for (int rep_ = 0; rep_ < nrep_; ++rep_) { if (rep_) cg::this_grid().sync();
#endif
        if (ph == 0) prologue_phase(P, L);
        else if (ph == 1) rowwise_phase(P, MALL, true, 0, 0, 0, 0.f, false, 0, 0, 0, 1);
        else {
            const int q = ph - 2, l = q / 12, k = q % 12;
            const int Mg = (l == 1 && k >= 6) ? MLAT : MALL;
            if (k == 0 || k == 9) {
                const int lf = l * 2 + (k == 9);
                pg8::Gemm g{(const pg8::bf16_t*)(ws + WS_H), (const pg8::bf16_t*)(ws + WS_W13) + (size_t)lf * NUP * DM, Mg, NUP, DM, DM};
                pg8::StaticOrder S; S.init(Mg, NUP, (int)gridDim.x, bid_());
                pg8::EpiSwiGLU E{(pg8::bf16_t*)(ws + WS_U), FF};
                pg8::gemm_phase<pg8::EpiSwiGLU, pg8::StaticOrder, true, true>((LAS unsigned char*)lds_raw, g, S, E);
            } else if (k == 1 || k == 10 || k == 3 || k == 7) {
                const pg8::bf16_t* A; const pg8::bf16_t* Bt; int N, K; float* O;
                if (k == 3) { A = (const pg8::bf16_t*)(ws + WS_H); Bt = (const pg8::bf16_t*)(ws + WS_WIN) + (size_t)l * NINP_W * DM; N = NINP_W; K = DM; O = (float*)(ws + WS_U); }
                else if (k == 7) { A = (const pg8::bf16_t*)(ws + WS_H); Bt = (const pg8::bf16_t*)(ws + WS_WOUT) + (size_t)l * DM * DM; N = DM; K = DM; O = (float*)(ws + WS_Y); }
                else { const int lf = l * 2 + (k == 10); A = (const pg8::bf16_t*)(ws + WS_U); Bt = (const pg8::bf16_t*)(ws + WS_W2) + (size_t)lf * DM * FF; N = DM; K = FF; O = (float*)(ws + WS_Y); }
                const bool splitk = (k != 3) && (Mg == MALL);
                const int M1 = splitk ? MLAT : Mg;
                { pg8::Gemm g{A, Bt, M1, N, K, K};
                  pg8::Order2 S; S.so.init(M1, N, (int)gridDim.x, bid_()); S.one = 0; S.valid = 1; S.u1.pm = 0; S.u1.pn = 0;
                  pg8::EpiF32 E{O, (k == 3) ? NUF : N, (k != 3) ? 1 : 0, (pg8::bf16_t*)(ws + WS_UG), NUG, (k == 3) ? NUF / 256 : 0};
                  pg8::gemm_phase<pg8::EpiF32, pg8::Order2, true, true>((LAS unsigned char*)lds_raw, g, S, E); }
                if (splitk) {
                    for (int c = bid_(); c < 256; c += (int)gridDim.x) {
                        const int u = c >> 3, ks = c & 7, nt2 = K >> 7;
                        const int kt0 = 2 * ((ks * nt2) >> 3), kt1 = 2 * (((ks + 1) * nt2) >> 3);
                        pg8::Gemm g{A + kt0 * 64, Bt + kt0 * 64, MALL, N, (kt1 - kt0) * 64, K};
                        pg8::Order2 S; S.so.init(MALL, N, 1, 0); S.one = 1; S.valid = 1; S.u1.pm = 32 + (u >> 3); S.u1.pn = u & 7;
                        pg8::EpiF32 E{(float*)((bf16*)(ws + WS_YD) + (size_t)ks * MCTX * DM - (size_t)MLAT * DM), N, 1, nullptr, 0, 0};
                        pg8::gemm_phase<pg8::EpiF32, pg8::Order2, true, true>((LAS unsigned char*)lds_raw, g, S, E);
                    }
                }
            } else if (k == 2) rowwise_phase(P, MALL, false, l, 0, 2, 0.5f, false, l, 1, 3, 4);
            else if (k == 8) rowwise_phase(P, Mg, false, l, 1, 5, 1.0f, false, l, 2, 6, 7);
            else if (k == 11) rowwise_phase(P, Mg, false, l, 2, 8, 0.5f, l == 1, l + 1, 0, 0, 1);
            else if (k == 4) prep_phase(P, L, l);
            else if (k == 5) scan_phase(P, L, l);
            else post_phase(P, l, Mg);
        }
#ifdef PROBE_DUP
        }
#endif
        if (ph + 1 < ph_hi) {
            if (ph == 0) cg::this_grid().sync();
            else { XcdBarrier xb; xb.bar = (unsigned*)ws; xb.x = xb_xcc_id(); xb.st = (volatile LAS unsigned*)((LAS unsigned char*)lds_raw + (LDS_BYTES - 128)); xcd_barrier(xb); }
        }
    }
}

extern "C" void kernel_launch(void* const* d_in, const int* in_sizes, int n_in, void* d_out, int out_size, void* d_ws, size_t ws_size, hipStream_t stream) {
    static int grid = 0;
    if (grid == 0) {
        if (n_in != 28 || out_size != MLAT * DM || ws_size < WS_END) { fprintf(stderr, "kernel_launch: unexpected shapes (n_in %d out %d ws %zu need %zu)\n", n_in, out_size, ws_size, (size_t)WS_END); grid = -1; return; }
        int dev = 0, cus = 0, per_cu = 0;
        (void)hipGetDevice(&dev); (void)hipDeviceGetAttribute(&cus, hipDeviceAttributeMultiprocessorCount, dev);
        if (hipFuncSetAttribute((const void*)mk_fwd, hipFuncAttributeMaxDynamicSharedMemorySize, LDS_BYTES) != hipSuccess) { fprintf(stderr, "kernel_launch: hipFuncSetAttribute failed\n"); grid = -1; return; }
        if (hipOccupancyMaxActiveBlocksPerMultiprocessor(&per_cu, (const void*)mk_fwd, 512, LDS_BYTES) != hipSuccess || per_cu < 1) { fprintf(stderr, "kernel_launch: occupancy query says %d\n", per_cu); per_cu = 1; }
        (void)hipGetLastError();
        grid = cus * per_cu;
    }
    if (grid < 0) return;
    (void)hipMemsetAsync(d_ws, 0, 16384, stream);
    Params p{};
    const float** pp = (const float**)&p;
    for (int i = 0; i < 28; ++i) pp[i] = (const float*)d_in[i];
    p.out = (float*)d_out; p.ws = (unsigned char*)d_ws;
#if MK_SINGLE
    p.ph_lo = 0; p.ph_hi = NPHASES;
    void* args[] = {&p};
    hipError_t e = hipLaunchCooperativeKernel((const void*)mk_fwd, dim3(grid), dim3(512), args, LDS_BYTES, stream);
    if (e != hipSuccess) fprintf(stderr, "cooperative launch failed: %s (grid %d)\n", hipGetErrorString(e), grid);
#else
    for (int ph = 0; ph < NPHASES; ++ph) { p.ph_lo = ph; p.ph_hi = ph + 1; hipLaunchKernelGGL(mk_fwd, dim3(grid), dim3(512), LDS_BYTES, stream, p); }
#endif
}
```

```cpp
#include <hip/hip_runtime.h>
#include <hip/hip_cooperative_groups.h>
#include <cstdio>
#include <cstdint>
namespace cg = cooperative_groups;
#ifndef MK_SINGLE
#define MK_SINGLE 1
#endif
namespace pg8 {
#define PG8_LAS __attribute__((address_space(3)))
typedef unsigned short bf16_t;
typedef short bf16x8 __attribute__((ext_vector_type(8)));
typedef float f32x4 __attribute__((ext_vector_type(4)));
typedef unsigned u32x4 __attribute__((ext_vector_type(4)));
constexpr int BM = 256, BK = 64, HALF = 128, HTB = HALF * BK * 2  , STAGE_BYTES = 8 * HTB, NXCD = 8, WGM = 8;

__host__ __device__ __forceinline__ int lds_byte(int r, int c) { const int st = (r >> 4) * 2 + (c >> 5), rr = r & 15, cc = c & 31, ob = rr * 64 + cc * 2; return st * 1024 + (ob ^ (((ob >> 9) & 1) << 5)); }
__host__ __device__ __forceinline__ void stage_rc(int b, int& R, int& C) { const int st = b / 1024, sb = b % 1024, swz = sb ^ (((sb >> 9) & 1) << 5); R = (st >> 1) * 16 + swz / 64; C = (st & 1) * 32 + (swz % 64) / 2; }
__host__ __device__ __forceinline__ int perm32(int rho) { const int n = rho >> 4, i = rho & 15; return 8 * (i >> 2) + 4 * n + (i & 3); }

struct Unit { int pm, pn; };
struct Gemm { const bf16_t* A; const bf16_t* Bt; int M, N, K, ld; };

struct StaticOrder {
    int nM, nN, nwg, G, c;
    __host__ __device__ void init(int M, int N, int G_, int c_) { nM = M / BM; nN = N / BM; nwg = nM * nN; G = G_; c = c_; }
    __host__ __device__ bool next(int i, Unit& u) const {
        const long L = (long)i * G + c; if (L >= nwg) return false;
        int wgid = (int)L; { const int q = nwg / NXCD, r = nwg % NXCD, xcd = wgid % NXCD, off = wgid / NXCD; wgid = (xcd < r ? xcd * (q + 1) : r * (q + 1) + (xcd - r) * q) + off; }
        const int nig = WGM * nN, gid = wgid / nig, fm = gid * WGM, gsz = (nM - fm) < WGM ? (nM - fm) : WGM;
        u.pm = fm + ((wgid % nig) % gsz); u.pn = (wgid % nig) / gsz; return true;
    }
    __device__ __forceinline__ void a_ready(const Unit&) const {}
    __device__ __forceinline__ void done(const Unit&) const {}
};

__device__ __forceinline__ unsigned cvt_pk_bf16(float lo, float hi) { unsigned r; asm volatile("v_cvt_pk_bf16_f32 %0, %1, %2" : "=v"(r) : "v"(lo), "v"(hi)); return r; }
template <class Epi, class Sched, bool ALIGN_EPI = false, bool SP2 = false>
__device__ __forceinline__ void gemm_phase(PG8_LAS unsigned char* lds, const Gemm g, const Sched& S, const Epi& E) {
    int tid_l = threadIdx.x; asm volatile("" : "+v"(tid_l)); const int tid = tid_l, wid = __builtin_amdgcn_readfirstlane(tid >> 6), lane = tid & 63, wr = wid >> 2, wc = wid & 3, fr = lane & 15, fq = lane >> 4;
    const int K = g.ld, nt = g.K / BK;
    unsigned voffA[2], voffB[2];
#pragma unroll
    for (int i = 0; i < 2; ++i) { int R, C; stage_rc(tid * 16 + i * 8192, R, C); const int Rb = Epi::PERM ? ((R & ~31) + perm32(R & 31)) : R;
        voffA[i] = (unsigned)(R * K + C) * 2u; voffB[i] = (unsigned)(Rb * K + C) * 2u; }
    const size_t kstep = (size_t)(BK * 2);
    const size_t hstep = (size_t)HALF * K * 2;
    const size_t tstep = 2 * hstep;
    const unsigned ldsw = (unsigned)wid * 1024u;
    const int aoff = lds_byte(wr * 64 + fr, fq * 8), boff = lds_byte(wc * 32 + fr, fq * 8);
#define PG8_SA(b, h) (((b) * 2 + (h)) * HTB)
#define PG8_SB(b, h) ((4 + (b) * 2 + (h)) * HTB)
#define PG8_STAGE(bufoff, gbase, voff) do { _Pragma("unroll") for (int _i = 0; _i < 2; ++_i) \
        __builtin_amdgcn_global_load_lds((const unsigned*)((const char*)(gbase) + (voff)[_i]), (PG8_LAS unsigned*)(lds + (bufoff) + ldsw + _i * 8192), 16, 0, 0); } while (0)
#define PG8_LDA(dst, b, h) do { _Pragma("unroll") for (int m = 0; m < 4; ++m) _Pragma("unroll") for (int k = 0; k < 2; ++k) dst[m][k] = *(const PG8_LAS bf16x8*)(lds + PG8_SA(b, h) + aoff + m * 2048 + k * 1024); } while (0)
#define PG8_LDB(dst, b, h) do { _Pragma("unroll") for (int n = 0; n < 2; ++n) _Pragma("unroll") for (int k = 0; k < 2; ++k) dst[n][k] = *(const PG8_LAS bf16x8*)(lds + PG8_SB(b, h) + boff + n * 2048 + k * 1024); } while (0)
#define PG8_MMA(ai, bj, At, Bt) do { __builtin_amdgcn_s_setprio(1); _Pragma("unroll") for (int m = 0; m < 4; ++m) _Pragma("unroll") for (int n = 0; n < 2; ++n) _Pragma("unroll") for (int k = 0; k < 2; ++k) \
        acc[ai][bj][m][n] = __builtin_amdgcn_mfma_f32_16x16x32_bf16(Bt[n][k], At[m][k], acc[ai][bj][m][n], 0, 0, 0); __builtin_amdgcn_s_setprio(0); } while (0)
#define PG8_WAIT_V(n) asm volatile("s_waitcnt vmcnt(" #n ")" ::: "memory")
#define PG8_WAIT_L(n) asm volatile("s_waitcnt lgkmcnt(" #n ")" ::: "memory")
#define PG8_BAR __builtin_amdgcn_s_barrier()
#define PG8_SCHED __builtin_amdgcn_sched_barrier(0)
    Unit cur, nxt; int ui = 0;
    if (!S.next(0, cur)) return;
    f32x4 acc[2][2][4][2];
#pragma unroll
    for (int a = 0; a < 2; ++a)
#pragma unroll
        for (int b = 0; b < 2; ++b)
#pragma unroll
            for (int m = 0; m < 4; ++m)
#pragma unroll
                for (int n = 0; n < 2; ++n) acc[a][b][m][n] = (f32x4){0.f, 0.f, 0.f, 0.f};
    bf16x8 At[4][2], B0[2][2], B1[2][2];
    const char* cA = (const char*)g.A + (size_t)cur.pm * tstep; const char* cB = (const char*)g.Bt + (size_t)cur.pn * tstep;
    S.a_ready(cur);
    if constexpr (SP2) {
        PG8_STAGE(PG8_SB(0, 0), cB, voffB); PG8_STAGE(PG8_SB(0, 1), cB + hstep, voffB); PG8_STAGE(PG8_SA(0, 0), cA, voffA); PG8_STAGE(PG8_SA(0, 1), cA + hstep, voffA);
        if (wr == 1) PG8_BAR;
        PG8_WAIT_V(2); PG8_BAR;
        PG8_STAGE(PG8_SB(1, 0), cB + kstep, voffB); PG8_STAGE(PG8_SA(1, 0), cA + kstep, voffA); PG8_STAGE(PG8_SB(1, 1), cB + hstep + kstep, voffB);
        PG8_WAIT_V(6); PG8_BAR;
    } else {
        PG8_STAGE(PG8_SB(0, 0), cB, voffB); PG8_STAGE(PG8_SA(0, 0), cA, voffA); PG8_STAGE(PG8_SB(0, 1), cB + hstep, voffB); PG8_STAGE(PG8_SA(0, 1), cA + hstep, voffA);
        if (wr == 1) PG8_BAR;
        PG8_WAIT_V(4); PG8_BAR;
        PG8_STAGE(PG8_SB(1, 0), cB + kstep, voffB); PG8_STAGE(PG8_SA(1, 0), cA + kstep, voffA); PG8_STAGE(PG8_SB(1, 1), cB + hstep + kstep, voffB);
        PG8_WAIT_V(6); PG8_BAR;
    }
    for (;;) {
        const bool has_next = S.next(ui + 1, nxt);
        const char* nA = has_next ? (const char*)g.A + (size_t)nxt.pm * tstep : cA; const char* nB = has_next ? (const char*)g.Bt + (size_t)nxt.pn * tstep : cB;
        for (int t = 0; t < nt; t += 2) {
            const bool last = (t == nt - 2);
            const char* a1 = cA + (size_t)(t + 1) * kstep;
            const char* a2 = last ? nA : cA + (size_t)(t + 2) * kstep; const char* b2 = last ? nB : cB + (size_t)(t + 2) * kstep;
            const char* a3 = a2 + kstep; const char* b3 = b2 + kstep;
            if (last && has_next) S.a_ready(nxt);
            if constexpr (SP2) {
            PG8_LDB(B0, 0, 0); PG8_LDB(B1, 0, 1); PG8_SCHED; PG8_LDA(At, 0, 0); PG8_STAGE(PG8_SA(1, 1), a1 + hstep, voffA);
            PG8_WAIT_V(8); PG8_WAIT_L(0); PG8_BAR; PG8_MMA(0, 0, At, B0); PG8_MMA(0, 1, At, B1); PG8_BAR; PG8_SCHED;
            PG8_LDA(At, 0, 1); PG8_STAGE(PG8_SB(0, 0), b2, voffB); PG8_STAGE(PG8_SB(0, 1), b2 + hstep, voffB); PG8_STAGE(PG8_SA(0, 0), a2, voffA);
            PG8_WAIT_V(8); PG8_WAIT_L(0); PG8_BAR; PG8_MMA(1, 0, At, B0); PG8_MMA(1, 1, At, B1); PG8_BAR; PG8_SCHED;
            PG8_LDB(B0, 1, 0); PG8_LDB(B1, 1, 1); PG8_SCHED; PG8_LDA(At, 1, 0); PG8_STAGE(PG8_SA(0, 1), a2 + hstep, voffA);
            PG8_WAIT_V(8); PG8_WAIT_L(0); PG8_BAR; PG8_MMA(0, 0, At, B0); PG8_MMA(0, 1, At, B1); PG8_BAR; PG8_SCHED;
            PG8_LDA(At, 1, 1); PG8_STAGE(PG8_SB(1, 0), b3, voffB); PG8_STAGE(PG8_SB(1, 1), b3 + hstep, voffB); PG8_STAGE(PG8_SA(1, 0), a3, voffA);
            PG8_WAIT_V(8); PG8_WAIT_L(0); PG8_BAR; PG8_MMA(1, 0, At, B0); PG8_MMA(1, 1, At, B1); PG8_BAR; PG8_SCHED;
            } else {
            PG8_LDB(B0, 0, 0); PG8_SCHED; PG8_LDA(At, 0, 0); PG8_STAGE(PG8_SA(1, 1), a1 + hstep, voffA);
            PG8_WAIT_L(8); PG8_BAR; PG8_WAIT_L(0); PG8_MMA(0, 0, At, B0); PG8_BAR; PG8_SCHED;
            PG8_LDB(B1, 0, 1); PG8_STAGE(PG8_SB(0, 0), b2, voffB);
            PG8_BAR; PG8_WAIT_L(0); PG8_MMA(0, 1, At, B1); PG8_BAR;
            PG8_LDA(At, 0, 1); PG8_STAGE(PG8_SA(0, 0), a2, voffA);
            PG8_BAR; PG8_WAIT_L(0); PG8_MMA(1, 0, At, B0); PG8_BAR; PG8_SCHED;
            PG8_STAGE(PG8_SB(0, 1), b2 + hstep, voffB);
            PG8_WAIT_V(6); PG8_BAR; PG8_MMA(1, 1, At, B1); PG8_BAR;
            PG8_LDB(B0, 1, 0); PG8_SCHED; PG8_LDA(At, 1, 0); PG8_STAGE(PG8_SA(0, 1), a2 + hstep, voffA);
            PG8_WAIT_L(8); PG8_BAR; PG8_WAIT_L(0); PG8_MMA(0, 0, At, B0); PG8_BAR; PG8_SCHED;
            PG8_LDB(B1, 1, 1); PG8_STAGE(PG8_SB(1, 0), b3, voffB);
            PG8_BAR; PG8_WAIT_L(0); PG8_MMA(0, 1, At, B1); PG8_BAR;
            PG8_LDA(At, 1, 1); PG8_STAGE(PG8_SA(1, 0), a3, voffA);
            PG8_BAR; PG8_WAIT_L(0); PG8_MMA(1, 0, At, B0); PG8_BAR; PG8_SCHED;
            PG8_STAGE(PG8_SB(1, 1), b3 + hstep, voffB);
            PG8_WAIT_V(6); PG8_BAR; PG8_MMA(1, 1, At, B1); PG8_BAR;
            }
        }
        if constexpr (ALIGN_EPI) { if (wr == 0) PG8_BAR; }
        if constexpr (!Epi::AFTER_DRAIN) { E(acc, cur, wr, wc, fr, fq); S.done(cur); }
        if (!has_next) break;
#pragma unroll
        for (int a = 0; a < 2; ++a)
#pragma unroll
            for (int b = 0; b < 2; ++b)
#pragma unroll
                for (int m = 0; m < 4; ++m)
#pragma unroll
                    for (int n = 0; n < 2; ++n) acc[a][b][m][n] = (f32x4){0.f, 0.f, 0.f, 0.f};
        cur = nxt; cA = nA; cB = nB; ++ui;
        if constexpr (ALIGN_EPI) { if (wr == 1) PG8_BAR; }
    }
    PG8_WAIT_V(0);
    if constexpr (!ALIGN_EPI) { if (wr == 0) PG8_BAR; }
    PG8_BAR;
    if constexpr (Epi::AFTER_DRAIN) { E.fused(acc, cur, wr, wc, fr, fq, lds, wid, lane); S.done(cur); }
#undef PG8_SA
#undef PG8_SB
#undef PG8_STAGE
#undef PG8_LDA
#undef PG8_LDB
#undef PG8_MMA
#undef PG8_WAIT_V
#undef PG8_WAIT_L
#undef PG8_BAR
#undef PG8_SCHED
}
}

#define LAS __attribute__((address_space(3)))
typedef unsigned short bf16;
typedef float f32x4 __attribute__((ext_vector_type(4)));
typedef float f32x2 __attribute__((ext_vector_type(2)));
typedef unsigned u32x4 __attribute__((ext_vector_type(4)));
typedef unsigned u32x2 __attribute__((ext_vector_type(2)));
typedef short bf16x8_t __attribute__((ext_vector_type(8)));
constexpr int DM = 2048, NB = 4, TL = 2048, TC = 256, MLAT = NB * TL, MCTX = NB * TC, MALL = MLAT + MCTX;
constexpr int FF = 5632, NUP = 2 * FF, NIN = 6416, NINP_W = 6656, NMODV = 9 * DM;
constexpr int TSTEPS = TL + TC, NTILES = TSTEPS / 32;
constexpr float EPS = 1e-6f;
constexpr int NUF = 1280, NUG = 5376;
constexpr int U_SSD_DT = 0, U_HG_F = 16;
constexpr int G_SSD_Z = 0, G_LRU_G = 512, G_HG_G = 1024, G_RT_G = 1536, G_HG_I = 2048, G_RT_V = 2560, G_HG_Q = 3072, G_RT_Q = 3584, G_RT_K = 3840, G_SSD_XBC = 4096, G_LRU_X = 4864;
constexpr int U_LRU_G = 0, U_HG_G = 0, U_RT_G = 0, U_HG_I = 0, U_RT_V = 0, U_HG_Q = 0, U_RT_Q = 0, U_RT_K = 0, U_SSD_XBC = 0, U_LRU_X = 0;
__host__ __device__ constexpr int u_newpos(int n) {
    return n < 512 ? NUF + G_SSD_Z + n : n < 1280 ? NUF + G_SSD_XBC + (n - 512) : n < 1296 ? U_SSD_DT + (n - 1280) : n < 1808 ? NUF + G_LRU_X + (n - 1296) : n < 2320 ? NUF + G_LRU_G + (n - 1808)
         : n < 2832 ? NUF + G_HG_Q + (n - 2320) : n < 3856 ? U_HG_F + (n - 2832) : n < 4368 ? NUF + G_HG_I + (n - 3856) : n < 4880 ? NUF + G_HG_G + (n - 4368) : n < 5136 ? NUF + G_RT_Q + (n - 4880)
         : n < 5392 ? NUF + G_RT_K + (n - 5136) : n < 5904 ? NUF + G_RT_V + (n - 5392) : n < 6416 ? NUF + G_RT_G + (n - 5904) : 1040 + (n - 6416); }
constexpr int NPHASES = 26;
constexpr int LDS_BYTES = 147456;
constexpr size_t MiB = 1u << 20;
constexpr size_t WS_MOD = 1 * MiB, WS_W13 = 2 * MiB, WS_W2 = 178 * MiB, WS_WIN = 266 * MiB, WS_WOUT = 318 * MiB, WS_X = 334 * MiB, WS_H = 406 * MiB,
                 WS_Y = 442 * MiB, WS_U = 514 * MiB, WS_XBC = 748 * MiB, WS_LA = 775 * MiB, WS_LB = 811 * MiB, WS_YD = 847 * MiB, WS_END = 991 * MiB, WS_UG = 610 * MiB;

struct Params {
    const float *x, *c, *ctx, *c_ctx, *w_mod, *b_mod, *norm_pre, *norm_post, *ffn_w1, *ffn_w3, *ffn_w2, *w_in, *w_out,
        *ssd_conv_w, *ssd_conv_b, *ssd_dt_bias, *ssd_a_log, *ssd_d, *ssd_norm_w, *lru_conv_w, *lru_conv_b, *lru_wa, *lru_ba, *lru_wx, *lru_bx, *lru_lambda,
        *hgrn_lb_logits, *hgrn_norm_w;
    float* out; unsigned char* ws; int ph_lo, ph_hi;
};

__device__ __forceinline__ float sigmoid_(float x) { return __builtin_amdgcn_rcpf(1.f + __expf(-x)); }
__device__ __forceinline__ float silu_(float x) { return x * sigmoid_(x); }
__device__ __forceinline__ float softplus_(float x) { return fmaxf(x, 0.f) + log1pf(__expf(-fabsf(x))); }
__device__ __forceinline__ float gelu_tanh_(float x) { const float z = 0.7978845608f * (x + 0.044715f * x * x * x); const float t = 1.f - 2.f * __builtin_amdgcn_rcpf(1.f + __expf(2.f * z)); return 0.5f * x * (1.f + t); }
__device__ __forceinline__ unsigned f2bf(float f) { unsigned u = __builtin_bit_cast(unsigned, f); return (u + 0x7fffu + ((u >> 16) & 1u)) >> 16; }
__device__ __forceinline__ unsigned pk2(float lo, float hi) { return f2bf(lo) | (f2bf(hi) << 16); }
__device__ __forceinline__ float wave_sum(float v) {
#pragma unroll
    for (int o = 1; o < 64; o <<= 1) v += __shfl_xor(v, o);
    return v;
}
__device__ __forceinline__ float half_sum(float v) {
#pragma unroll
    for (int o = 1; o < 32; o <<= 1) v += __shfl_xor(v, o);
    return v;
}
__device__ __forceinline__ float dot4(f32x4 a) { return (a.x * a.x + a.y * a.y) + (a.z * a.z + a.w * a.w); }
__device__ __forceinline__ f32x4 ld_bf4(const bf16* p) { const u32x2 w = *(const u32x2*)p; return (f32x4){__builtin_bit_cast(float, w.x << 16), __builtin_bit_cast(float, w.x & 0xffff0000u), __builtin_bit_cast(float, w.y << 16), __builtin_bit_cast(float, w.y & 0xffff0000u)}; }
#define LDS_WAIT() asm volatile("s_waitcnt lgkmcnt(0)" ::: "memory")
__device__ __forceinline__ int tid_() { int t = threadIdx.x; asm volatile("" : "+v"(t)); return t; }
__device__ __forceinline__ int bid_() { int t = blockIdx.x; asm volatile("" : "+s"(t)); return t; }
__device__ __forceinline__ int scan_row(int b, int d, int i) {
    if (i < TC) { const int t = d ? (TC - 1 - i) : i; return MLAT + b * TC + t; }
    int t = i - TC; if (d) t = TL - 1 - t; return b * TL + t;
}

#define XB_TMO      128
#define XB_XCNT(j)  (256  + 64 * (j))
#define XB_XSUB(j)  (1280 + 64 * (j))
#define XB_XGEN(j)  (2304 + 64 * (j))
#define XB_TOP      3328
#define XB_TOPGEN   3392
#define XCD_BAR_WORDS 3456
#define XB_SPIN_CAP (1u << 18)

__device__ __forceinline__ unsigned xb_ld(unsigned* p)              { return __hip_atomic_load(p, __ATOMIC_RELAXED, __HIP_MEMORY_SCOPE_AGENT); }
__device__ __forceinline__ unsigned xb_add(unsigned* p, unsigned v) { return __hip_atomic_fetch_add(p, v, __ATOMIC_RELAXED, __HIP_MEMORY_SCOPE_AGENT); }
__device__ __forceinline__ unsigned xb_xcc_id() { return (unsigned)__builtin_amdgcn_s_getreg((3 << 11) | 20) & 0xFu; }
#define XB_SPIN(cond, bar) do { unsigned _sp = 0; while (cond) { __builtin_amdgcn_s_sleep(1); \
    if ((++_sp & 255u) == 0u) { if (xb_ld(&(bar)[XB_TMO])) break; if (_sp > XB_SPIN_CAP) { atomicAdd(&(bar)[XB_TMO], 1u); break; } } } } while (0)

struct XcdBarrier {
    unsigned* bar; unsigned x;
    volatile LAS unsigned* st;
};

__device__ __forceinline__ XcdBarrier xcd_barrier_post(unsigned* bar, volatile LAS unsigned* st) {
    XcdBarrier b; b.bar = bar; b.x = xb_xcc_id(); b.st = st;
    if (threadIdx.x == 0) (void)xb_add(&bar[XB_XCNT(b.x)], 1u);
    return b;
}
__device__ __forceinline__ void xcd_barrier_complete(unsigned* bar, unsigned x, unsigned& nloc, unsigned& nx) {
    const unsigned G = gridDim.x * gridDim.y * gridDim.z;
    unsigned sum, cnt, mine, sp = 0u;
    for (;;) {
        sum = 0u; cnt = 0u; mine = 0u;
#pragma unroll
        for (unsigned j = 0; j < 16; ++j) { const unsigned c = xb_ld(&bar[XB_XCNT(j)]); sum += c; cnt += (c > 0u) ? 1u : 0u; mine = (j == x) ? c : mine; }
        if (sum == G) break;
        __builtin_amdgcn_s_sleep(1);
        if ((++sp & 255u) == 0u) { if (xb_ld(&bar[XB_TMO])) break; if (sp > XB_SPIN_CAP) { atomicAdd(&bar[XB_TMO], 1u); break; } }
    }
    nloc = mine > 0u ? mine : 1u; nx = cnt > 0u ? cnt : 1u;
}

__device__ __forceinline__ void xcd_barrier(const XcdBarrier& b) {
    asm volatile("s_waitcnt vmcnt(0)" ::: "memory");
    __syncthreads();
    if (threadIdx.x == 0) {
        unsigned* bar = b.bar;
        __builtin_amdgcn_s_waitcnt(0);
        unsigned nloc = b.st[0], nx = b.st[1];
        if (nloc == 0u) { xcd_barrier_complete(bar, b.x, nloc, nx); b.st[0] = nloc; b.st[1] = nx; }
        const unsigned old = xb_add(&bar[XB_XSUB(b.x)], 1u);
        const unsigned gen = old / nloc;
        if (old + 1u == (gen + 1u) * nloc) {
            __builtin_amdgcn_fence(__ATOMIC_RELEASE, "agent");
            asm volatile("s_waitcnt vmcnt(0)" ::: "memory");
            const unsigned og = xb_add(&bar[XB_TOP], 1u);
            const unsigned tg = og / nx;
            if (og + 1u == (tg + 1u) * nx) xb_add(&bar[XB_TOPGEN], 1u);
            else XB_SPIN(xb_ld(&bar[XB_TOPGEN]) == tg, bar);
            __builtin_amdgcn_fence(__ATOMIC_ACQUIRE, "agent");
            xb_add(&bar[XB_XGEN(b.x)], 1u);
            asm volatile("s_waitcnt vmcnt(0)" ::: "memory");
        } else {
            XB_SPIN(xb_ld(&bar[XB_XGEN(b.x)]) == gen, bar);
            __builtin_amdgcn_fence(__ATOMIC_ACQUIRE, "agent");
            asm volatile("s_waitcnt vmcnt(0)" ::: "memory");
        }
    }
    __syncthreads();
}

namespace pg8 {
struct EpiSwiGLU {
    static constexpr bool PERM = true, AFTER_DRAIN = false;
    bf16_t* O; int ldc;
    __device__ __forceinline__ void operator()(const f32x4 (&acc)[2][2][4][2], const Unit& u, int wr, int wc, int fr, int fq) const {
        const int row0 = u.pm * BM + wr * 64 + fr, col0 = u.pn * HALF + wc * 32 + 8 * fq;
#pragma unroll
        for (int ai = 0; ai < 2; ++ai)
#pragma unroll
            for (int m = 0; m < 4; ++m) {
                bf16_t* rowp = O + (size_t)(row0 + ai * HALF + m * 16) * ldc + col0;
                const f32x4 a0 = acc[ai][0][m][0], a1 = acc[ai][0][m][1], b0 = acc[ai][1][m][0], b1 = acc[ai][1][m][1];
                float r[8];
#pragma unroll
                for (int j = 0; j < 4; ++j) { r[j] = a0[j] * __builtin_amdgcn_rcpf(1.f + __expf(-a0[j])) * b0[j]; r[4 + j] = a1[j] * __builtin_amdgcn_rcpf(1.f + __expf(-a1[j])) * b1[j]; }
                u32x4 w; w.x = cvt_pk_bf16(r[0], r[1]); w.y = cvt_pk_bf16(r[2], r[3]); w.z = cvt_pk_bf16(r[4], r[5]); w.w = cvt_pk_bf16(r[6], r[7]);
                *(u32x4*)rowp = w;
                asm volatile("" ::: "memory");
            }
    }
};
struct EpiF32 {
    static constexpr bool PERM = true, AFTER_DRAIN = false;
    float* O; int ldc; int asbf; bf16_t* O2; int ldc2, split_pn;
    __device__ __forceinline__ void operator()(const f32x4 (&acc)[2][2][4][2], const Unit& u, int wr, int wc, int fr, int fq) const {
        const bool sec = split_pn > 0 && u.pn >= split_pn;
        const int row0 = u.pm * BM + wr * 64 + fr, col0 = (sec ? u.pn - split_pn : u.pn) * BM + wc * 32 + 8 * fq;
        if (asbf || sec) {
            bf16_t* Ob = sec ? O2 : (bf16_t*)O; const int ldc = sec ? ldc2 : this->ldc;
#pragma unroll
            for (int ai = 0; ai < 2; ++ai)
#pragma unroll
                for (int m = 0; m < 4; ++m) {
                    bf16_t* rowp = Ob + (size_t)(row0 + ai * HALF + m * 16) * ldc + col0;
#pragma unroll
                    for (int bj = 0; bj < 2; ++bj) { const f32x4 v0 = acc[ai][bj][m][0], v1 = acc[ai][bj][m][1]; u32x4 w; w.x = cvt_pk_bf16(v0[0], v0[1]); w.y = cvt_pk_bf16(v0[2], v0[3]); w.z = cvt_pk_bf16(v1[0], v1[1]); w.w = cvt_pk_bf16(v1[2], v1[3]);
                        *(u32x4*)(rowp + bj * HALF) = w; }
                }
            return;
        }
#pragma unroll
        for (int ai = 0; ai < 2; ++ai)
#pragma unroll
            for (int m = 0; m < 4; ++m) {
                float* rowp = O + (size_t)(row0 + ai * HALF + m * 16) * ldc + col0;
#pragma unroll
                for (int bj = 0; bj < 2; ++bj)
#pragma unroll
                    for (int n = 0; n < 2; ++n) *(f32x4*)(rowp + bj * HALF + n * 4) = acc[ai][bj][m][n];
            }
    }
};
}


namespace pg8 {
struct Order2 {
    StaticOrder so; int one, valid; Unit u1;
    __device__ bool next(int i, Unit& u) const { if (one) { if (i > 0 || !valid) return false; u = u1; return true; } return so.next(i, u); }
    __device__ __forceinline__ void a_ready(const Unit&) const {}
    __device__ __forceinline__ void done(const Unit&) const {}
};
}
__device__ __forceinline__ void transpose_item64(const float* __restrict__ W, int K, int N, bf16* __restrict__ WT, int mode, float* scr, int item, int lane) {
    const int nblk = (N + 63) >> 6, kb = item / nblk, nb = item - kb * nblk, k0 = kb << 6, n0 = nb << 6;
    const int lr = lane >> 4, lc = (lane & 15) << 2;
    const bool ok = (n0 + lc) < N;
#pragma unroll
    for (int i = 0; i < 16; ++i) {
        const int kk = 4 * i + lr; f32x4 v = {0.f, 0.f, 0.f, 0.f};
        if (ok) v = __builtin_nontemporal_load((const f32x4*)(W + (size_t)(k0 + kk) * N + n0 + lc));
        float* s = scr + kk * 65 + lc; s[0] = v.x; s[1] = v.y; s[2] = v.z; s[3] = v.w;
    }
    LDS_WAIT();
    const int c = lane & 7;
#pragma unroll
    for (int j = 0; j < 8; ++j) {
        const int n = (lane >> 3) + 8 * j; const float* s = scr + (8 * c) * 65 + n;
        u32x4 o; o.x = pk2(s[0], s[65]); o.y = pk2(s[2 * 65], s[3 * 65]); o.z = pk2(s[4 * 65], s[5 * 65]); o.w = pk2(s[6 * 65], s[7 * 65]);
        const int dn = n0 + n; int row = dn; if (mode == 3) row = u_newpos(dn); else if (mode) row = ((dn >> 7) << 8) + (dn & 127) + (mode == 2 ? 128 : 0);
        *(u32x4*)(WT + (size_t)row * K + k0 + 8 * c) = o;
    }
    LDS_WAIT();
}

__device__ __forceinline__ void prologue_phase(const Params& P, float* L) {
    const int tid = tid_(), lane = tid & 63, wave = __builtin_amdgcn_readfirstlane(tid >> 6);
    unsigned char* ws = P.ws;
    float* MOD = (float*)(ws + WS_MOD);
    float* sc = L;
    float* red = L + 5 * DM;
    for (int i = tid; i < 5 * DM; i += 512) { const int r = i >> 11, k = i & (DM - 1); const float v = r < 4 ? P.c[r * DM + k] : P.c_ctx[k]; sc[i] = silu_(v); }
    __syncthreads();
    for (int it = bid_(); it < 1152; it += gridDim.x) {
        const int l = it / 576, j0 = (it % 576) * 32;
        const float* Wm = P.w_mod + (size_t)l * DM * NMODV;
        const int kr = lane >> 3, c4 = (lane & 7) << 2;
        f32x4 acc[5];
#pragma unroll
        for (int r = 0; r < 5; ++r) acc[r] = (f32x4){0.f, 0.f, 0.f, 0.f};
        const int kbase = wave * 256 + kr;
#pragma unroll 16
        for (int kk = 0; kk < 256; kk += 8) {
            const int k = kbase + kk; const f32x4 w = __builtin_nontemporal_load((const f32x4*)(Wm + (size_t)k * NMODV + j0 + c4));
#pragma unroll
            for (int r = 0; r < 5; ++r) acc[r] += w * sc[r * DM + k];
        }
#pragma unroll
        for (int r = 0; r < 5; ++r)
#pragma unroll
            for (int e = 0; e < 4; ++e) { float v = acc[r][e]; v += __shfl_xor(v, 8); v += __shfl_xor(v, 16); v += __shfl_xor(v, 32); acc[r][e] = v; }
        if (lane < 8) {
#pragma unroll
            for (int r = 0; r < 5; ++r) *(f32x4*)&red[(wave * 5 + r) * 32 + c4] = acc[r];
        }
        __syncthreads();
        if (tid < 160) { const int r = tid >> 5, j = tid & 31; float s_ = 0.f;
#pragma unroll
            for (int w = 0; w < 8; ++w) s_ += red[(w * 5 + r) * 32 + j];
            MOD[(size_t)(l * 5 + r) * NMODV + j0 + j] = s_ + P.b_mod[l * NMODV + j0 + j]; }
        __syncthreads();
    }
    bf16* W13 = (bf16*)(ws + WS_W13); bf16* W2 = (bf16*)(ws + WS_W2); bf16* WIN = (bf16*)(ws + WS_WIN); bf16* WOUT = (bf16*)(ws + WS_WOUT);
    float* scr = L + wave * (64 * 65);
    const int gw = bid_() * 8 + wave, NGW = gridDim.x * 8;
    constexpr int I_F = 2816, I_LF = 3 * I_F, I_FFN = 4 * I_LF, I_IN = 32 * 101, I_OUT = 32 * 32, I_ALL = I_FFN + 2 * I_IN + 2 * I_OUT;
    for (int it = gw; it < I_ALL; it += NGW) {
        int r = it;
        if (r < I_FFN) {
            const int lf = r / I_LF, q = r % I_LF, which = q / I_F, item = q % I_F;
            if (which == 0) transpose_item64(P.ffn_w1 + (size_t)lf * DM * FF, DM, FF, W13 + (size_t)lf * NUP * DM, 1, scr, item, lane);
            else if (which == 1) transpose_item64(P.ffn_w3 + (size_t)lf * DM * FF, DM, FF, W13 + (size_t)lf * NUP * DM, 2, scr, item, lane);
            else transpose_item64(P.ffn_w2 + (size_t)lf * FF * DM, FF, DM, W2 + (size_t)lf * DM * FF, 0, scr, item, lane);
        } else {
            r -= I_FFN;
            if (r < 2 * I_IN) { const int l = r / I_IN, item = r % I_IN; transpose_item64(P.w_in + (size_t)l * DM * NIN, DM, NIN, WIN + (size_t)l * NINP_W * DM, 3, scr, item, lane); }
            else { r -= 2 * I_IN; const int l = r / I_OUT, item = r % I_OUT; transpose_item64(P.w_out + (size_t)l * DM * DM, DM, DM, WOUT + (size_t)l * DM * DM, 0, scr, item, lane); }
        }
    }
}

__device__ __forceinline__ void rowwise_phase(const Params& P, int mrows, bool first, int l_post, int j_post, int gate_idx, float coef, bool final_, int l_pre, int j_pre, int shift_idx, int scale_idx) {
    const int tid = tid_(), lane = tid & 63, wave = __builtin_amdgcn_readfirstlane(tid >> 6);
    const int gw = bid_() * 8 + wave, NGW = gridDim.x * 8;
    const float* MOD = (const float*)(P.ws + WS_MOD);
    float* X = (float*)(P.ws + WS_X); const float* Y = (const float*)(P.ws + WS_Y); bf16* H = (bf16*)(P.ws + WS_H);
    for (int row = gw; row < mrows; row += NGW) {
        const int b = row < MLAT ? (row >> 11) : 4;
        f32x4 xv[8]; float ss_new = 0.f;
        if (first) {
            const float* src = row < MLAT ? P.x + (size_t)row * DM : P.ctx + (size_t)(row - MLAT) * DM;
#pragma unroll
            for (int j = 0; j < 8; ++j) xv[j] = *(const f32x4*)(src + 4 * lane + 256 * j);
        } else {
            const float* xr = (l_post == 0 && j_post == 0) ? (row < MLAT ? P.x + (size_t)row * DM : P.ctx + (size_t)(row - MLAT) * DM) : X + (size_t)row * DM;
            f32x4 yv[8]; float ss = 0.f;
            if (row < MLAT) {
                const bf16* yb = (const bf16*)Y + (size_t)row * DM;
#pragma unroll
                for (int j = 0; j < 8; ++j) { const u32x2 w = *(const u32x2*)(yb + 4 * lane + 256 * j);
                    yv[j] = (f32x4){__builtin_bit_cast(float, w.x << 16), __builtin_bit_cast(float, w.x & 0xffff0000u), __builtin_bit_cast(float, w.y << 16), __builtin_bit_cast(float, w.y & 0xffff0000u)}; }
            } else {
                const bf16* pr = (const bf16*)(P.ws + WS_YD) + (size_t)(row - MLAT) * DM;
#pragma unroll
                for (int j = 0; j < 8; ++j) yv[j] = ld_bf4(pr + 4 * lane + 256 * j);
                for (int ks = 1; ks < 8; ++ks) {
#pragma unroll
                    for (int j = 0; j < 8; ++j) yv[j] += ld_bf4(pr + (size_t)ks * MCTX * DM + 4 * lane + 256 * j);
                }
            }
            const float* gp = P.norm_post + (size_t)(l_post * 3 + j_post) * DM; const float* mg = MOD + (size_t)(l_post * 5 + b) * NMODV + gate_idx * DM;
            float sxx = 0.f, sxt = 0.f, stt = 0.f;
#pragma unroll
            for (int j = 0; j < 8; ++j) { const int c = 4 * lane + 256 * j; xv[j] = *(const f32x4*)(xr + c); const f32x4 g4 = *(const f32x4*)(gp + c), m4 = *(const f32x4*)(mg + c);
                ss += dot4(yv[j]); yv[j] = yv[j] * g4 * m4; sxx += dot4(xv[j]); stt += dot4(yv[j]);
                const f32x4 xt = xv[j] * yv[j]; sxt += (xt.x + xt.y) + (xt.z + xt.w); }
#pragma unroll
            for (int o = 1; o < 64; o <<= 1) { ss += __shfl_xor(ss, o); sxx += __shfl_xor(sxx, o); sxt += __shfl_xor(sxt, o); stt += __shfl_xor(stt, o); }
            const float rs = rsqrtf(ss * (1.f / DM) + EPS) * coef;
            ss_new = sxx + 2.f * rs * sxt + rs * rs * stt;
#pragma unroll
            for (int j = 0; j < 8; ++j) xv[j] += yv[j] * rs;
        }
        if (final_) {
            float* o = P.out + (size_t)row * DM;
#pragma unroll
            for (int j = 0; j < 8; ++j) *(f32x4*)(o + 4 * lane + 256 * j) = xv[j];
            continue;
        }
        {
            float* xr = X + (size_t)row * DM; float ss = 0.f;
#pragma unroll
            for (int j = 0; j < 8; ++j) { if (!first) *(f32x4*)(xr + 4 * lane + 256 * j) = xv[j]; else ss += dot4(xv[j]); }
            if (first) ss = wave_sum(ss); else ss = ss_new;
            const float rs = rsqrtf(ss * (1.f / DM) + EPS);
            const float* gp = P.norm_pre + (size_t)(l_pre * 3 + j_pre) * DM; const float* mb = MOD + (size_t)(l_pre * 5 + b) * NMODV;
            bf16* hr = H + (size_t)row * DM;
#pragma unroll
            for (int j = 0; j < 8; ++j) { const int c = 4 * lane + 256 * j; const f32x4 g4 = *(const f32x4*)(gp + c), sh = *(const f32x4*)(mb + shift_idx * DM + c), scl = *(const f32x4*)(mb + scale_idx * DM + c);
                const f32x4 h = (xv[j] * rs) * g4 * (scl + 1.f) + sh; u32x2 w; w.x = pk2(h.x, h.y); w.y = pk2(h.z, h.w); *(u32x2*)(hr + c) = w; }
        }
    }
}

__device__ __forceinline__ f32x4 conv4(const bf16* __restrict__ U, int row, int col, const float* __restrict__ cw, int C, const float* __restrict__ cb) {
    int t, len; if (row < MLAT) { t = row & (TL - 1); len = TL; } else { t = (row - MLAT) & (TC - 1); len = TC; }
    f32x4 acc = *(const f32x4*)cb;
#pragma unroll
    for (int j = 0; j < 4; ++j) { const int tt = t + j - 1; if (tt >= 0 && tt < len) { const f32x4 xx = ld_bf4(U + (size_t)(row + j - 1) * NUG + col); const f32x4 w = *(const f32x4*)(cw + j * C); acc += xx * w; } }
    return acc;
}
__device__ __forceinline__ void prep_phase(const Params& P, float* L, int l) {
    const int tid = tid_();
    const float* U = (const float*)(P.ws + WS_U); bf16* XBC = (bf16*)(P.ws + WS_XBC); float* LA = (float*)(P.ws + WS_LA); bf16* LB = (bf16*)(P.ws + WS_LB);
    { const float* cw = P.ssd_conv_w + (size_t)l * 4 * 768; const float* cb = P.ssd_conv_b + (size_t)l * 768;
      for (int idx = bid_() * 512 + tid; idx < (MALL / 16) * 192; idx += gridDim.x * 512) {
          const int chunk = idx / 192, c4 = (idx - chunk * 192) << 2, row0 = chunk * 16;
          int t0, len; if (row0 < MLAT) { t0 = row0 & (TL - 1); len = TL; } else { t0 = (row0 - MLAT) & (TC - 1); len = TC; }
          const f32x4 w0 = *(const f32x4*)(cw + c4), w1 = *(const f32x4*)(cw + 768 + c4), w2 = *(const f32x4*)(cw + 2 * 768 + c4), w3 = *(const f32x4*)(cw + 3 * 768 + c4), bb = *(const f32x4*)(cb + c4);
          const bf16* up = (const bf16*)(P.ws + WS_UG) + (size_t)row0 * NUG + G_SSD_XBC + c4;
          const f32x4 z4 = {0.f, 0.f, 0.f, 0.f};
          f32x4 xm1 = (t0 > 0) ? ld_bf4(up - NUG) : z4, x0 = ld_bf4(up), x1 = ld_bf4(up + NUG);
#pragma unroll
          for (int r = 0; r < 16; ++r) {
              const f32x4 x2 = (t0 + r + 2 < len) ? ld_bf4(up + (size_t)(r + 2) * NUG) : z4;
              f32x4 v = bb + xm1 * w0 + x0 * w1 + x1 * w2 + x2 * w3;
              v.x = silu_(v.x); v.y = silu_(v.y); v.z = silu_(v.z); v.w = silu_(v.w);
              { u32x2 w_; w_.x = pk2(v.x, v.y); w_.y = pk2(v.z, v.w); *(u32x2*)(XBC + (size_t)(row0 + r) * 768 + c4) = w_; }
              xm1 = x0; x0 = x1; x1 = x2;
          } } }
    unsigned short* WT = (unsigned short*)L;
    unsigned short* xb = WT + 4 * 64 * 72;
    float* xs = (float*)(xb + 64 * 72);
    const float* cw = P.lru_conv_w + (size_t)l * 4 * 512; const float* cb = P.lru_conv_b + (size_t)l * 512;
    const int lane = tid & 63, wave = __builtin_amdgcn_readfirstlane(tid >> 6), fr = lane & 15, fq = lane >> 4;
    int cur_h = -1;
    for (int it = bid_(); it < 144 * 8; it += gridDim.x) {
        const int h = it & 7, row0 = (it >> 3) * 64;
        __syncthreads();
        if (h != cur_h) {
            for (int i = tid; i < 4 * 4096; i += 512) { const int m = i >> 12, ii = (i >> 6) & 63, j = i & 63, d = m >> 1; const float* src = (m & 1) ? P.lru_wx : P.lru_wa;
                WT[(m * 64 + j) * 72 + ii] = (unsigned short)f2bf(src[((size_t)(l * 2 + d) * 8 + h) * 4096 + ii * 64 + j]); }
            cur_h = h;
        }
        for (int i = tid; i < 1024; i += 512) { const int r = i >> 4, c4 = (i & 15) << 2;
            const f32x4 v = conv4((const bf16*)(P.ws + WS_UG), row0 + r, G_LRU_X + h * 64 + c4, cw + h * 64 + c4, 512, cb + h * 64 + c4);
            *(f32x4*)&xs[r * 68 + c4] = v; u32x2 w; w.x = pk2(v.x, v.y); w.y = pk2(v.z, v.w); *(u32x2*)&xb[r * 72 + c4] = w; }
        __syncthreads();
        {
            const int tt = wave & 3, d = wave >> 2;
            f32x4 acc[2][4];
#pragma unroll
            for (int g2 = 0; g2 < 2; ++g2)
#pragma unroll
                for (int jt = 0; jt < 4; ++jt) acc[g2][jt] = (f32x4){0.f, 0.f, 0.f, 0.f};
#pragma unroll
            for (int ks = 0; ks < 2; ++ks) {
                const bf16x8_t a = *(const bf16x8_t*)&xb[(tt * 16 + fr) * 72 + ks * 32 + fq * 8];
#pragma unroll
                for (int g2 = 0; g2 < 2; ++g2)
#pragma unroll
                    for (int jt = 0; jt < 4; ++jt) { const bf16x8_t bq = *(const bf16x8_t*)&WT[((d * 2 + g2) * 64 + jt * 16 + fr) * 72 + ks * 32 + fq * 8];
                        acc[g2][jt] = __builtin_amdgcn_mfma_f32_16x16x32_bf16(a, bq, acc[g2][jt], 0, 0, 0); }
            }
#pragma unroll
            for (int jt = 0; jt < 4; ++jt) {
                const int j = jt * 16 + fr, c = h * 64 + j;
                const float ba1 = P.lru_ba[(size_t)(l * 2 + d) * 512 + c], bx1 = P.lru_bx[(size_t)(l * 2 + d) * 512 + c], sp = softplus_(-P.lru_lambda[(size_t)(l * 2 + d) * 512 + c]);
#pragma unroll
                for (int jj = 0; jj < 4; ++jj) {
                    const int t = tt * 16 + 4 * fq + jj, row = row0 + t;
                    const float rg = sigmoid_(acc[0][jt][jj] + ba1), ig = sigmoid_(acc[1][jt][jj] + bx1);
                    const float la = -8.f * rg * sp;
                    const float a_ = __expf(la); LA[((size_t)d * MALL + row) * 512 + c] = a_;
                    LB[((size_t)d * MALL + row) * 512 + c] = (bf16)f2bf(sqrtf(fmaxf(1.f - a_ * a_, 1e-12f)) * (ig * xs[t * 68 + j]));
                }
            }
        }
    }
}


#define MEMFENCE() asm volatile("" ::: "memory")
struct StepOps { f32x4 k0, k1, q0, q1; float v, a; };
__device__ __forceinline__ void ssd_core(const float* __restrict__ qs, const float* __restrict__ ks, const float* __restrict__ vs, const float* __restrict__ as, const float* __restrict__ la, const float* __restrict__ lb,
                                         float* __restrict__ lo, float* __restrict__ yp, f32x2& S0, f32x2& S1, f32x2& S2, f32x2& S3, float& hl, int tid, int p, int sl, float dsk, bool has_a) {
    StepOps c, n;
#define LD_OPS(o, s_) do { (o).k0 = *(const f32x4*)&ks[(s_) * 64 + sl * 8]; (o).k1 = *(const f32x4*)&ks[(s_) * 64 + sl * 8 + 4]; (o).q0 = *(const f32x4*)&qs[(s_) * 64 + sl * 8]; (o).q1 = *(const f32x4*)&qs[(s_) * 64 + sl * 8 + 4]; \
        (o).v = vs[(s_) * 64 + p]; (o).a = has_a ? as[(s_)] : dsk; } while (0)
#define DO_STEP(o, s_) do { const float a_ = has_a ? (o).a : dsk; const float v_ = (o).v; \
        S0 = S0 * a_ + (f32x2){(o).k0.x, (o).k0.y} * v_; S1 = S1 * a_ + (f32x2){(o).k0.z, (o).k0.w} * v_; S2 = S2 * a_ + (f32x2){(o).k1.x, (o).k1.y} * v_; S3 = S3 * a_ + (f32x2){(o).k1.z, (o).k1.w} * v_; \
        const f32x2 y2_ = ((f32x2){(o).q0.x, (o).q0.y} * S0 + (f32x2){(o).q0.z, (o).q0.w} * S1) + ((f32x2){(o).q1.x, (o).q1.y} * S2 + (f32x2){(o).q1.z, (o).q1.w} * S3); \
        float y_ = y2_.x + y2_.y; if (has_a && sl == 0) y_ += dsk * v_; yp[(s_) * 512 + tid] = y_; } while (0)
    LD_OPS(c, 0); MEMFENCE();
#pragma unroll 2
    for (int s = 0; s < 32; s += 2) {
        LD_OPS(n, s + 1); MEMFENCE();
        DO_STEP(c, s); MEMFENCE();
        if (s + 2 < 32) { LD_OPS(c, s + 2); } MEMFENCE();
        DO_STEP(n, s + 1); MEMFENCE();
    }
#undef LD_OPS
#undef DO_STEP
    if (has_a && tid < 64) {
#pragma unroll 8
        for (int s = 0; s < 32; ++s) { hl = la[s * 64 + tid] * hl + lb[s * 64 + tid]; lo[s * 64 + tid] = hl; }
    }
}
__device__ __forceinline__ void hgrn_core(const float* __restrict__ qs, const float* __restrict__ fs, const float* __restrict__ vs, float* __restrict__ yp, f32x2& S0, f32x2& S1, f32x2& S2, f32x2& S3, int tid, int p, int sl) {
    StepOps c, n;
#define LD_OPS(o, s_) do { (o).k0 = *(const f32x4*)&fs[(s_) * 128 + sl * 4]; (o).k1 = *(const f32x4*)&fs[(s_) * 128 + 64 + sl * 4]; (o).q0 = *(const f32x4*)&qs[(s_) * 128 + sl * 4]; (o).q1 = *(const f32x4*)&qs[(s_) * 128 + 64 + sl * 4]; \
        (o).v = vs[(s_) * 32 + p]; } while (0)
#define DO_STEP(o, s_) do { const f32x2 v2_ = {(o).v, (o).v}; \
        S0 = v2_ + (f32x2){(o).k0.x, (o).k0.y} * (S0 - v2_); S1 = v2_ + (f32x2){(o).k0.z, (o).k0.w} * (S1 - v2_); S2 = v2_ + (f32x2){(o).k1.x, (o).k1.y} * (S2 - v2_); S3 = v2_ + (f32x2){(o).k1.z, (o).k1.w} * (S3 - v2_); \
        const f32x2 y2_ = ((f32x2){(o).q0.x, (o).q0.y} * S0 + (f32x2){(o).q0.z, (o).q0.w} * S1) + ((f32x2){(o).q1.x, (o).q1.y} * S2 + (f32x2){(o).q1.z, (o).q1.w} * S3); \
        yp[(s_) * 512 + tid] = y2_.x + y2_.y; } while (0)
    LD_OPS(c, 0); MEMFENCE();
#pragma unroll 2
    for (int s = 0; s < 32; s += 2) {
        LD_OPS(n, s + 1); MEMFENCE();
        DO_STEP(c, s); MEMFENCE();
        if (s + 2 < 32) { LD_OPS(c, s + 2); } MEMFENCE();
        DO_STEP(n, s + 1); MEMFENCE();
    }
#undef LD_OPS
#undef DO_STEP
}
constexpr int L_YP = 12544;
__device__ __forceinline__ void scan_ssd(const Params& P, float* L, int l, int c) {
    const int tid = tid_(), b = c >> 4, d = (c >> 3) & 1, h = c & 7, g = h >> 2;
    const float* U = (const float*)(P.ws + WS_U); const float* XBC = (const float*)(P.ws + WS_XBC); const float* LA = (const float*)(P.ws + WS_LA); const float* LB = (const float*)(P.ws + WS_LB);
    bf16* YD = (bf16*)(P.ws + WS_YD);
    float* qs = L; float* ks = L + 2048; float* vs = L + 4096; float* as = L + 6144; float* la = L + 6400; float* lb = L + 8448; float* lo = L + 10496; float* yp = L + L_YP;
    const float dtb = P.ssd_dt_bias[(l * 2 + d) * 8 + h], aneg = -__expf(P.ssd_a_log[(l * 2 + d) * 8 + h]), dsk = (d == 0) ? P.ssd_d[l * 8 + h] : 0.f;
    const int st = tid >> 4, sc4 = (tid & 15) << 2, p = tid >> 3, sl = tid & 7;
    f32x2 S0 = {0.f, 0.f}, S1 = {0.f, 0.f}, S2 = {0.f, 0.f}, S3 = {0.f, 0.f}; float hl = 0.f;
    f32x4 rx, rB, rC, ra, rb; float rdt;
#define SSD_LOAD(tile) do { const int row_ = scan_row(b, d, (tile) * 32 + st); const float* xr_ = XBC + (size_t)row_ * 768; \
        rx = *(const f32x4*)(xr_ + h * 64 + sc4); rB = *(const f32x4*)(xr_ + 512 + g * 64 + sc4); rC = *(const f32x4*)(xr_ + 640 + g * 64 + sc4); \
        rdt = U[(size_t)row_ * NUF + U_SSD_DT + d * 8 + h]; \
        ra = *(const f32x4*)(LA + ((size_t)d * MALL + row_) * 512 + h * 64 + sc4); rb = *(const f32x4*)(LB + ((size_t)d * MALL + row_) * 512 + h * 64 + sc4); } while (0)
    __syncthreads();
    SSD_LOAD(0);
    for (int tile = 0; tile < NTILES; ++tile) {
        { const float delta = softplus_(rdt + dtb);
          *(f32x4*)&vs[st * 64 + sc4] = rx; *(f32x4*)&ks[st * 64 + sc4] = rB * delta; *(f32x4*)&qs[st * 64 + sc4] = rC;
          if ((tid & 15) == 0) as[st] = __expf(aneg * delta);
          *(f32x4*)&la[st * 64 + sc4] = ra; *(f32x4*)&lb[st * 64 + sc4] = rb; }
        __syncthreads();
        if (tile + 1 < NTILES) SSD_LOAD(tile + 1);
        ssd_core(qs, ks, vs, as, la, lb, lo, yp, S0, S1, S2, S3, hl, tid, p, sl, dsk, true);
        __syncthreads();
#pragma unroll
        for (int j = 0; j < 4; ++j) {
            const int idx = tid + 512 * j, t = idx >> 6, pp = idx & 63;
            const f32x4 a0 = *(const f32x4*)&yp[t * 512 + pp * 8], a1 = *(const f32x4*)&yp[t * 512 + pp * 8 + 4];
            const int row = scan_row(b, d, tile * 32 + t);
            YD[((size_t)(0 * 2 + d) * MALL + row) * 512 + h * 64 + pp] = ((a0.x + a0.y) + (a0.z + a0.w)) + ((a1.x + a1.y) + (a1.z + a1.w));
            YD[((size_t)(1 * 2 + d) * MALL + row) * 512 + h * 64 + pp] = lo[t * 64 + pp];
        }
    }
#undef SSD_LOAD
}
__device__ __forceinline__ void scan_ret(const Params& P, float* L, int c) {
    const int tid = tid_(), b = c >> 4, h = (c >> 2) & 3, d = (c >> 1) & 1, vh = c & 1;
    const float* U = (const float*)(P.ws + WS_U); bf16* YD = (bf16*)(P.ws + WS_YD);
    float* qs = L; float* ks = L + 2048; float* vs = L + 4096; float* rope = L + 6400; float* yp = L + L_YP;
    const float a = 1.f - exp2f(-5.f - (float)h);
    const int st = tid >> 4, rem = tid & 15, sc4 = rem << 2, isk = rem >> 3, hs = (rem >> 2) & 1, cc = rem & 3, p = tid >> 3, sl = tid & 7;
    __syncthreads();
    for (int i = tid; i < 1024; i += 512) { const int pos = i >> 4, fi = i & 15; const float inv = exp2f(-(float)fi * 0.83048202372184f); const float rev = ((float)pos * inv) * 0.15915494309189535f;
        rope[2 * i] = __builtin_amdgcn_cosf(rev); rope[2 * i + 1] = __builtin_amdgcn_sinf(rev); }
    f32x2 S0 = {0.f, 0.f}, S1 = {0.f, 0.f}, S2 = {0.f, 0.f}, S3 = {0.f, 0.f};
    f32x4 r1, r2, rv;
    const int qkbase = (isk ? U_RT_K : U_RT_Q) + h * 64 + hs * 32 + 4 * cc;
#define RET_LOAD(tile) do { const float* ur_ = U + (size_t)scan_row(b, d, (tile) * 32 + st) * NUF; r1 = *(const f32x4*)(ur_ + qkbase); r2 = *(const f32x4*)(ur_ + qkbase + 16); \
        rv = *(const f32x4*)(ur_ + U_RT_V + h * 128 + vh * 64 + sc4); } while (0)
    RET_LOAD(0);
    for (int tile = 0; tile < NTILES; ++tile) {
        { f32x4 o1 = r1, o2 = r2;
          if (tile >= TC / 32) {
              const int tok = scan_row(b, d, tile * 32 + st) & (TL - 1); const int pos = hs ? (tok & 63) : (tok >> 6);
              const f32x4 cs0 = *(const f32x4*)&rope[(pos * 16 + 4 * cc) * 2], cs1 = *(const f32x4*)&rope[(pos * 16 + 4 * cc) * 2 + 4];
              const f32x4 cv = {cs0.x, cs0.z, cs1.x, cs1.z}, sv = {cs0.y, cs0.w, cs1.y, cs1.w};
              o1 = r1 * cv - r2 * sv; o2 = r1 * sv + r2 * cv;
          }
          float* dst = isk ? ks : qs; const float scl = isk ? 0.125f : 1.f;
          *(f32x4*)&dst[st * 64 + hs * 32 + 4 * cc] = o1 * scl; *(f32x4*)&dst[st * 64 + hs * 32 + 16 + 4 * cc] = o2 * scl;
          *(f32x4*)&vs[st * 64 + sc4] = rv; }
        __syncthreads();
        if (tile + 1 < NTILES) RET_LOAD(tile + 1);
        { float hl_ = 0.f; ssd_core(qs, ks, vs, vs, vs, vs, yp, yp, S0, S1, S2, S3, hl_, tid, p, sl, a, false); }
        __syncthreads();
#pragma unroll
        for (int j = 0; j < 4; ++j) {
            const int idx = tid + 512 * j, t = idx >> 6, pp = idx & 63;
            const f32x4 a0 = *(const f32x4*)&yp[t * 512 + pp * 8], a1 = *(const f32x4*)&yp[t * 512 + pp * 8 + 4];
            const int row = scan_row(b, d, tile * 32 + t);
            YD[((size_t)(3 * 2 + d) * MALL + row) * 512 + h * 128 + vh * 64 + pp] = ((a0.x + a0.y) + (a0.z + a0.w)) + ((a1.x + a1.y) + (a1.z + a1.w));
        }
    }
#undef RET_LOAD
}
__device__ __forceinline__ void scan_hgrn(const Params& P, float* L, int l, int c) {
    const int tid = tid_(), b = c >> 5, h = (c >> 3) & 3, d = (c >> 2) & 1, vq = c & 3;
    const float* U = (const float*)(P.ws + WS_U); bf16* YD = (bf16*)(P.ws + WS_YD);
    float* qs = L; float* fs = L + 4096; float* vs = L + 8192; float* yp = L + L_YP;
    const int st = tid >> 5, sc4 = (tid & 31) << 2, p = tid >> 4, sl = tid & 15;
    f32x4 lbv = {0.f, 0.f, 0.f, 0.f};
    if (l == 1) { const f32x4 g0 = *(const f32x4*)(P.hgrn_lb_logits + (size_t)(d * 2 + 0) * 512 + h * 128 + sc4), g1 = *(const f32x4*)(P.hgrn_lb_logits + (size_t)(d * 2 + 1) * 512 + h * 128 + sc4);
        lbv.x = sigmoid_(g1.x - g0.x); lbv.y = sigmoid_(g1.y - g0.y); lbv.z = sigmoid_(g1.z - g0.z); lbv.w = sigmoid_(g1.w - g0.w); }
    f32x2 S0 = {0.f, 0.f}, S1 = {0.f, 0.f}, S2 = {0.f, 0.f}, S3 = {0.f, 0.f};
    f32x4 rq0, rq1, rf0, rf1, rv = {0.f, 0.f, 0.f, 0.f};
#define HG_LOAD(tile) do { const float* u0_ = U + (size_t)scan_row(b, d, (tile) * 32 + st) * NUF; const float* u1_ = U + (size_t)scan_row(b, d, (tile) * 32 + st + 16) * NUF; \
        rq0 = *(const f32x4*)(u0_ + U_HG_Q + h * 128 + sc4); rq1 = *(const f32x4*)(u1_ + U_HG_Q + h * 128 + sc4); \
        rf0 = *(const f32x4*)(u0_ + U_HG_F + d * 512 + h * 128 + sc4); rf1 = *(const f32x4*)(u1_ + U_HG_F + d * 512 + h * 128 + sc4); \
        if (tid < 256) rv = *(const f32x4*)(U + (size_t)scan_row(b, d, (tile) * 32 + (tid >> 3)) * NUF + U_HG_I + h * 128 + vq * 32 + ((tid & 7) << 2)); } while (0)
    __syncthreads();
    HG_LOAD(0);
    for (int tile = 0; tile < NTILES; ++tile) {
        { f32x4 q, f;
#pragma unroll
          for (int e = 0; e < 4; ++e) { q[e] = silu_(rq0[e]) * 0.08838834764831845f; f[e] = lbv[e] + (1.f - lbv[e]) * sigmoid_(rf0[e]); }
          *(f32x4*)&qs[st * 128 + sc4] = q; *(f32x4*)&fs[st * 128 + sc4] = f;
#pragma unroll
          for (int e = 0; e < 4; ++e) { q[e] = silu_(rq1[e]) * 0.08838834764831845f; f[e] = lbv[e] + (1.f - lbv[e]) * sigmoid_(rf1[e]); }
          *(f32x4*)&qs[(st + 16) * 128 + sc4] = q; *(f32x4*)&fs[(st + 16) * 128 + sc4] = f;
          if (tid < 256) *(f32x4*)&vs[(tid >> 3) * 32 + ((tid & 7) << 2)] = rv; }
        __syncthreads();
        if (tile + 1 < NTILES) HG_LOAD(tile + 1);
        hgrn_core(qs, fs, vs, yp, S0, S1, S2, S3, tid, p, sl);
        __syncthreads();
#pragma unroll
        for (int j = 0; j < 2; ++j) {
            const int idx = tid + 512 * j, t = idx >> 5, pp = idx & 31;
            const f32x4 a0 = *(const f32x4*)&yp[t * 512 + pp * 16], a1 = *(const f32x4*)&yp[t * 512 + pp * 16 + 4], a2 = *(const f32x4*)&yp[t * 512 + pp * 16 + 8], a3 = *(const f32x4*)&yp[t * 512 + pp * 16 + 12];
            const int row = scan_row(b, d, tile * 32 + t);
            YD[((size_t)(2 * 2 + d) * MALL + row) * 512 + h * 128 + vq * 32 + pp] =
                (((a0.x + a0.y) + (a0.z + a0.w)) + ((a1.x + a1.y) + (a1.z + a1.w))) + (((a2.x + a2.y) + (a2.z + a2.w)) + ((a3.x + a3.y) + (a3.z + a3.w)));
        }
    }
#undef HG_LOAD
}

typedef __bf16 bf16x2_n __attribute__((ext_vector_type(2)));
__device__ __forceinline__ unsigned cvtpk(float lo, float hi) { f32x2 v = {lo, hi}; bf16x2_n b = __builtin_convertvector(v, bf16x2_n); return __builtin_bit_cast(unsigned, b); }
template <int KD, int VN> struct ChunkLds {
    static constexpr int PQ = (KD + 8) * 2;
    static constexpr int PT = 80;
    static constexpr int KM = 0, QM = KM + 16 * PQ, QE = QM + 16 * PQ, KWT = QE + 16 * PQ, G = KWT + KD * PT, VT = G + KD * 4, SIZE = VT + VN * PT;
};
template <int KD, int VN>
__device__ __forceinline__ f32x4 chunk_step(const unsigned char* C, int v0, int fr, int fq, f32x4 (&S)[KD / 16]) {
    using CL = ChunkLds<KD, VN>;
    f32x4 mt = {0.f, 0.f, 0.f, 0.f}, mt1 = {0.f, 0.f, 0.f, 0.f};
#pragma unroll
    for (int ks = 0; ks < KD / 32; ks += 2) {
        const bf16x8_t a = *(const bf16x8_t*)(C + CL::KM + fr * CL::PQ + (32 * ks + 8 * fq) * 2);
        const bf16x8_t b = *(const bf16x8_t*)(C + CL::QM + fr * CL::PQ + (32 * ks + 8 * fq) * 2);
        mt = __builtin_amdgcn_mfma_f32_16x16x32_bf16(a, b, mt, 0, 0, 0);
        const bf16x8_t a1 = *(const bf16x8_t*)(C + CL::KM + fr * CL::PQ + (32 * ks + 32 + 8 * fq) * 2);
        const bf16x8_t b1 = *(const bf16x8_t*)(C + CL::QM + fr * CL::PQ + (32 * ks + 32 + 8 * fq) * 2);
        mt1 = __builtin_amdgcn_mfma_f32_16x16x32_bf16(a1, b1, mt1, 0, 0, 0);
    }
    mt += mt1;
#pragma unroll
    for (int j = 0; j < 4; ++j) if (4 * fq + j > fr) mt[j] = 0.f;
    u32x4 bw; bw.x = cvtpk(mt[0], mt[1]); bw.y = cvtpk(mt[2], mt[3]); bw.z = 0u; bw.w = 0u;
    const u32x2 va = *(const u32x2*)(C + CL::VT + (v0 + fr) * CL::PT + (4 * fq) * 2);
    u32x4 aw; aw.x = va.x; aw.y = va.y; aw.z = 0u; aw.w = 0u;
    f32x4 yi = __builtin_amdgcn_mfma_f32_16x16x32_bf16(__builtin_bit_cast(bf16x8_t, aw), __builtin_bit_cast(bf16x8_t, bw), (f32x4){0.f, 0.f, 0.f, 0.f}, 0, 0, 0);
    f32x4 y = {0.f, 0.f, 0.f, 0.f};
#pragma unroll
    for (int i = 0; i < KD / 32; ++i) {
        u32x4 sa; sa.x = cvtpk(S[2 * i][0], S[2 * i][1]); sa.y = cvtpk(S[2 * i][2], S[2 * i][3]); sa.z = cvtpk(S[2 * i + 1][0], S[2 * i + 1][1]); sa.w = cvtpk(S[2 * i + 1][2], S[2 * i + 1][3]);
        const u32x2 lo = *(const u32x2*)(C + CL::QE + fr * CL::PQ + (32 * i + 4 * fq) * 2), hi = *(const u32x2*)(C + CL::QE + fr * CL::PQ + (32 * i + 16 + 4 * fq) * 2);
        u32x4 qb; qb.x = lo.x; qb.y = lo.y; qb.z = hi.x; qb.w = hi.y;
        y = __builtin_amdgcn_mfma_f32_16x16x32_bf16(__builtin_bit_cast(bf16x8_t, sa), __builtin_bit_cast(bf16x8_t, qb), y, 0, 0, 0);
    }
    y += yi;
    const bf16x8_t bv = *(const bf16x8_t*)(C + CL::VT + (v0 + fr) * CL::PT + (8 * fq) * 2);
#pragma unroll
    for (int i = 0; i < KD / 16; ++i) {
        const f32x4 g4 = *(const f32x4*)(C + CL::G + (16 * i + 4 * fq) * 4);
        const bf16x8_t ak = *(const bf16x8_t*)(C + CL::KWT + (16 * i + fr) * CL::PT + (8 * fq) * 2);
        S[i] = __builtin_amdgcn_mfma_f32_16x16x32_bf16(ak, bv, S[i] * g4, 0, 0, 0);
    }
    return y;
}
template <int KD, int VN, bool LVEC>
__device__ __forceinline__ void build_operands(const float* __restrict__ rq, const float* __restrict__ rk, const float* __restrict__ rL, const float* __restrict__ rv, unsigned char* __restrict__ OP, int t0, int nthr) {
    using CL = ChunkLds<KD, VN>;
    for (int idx = t0; idx < 8 * KD; idx += nthr) {
        const int kq = idx % (KD / 4), t = (idx / (KD / 4)) & 15, c = idx / (4 * KD), k = 4 * kq, row = c * 16 + t;
        const f32x4 q4 = *(const f32x4*)&rq[row * KD + k], k4 = *(const f32x4*)&rk[row * KD + k];
        f32x4 Lt, Lm;
        if (LVEC) { Lt = *(const f32x4*)&rL[row * KD + k]; Lm = *(const f32x4*)&rL[(c * 16 + 7) * KD + k]; } else { const float a_ = rL[row], b_ = rL[c * 16 + 7]; Lt = (f32x4){a_, a_, a_, a_}; Lm = (f32x4){b_, b_, b_, b_}; }
        f32x4 qe, qm, km;
#pragma unroll
        for (int e = 0; e < 4; ++e) { qe[e] = q4[e] * __expf(Lt[e]); qm[e] = q4[e] * __expf(fminf(Lt[e] - Lm[e], 80.f)); km[e] = k4[e] * __expf(fminf(Lm[e] - Lt[e], 80.f)); }
        unsigned char* base = OP + c * CL::SIZE + t * CL::PQ + k * 2;
        u32x2 w; w.x = cvtpk(qe[0], qe[1]); w.y = cvtpk(qe[2], qe[3]); *(u32x2*)(base + CL::QE) = w;
        w.x = cvtpk(qm[0], qm[1]); w.y = cvtpk(qm[2], qm[3]); *(u32x2*)(base + CL::QM) = w;
        w.x = cvtpk(km[0], km[1]); w.y = cvtpk(km[2], km[3]); *(u32x2*)(base + CL::KM) = w;
    }
    for (int idx = t0; idx < 4 * KD; idx += nthr) {
        const int k = idx % KD, oc = (idx / KD) & 1, c = idx / (2 * KD);
        const float Le = LVEC ? rL[(c * 16 + 15) * KD + k] : rL[c * 16 + 15];
        float w[8];
#pragma unroll
        for (int e = 0; e < 8; ++e) { const int row = c * 16 + 8 * oc + e; const float Lt = LVEC ? rL[row * KD + k] : rL[row]; w[e] = rk[row * KD + k] * __expf(Le - Lt); }
        u32x4 o; o.x = cvtpk(w[0], w[1]); o.y = cvtpk(w[2], w[3]); o.z = cvtpk(w[4], w[5]); o.w = cvtpk(w[6], w[7]);
        *(u32x4*)(OP + c * CL::SIZE + CL::KWT + k * CL::PT + oc * 16) = o;
        if (oc == 0) *(float*)(OP + c * CL::SIZE + CL::G + k * 4) = __expf(Le);
    }
    for (int idx = t0; idx < 4 * VN; idx += nthr) {
        const int v = idx % VN, oc = (idx / VN) & 1, c = idx / (2 * VN);
        float w[8];
#pragma unroll
        for (int e = 0; e < 8; ++e) w[e] = rv[(c * 16 + 8 * oc + e) * VN + v];
        u32x4 o; o.x = cvtpk(w[0], w[1]); o.y = cvtpk(w[2], w[3]); o.z = cvtpk(w[4], w[5]); o.w = cvtpk(w[6], w[7]);
        *(u32x4*)(OP + c * CL::SIZE + CL::VT + v * CL::PT + oc * 16) = o;
    }
}
template <int KD, int VN>
__device__ __forceinline__ void zero_operand_pads(unsigned char* OP, int t0, int nthr) {
    using CL = ChunkLds<KD, VN>;
    for (int idx = t0; idx < 2 * (KD + VN) * 2; idx += nthr) {
        const int half = idx & 1, r = (idx >> 1) % (KD + VN), c = (idx >> 1) / (KD + VN);
        unsigned char* row = OP + c * CL::SIZE + (r < KD ? CL::KWT + r * CL::PT : CL::VT + (r - KD) * CL::PT);
        *(u32x4*)(row + 32 + half * 16) = (u32x4){0u, 0u, 0u, 0u};
    }
}
constexpr int L_RAW_Q = 0, L_RAW_K = 16384, L_RAW_L = 32768, L_RAW_V = 49152, L_OP = 65536;

__device__ __forceinline__ void scan_ret_mfma(const Params& P, unsigned char* LB, int c) {
    const int tid = tid_(), lane = tid & 63, wave = __builtin_amdgcn_readfirstlane(tid >> 6), fr = lane & 15, fq = lane >> 4;
    const int vh = c & 1, b = c >> 4, h = (c >> 2) & 3, d = (c >> 1) & 1;
    const float* U = (const float*)(P.ws + WS_U); bf16* YD = (bf16*)(P.ws + WS_YD);
    float* rq = (float*)(LB + L_RAW_Q); float* rk = (float*)(LB + L_RAW_K); float* rL = (float*)(LB + L_RAW_L); float* rv = (float*)(LB + L_RAW_V);
    float* rope = (float*)(LB + L_RAW_L + 1024);
    unsigned char* OP = LB + L_OP;
    const float la = __logf(1.f - exp2f(-5.f - (float)h));
    const int st = tid >> 4, rem = tid & 15, isk = rem >> 3, hs = (rem >> 2) & 1, cc = rem & 3;
    __syncthreads();
    for (int i = tid; i < 1024; i += 512) { const int pos = i >> 4, fi = i & 15; const float inv = exp2f(-(float)fi * 0.83048202372184f); const float rev = ((float)pos * inv) * 0.15915494309189535f;
        rope[2 * i] = __builtin_amdgcn_cosf(rev); rope[2 * i + 1] = __builtin_amdgcn_sinf(rev); }
    if (tid < 32) rL[tid] = (float)((tid & 15) + 1) * la;
    zero_operand_pads<64, 64>(OP, tid, 512);
    f32x4 S[4];
#pragma unroll
    for (int i = 0; i < 4; ++i) S[i] = (f32x4){0.f, 0.f, 0.f, 0.f};
    f32x4 r1, r2, rv0;
    const int qkbase = (isk ? G_RT_K : G_RT_Q) + h * 64 + hs * 32 + 4 * cc;
#define RETM_LOAD(tile) do { const bf16* ur_ = (const bf16*)(P.ws + WS_UG) + (size_t)scan_row(b, d, (tile) * 32 + st) * NUG; r1 = ld_bf4(ur_ + qkbase); r2 = ld_bf4(ur_ + qkbase + 16); \
        rv0 = ld_bf4((const bf16*)(P.ws + WS_UG) + (size_t)scan_row(b, d, (tile) * 32 + st) * NUG + G_RT_V + h * 128 + vh * 64 + rem * 4); } while (0)
    RETM_LOAD(0);
    for (int tile = 0; tile < NTILES; ++tile) {
        { f32x4 o1 = r1, o2 = r2;
          if (tile >= TC / 32) {
              const int tok = scan_row(b, d, tile * 32 + st) & (TL - 1); const int pos = hs ? (tok & 63) : (tok >> 6);
              const f32x4 cs0 = *(const f32x4*)&rope[(pos * 16 + 4 * cc) * 2], cs1 = *(const f32x4*)&rope[(pos * 16 + 4 * cc) * 2 + 4];
              const f32x4 cv = {cs0.x, cs0.z, cs1.x, cs1.z}, sv = {cs0.y, cs0.w, cs1.y, cs1.w};
              o1 = r1 * cv - r2 * sv; o2 = r1 * sv + r2 * cv;
          }
          float* dst = isk ? rk : rq; const float scl = isk ? 0.125f : 1.f;
          *(f32x4*)&dst[st * 64 + hs * 32 + 4 * cc] = o1 * scl; *(f32x4*)&dst[st * 64 + hs * 32 + 16 + 4 * cc] = o2 * scl;
          *(f32x4*)&rv[st * 64 + rem * 4] = rv0; }
        __syncthreads();
        if (tile + 1 < NTILES) RETM_LOAD(tile + 1);
        build_operands<64, 64, false>(rq, rk, rL, rv, OP, tid, 512);
        __syncthreads();
        if (wave < 4) {
#pragma unroll
        for (int ch = 0; ch < 2; ++ch) {
            const f32x4 y = chunk_step<64, 64>(OP + ch * ChunkLds<64, 64>::SIZE, wave * 16, fr, fq, S);
            const int row = scan_row(b, d, tile * 32 + ch * 16 + fr);
            { u32x2 w_; w_.x = cvtpk(y[0], y[1]); w_.y = cvtpk(y[2], y[3]); *(u32x2*)(YD + ((size_t)(3 * 2 + d) * MALL + row) * 512 + h * 128 + vh * 64 + wave * 16 + 4 * fq) = w_; }
        }
        }
    }
#undef RETM_LOAD
}

__device__ __forceinline__ void scan_hgrn_mfma(const Params& P, unsigned char* LB, int l, int c) {
    using CL = ChunkLds<128, 64>;
    const int tid = tid_(), lane = tid & 63, wave = __builtin_amdgcn_readfirstlane(tid >> 6), fr = lane & 15, fq = lane >> 4;
    const int vq = c & 1, b = c >> 4, h = (c >> 2) & 3, d = (c >> 1) & 1;
    const float* U = (const float*)(P.ws + WS_U); bf16* YD = (bf16*)(P.ws + WS_YD);
    unsigned char* OP = LB;
    float* tot = (float*)(LB + 58368);
    const int k = 2 * lane, qt = wave & 3, cb = wave >> 2;
    const int vv_ = tid & 63, vqt = wave & 3, vc = wave >> 2;
    f32x2 lb2 = {0.f, 0.f};
    if (l == 1) { const f32x2 g0 = *(const f32x2*)(P.hgrn_lb_logits + (size_t)(d * 2 + 0) * 512 + h * 128 + k), g1 = *(const f32x2*)(P.hgrn_lb_logits + (size_t)(d * 2 + 1) * 512 + h * 128 + k);
        lb2.x = sigmoid_(g1.x - g0.x); lb2.y = sigmoid_(g1.y - g0.y); }
    __syncthreads();
    zero_operand_pads<128, 64>(OP, tid, 512);
    f32x4 S[8];
#pragma unroll
    for (int i = 0; i < 8; ++i) S[i] = (f32x4){0.f, 0.f, 0.f, 0.f};
    f32x2 pq[4], pf[4]; float pv[4] = {0.f, 0.f, 0.f, 0.f};
#define HGM_LOAD(tile) do { _Pragma("unroll") for (int r_ = 0; r_ < 4; ++r_) { const float* u_ = U + (size_t)scan_row(b, d, (tile) * 32 + cb * 16 + qt * 4 + r_) * NUF; \
        { const unsigned qw_ = *(const unsigned*)((const bf16*)(P.ws + WS_UG) + (size_t)scan_row(b, d, (tile) * 32 + cb * 16 + qt * 4 + r_) * NUG + G_HG_Q + h * 128 + k); pq[r_] = (f32x2){__builtin_bit_cast(float, qw_ << 16), __builtin_bit_cast(float, qw_ & 0xffff0000u)}; } \
        pf[r_] = *(const f32x2*)(u_ + U_HG_F + d * 512 + h * 128 + k); } \
        { _Pragma("unroll") for (int r_ = 0; r_ < 4; ++r_) pv[r_] = __builtin_bit_cast(float, (unsigned)((const bf16*)(P.ws + WS_UG))[(size_t)scan_row(b, d, (tile) * 32 + vc * 16 + vqt * 4 + r_) * NUG + G_HG_I + h * 128 + vq * 64 + vv_] << 16); } } while (0)
    HGM_LOAD(0);
    for (int tile = 0; tile < NTILES; ++tile) {
        f32x2 q[4], kk[4], pre[4], suf[4]; float vv[4];
        { f32x2 fc[4];
#pragma unroll
          for (int r = 0; r < 4; ++r) {
              const float eq0 = 1.f + __expf(fminf(-pq[r].x, 40.f)), ef0 = 1.f + __expf(fminf(-pf[r].x, 40.f)), r0_ = __builtin_amdgcn_rcpf(eq0 * ef0);
              const float eq1 = 1.f + __expf(fminf(-pq[r].y, 40.f)), ef1 = 1.f + __expf(fminf(-pf[r].y, 40.f)), r1_ = __builtin_amdgcn_rcpf(eq1 * ef1);
              q[r].x = pq[r].x * (ef0 * r0_) * 0.08838834764831845f; q[r].y = pq[r].y * (ef1 * r1_) * 0.08838834764831845f;
              const float f0 = lb2.x + (1.f - lb2.x) * (eq0 * r0_), f1 = lb2.y + (1.f - lb2.y) * (eq1 * r1_);
              kk[r].x = 1.f - f0; kk[r].y = 1.f - f1; fc[r].x = fmaxf(f0, 1e-4f); fc[r].y = fmaxf(f1, 1e-4f); vv[r] = pv[r];
          }
          pre[0] = fc[0]; pre[1] = pre[0] * fc[1]; pre[2] = pre[1] * fc[2]; pre[3] = pre[2] * fc[3];
          suf[3] = (f32x2){1.f, 1.f}; suf[2] = fc[3]; suf[1] = suf[2] * fc[2]; suf[0] = suf[1] * fc[1]; }
        *(f32x2*)&tot[(cb * 4 + qt) * 128 + k] = pre[3];
        __syncthreads();
        if (tile + 1 < NTILES) HGM_LOAD(tile + 1);
        {
            const f32x2 t0 = *(const f32x2*)&tot[(cb * 4 + 0) * 128 + k], t1 = *(const f32x2*)&tot[(cb * 4 + 1) * 128 + k], t2 = *(const f32x2*)&tot[(cb * 4 + 2) * 128 + k], t3 = *(const f32x2*)&tot[(cb * 4 + 3) * 128 + k];
            const f32x2 Pm = t0 * t1, T23 = t2 * t3;
            unsigned char* C = OP + cb * CL::SIZE;
            float kw0[4], kw1[4];
#pragma unroll
            for (int r = 0; r < 4; ++r) {
                const int t = qt * 4 + r;
                f32x2 R, iR;
                if (qt >= 2) { R = pre[r]; if (qt == 3) R *= t2; iR.x = __builtin_amdgcn_rcpf(R.x); iR.y = __builtin_amdgcn_rcpf(R.y); }
                else { iR = suf[r]; if (qt == 0) iR *= t1; R.x = __builtin_amdgcn_rcpf(iR.x); R.y = __builtin_amdgcn_rcpf(iR.y); }
                const f32x2 Pt = Pm * R;
                unsigned char* p = C + t * CL::PQ + k * 2;
                *(unsigned*)(p + CL::QE) = cvtpk(q[r].x * Pt.x, q[r].y * Pt.y);
                *(unsigned*)(p + CL::QM) = cvtpk(q[r].x * R.x, q[r].y * R.y);
                *(unsigned*)(p + CL::KM) = cvtpk(kk[r].x * iR.x, kk[r].y * iR.y);
                kw0[r] = kk[r].x * T23.x * iR.x; kw1[r] = kk[r].y * T23.y * iR.y;
            }
            u32x2 w; w.x = cvtpk(kw0[0], kw0[1]); w.y = cvtpk(kw0[2], kw0[3]); *(u32x2*)(C + CL::KWT + k * CL::PT + qt * 8) = w;
            w.x = cvtpk(kw1[0], kw1[1]); w.y = cvtpk(kw1[2], kw1[3]); *(u32x2*)(C + CL::KWT + (k + 1) * CL::PT + qt * 8) = w;
            if (qt == 0) *(f32x2*)(C + CL::G + k * 4) = Pm * T23;
            { u32x2 wv; wv.x = cvtpk(vv[0], vv[1]); wv.y = cvtpk(vv[2], vv[3]); *(u32x2*)(OP + vc * CL::SIZE + CL::VT + vv_ * CL::PT + vqt * 8) = wv; }
        }
        __syncthreads();
        if (wave < 4) {
#pragma unroll
            for (int ch = 0; ch < 2; ++ch) {
                const f32x4 y = chunk_step<128, 64>(OP + ch * CL::SIZE, wave * 16, fr, fq, S);
                const int row = scan_row(b, d, tile * 32 + ch * 16 + fr);
                { u32x2 w_; w_.x = cvtpk(y[0], y[1]); w_.y = cvtpk(y[2], y[3]); *(u32x2*)(YD + ((size_t)(2 * 2 + d) * MALL + row) * 512 + h * 128 + vq * 64 + wave * 16 + 4 * fq) = w_; }
            }
        }
    }
#undef HGM_LOAD
}
__device__ __forceinline__ void scan_ssd_mfma(const Params& P, unsigned char* LB, int l, int c) {
    const int tid = tid_(), lane = tid & 63, wave = __builtin_amdgcn_readfirstlane(tid >> 6), fr = lane & 15, fq = lane >> 4;
    const int b = c >> 4, d = (c >> 3) & 1, h = c & 7, g = h >> 2;
    const float* U = (const float*)(P.ws + WS_U); const bf16* XBC = (const bf16*)(P.ws + WS_XBC); bf16* YD = (bf16*)(P.ws + WS_YD);
    float* rq = (float*)(LB + L_RAW_Q); float* rk = (float*)(LB + L_RAW_K); float* rL = (float*)(LB + L_RAW_L); float* lg = (float*)(LB + L_RAW_L + 256); float* rv = (float*)(LB + L_RAW_V);
    unsigned char* OP = LB + L_OP;
    const float dtb = P.ssd_dt_bias[(l * 2 + d) * 8 + h], aneg = -__expf(P.ssd_a_log[(l * 2 + d) * 8 + h]);
    const int st = tid >> 4, sc4 = (tid & 15) << 2;
    __syncthreads();
    zero_operand_pads<64, 64>(OP, tid, 512);
    f32x4 S[4];
#pragma unroll
    for (int i = 0; i < 4; ++i) S[i] = (f32x4){0.f, 0.f, 0.f, 0.f};
    f32x4 px, pB, pC; float pdt;
#define SSM_LOAD(tile) do { const int row_ = scan_row(b, d, (tile) * 32 + st); const bf16* xr_ = XBC + (size_t)row_ * 768; \
        px = ld_bf4(xr_ + h * 64 + sc4); pB = ld_bf4(xr_ + 512 + g * 64 + sc4); pC = ld_bf4(xr_ + 640 + g * 64 + sc4); pdt = U[(size_t)row_ * NUF + U_SSD_DT + d * 8 + h]; } while (0)
    SSM_LOAD(0);
    for (int tile = 0; tile < NTILES; ++tile) {
        { const float delta = softplus_(pdt + dtb); const int o = st * 64 + sc4;
          *(f32x4*)&rv[o] = px; *(f32x4*)&rk[o] = pB * delta; *(f32x4*)&rq[o] = pC;
          if ((tid & 15) == 0) lg[st] = aneg * delta; }
        __syncthreads();
        if (tile + 1 < NTILES) SSM_LOAD(tile + 1);
        if (tid < 32) { const int c0 = tid & 16; float acc = 0.f;
#pragma unroll
            for (int t = 0; t < 16; ++t) { const float v_ = lg[c0 + t]; acc += (c0 + t <= tid) ? v_ : 0.f; }
            rL[tid] = acc; }
        __syncthreads();
        build_operands<64, 64, false>(rq, rk, rL, rv, OP, tid, 512);
        __syncthreads();
        if (wave < 4) {
#pragma unroll
            for (int ch = 0; ch < 2; ++ch) {
                const f32x4 y = chunk_step<64, 64>(OP + ch * ChunkLds<64, 64>::SIZE, wave * 16, fr, fq, S);
                const int row = scan_row(b, d, tile * 32 + ch * 16 + fr);
                { u32x2 w_; w_.x = cvtpk(y[0], y[1]); w_.y = cvtpk(y[2], y[3]); *(u32x2*)(YD + ((size_t)(0 * 2 + d) * MALL + row) * 512 + h * 64 + wave * 16 + 4 * fq) = w_; }
            }
        }
    }
#undef SSM_LOAD
}
__device__ __forceinline__ void scan_lru(const Params& P, float* L, int c) {
    const int tid = tid_(), ch = tid & 63, seg = __builtin_amdgcn_readfirstlane(tid >> 6), b = c >> 3, d = (c >> 2) & 1, cgp = c & 3;
    const float* LA = (const float*)(P.ws + WS_LA) + (size_t)d * MALL * 512 + cgp * 128 + ch; const bf16* LBp = (const bf16*)(P.ws + WS_LB) + (size_t)d * MALL * 512 + cgp * 128 + ch;
    bf16* YD = (bf16*)(P.ws + WS_YD) + (size_t)(1 * 2 + d) * MALL * 512 + cgp * 128 + ch;
    float* car = L;
    const int s0 = seg * 288;
    __syncthreads();
    float h0 = 0.f, h1 = 0.f, ap0 = 1.f, ap1 = 1.f;
#pragma unroll 1
    for (int pass = 0; pass < 2; ++pass) {
        float a0[16], b0[16], c0[16], d0[16];
#pragma unroll
        for (int s = 0; s < 16; ++s) { const size_t r = (size_t)scan_row(b, d, s0 + s) * 512; a0[s] = LA[r]; b0[s] = __builtin_bit_cast(float, (unsigned)LBp[r] << 16); c0[s] = LA[r + 64]; d0[s] = __builtin_bit_cast(float, (unsigned)LBp[r + 64] << 16); }
#pragma unroll 1
        for (int tile = 0; tile < 18; ++tile) {
            float a1[16], b1[16], c1[16], d1[16];
            if (tile + 1 < 18) {
#pragma unroll
                for (int s = 0; s < 16; ++s) { const size_t r = (size_t)scan_row(b, d, s0 + (tile + 1) * 16 + s) * 512; a1[s] = LA[r]; b1[s] = __builtin_bit_cast(float, (unsigned)LBp[r] << 16); c1[s] = LA[r + 64]; d1[s] = __builtin_bit_cast(float, (unsigned)LBp[r + 64] << 16); }
            }
            if (pass == 0) {
#pragma unroll
                for (int s = 0; s < 16; ++s) { h0 = a0[s] * h0 + b0[s]; ap0 *= a0[s]; h1 = c0[s] * h1 + d0[s]; ap1 *= c0[s]; }
            } else {
#pragma unroll
                for (int s = 0; s < 16; ++s) { h0 = a0[s] * h0 + b0[s]; h1 = c0[s] * h1 + d0[s]; const size_t r = (size_t)scan_row(b, d, s0 + tile * 16 + s) * 512; YD[r] = (bf16)f2bf(h0); YD[r + 64] = (bf16)f2bf(h1); }
            }
#pragma unroll
            for (int s = 0; s < 16; ++s) { a0[s] = a1[s]; b0[s] = b1[s]; c0[s] = c1[s]; d0[s] = d1[s]; }
        }
        if (pass == 0) {
            car[(seg * 128 + ch) * 2] = ap0; car[(seg * 128 + ch) * 2 + 1] = h0; car[(seg * 128 + 64 + ch) * 2] = ap1; car[(seg * 128 + 64 + ch) * 2 + 1] = h1;
            __syncthreads();
            float hin0 = 0.f, hin1 = 0.f;
            for (int sg = 0; sg < seg; ++sg) { hin0 = car[(sg * 128 + ch) * 2] * hin0 + car[(sg * 128 + ch) * 2 + 1]; hin1 = car[(sg * 128 + 64 + ch) * 2] * hin1 + car[(sg * 128 + 64 + ch) * 2 + 1]; }
            h0 = hin0; h1 = hin1;
        }
    }
}
__device__ __forceinline__ void scan_phase(const Params& P, float* L, int l) {
    for (int it = bid_(); it < 224; it += gridDim.x) {
        if (it < 64) scan_hgrn_mfma(P, (unsigned char*)L, l, it);
        else if (it < 128) scan_ssd_mfma(P, (unsigned char*)L, l, it - 64);
        else if (it < 192) scan_ret_mfma(P, (unsigned char*)L, it - 128);
        else scan_lru(P, L, it - 192);
    }
}

__device__ __forceinline__ void post_phase(const Params& P, int l, int mrows) {
    const int tid = tid_(), lane = tid & 63, wave = __builtin_amdgcn_readfirstlane(tid >> 6);
    const int gw = bid_() * 8 + wave, NGW = gridDim.x * 8;
    const float* U = (const float*)(P.ws + WS_U); const bf16* YD = (const bf16*)(P.ws + WS_YD); bf16* YC = (bf16*)(P.ws + WS_H);
    for (int row = gw; row < mrows; row += NGW) {
        const bf16* ug = (const bf16*)(P.ws + WS_UG) + (size_t)row * NUG; bf16* yc = YC + (size_t)row * DM;
#define YDP(m, d) (YD + ((size_t)((m) * 2 + (d)) * MALL + row) * 512)
#define LDY(p) ld_bf4(p)
        {
            f32x4 gg[2]; float ss = 0.f;
#pragma unroll
            for (int j = 0; j < 2; ++j) { const int c = 4 * lane + 256 * j; const float dsk = P.ssd_d[l * 8 + (c >> 6)]; const f32x4 y = LDY(YDP(0, 0) + c) + LDY(YDP(0, 1) + c) + ld_bf4((const bf16*)(P.ws + WS_XBC) + (size_t)row * 768 + c) * dsk; const f32x4 z = ld_bf4(ug + G_SSD_Z + c);
                f32x4 t; t.x = y.x * silu_(z.x); t.y = y.y * silu_(z.y); t.z = y.z * silu_(z.z); t.w = y.w * silu_(z.w); gg[j] = t; ss += dot4(t); }
            const float rs = rsqrtf(wave_sum(ss) * (1.f / 512.f) + EPS);
#pragma unroll
            for (int j = 0; j < 2; ++j) { const int c = 4 * lane + 256 * j; const f32x4 w = *(const f32x4*)(P.ssd_norm_w + (size_t)l * 512 + c); const f32x4 o = gg[j] * rs * w;
                u32x2 pk; pk.x = pk2(o.x, o.y); pk.y = pk2(o.z, o.w); *(u32x2*)(yc + c) = pk; }
        }
        {
#pragma unroll
            for (int j = 0; j < 2; ++j) { const int c = 4 * lane + 256 * j; const f32x4 hh = LDY(YDP(1, 0) + c) + LDY(YDP(1, 1) + c); const f32x4 gb = ld_bf4(ug + G_LRU_G + c);
                f32x4 o; o.x = hh.x * gelu_tanh_(gb.x); o.y = hh.y * gelu_tanh_(gb.y); o.z = hh.z * gelu_tanh_(gb.z); o.w = hh.w * gelu_tanh_(gb.w);
                u32x2 pk; pk.x = pk2(o.x, o.y); pk.y = pk2(o.z, o.w); *(u32x2*)(yc + 512 + c) = pk; }
        }
        {
#pragma unroll
            for (int j = 0; j < 2; ++j) { const int c = 4 * lane + 256 * j; const f32x4 o = LDY(YDP(2, 0) + c) + LDY(YDP(2, 1) + c);
                const float rs = rsqrtf(half_sum(dot4(o)) * (1.f / 128.f) + EPS); const f32x4 w = *(const f32x4*)(P.hgrn_norm_w + (size_t)l * 128 + (c & 127)); const f32x4 gt = ld_bf4(ug + G_HG_G + c);
                f32x4 r; r.x = o.x * rs * w.x * silu_(gt.x); r.y = o.y * rs * w.y * silu_(gt.y); r.z = o.z * rs * w.z * silu_(gt.z); r.w = o.w * rs * w.w * silu_(gt.w);
                u32x2 pk; pk.x = pk2(r.x, r.y); pk.y = pk2(r.z, r.w); *(u32x2*)(yc + 1024 + c) = pk; }
        }
        {
#pragma unroll
            for (int j = 0; j < 2; ++j) { const int c = 4 * lane + 256 * j; const f32x4 o = LDY(YDP(3, 0) + c) + LDY(YDP(3, 1) + c);
                const float rs = rsqrtf(half_sum(dot4(o)) * (1.f / 128.f) + EPS); const f32x4 gt = ld_bf4(ug + G_RT_G + c);
                f32x4 r; r.x = o.x * rs * silu_(gt.x); r.y = o.y * rs * silu_(gt.y); r.z = o.z * rs * silu_(gt.z); r.w = o.w * rs * silu_(gt.w);
                u32x2 pk; pk.x = pk2(r.x, r.y); pk.y = pk2(r.z, r.w); *(u32x2*)(yc + 1536 + c) = pk; }
        }
#undef YDP
    }
}

__global__ void __launch_bounds__(512, 2) mk_fwd(Params Pkarg) {
    extern __shared__ __attribute__((aligned(16))) unsigned char lds_raw[];
    float* L = (float*)lds_raw;
    const __attribute__((address_space(4))) Params* kp = (const __attribute__((address_space(4))) Params*)__builtin_amdgcn_kernarg_segment_ptr();
    const int ph_lo = kp->ph_lo, ph_hi = kp->ph_hi;
    {
        volatile LAS unsigned* st0 = (volatile LAS unsigned*)((LAS unsigned char*)lds_raw + (LDS_BYTES - 128));
        if (threadIdx.x == 0) { st0[0] = 0u; st0[1] = 0u; }
        __syncthreads();
        (void)xcd_barrier_post((unsigned*)kp->ws, st0);
    }
    for (int ph = ph_lo; ph < ph_hi; ++ph) {
        asm volatile("" : "+s"(kp));
#if defined(__HIP_DEVICE_COMPILE__)
        const Params P = *kp;
#else
        const Params P = Pkarg;
#endif
        unsigned char* ws = P.ws;
#ifdef PROBE_DUP
        const int kk_ = ph < 2 ? 100 + ph : (ph - 2) % 12;
        const int nrep_ = (kk_ == PROBE_DUP || kk_ == PROBE_DUP2) ? 2 : 1;
        for (int rep_ = 0; rep_ < nrep_; ++rep_) { if (rep_) cg::this_grid().sync();
#endif
        if (ph == 0) prologue_phase(P, L);
        else if (ph == 1) rowwise_phase(P, MALL, true, 0, 0, 0, 0.f, false, 0, 0, 0, 1);
        else {
            const int q = ph - 2, l = q / 12, k = q % 12;
            const int Mg = (l == 1 && k >= 6) ? MLAT : MALL;
            if (k == 0 || k == 9) {
                const int lf = l * 2 + (k == 9);
                pg8::Gemm g{(const pg8::bf16_t*)(ws + WS_H), (const pg8::bf16_t*)(ws + WS_W13) + (size_t)lf * NUP * DM, Mg, NUP, DM, DM};
                pg8::StaticOrder S; S.init(Mg, NUP, (int)gridDim.x, bid_());
                pg8::EpiSwiGLU E{(pg8::bf16_t*)(ws + WS_U), FF};
                pg8::gemm_phase<pg8::EpiSwiGLU, pg8::StaticOrder, true, true>((LAS unsigned char*)lds_raw, g, S, E);
            } else if (k == 1 || k == 10 || k == 3 || k == 7) {
                const pg8::bf16_t* A; const pg8::bf16_t* Bt; int N, K; float* O;
                if (k == 3) { A = (const pg8::bf16_t*)(ws + WS_H); Bt = (const pg8::bf16_t*)(ws + WS_WIN) + (size_t)l * NINP_W * DM; N = NINP_W; K = DM; O = (float*)(ws + WS_U); }
                else if (k == 7) { A = (const pg8::bf16_t*)(ws + WS_H); Bt = (const pg8::bf16_t*)(ws + WS_WOUT) + (size_t)l * DM * DM; N = DM; K = DM; O = (float*)(ws + WS_Y); }
                else { const int lf = l * 2 + (k == 10); A = (const pg8::bf16_t*)(ws + WS_U); Bt = (const pg8::bf16_t*)(ws + WS_W2) + (size_t)lf * DM * FF; N = DM; K = FF; O = (float*)(ws + WS_Y); }
                const bool splitk = (k != 3) && (Mg == MALL);
                const int M1 = splitk ? MLAT : Mg;
                { pg8::Gemm g{A, Bt, M1, N, K, K};
                  pg8::Order2 S; S.so.init(M1, N, (int)gridDim.x, bid_()); S.one = 0; S.valid = 1; S.u1.pm = 0; S.u1.pn = 0;
                  pg8::EpiF32 E{O, (k == 3) ? NUF : N, (k != 3) ? 1 : 0, (pg8::bf16_t*)(ws + WS_UG), NUG, (k == 3) ? NUF / 256 : 0};
                  pg8::gemm_phase<pg8::EpiF32, pg8::Order2, true, true>((LAS unsigned char*)lds_raw, g, S, E); }
                if (splitk) {
                    for (int c = bid_(); c < 256; c += (int)gridDim.x) {
                        const int u = c >> 3, ks = c & 7, nt2 = K >> 7;
                        const int kt0 = 2 * ((ks * nt2) >> 3), kt1 = 2 * (((ks + 1) * nt2) >> 3);
                        pg8::Gemm g{A + kt0 * 64, Bt + kt0 * 64, MALL, N, (kt1 - kt0) * 64, K};
                        pg8::Order2 S; S.so.init(MALL, N, 1, 0); S.one = 1; S.valid = 1; S.u1.pm = 32 + (u >> 3); S.u1.pn = u & 7;
                        pg8::EpiF32 E{(float*)((bf16*)(ws + WS_YD) + (size_t)ks * MCTX * DM - (size_t)MLAT * DM), N, 1, nullptr, 0, 0};
                        pg8::gemm_phase<pg8::EpiF32, pg8::Order2, true, true>((LAS unsigned char*)lds_raw, g, S, E);
                    }
                }
            } else if (k == 2) rowwise_phase(P, MALL, false, l, 0, 2, 0.5f, false, l, 1, 3, 4);
            else if (k == 8) rowwise_phase(P, Mg, false, l, 1, 5, 1.0f, false, l, 2, 6, 7);
            else if (k == 11) rowwise_phase(P, Mg, false, l, 2, 8, 0.5f, l == 1, l + 1, 0, 0, 1);
            else if (k == 4) prep_phase(P, L, l);
            else if (k == 5) scan_phase(P, L, l);
            else post_phase(P, l, Mg);
        }
#ifdef PROBE_DUP
        }
#endif
        if (ph + 1 < ph_hi) {
            if (ph == 0) cg::this_grid().sync();
            else { XcdBarrier xb; xb.bar = (unsigned*)ws; xb.x = xb_xcc_id(); xb.st = (volatile LAS unsigned*)((LAS unsigned char*)lds_raw + (LDS_BYTES - 128)); xcd_barrier(xb); }
        }
    }
}

extern "C" void kernel_launch(void* const* d_in, const int* in_sizes, int n_in, void* d_out, int out_size, void* d_ws, size_t ws_size, hipStream_t stream) {
    static int grid = 0;
    if (grid == 0) {
        if (n_in != 28 || out_size != MLAT * DM || ws_size < WS_END) { fprintf(stderr, "kernel_launch: unexpected shapes (n_in %d out %d ws %zu need %zu)\n", n_in, out_size, ws_size, (size_t)WS_END); grid = -1; return; }
        int dev = 0, cus = 0, per_cu = 0;
        (void)hipGetDevice(&dev); (void)hipDeviceGetAttribute(&cus, hipDeviceAttributeMultiprocessorCount, dev);
        if (hipFuncSetAttribute((const void*)mk_fwd, hipFuncAttributeMaxDynamicSharedMemorySize, LDS_BYTES) != hipSuccess) { fprintf(stderr, "kernel_launch: hipFuncSetAttribute failed\n"); grid = -1; return; }
        if (hipOccupancyMaxActiveBlocksPerMultiprocessor(&per_cu, (const void*)mk_fwd, 512, LDS_BYTES) != hipSuccess || per_cu < 1) { fprintf(stderr, "kernel_launch: occupancy query says %d\n", per_cu); per_cu = 1; }
        (void)hipGetLastError();
        grid = cus * per_cu;
    }
    if (grid < 0) return;
    (void)hipMemsetAsync(d_ws, 0, 16384, stream);
    Params p{};
    const float** pp = (const float**)&p;
    for (int i = 0; i < 28; ++i) pp[i] = (const float*)d_in[i];
    p.out = (float*)d_out; p.ws = (unsigned char*)d_ws;
#if MK_SINGLE
    p.ph_lo = 0; p.ph_hi = NPHASES;
    void* args[] = {&p};
    hipError_t e = hipLaunchCooperativeKernel((const void*)mk_fwd, dim3(grid), dim3(512), args, LDS_BYTES, stream);
    if (e != hipSuccess) fprintf(stderr, "cooperative launch failed: %s (grid %d)\n", hipGetErrorString(e), grid);
#else
    for (int ph = 0; ph < NPHASES; ++ph) { p.ph_lo = ph; p.ph_hi = ph + 1; hipLaunchKernelGGL(mk_fwd, dim3(grid), dim3(512), LDS_BYTES, stream, p); }
#endif
}
```
